# Optimizing an MI355X kernel written in HIP

```python
import math
import jax
import jax.numpy as jnp
from jax import lax
import numpy as np

D_MODEL = 1024
BATCH = 2
SEQ = 16384
DEPTH = 2

GRID_W = 64
CTX_LEN = 256
HEAD_DIM = 64
N_BRANCH = 4
BRANCH_W = D_MODEL // N_BRANCH
BLOCK = 128
WINDOW = 128
ROPE_THETA = 10000.0
EPS = 1e-6
D_FF = 2816
N_SUB = 3
POOL_WINDOWS = (2, 4, 8, 16)
POOL_GROUP = BRANCH_W // len(POOL_WINDOWS)
WIN_HEADS = BRANCH_W // HEAD_DIM
WIN_KV_HEADS = WIN_HEADS // 2
GLB_HEADS = BRANCH_W // HEAD_DIM
GLB_KV_HEADS = GLB_HEADS // 2
SSM_GROUP = 16
SSM_GROUPS = BRANCH_W // SSM_GROUP
SSM_STATE = 64

O_KB = 0
O_VB = O_KB + WIN_KV_HEADS * HEAD_DIM
O_UC = O_VB + WIN_KV_HEADS * HEAD_DIM
O_KD = O_UC + BRANCH_W
O_VD = O_KD + GLB_KV_HEADS * HEAD_DIM
CTX_COLS = O_VD + GLB_KV_HEADS * HEAD_DIM
O_QB = CTX_COLS
O_QD = O_QB + WIN_HEADS * HEAD_DIM
O_XA = O_QD + GLB_HEADS * HEAD_DIM
O_GATE = O_XA + BRANCH_W
IN_W = O_GATE + N_BRANCH * D_MODEL

kernel_name = 'hybrid_gated_pool_swa_s5_gqa_flow'


def rms_norm(x, g):
    x32 = x.astype(jnp.float32)
    y = x32 * lax.rsqrt(jnp.mean(x32 * x32, axis=-1, keepdims=True) + EPS)
    return (y * g.astype(jnp.float32)).astype(x.dtype)


def modulate(h, shift, scale):
    return h * (1.0 + scale) + shift


def swiglu(h, w_in, w_out):
    gate, up = jnp.split(h @ w_in, 2, axis=-1)
    return (jax.nn.silu(gate) * up) @ w_out


def split_heads(z, n_heads):
    return z.reshape(z.shape[:-1] + (n_heads, HEAD_DIM))


def rope_tables(rows):
    n_freq = HEAD_DIM // 4
    row = jnp.repeat(jnp.arange(rows), GRID_W)
    col = jnp.tile(jnp.arange(GRID_W), rows)
    inv = ROPE_THETA ** (-jnp.arange(n_freq, dtype=jnp.float32) / n_freq)
    ang = jnp.stack([row, col], axis=-1).astype(jnp.float32)[..., None] * inv
    return jnp.cos(ang), jnp.sin(ang)


def apply_rope(x, cos, sin):
    xs = x.astype(jnp.float32).reshape(x.shape[:-1] + (2, 2, HEAD_DIM // 4))
    x1, x2 = xs[..., 0, :], xs[..., 1, :]
    c = cos[None, :, None]
    s = sin[None, :, None]
    out = jnp.stack([x1 * c - x2 * s, x2 * c + x1 * s], axis=-2)
    return out.reshape(x.shape).astype(x.dtype)


def multi_scale_pool(xa, w_pool, pool_scale):
    b, n, _ = xa.shape
    xg = xa.astype(jnp.float32).reshape(b, n, len(POOL_WINDOWS), POOL_GROUP)
    csum = jnp.concatenate([jnp.zeros((b, 1, len(POOL_WINDOWS), POOL_GROUP), jnp.float32),
                            jnp.cumsum(xg, axis=1)], axis=1)
    t = jnp.arange(n)
    pooled = []
    for gi, w in enumerate(POOL_WINDOWS):
        lo = jnp.clip(t - w // 2, 0, n)
        hi = jnp.clip(t - w // 2 + w, 0, n)
        cg = csum[:, :, gi]
        pooled.append((cg[:, hi] - cg[:, lo]) / (hi - lo).astype(jnp.float32)[:, None])
    diff = jnp.stack(pooled, axis=2) - xg
    y = jnp.einsum('bngc,gcd->bngd', diff, w_pool.astype(jnp.float32))
    return (y.reshape(b, n, BRANCH_W) * pool_scale.astype(jnp.float32)).astype(xa.dtype)


def window_attention(q, k, v, kc, vc, sink):
    b, n, h, dh = q.shape
    kvh = k.shape[2]
    g = h // kvh
    nb = n // BLOCK
    n_ctx = kc.shape[1]
    qb = q.reshape(b, nb, BLOCK, kvh, g, dh)
    pad = ((0, 0), (BLOCK, BLOCK), (0, 0), (0, 0))

    def band(z):
        zp = jnp.pad(z, pad).reshape(b, nb + 2, BLOCK, kvh, dh)
        return jnp.concatenate([zp[:, :-2], zp[:, 1:-1], zp[:, 2:]], axis=2)

    kw, vw = band(k), band(v)
    scale = dh ** -0.5
    s_lat = jnp.einsum('bnqhgd,bnkhd->bnhgqk', qb, kw, preferred_element_type=jnp.float32) * scale
    rel = (jnp.arange(3 * BLOCK)[None, :] - BLOCK) - jnp.arange(BLOCK)[:, None]
    kpos = jnp.arange(nb)[:, None] * BLOCK - BLOCK + jnp.arange(3 * BLOCK)[None, :]
    mask = (jnp.abs(rel) <= WINDOW)[None] & ((kpos >= 0) & (kpos < n))[:, None, :]
    s_lat = jnp.where(mask[None, :, None, None], s_lat, -jnp.inf)
    s_ctx = jnp.einsum('bnqhgd,bchd->bnhgqc', qb, kc, preferred_element_type=jnp.float32) * scale
    sink_col = jnp.broadcast_to(sink.astype(jnp.float32).reshape(1, 1, kvh, g, 1, 1), s_lat.shape[:-1] + (1,))
    p = jax.nn.softmax(jnp.concatenate([s_lat, s_ctx, sink_col], axis=-1), axis=-1)
    p_lat = p[..., :3 * BLOCK].astype(v.dtype)
    p_ctx = p[..., 3 * BLOCK:3 * BLOCK + n_ctx].astype(v.dtype)
    o = (jnp.einsum('bnhgqk,bnkhd->bnqhgd', p_lat, vw)
         + jnp.einsum('bnhgqc,bchd->bnqhgd', p_ctx, vc))
    return o.reshape(b, n, h * dh)


def context_attention(q, k, v, sink):
    b, c, h, dh = q.shape
    kvh = k.shape[2]
    g = h // kvh
    s = jnp.einsum('bqhgd,bkhd->bhgqk', q.reshape(b, c, kvh, g, dh), k,
                   preferred_element_type=jnp.float32) * dh ** -0.5
    if sink is not None:
        sink_col = jnp.broadcast_to(sink.astype(jnp.float32).reshape(1, kvh, g, 1, 1), s.shape[:-1] + (1,))
        s = jnp.concatenate([s, sink_col], axis=-1)
    p = jax.nn.softmax(s, axis=-1)[..., :k.shape[1]]
    o = jnp.einsum('bhgqk,bkhd->bqhgd', p.astype(v.dtype), v)
    return o.reshape(b, c, h * dh)


def global_attention(q, k_all, v_all):
    b, n, h, dh = q.shape
    kvh = k_all.shape[2]
    g = h // kvh
    nb = n // BLOCK
    qb = jnp.moveaxis(q.reshape(b, nb, BLOCK, kvh, g, dh), 1, 0)
    scale = dh ** -0.5

    def one_block(qblk):
        s = jnp.einsum('bqhgd,bkhd->bhgqk', qblk, k_all, preferred_element_type=jnp.float32) * scale
        p = jax.nn.softmax(s, axis=-1)
        return jnp.einsum('bhgqk,bkhd->bqhgd', p.astype(v_all.dtype), v_all)

    o = lax.map(one_block, qb)
    return jnp.moveaxis(o, 0, 1).reshape(b, n, h * dh)


def s5_discretize(a_re, a_im, log_dt, b_re, b_im):
    lam = lax.complex(a_re.astype(jnp.float32), a_im.astype(jnp.float32))
    dt = jnp.exp(log_dt.astype(jnp.float32))[:, None]
    lam_bar = jnp.exp(lam * dt)
    b_mat = lax.complex(b_re.astype(jnp.float32), b_im.astype(jnp.float32))
    return lam_bar, ((lam_bar - 1.0) / lam)[..., None] * b_mat


def _ssm_combine(e_i, e_j):
    a_i, b_i = e_i
    a_j, b_j = e_j
    return a_j * a_i, a_j * b_i + b_j


def s5_scan(u, lam_bar, b_bar, h0):
    bu = jnp.einsum('btgh,gph->btgp', u.astype(jnp.complex64), b_bar)
    bu = bu.at[:, 0].add(lam_bar * h0)
    a = jnp.broadcast_to(lam_bar, bu.shape)
    _, states = lax.associative_scan(_ssm_combine, (a, bu), axis=1)
    return states


def s5_readout(states, c_re, c_im):
    return (jnp.einsum('btgp,ghp->btgh', states.real, c_re.astype(jnp.float32))
            - jnp.einsum('btgp,ghp->btgh', states.imag, c_im.astype(jnp.float32)))


def s5_output(y, u, d_skip, w_glu):
    b, n = y.shape[:2]
    y = (y + d_skip.astype(jnp.float32).reshape(SSM_GROUPS, SSM_GROUP) * u).reshape(b, n, BRANCH_W)
    z = jax.nn.gelu(y) @ w_glu.astype(jnp.float32)
    return z[..., :BRANCH_W] * jax.nn.sigmoid(z[..., BRANCH_W:])


def maybe_flip(z, rev):
    return jnp.flip(z, axis=1) if rev else z


def s5_branch(u_lat, u_ctx, a_re, a_im, log_dt, b_re, b_im, c_re, c_im, d_skip, w_glu, with_ctx_out):
    b, n, _ = u_lat.shape
    ul = u_lat.astype(jnp.float32).reshape(b, n, SSM_GROUPS, SSM_GROUP)
    uc = u_ctx.astype(jnp.float32).reshape(b, u_ctx.shape[1], SSM_GROUPS, SSM_GROUP)
    h_zero = jnp.zeros((b, SSM_GROUPS, SSM_STATE), jnp.complex64)
    ys_lat, ys_ctx = [], []
    for d in range(2):
        rev = d == 1
        lam_bar, b_bar = s5_discretize(a_re[d], a_im[d], log_dt[d], b_re[d], b_im[d])
        st_ctx = s5_scan(maybe_flip(uc, rev), lam_bar, b_bar, h_zero)
        st_lat = s5_scan(maybe_flip(ul, rev), lam_bar, b_bar, st_ctx[:, -1])
        ys_lat.append(maybe_flip(s5_readout(st_lat, c_re[d], c_im[d]), rev))
        if with_ctx_out:
            ys_ctx.append(maybe_flip(s5_readout(st_ctx, c_re[d], c_im[d]), rev))
    y_lat = s5_output(ys_lat[0] + ys_lat[1], ul, d_skip, w_glu).astype(u_lat.dtype)
    if not with_ctx_out:
        return y_lat, None
    y_ctx = s5_output(ys_ctx[0] + ys_ctx[1], uc, d_skip, w_glu).astype(u_ctx.dtype)
    return y_lat, y_ctx


def merge_branches(branches, gate_logits, w_branch, w_out):
    g = jax.nn.sigmoid(gate_logits.reshape(gate_logits.shape[:-1] + (N_BRANCH, D_MODEL)))
    terms = [g[..., k, :] * (y_k @ w_branch[k]) for k, y_k in enumerate(branches)]
    return sum(terms[1:], terms[0]) @ w_out


def token_mixer(h, hc, cos, sin, w_in, sink, qk_g, pool_w, pool_scale, a_re, a_im, log_dt,
                b_re, b_im, c_re, c_im, d_skip, w_glu, w_branch, w_out, with_ctx_out):
    p = h @ w_in
    pc = hc @ (w_in if with_ctx_out else w_in[:, :CTX_COLS])
    q_g, k_g = qk_g[0], qk_g[1]
    k_win_c = split_heads(pc[..., O_KB:O_VB], WIN_KV_HEADS)
    v_win_c = split_heads(pc[..., O_VB:O_UC], WIN_KV_HEADS)
    k_glb_c = rms_norm(split_heads(pc[..., O_KD:O_VD], GLB_KV_HEADS), k_g)
    v_glb_c = split_heads(pc[..., O_VD:CTX_COLS], GLB_KV_HEADS)
    y_a = multi_scale_pool(p[..., O_XA:O_GATE], pool_w, pool_scale)
    q_win = apply_rope(split_heads(p[..., O_QB:O_QD], WIN_HEADS), cos, sin)
    k_win = apply_rope(split_heads(p[..., O_KB:O_VB], WIN_KV_HEADS), cos, sin)
    v_win = split_heads(p[..., O_VB:O_UC], WIN_KV_HEADS)
    y_b = window_attention(q_win, k_win, v_win, k_win_c, v_win_c, sink)
    y_c, y_c_ctx = s5_branch(p[..., O_UC:O_KD], pc[..., O_UC:O_KD], a_re, a_im, log_dt,
                             b_re, b_im, c_re, c_im, d_skip, w_glu, with_ctx_out)
    q_glb = apply_rope(rms_norm(split_heads(p[..., O_QD:O_XA], GLB_HEADS), q_g), cos, sin)
    k_glb = apply_rope(rms_norm(split_heads(p[..., O_KD:O_VD], GLB_KV_HEADS), k_g), cos, sin)
    v_glb = split_heads(p[..., O_VD:CTX_COLS], GLB_KV_HEADS)
    y_d = global_attention(q_glb, jnp.concatenate([k_glb_c, k_glb], axis=1),
                           jnp.concatenate([v_glb_c, v_glb], axis=1))
    y = merge_branches((y_a, y_b, y_c, y_d), p[..., O_GATE:], w_branch, w_out)
    if not with_ctx_out:
        return y, None
    y_a_c = multi_scale_pool(pc[..., O_XA:O_GATE], pool_w, pool_scale)
    y_b_c = context_attention(split_heads(pc[..., O_QB:O_QD], WIN_HEADS), k_win_c, v_win_c, sink)
    q_glb_c = rms_norm(split_heads(pc[..., O_QD:O_XA], GLB_HEADS), q_g)
    y_d_c = context_attention(q_glb_c, k_glb_c, v_glb_c, None)
    y_ctx = merge_branches((y_a_c, y_b_c, y_c_ctx, y_d_c), pc[..., O_GATE:], w_branch, w_out)
    return y, y_ctx


def setup_inputs(seed: int = 0) -> dict:
    key = jax.random.key(seed)
    ks = jax.random.split(key, 26)
    L = DEPTH
    G, P, H = SSM_GROUPS, SSM_STATE, SSM_GROUP

    def nrm(k, shape, s):
        return jax.random.normal(k, shape, jnp.float32) * s

    return {
        'x': nrm(ks[0], (BATCH, SEQ, D_MODEL), 1.0),
        'c': nrm(ks[1], (BATCH, D_MODEL), 1.0),
        'ctx': nrm(ks[2], (BATCH, CTX_LEN, D_MODEL), 1.0),
        'c_ctx': nrm(ks[3], (D_MODEL,), 1.0),
        'w_mod': nrm(ks[4], (L, D_MODEL, N_SUB * 3 * D_MODEL), 0.5 * D_MODEL ** -0.5),
        'b_mod': nrm(ks[5], (L, N_SUB * 3 * D_MODEL), 0.02),
        'norm_g': 1.0 + nrm(ks[6], (L, N_SUB, D_MODEL), 0.02),
        'ffn_in': nrm(ks[7], (L, 2, D_MODEL, 2 * D_FF), D_MODEL ** -0.5),
        'ffn_out': nrm(ks[8], (L, 2, D_FF, D_MODEL), D_FF ** -0.5),
        'w_in': nrm(ks[9], (L, D_MODEL, IN_W), D_MODEL ** -0.5),
        'win_sink': nrm(ks[10], (L, WIN_HEADS), 0.5),
        'qk_norm': 1.0 + nrm(ks[11], (L, 2, HEAD_DIM), 0.02),
        'pool_w': nrm(ks[12], (L, len(POOL_WINDOWS), POOL_GROUP, POOL_GROUP), POOL_GROUP ** -0.5),
        'pool_scale': 1.0 + nrm(ks[13], (L, BRANCH_W), 0.1),
        'ssm_a_re': -0.5 + nrm(ks[14], (L, 2, G, P), 0.01),
        'ssm_a_im': math.pi * jnp.arange(P, dtype=jnp.float32) + nrm(ks[15], (L, 2, G, P), 0.01),
        'ssm_log_dt': jax.random.uniform(ks[16], (L, 2, G), jnp.float32, math.log(1e-3), math.log(1e-1)),
        'ssm_b_re': nrm(ks[17], (L, 2, G, P, H), (2 * H) ** -0.5),
        'ssm_b_im': nrm(ks[18], (L, 2, G, P, H), (2 * H) ** -0.5),
        'ssm_c_re': nrm(ks[19], (L, 2, G, H, P), P ** -0.5),
        'ssm_c_im': nrm(ks[20], (L, 2, G, H, P), P ** -0.5),
        'ssm_d': nrm(ks[21], (L, BRANCH_W), 1.0),
        'glu_w': nrm(ks[22], (L, BRANCH_W, 2 * BRANCH_W), BRANCH_W ** -0.5),
        'branch_w': nrm(ks[23], (L, N_BRANCH, BRANCH_W, D_MODEL), BRANCH_W ** -0.5),
        'out_w': nrm(ks[24], (L, D_MODEL, D_MODEL), D_MODEL ** -0.5),
        'final_g': 1.0 + nrm(ks[25], (D_MODEL,), 0.02),
    }


def reference(x, c, ctx, c_ctx, w_mod, b_mod, norm_g, ffn_in, ffn_out, w_in, win_sink, qk_norm,
              pool_w, pool_scale, ssm_a_re, ssm_a_im, ssm_log_dt, ssm_b_re, ssm_b_im, ssm_c_re,
              ssm_c_im, ssm_d, glu_w, branch_w, out_w, final_g):
    b = x.shape[0]
    rows = x.shape[1] // GRID_W
    cos, sin = rope_tables(rows)
    s_lat = jax.nn.silu(c)
    s_ctx = jax.nn.silu(c_ctx)
    for l in range(DEPTH):
        last = l == DEPTH - 1
        m = (s_lat @ w_mod[l] + b_mod[l]).reshape(b, N_SUB, 3, D_MODEL)[:, :, :, None, :]
        mc = (s_ctx @ w_mod[l] + b_mod[l]).reshape(N_SUB, 3, D_MODEL)
        h = modulate(rms_norm(x, norm_g[l, 0]), m[:, 0, 0], m[:, 0, 1])
        x = x + 0.5 * m[:, 0, 2] * swiglu(h, ffn_in[l, 0], ffn_out[l, 0])
        hc = modulate(rms_norm(ctx, norm_g[l, 0]), mc[0, 0], mc[0, 1])
        ctx = ctx + 0.5 * mc[0, 2] * swiglu(hc, ffn_in[l, 0], ffn_out[l, 0])
        h = modulate(rms_norm(x, norm_g[l, 1]), m[:, 1, 0], m[:, 1, 1])
        hc = modulate(rms_norm(ctx, norm_g[l, 1]), mc[1, 0], mc[1, 1])
        y, y_ctx = token_mixer(h, hc, cos, sin, w_in[l], win_sink[l], qk_norm[l], pool_w[l],
                               pool_scale[l], ssm_a_re[l], ssm_a_im[l], ssm_log_dt[l], ssm_b_re[l],
                               ssm_b_im[l], ssm_c_re[l], ssm_c_im[l], ssm_d[l], glu_w[l],
                               branch_w[l], out_w[l], not last)
        x = x + m[:, 1, 2] * y
        if not last:
            ctx = ctx + mc[1, 2] * y_ctx
        h = modulate(rms_norm(x, norm_g[l, 2]), m[:, 2, 0], m[:, 2, 1])
        x = x + 0.5 * m[:, 2, 2] * swiglu(h, ffn_in[l, 1], ffn_out[l, 1])
        if not last:
            hc = modulate(rms_norm(ctx, norm_g[l, 2]), mc[2, 0], mc[2, 1])
            ctx = ctx + 0.5 * mc[2, 2] * swiglu(hc, ffn_in[l, 1], ffn_out[l, 1])
    return rms_norm(x, final_g)
```

```cpp
#include <hip/hip_cooperative_groups.h>
#include <hip/hip_runtime.h>
#include <cstdio>
#include <cstdint>
namespace pg8 {
#define PG8_LAS __attribute__((address_space(3)))
typedef unsigned short bf16_t;
typedef short bf16x8 __attribute__((ext_vector_type(8)));
typedef float f32x4 __attribute__((ext_vector_type(4)));
typedef unsigned u32x4 __attribute__((ext_vector_type(4)));
constexpr int BM = 256, BK = 64, HALF = 128, HTB = HALF * BK * 2  , STAGE_BYTES = 8 * HTB, NXCD = 8, WGM = 8;

__host__ __device__ __forceinline__ int lds_byte(int r, int c) { const int st = (r >> 4) * 2 + (c >> 5), rr = r & 15, cc = c & 31, ob = rr * 64 + cc * 2; return st * 1024 + (ob ^ (((ob >> 9) & 1) << 5)); }
__host__ __device__ __forceinline__ void stage_rc(int b, int& R, int& C) { const int st = b / 1024, sb = b % 1024, swz = sb ^ (((sb >> 9) & 1) << 5); R = (st >> 1) * 16 + swz / 64; C = (st & 1) * 32 + (swz % 64) / 2; }
__host__ __device__ __forceinline__ int perm32(int rho) { const int n = rho >> 4, i = rho & 15; return 8 * (i >> 2) + 4 * n + (i & 3); }

struct Unit { int pm, pn; };
struct Gemm { const bf16_t* A; const bf16_t* Bt; int M, N, K; };

struct StaticOrder {
    int nM, nN, nwg, G, c;
    __host__ __device__ void init(int M, int N, int G_, int c_) { nM = M / BM; nN = N / BM; nwg = nM * nN; G = G_; c = c_; }
    __host__ __device__ bool next(int i, Unit& u) const {
        const long L = (long)i * G + c; if (L >= nwg) return false;
        int wgid = (int)L; { const int q = nwg / NXCD, r = nwg % NXCD, xcd = wgid % NXCD, off = wgid / NXCD; wgid = (xcd < r ? xcd * (q + 1) : r * (q + 1) + (xcd - r) * q) + off; }
        const int nig = WGM * nN, gid = wgid / nig, fm = gid * WGM, gsz = (nM - fm) < WGM ? (nM - fm) : WGM;
        u.pm = fm + ((wgid % nig) % gsz); u.pn = (wgid % nig) / gsz; return true;
    }
    __device__ __forceinline__ void a_ready(const Unit&) const {}
    __device__ __forceinline__ void done(const Unit&) const {}
};

typedef float f32x2cv __attribute__((ext_vector_type(2))); typedef __bf16 bf16x2cv __attribute__((ext_vector_type(2)));
__device__ __forceinline__ unsigned cvt_pk_bf16(float lo, float hi) { f32x2cv v = {lo, hi}; bf16x2cv b = __builtin_convertvector(v, bf16x2cv); return __builtin_bit_cast(unsigned, b); }
typedef float f32x2 __attribute__((ext_vector_type(2)));
template <class Epi, class Sched, bool ALIGN_EPI = false, bool SP2 = false>
__device__ __forceinline__ void gemm_phase(PG8_LAS unsigned char* lds, const Gemm g, const Sched& S, const Epi& E, int tid) {
    float zf = 0.f; asm volatile("" : "+v"(zf));
    const int wid = __builtin_amdgcn_readfirstlane(tid >> 6), lane = tid & 63, wr = wid >> 2, wc = wid & 3, fr = lane & 15, fq = lane >> 4;
    const int K = g.K, nt = K / BK;
    unsigned voffA[2], voffB[2];
#pragma unroll
    for (int i = 0; i < 2; ++i) { int R, C; stage_rc(tid * 16 + i * 8192, R, C); const int Rb = Epi::PERM ? ((R & ~31) + perm32(R & 31)) : R;
        voffA[i] = (unsigned)(R * K + C) * 2u; voffB[i] = (unsigned)(Rb * K + C) * 2u; }
    const size_t kstep = (size_t)(BK * 2);
    const size_t hstep = (size_t)HALF * K * 2;
    const size_t tstep = 2 * hstep;
    const unsigned ldsw = (unsigned)wid * 1024u;
    const int aoff = lds_byte(wr * 64 + fr, fq * 8), boff = lds_byte(wc * 32 + fr, fq * 8);
#define PG8_SA(b, h) (((b) * 2 + (h)) * HTB)
#define PG8_SB(b, h) ((4 + (b) * 2 + (h)) * HTB)
#define PG8_STAGE(bufoff, gbase, voff) do { _Pragma("unroll") for (int _i = 0; _i < 2; ++_i) \
        __builtin_amdgcn_global_load_lds((const unsigned*)((const char*)(gbase) + (voff)[_i]), (PG8_LAS unsigned*)(lds + (bufoff) + ldsw + _i * 8192), 16, 0, 0); } while (0)
#define PG8_LDA(dst, b, h) do { _Pragma("unroll") for (int m = 0; m < 4; ++m) _Pragma("unroll") for (int k = 0; k < 2; ++k) dst[m][k] = *(const PG8_LAS bf16x8*)(lds + PG8_SA(b, h) + aoff + m * 2048 + k * 1024); } while (0)
#define PG8_LDB(dst, b, h) do { _Pragma("unroll") for (int n = 0; n < 2; ++n) _Pragma("unroll") for (int k = 0; k < 2; ++k) dst[n][k] = *(const PG8_LAS bf16x8*)(lds + PG8_SB(b, h) + boff + n * 2048 + k * 1024); } while (0)
#define PG8_MMA(ai, bj, At, Bt) do { __builtin_amdgcn_s_setprio(1); _Pragma("unroll") for (int m = 0; m < 4; ++m) _Pragma("unroll") for (int n = 0; n < 2; ++n) _Pragma("unroll") for (int k = 0; k < 2; ++k) \
        acc[ai][bj][m][n] = __builtin_amdgcn_mfma_f32_16x16x32_bf16(Bt[n][k], At[m][k], acc[ai][bj][m][n], 0, 0, 0); __builtin_amdgcn_s_setprio(0); } while (0)
#define PG8_WAIT_V(n) asm volatile("s_waitcnt vmcnt(" #n ")" ::: "memory")
#define PG8_WAIT_L(n) asm volatile("s_waitcnt lgkmcnt(" #n ")" ::: "memory")
#define PG8_BAR __builtin_amdgcn_s_barrier()
#define PG8_SCHED __builtin_amdgcn_sched_barrier(0)
    Unit cur, nxt; int ui = 0;
    if (!S.next(0, cur)) return;
    f32x4 acc[2][2][4][2];
#pragma unroll
    for (int a = 0; a < 2; ++a)
#pragma unroll
        for (int b = 0; b < 2; ++b)
#pragma unroll
            for (int m = 0; m < 4; ++m)
#pragma unroll
                for (int n = 0; n < 2; ++n) acc[a][b][m][n] = (f32x4){zf, zf, zf, zf};
    bf16x8 At[4][2], B0[2][2], B1[2][2];
    const char* cA = (const char*)g.A + (size_t)cur.pm * tstep; const char* cB = (const char*)g.Bt + (size_t)cur.pn * tstep;
    S.a_ready(cur);
    if constexpr (SP2) {
        PG8_STAGE(PG8_SB(0, 0), cB, voffB); PG8_STAGE(PG8_SB(0, 1), cB + hstep, voffB); PG8_STAGE(PG8_SA(0, 0), cA, voffA); PG8_STAGE(PG8_SA(0, 1), cA + hstep, voffA);
        if (wr == 1) PG8_BAR;
        PG8_WAIT_V(2); PG8_BAR;
        PG8_STAGE(PG8_SB(1, 0), cB + kstep, voffB); PG8_STAGE(PG8_SA(1, 0), cA + kstep, voffA); PG8_STAGE(PG8_SB(1, 1), cB + hstep + kstep, voffB);
        PG8_WAIT_V(6); PG8_BAR;
    } else {
        PG8_STAGE(PG8_SB(0, 0), cB, voffB); PG8_STAGE(PG8_SA(0, 0), cA, voffA); PG8_STAGE(PG8_SB(0, 1), cB + hstep, voffB); PG8_STAGE(PG8_SA(0, 1), cA + hstep, voffA);
        if (wr == 1) PG8_BAR;
        PG8_WAIT_V(4); PG8_BAR;
        PG8_STAGE(PG8_SB(1, 0), cB + kstep, voffB); PG8_STAGE(PG8_SA(1, 0), cA + kstep, voffA); PG8_STAGE(PG8_SB(1, 1), cB + hstep + kstep, voffB);
        PG8_WAIT_V(6); PG8_BAR;
    }
    for (;;) {
        const bool has_next = S.next(ui + 1, nxt);
        const char* nA = has_next ? (const char*)g.A + (size_t)nxt.pm * tstep : cA; const char* nB = has_next ? (const char*)g.Bt + (size_t)nxt.pn * tstep : cB;
#pragma nounroll
        for (int t = 0; t < nt; t += 2) {
            const bool last = (t == nt - 2);
            const char* a1 = cA + (size_t)(t + 1) * kstep;
            const char* a2 = last ? nA : cA + (size_t)(t + 2) * kstep; const char* b2 = last ? nB : cB + (size_t)(t + 2) * kstep;
            const char* a3 = a2 + kstep; const char* b3 = b2 + kstep;
            if (last && has_next) S.a_ready(nxt);
            if constexpr (SP2) {
            PG8_LDB(B0, 0, 0); PG8_LDB(B1, 0, 1); PG8_SCHED; PG8_LDA(At, 0, 0); PG8_STAGE(PG8_SA(1, 1), a1 + hstep, voffA);
            PG8_WAIT_V(8); PG8_WAIT_L(0); PG8_BAR; PG8_MMA(0, 0, At, B0); PG8_MMA(0, 1, At, B1); PG8_BAR; PG8_SCHED;
            PG8_LDA(At, 0, 1); PG8_STAGE(PG8_SB(0, 0), b2, voffB); PG8_STAGE(PG8_SB(0, 1), b2 + hstep, voffB); PG8_STAGE(PG8_SA(0, 0), a2, voffA);
            PG8_WAIT_V(8); PG8_WAIT_L(0); PG8_BAR; PG8_MMA(1, 0, At, B0); PG8_MMA(1, 1, At, B1); PG8_BAR; PG8_SCHED;
            PG8_LDB(B0, 1, 0); PG8_LDB(B1, 1, 1); PG8_SCHED; PG8_LDA(At, 1, 0); PG8_STAGE(PG8_SA(0, 1), a2 + hstep, voffA);
            PG8_WAIT_V(8); PG8_WAIT_L(0); PG8_BAR; PG8_MMA(0, 0, At, B0); PG8_MMA(0, 1, At, B1); PG8_BAR; PG8_SCHED;
            PG8_LDA(At, 1, 1); PG8_STAGE(PG8_SB(1, 0), b3, voffB); PG8_STAGE(PG8_SB(1, 1), b3 + hstep, voffB); PG8_STAGE(PG8_SA(1, 0), a3, voffA);
            PG8_WAIT_V(8); PG8_WAIT_L(0); PG8_BAR; PG8_MMA(1, 0, At, B0); PG8_MMA(1, 1, At, B1); PG8_BAR; PG8_SCHED;
            } else {
            PG8_LDB(B0, 0, 0); PG8_SCHED; PG8_LDA(At, 0, 0); PG8_STAGE(PG8_SA(1, 1), a1 + hstep, voffA);
            PG8_WAIT_L(8); PG8_BAR; PG8_WAIT_L(0); PG8_MMA(0, 0, At, B0); PG8_BAR; PG8_SCHED;
            PG8_LDB(B1, 0, 1); PG8_STAGE(PG8_SB(0, 0), b2, voffB);
            PG8_BAR; PG8_WAIT_L(0); PG8_MMA(0, 1, At, B1); PG8_BAR;
            PG8_LDA(At, 0, 1); PG8_STAGE(PG8_SA(0, 0), a2, voffA);
            PG8_BAR; PG8_WAIT_L(0); PG8_MMA(1, 0, At, B0); PG8_BAR; PG8_SCHED;
            PG8_STAGE(PG8_SB(0, 1), b2 + hstep, voffB);
            PG8_WAIT_V(6); PG8_BAR; PG8_MMA(1, 1, At, B1); PG8_BAR;
            PG8_LDB(B0, 1, 0); PG8_SCHED; PG8_LDA(At, 1, 0); PG8_STAGE(PG8_SA(0, 1), a2 + hstep, voffA);
            PG8_WAIT_L(8); PG8_BAR; PG8_WAIT_L(0); PG8_MMA(0, 0, At, B0); PG8_BAR; PG8_SCHED;
            PG8_LDB(B1, 1, 1); PG8_STAGE(PG8_SB(1, 0), b3, voffB);
            PG8_BAR; PG8_WAIT_L(0); PG8_MMA(0, 1, At, B1); PG8_BAR;
            PG8_LDA(At, 1, 1); PG8_STAGE(PG8_SA(1, 0), a3, voffA);
            PG8_BAR; PG8_WAIT_L(0); PG8_MMA(1, 0, At, B0); PG8_BAR; PG8_SCHED;
            PG8_STAGE(PG8_SB(1, 1), b3 + hstep, voffB);
            PG8_WAIT_V(6); PG8_BAR; PG8_MMA(1, 1, At, B1); PG8_BAR;
            }
        }
        if constexpr (ALIGN_EPI) { if (wr == 0) PG8_BAR; }
        if constexpr (!Epi::AFTER_DRAIN) { E(acc, cur, wr, wc, fr, fq); S.done(cur); }
        if (!has_next) break;
#pragma unroll
        for (int a = 0; a < 2; ++a)
#pragma unroll
            for (int b = 0; b < 2; ++b)
#pragma unroll
                for (int m = 0; m < 4; ++m)
#pragma unroll
                    for (int n = 0; n < 2; ++n) acc[a][b][m][n] = (f32x4){zf, zf, zf, zf};
        cur = nxt; cA = nA; cB = nB; ++ui;
        if constexpr (ALIGN_EPI) { if (wr == 1) PG8_BAR; }
    }
    PG8_WAIT_V(0);
    if constexpr (!ALIGN_EPI) { if (wr == 0) PG8_BAR; }
    PG8_BAR;
    if constexpr (Epi::AFTER_DRAIN) { E.fused(acc, cur, wr, wc, fr, fq, lds, wid, lane); S.done(cur); }
#undef PG8_SA
#undef PG8_SB
#undef PG8_STAGE
#undef PG8_LDA
#undef PG8_LDB
#undef PG8_MMA
#undef PG8_WAIT_V
#undef PG8_WAIT_L
#undef PG8_BAR
#undef PG8_SCHED
}
}
namespace cg = cooperative_groups;
#include <hip/hip_bf16.h>
#include <cmath>
namespace attn_body {
using bf16=__hip_bfloat16;
using bf16x8=__attribute__((ext_vector_type(8)))short;
using s16x4=__attribute__((ext_vector_type(4)))short;
using f32x16=__attribute__((ext_vector_type(16)))float;
using u32x4=__attribute__((ext_vector_type(4)))unsigned;
constexpr int D=64,QP=512,KP=256,OP=256;
constexpr int NW=8,QBLK=32,QB=QBLK*NW,KVBLK=64;
__device__ __forceinline__ int crow(int r,int hi){return (r&3)+8*(r>>2)+4*hi;}
#define SBAR() __builtin_amdgcn_sched_barrier(0)
__device__ __forceinline__ void wmask(f32x16&p0,f32x16&p1,int dbase){
  const float NEG=-INFINITY;
  #pragma unroll
  for(int r=0;r<16;++r){int d=dbase+(r&3)+8*(r>>2); if((unsigned)(d+128)>256u)p0[r]=NEG; if((unsigned)(d+160)>256u)p1[r]=NEG;}
}

constexpr int NSLOT=3, SLOTB=8192;
constexpr int LDS_K=0, LDS_V=NSLOT*SLOTB, LDS_WS=2*NSLOT*SLOTB, LDS_OST=LDS_WS+NW*64*4, LDS_BYTES=LDS_OST+NW*4096;
constexpr float C2=0.125f*1.4426950408889634f;
__device__ __forceinline__ void glds16(const void*gsrc,unsigned lds_dst){unsigned keep;
  asm volatile("s_mov_b32 %0, m0\n\ts_mov_b32 m0, %2\n\ts_nop 0\n\tglobal_load_lds_dwordx4 %1, off\n\ts_mov_b32 m0, %0":"=&s"(keep):"v"(gsrc),"s"(lds_dst):"memory");}
__device__ __forceinline__ float max3f(float a,float b,float c){float r;asm("v_max3_f32 %0, %1, %2, %3":"=v"(r):"v"(a),"v"(b),"v"(c));return r;}
__device__ __forceinline__ float max2f(float a,float b){float r;asm("v_max_f32_e32 %0, %1, %2":"=v"(r):"v"(a),"v"(b));return r;}
__device__ __forceinline__ float fadd_s(float a,float b){float r;asm("v_add_f32_e32 %0, %1, %2":"=v"(r):"v"(a),"v"(b));return r;}
__device__ __forceinline__ float fsub_s(float a,float b){float r;asm("v_sub_f32_e32 %0, %1, %2":"=v"(r):"v"(a),"v"(b));return r;}
typedef float f32x2_t __attribute__((ext_vector_type(2))); typedef __bf16 bf16x2_t __attribute__((ext_vector_type(2)));
__device__ __forceinline__ unsigned cvtpk_s(float lo,float hi){f32x2_t v={lo,hi};bf16x2_t b=__builtin_convertvector(v,bf16x2_t);return __builtin_bit_cast(unsigned,b);}
#define WAIT_BAR(N) asm volatile("s_waitcnt vmcnt(" #N ") lgkmcnt(0)\n\ts_barrier":::"memory")

__device__ __forceinline__ void qkt(f32x16&p0,f32x16&p1,const char*Kslot,const bf16x8*qr,const f32x16&negm,int r32,int hi){
  const char*kb=Kslot+hi*1024+r32*16;
  #pragma unroll
  for(int d0=0;d0<4;++d0){
    const bf16x8 b0=*reinterpret_cast<const bf16x8*>(kb+d0*2048);
    const bf16x8 b1=*reinterpret_cast<const bf16x8*>(kb+d0*2048+512);
    if(d0==0){p0=__builtin_amdgcn_mfma_f32_32x32x16_bf16(b0,qr[0],negm,0,0,0);p1=__builtin_amdgcn_mfma_f32_32x32x16_bf16(b1,qr[0],negm,0,0,0);}
    else{p0=__builtin_amdgcn_mfma_f32_32x32x16_bf16(b0,qr[d0],p0,0,0,0);p1=__builtin_amdgcn_mfma_f32_32x32x16_bf16(b1,qr[d0],p1,0,0,0);}}
}
typedef __attribute__((address_space(3))) const char* lds_cptr;
typedef short v4i16_t __attribute__((ext_vector_type(4)));
__device__ __forceinline__ void kload8(bf16x8*kf,lds_cptr kp){
  kf[0]=*(const __attribute__((address_space(3))) bf16x8*)(kp);      kf[1]=*(const __attribute__((address_space(3))) bf16x8*)(kp+512);
  kf[2]=*(const __attribute__((address_space(3))) bf16x8*)(kp+2048); kf[3]=*(const __attribute__((address_space(3))) bf16x8*)(kp+2560);
  kf[4]=*(const __attribute__((address_space(3))) bf16x8*)(kp+4096); kf[5]=*(const __attribute__((address_space(3))) bf16x8*)(kp+4608);
  kf[6]=*(const __attribute__((address_space(3))) bf16x8*)(kp+6144); kf[7]=*(const __attribute__((address_space(3))) bf16x8*)(kp+6656);
}
__device__ __forceinline__ void kload2(bf16x8*kf,lds_cptr kp,int j){ kf[2*j]=*(const __attribute__((address_space(3))) bf16x8*)(kp+j*2048); kf[2*j+1]=*(const __attribute__((address_space(3))) bf16x8*)(kp+j*2048+512); }
__device__ __forceinline__ s16x4 vtr(lds_cptr p){ return __builtin_bit_cast(s16x4,__builtin_amdgcn_ds_read_tr16_b64_v4i16((__attribute__((address_space(3))) v4i16_t*)p)); }
__device__ __forceinline__ float rowmax(const f32x16&p0,const f32x16&p1){
  float a=max3f(p0[0],p0[1],p1[0]),b=max3f(p0[2],p0[3],p1[1]);a=max3f(a,p1[2],p1[3]);
  #pragma unroll
  for(int r=4;r<16;r+=4){a=max3f(a,p0[r],p0[r+1]);b=max3f(b,p0[r+2],p0[r+3]);a=max3f(a,p1[r],p1[r+1]);b=max3f(b,p1[r+2],p1[r+3]);}
  const float m=max2f(a,b);
  auto rr=__builtin_amdgcn_permlane32_swap(__float_as_uint(m),__float_as_uint(m),false,false);
  return max2f(__uint_as_float(rr[0]),__uint_as_float(rr[1]));
}
__device__ __forceinline__ void pv(f32x16*o,int vb,bf16x8 pa0,bf16x8 pa1,bf16x8 pa2,bf16x8 pa3){
  #pragma unroll
  for(int d0=0;d0<2;++d0){s16x4 lo[4],hi[4];
    #pragma unroll
    for(int ks=0;ks<4;++ks){
      asm volatile("ds_read_b64_tr_b16 %0,%1 offset:%c2":"=&v"(lo[ks]):"v"(vb),"i"(d0*4096+ks*1024):"memory");
      asm volatile("ds_read_b64_tr_b16 %0,%1 offset:%c2":"=&v"(hi[ks]):"v"(vb),"i"(d0*4096+ks*1024+512):"memory");}
    asm volatile("s_waitcnt lgkmcnt(0)":::"memory");SBAR();
    #define PK(k) (bf16x8){lo[k][0],lo[k][1],lo[k][2],lo[k][3],hi[k][0],hi[k][1],hi[k][2],hi[k][3]}
    o[d0]=__builtin_amdgcn_mfma_f32_32x32x16_bf16(pa0,PK(0),o[d0],0,0,0);
    o[d0]=__builtin_amdgcn_mfma_f32_32x32x16_bf16(pa1,PK(1),o[d0],0,0,0);
    o[d0]=__builtin_amdgcn_mfma_f32_32x32x16_bf16(pa2,PK(2),o[d0],0,0,0);
    o[d0]=__builtin_amdgcn_mfma_f32_32x32x16_bf16(pa3,PK(3),o[d0],0,0,0);
    #undef PK
  }
}

#ifndef ATTN_STORE16
#define ATTN_STORE16(p,v) (*(u32x4*)(p)=(v))
#endif
template<int THRL,bool WIN> __device__ __forceinline__ void attn_unit(const bf16*Qu,const bf16*__restrict__ Kh,const bf16*__restrict__ Vh,bf16*Ou,int NT,int shift,int qpos0,float sinkl2,char*shm,int tid){
  const int lane=tid&63,r32=lane&31,hi=lane>>5; const int wid=__builtin_amdgcn_readfirstlane(tid>>6);
  const bf16*Qw=Qu+(long)(wid*QBLK)*QP;
  const unsigned lds0=(unsigned)(uintptr_t)shm;
  float*wsf=(float*)(shm+LDS_WS)+wid*64;
  const bf16*ksrc=Kh+(long)lane*KP+wid*8;
  const bf16*vsrc=Vh+(long)(16*(wid&3)+(lane>>2))*KP+(wid>>2)*32+(lane&3)*8;
  const unsigned kdst=lds0+LDS_K+wid*1024, vdst=lds0+LDS_V+wid*1024;
  #define KROW(t) ((long)(((t)<4)?(t):((t)+shift))*(KVBLK*KP))
  #define DMA_K(t,slot) glds16(ksrc+KROW(t),(unsigned)__builtin_amdgcn_readfirstlane(kdst+(slot)))
  #define DMA_V(t,slot) glds16(vsrc+KROW(t),(unsigned)__builtin_amdgcn_readfirstlane(vdst+(slot)))
  const int vb0=(int)(lds0+LDS_V)+((lane>>4)&1)*32+(lane&3)*8+(4*hi+((lane&15)>>2))*64;
  const char*Kbase=shm+LDS_K; bf16x8 kf[8];
  const lds_cptr shm3=(lds_cptr)shm; const lds_cptr kp0=shm3+LDS_K+hi*1024+r32*16; const lds_cptr vp0=shm3+LDS_V+((lane>>4)&1)*32+(lane&3)*8+(4*hi+((lane&15)>>2))*64;
  DMA_K(0,0);DMA_V(0,0);DMA_K(1,SLOTB);
  bf16x8 qr[4];
  #pragma unroll
  for(int d0=0;d0<4;++d0)qr[d0]=*reinterpret_cast<const bf16x8*>(&Qw[(long)r32*QP+d0*16+hi*8]);
  float zf_=0.f;asm volatile("":"+v"(zf_)); float mhat=zf_,l_reg=zf_;f32x16 o[2];
  #pragma unroll
  for(int r=0;r<16;++r){o[0][r]=zf_;o[1][r]=zf_;}
  f32x16 negm;
  #pragma unroll
  for(int r=0;r<16;++r)negm[r]=zf_;
  asm volatile("":"+v"(negm));
  const int qrel=wid*QBLK+r32;
  const int mbase=4*hi-256-qpos0-qrel;
  #define CMASK(P0,P1,t) do{ if(WIN){ if((t)>=4) wmask(P0,P1,mbase+64*((t)+shift)); } }while(0)
  bool resc=false;
  #define START(P0,P1) do{ const float rm=rowmax(P0,P1); resc=false; \
    { const float dl=rm; mhat=fadd_s(mhat,dl); \
      _Pragma("unroll") for(int r=0;r<16;++r){P0[r]=fsub_s(P0[r],dl);P1[r]=fsub_s(P1[r],dl);} \
      _Pragma("unroll") for(int r=0;r<16;++r)negm[r]=-mhat; asm volatile("":"+v"(negm)); } \
    _Pragma("unroll") for(int r=0;r<16;++r)P0[r]=__builtin_amdgcn_exp2f(P0[r]); }while(0)
  #define RESC() do{ if(resc){ asm volatile("s_waitcnt lgkmcnt(0)":::"memory"); \
      _Pragma("unroll") for(int d_=0;d_<2;++d_) _Pragma("unroll") for(int r=0;r<16;++r)o[d_][r]*=wsf[crow(r,hi)]; } }while(0)
  f32x16 pA0,pA1,pB0,pB1;
  int sl_prev=0,sl_cur=0,sl_next=SLOTB;
  #define ROT() do{sl_prev=sl_cur;sl_cur=sl_next;sl_next=(sl_next==(NSLOT-1)*SLOTB)?0:sl_next+SLOTB;}while(0)
  DMA_K(2,2*SLOTB);
  WAIT_BAR(3);
  qkt(pA0,pA1,Kbase,qr,negm,r32,hi);asm volatile("s_nop 15\n\ts_nop 7":"+v"(pA0),"+v"(pA1));CMASK(pA0,pA1,0);
  START(pA0,pA1);
  _Pragma("unroll") for(int r=0;r<16;++r)pA1[r]=__builtin_amdgcn_exp2f(pA1[r]);
  WAIT_BAR(0);
  DMA_K(3,0);DMA_V(1,SLOTB);
  ROT();
  kload8(kf,kp0+sl_cur);
  WAIT_BAR(2);
  s16x4 vlo[8],vhi[8]; u32x4 pw0,pw1,pw2,pw3;
  #define PKW(P,B) cvtpk_s(P[B],P[B+1])
  #define PAF(k) __builtin_bit_cast(bf16x8,pw##k)
  #define VFR(i) (bf16x8){vlo[i][0],vlo[i][1],vlo[i][2],vlo[i][3],vhi[i][0],vhi[i][1],vhi[i][2],vhi[i][3]}
  #define PIN(x) asm volatile("":"+v"(x))
  #define MX3(a,b,c) __builtin_fmaxf(__builtin_fmaxf((a),(b)),(c))
  #define GAPA(MF,A0,A1,A2,A3,W0,W1,PW) do{ MF; sacc+=A0; sacc+=A1; sacc+=A2; sacc+=A3; PIN(sacc); W0; W1; PIN(PW); SBAR(); }while(0)
  #define EX(v) __builtin_amdgcn_exp2f(v)
  #define GAPB(MF,X,B) do{ MF; X[B]=EX(X[B]); X[B+1]=EX(X[B+1]); X[B+2]=EX(X[B+2]); X[B+3]=EX(X[B+3]); PIN(X); SBAR(); }while(0)
  #define VRD(i) do{ vlo[i]=vtr(vp_+(((i)>>2)*4096+((i)&3)*1024)); vhi[i]=vtr(vp_+(((i)>>2)*4096+((i)&3)*1024+512)); }while(0)
  #define KRD(G,j) do{ if(G){ kload2(kf,kp0+sl_next,j); SBAR(); } }while(0)
  #define STEP(C0,C1,P0,P1,t,GK,GV,GL) do{ SBAR(); \
    const lds_cptr vp_=vp0+sl_prev; \
    VRD(0); SBAR(); float sacc=(P0[0]+P0[1]); \
    GAPA(C0=__builtin_amdgcn_mfma_f32_32x32x16_bf16(kf[0],qr[0],negm,0,0,0), P0[2],P0[3],P0[4],P0[5],     pw0[0]=PKW(P0,0), pw0[1]=PKW(P0,2), pw0); \
    VRD(4); SBAR(); GAPA(C1=__builtin_amdgcn_mfma_f32_32x32x16_bf16(kf[1],qr[0],negm,0,0,0), P0[6],P0[7],P0[8],P0[9],     pw0[2]=PKW(P0,4), pw0[3]=PKW(P0,6), pw0); \
    VRD(1); SBAR(); GAPA(C0=__builtin_amdgcn_mfma_f32_32x32x16_bf16(kf[2],qr[1],C0,0,0,0),   P0[10],P0[11],P0[12],P0[13], pw1[0]=PKW(P0,8), pw1[1]=PKW(P0,10), pw1); \
    VRD(5); SBAR(); GAPA(C1=__builtin_amdgcn_mfma_f32_32x32x16_bf16(kf[3],qr[1],C1,0,0,0),   P0[14],P0[15],P1[0],P1[1],   pw1[2]=PKW(P0,12),pw1[3]=PKW(P0,14), pw1); \
    VRD(2); SBAR(); GAPA(C0=__builtin_amdgcn_mfma_f32_32x32x16_bf16(kf[4],qr[2],C0,0,0,0),   P1[2],P1[3],P1[4],P1[5],     pw2[0]=PKW(P1,0), pw2[1]=PKW(P1,2), pw2); \
    VRD(6); SBAR(); GAPA(C1=__builtin_amdgcn_mfma_f32_32x32x16_bf16(kf[5],qr[2],C1,0,0,0),   P1[6],P1[7],P1[8],P1[9],     pw2[2]=PKW(P1,4), pw2[3]=PKW(P1,6), pw2); \
    VRD(3); SBAR(); GAPA(C0=__builtin_amdgcn_mfma_f32_32x32x16_bf16(kf[6],qr[3],C0,0,0,0),   P1[10],P1[11],P1[12],P1[13], pw3[0]=PKW(P1,8), pw3[1]=PKW(P1,10), pw3); \
    VRD(7); SBAR(); GAPA(C1=__builtin_amdgcn_mfma_f32_32x32x16_bf16(kf[7],qr[3],C1,0,0,0),   P1[14],P1[15],0.f,0.f,       pw3[2]=PKW(P1,12),pw3[3]=PKW(P1,14), pw3); \
    l_reg+=sacc; \
    if(GK){DMA_K((t)+3,sl_cur);} if(GV){DMA_V((t)+1,sl_next);} \
    CMASK(C0,C1,t); \
    { float a=MX3(C0[0],C0[1],C1[0]),b=MX3(C0[2],C0[3],C1[1]); a=MX3(a,C1[2],C1[3]); \
      _Pragma("unroll") for(int r=4;r<16;r+=4){a=MX3(a,C0[r],C0[r+1]);b=MX3(b,C0[r+2],C0[r+3]);a=MX3(a,C1[r],C1[r+1]);b=MX3(b,C1[r+2],C1[r+3]);} \
      float rm=__builtin_fmaxf(a,b); { auto rr=__builtin_amdgcn_permlane32_swap(__float_as_uint(rm),__float_as_uint(rm),false,false); rm=__builtin_fmaxf(__uint_as_float(rr[0]),__uint_as_float(rr[1])); } \
      resc=false; \
      if(__builtin_expect(__any(rm>(float)THRL),0)){ const float dl=__builtin_fmaxf(rm,0.f); mhat+=dl; \
        _Pragma("unroll") for(int r=0;r<16;++r){C0[r]-=dl;C1[r]-=dl;} \
        _Pragma("unroll") for(int r=0;r<16;++r)negm[r]=-mhat; asm volatile("":"+v"(negm)); \
        const float f=__builtin_amdgcn_exp2f(-dl); l_reg*=f; if(hi==0)wsf[r32]=f; resc=true; } } \
    SBAR(); \
    GAPB(o[0]=__builtin_amdgcn_mfma_f32_32x32x16_bf16(PAF(0),VFR(0),o[0],0,0,0), C0,0); \
    GAPB(o[1]=__builtin_amdgcn_mfma_f32_32x32x16_bf16(PAF(0),VFR(4),o[1],0,0,0), C0,4); \
    KRD(GL,0); GAPB(o[0]=__builtin_amdgcn_mfma_f32_32x32x16_bf16(PAF(1),VFR(1),o[0],0,0,0), C0,8); \
    KRD(GL,1); GAPB(o[1]=__builtin_amdgcn_mfma_f32_32x32x16_bf16(PAF(1),VFR(5),o[1],0,0,0), C0,12); \
    KRD(GL,2); GAPB(o[0]=__builtin_amdgcn_mfma_f32_32x32x16_bf16(PAF(2),VFR(2),o[0],0,0,0), C1,0); \
    KRD(GL,3); GAPB(o[1]=__builtin_amdgcn_mfma_f32_32x32x16_bf16(PAF(2),VFR(6),o[1],0,0,0), C1,4); \
    GAPB(o[0]=__builtin_amdgcn_mfma_f32_32x32x16_bf16(PAF(3),VFR(3),o[0],0,0,0), C1,8); \
    GAPB(o[1]=__builtin_amdgcn_mfma_f32_32x32x16_bf16(PAF(3),VFR(7),o[1],0,0,0), C1,12); \
    }while(0)
  int t=1;
  for(;t+5<NT;t+=2){
    STEP(pB0,pB1,pA0,pA1,t,true,true,true);     WAIT_BAR(2); RESC(); ROT();
    STEP(pA0,pA1,pB0,pB1,t+1,true,true,true);   WAIT_BAR(2); RESC(); ROT();
  }
  #define ENDW(tt) do{ if((tt)+3<NT){WAIT_BAR(2);} else if((tt)+2<NT){WAIT_BAR(1);} else {WAIT_BAR(0);} }while(0)
  for(;t+1<NT;t+=2){
    STEP(pB0,pB1,pA0,pA1,t,(t+3<NT),(t+1<NT),(t+1<NT));       ENDW(t);   RESC(); ROT();
    STEP(pA0,pA1,pB0,pB1,t+1,(t+4<NT),(t+2<NT),(t+2<NT));     ENDW(t+1); RESC(); ROT();
  }
  STEP(pB0,pB1,pA0,pA1,NT-1,false,false,false); RESC();
  { float sacc=pB0[0]+pB0[1]; _Pragma("unroll") for(int r=2;r<16;++r)sacc+=pB0[r]; _Pragma("unroll") for(int r=0;r<16;++r)sacc+=pB1[r]; l_reg+=sacc;
    pw0=(u32x4){PKW(pB0,0),PKW(pB0,2),PKW(pB0,4),PKW(pB0,6)};pw1=(u32x4){PKW(pB0,8),PKW(pB0,10),PKW(pB0,12),PKW(pB0,14)};pw2=(u32x4){PKW(pB1,0),PKW(pB1,2),PKW(pB1,4),PKW(pB1,6)};pw3=(u32x4){PKW(pB1,8),PKW(pB1,10),PKW(pB1,12),PKW(pB1,14)};
    SBAR(); pv(o,vb0+sl_cur,PAF(0),PAF(1),PAF(2),PAF(3)); }
  #undef PKW
  #undef PAF
  #undef VFR
  #undef PIN
  #undef MX3
  #undef GAPA
  #undef GAPB
  #undef EX
  #undef VRD
  #undef KRD
  #undef STEP
  #undef ENDW
  {auto rr=__builtin_amdgcn_permlane32_swap(__float_as_uint(l_reg),__float_as_uint(l_reg),false,false);l_reg=__uint_as_float(rr[0])+__uint_as_float(rr[1]);}
  if(WIN)l_reg+=__builtin_amdgcn_exp2f(sinkl2-mhat);
  if(hi==0)wsf[32+r32]=l_reg;asm volatile("s_waitcnt lgkmcnt(0)":::"memory");
  float rli[16];
  #pragma unroll
  for(int r=0;r<16;++r)rli[r]=__builtin_amdgcn_rcpf(wsf[32+crow(r,hi)]);
  bf16*Ow=Ou+(long)(wid*QBLK)*OP;
  { bf16*stg=(bf16*)(shm+LDS_OST)+wid*2048;
    #pragma unroll
    for(int r=0;r<16;++r){const int orow=crow(r,hi);
      #pragma unroll
      for(int d0=0;d0<2;++d0)stg[orow*64+d0*32+r32]=__float2bfloat16(o[d0][r]*rli[r]);}
    asm volatile("s_waitcnt lgkmcnt(0)":::"memory");
    #pragma unroll
    for(int i=0;i<4;++i){const int row=i*8+(lane>>3),ch=lane&7; const u32x4 v=*(const u32x4*)(stg+row*64+ch*8); ATTN_STORE16(Ow+(long)row*OP+ch*8,v);} }
  asm volatile("s_waitcnt lgkmcnt(0)\n\ts_barrier":::"memory");
  #undef DMA_K
  #undef KROW
  #undef DMA_V
  #undef CMASK
  #undef START
  #undef RESC
  #undef ROT
}
constexpr int ATTN_LDS_BYTES=LDS_BYTES;
#undef SBAR
#undef WAIT_BAR
}
constexpr int NWAVES = 8;
constexpr int DM = 1024, NBATCH = 2, SEQ = 16384, CTXL = 256, TOK = SEQ + CTXL  , MR = NBATCH * TOK  ;
constexpr int DFF = 2816, NSUBMOD = 9216, DEPTH = 2;
constexpr float EPS = 1e-6f, LOG2E = 1.4426950408889634f;
constexpr int S5L = 32, S5ROWS = 1280  , S5CH = MR / S5L  , S5K = 768;

typedef unsigned short bf16;
typedef unsigned v4u __attribute__((ext_vector_type(4)));
typedef float f32x4 __attribute__((ext_vector_type(4)));
#define LAS __attribute__((address_space(3)))
#define LDS_WAIT() asm volatile("s_waitcnt lgkmcnt(0)" ::: "memory")
__device__ __forceinline__ unsigned f2bf(float f) { unsigned u = __builtin_bit_cast(unsigned, f); return (u + 0x7fffu + ((u >> 16) & 1u)) >> 16; }
__device__ __forceinline__ unsigned pk2(float lo, float hi) { return f2bf(lo) | (f2bf(hi) << 16); }
__device__ __forceinline__ float bf2f(unsigned short h) { return __builtin_bit_cast(float, (unsigned)h << 16); }
__device__ __forceinline__ float sigm(float x) { return __builtin_amdgcn_rcpf(1.0f + __builtin_amdgcn_exp2f(-x * LOG2E)); }

constexpr size_t MiB = 1u << 20;
constexpr size_t WS_MOD = 1 * MiB, WS_XC = 2 * MiB;
constexpr size_t WS_W1T = 4 * MiB, WS_W2T = 26 * MiB, WS_WINT = 37 * MiB, WS_WBT = 48 * MiB, WS_WOT = 50 * MiB, WS_WGT = 52 * MiB, WS_WPT = 52 * MiB + 256 * 1024;
constexpr size_t WS_BTY = 53 * MiB, WS_BTE = 65 * MiB, WS_E = 71 * MiB, WS_A2 = 91 * MiB, WS_HN = 121 * MiB, WS_T = 186 * MiB;
constexpr size_t WS_R = 251 * MiB;
constexpr size_t WS_HID = WS_R, WS_GS = WS_R, WS_Q = WS_R + 65 * MiB, WS_K = WS_Q + 65 * MiB / 2, WS_V = WS_K + 65 * MiB / 4, WS_XA = WS_V + 65 * MiB / 4, WS_G = WS_XA + 65 * MiB / 4,
                 WS_DIFF = WS_G + 65 * MiB / 4, WS_Y4 = WS_DIFF + 65 * MiB / 4, WS_END = WS_Y4 + 65 * MiB;
static_assert(WS_END <= 512 * MiB && WS_HID + (size_t)MR * DFF * 2 <= WS_Y4 + 65 * MiB, "ws map");
constexpr int RING_BYTES = 131072, LDS_BYTES = 147456;

struct Args { const float* in[26]; float* out; unsigned char* ws; int ph_lo, ph_hi; };
struct Frame { LAS unsigned char* lds; int lane, wave, vcu, G; };
typedef const volatile __attribute__((address_space(4))) unsigned long long karg_t;
__device__ __forceinline__ unsigned long long karg(int i) { return ((karg_t*)__builtin_amdgcn_kernarg_segment_ptr())[i]; }
#define AIN(i) ((const float*)karg(i))
#define AOUT ((float*)karg(26))
#define AWS ((unsigned char*)karg(27))
#define WSP(T, off) ((T*)(AWS + (off)))

__device__ __forceinline__ float* xrow_ptr(float* lat, float* ctxp, int r) { const int b = r / TOK, i = r - b * TOK; return i < CTXL ? ctxp + (size_t)(b * CTXL + i) * DM : lat + (size_t)(b * SEQ + i - CTXL) * DM; }

using pg8::f32x4; using pg8::Unit; using pg8::bf16_t; using pg8::cvt_pk_bf16; using pg8::u32x4;
#define EPI_ARGS const pg8::f32x4 (&acc)[2][2][4][2], const pg8::Unit& u, int wr, int wc, int fr_, int fq_
#define EPI_PIN int fr = fr_, fq = fq_; asm volatile("" : "+v"(fr), "+v"(fq));
struct EpiSwiglu { static constexpr bool PERM = true, AFTER_DRAIN = false; bf16_t* H;
    __device__ __forceinline__ void operator()(EPI_ARGS) const { EPI_PIN
        const int row0 = u.pm * 256 + wr * 64 + fr, hc = u.pn * 128 + wc * 32 + 8 * fq;
#pragma unroll
        for (int ai = 0; ai < 2; ++ai)
#pragma unroll
            for (int m = 0; m < 4; ++m) { bf16_t* rowp = H + (size_t)(row0 + ai * 128 + m * 16) * DFF + hc; float v[8];
#pragma unroll
                for (int n = 0; n < 2; ++n)
#pragma unroll
                    for (int j = 0; j < 4; ++j) { const float g = acc[ai][0][m][n][j], up = acc[ai][1][m][n][j]; v[n * 4 + j] = g * sigm(g) * up; }
                u32x4 w; w.x = cvt_pk_bf16(v[0], v[1]); w.y = cvt_pk_bf16(v[2], v[3]); w.z = cvt_pk_bf16(v[4], v[5]); w.w = cvt_pk_bf16(v[6], v[7]); *(u32x4*)rowp = w; }
    }
};
struct EpiResid { static constexpr bool PERM = true, AFTER_DRAIN = false; const float* src_lat; const float* src_ctx; float* dst_lat; float* dst_ctx; const float* gate; float sc;
    __device__ __forceinline__ void operator()(EPI_ARGS) const { EPI_PIN
        const int b = u.pm / 65, tq = u.pm - b * 65; const bool isc = tq == 0;
        const size_t off = isc ? (size_t)b * CTXL * DM : ((size_t)b * SEQ + (size_t)(tq - 1) * 256) * DM;
        const float* sp = (isc ? src_ctx : src_lat) + off; float* dp = (isc ? dst_ctx : dst_lat) + off;
        const float* gp = gate + (isc ? 2 : b) * NSUBMOD; const int col0 = u.pn * 256 + wc * 32 + 8 * fq;
        f32x4 gv[2][2];
#pragma unroll
        for (int bj = 0; bj < 2; ++bj)
#pragma unroll
            for (int n = 0; n < 2; ++n) gv[bj][n] = *(const f32x4*)(gp + col0 + bj * 128 + 4 * n) * sc;
#pragma unroll
        for (int ai = 0; ai < 2; ++ai)
#pragma unroll
            for (int m = 0; m < 4; ++m) { const size_t ro = (size_t)(ai * 128 + wr * 64 + m * 16 + fr) * DM + col0;
#pragma unroll
                for (int bj = 0; bj < 2; ++bj)
#pragma unroll
                    for (int n = 0; n < 2; ++n) { const f32x4 xv = *(const f32x4*)(sp + ro + bj * 128 + 4 * n); *(f32x4*)(dp + ro + bj * 128 + 4 * n) = xv + gv[bj][n] * acc[ai][bj][m][n]; } }
    }
};
__device__ __forceinline__ u32x4 pack8(const f32x4& a, const f32x4& b) { u32x4 w; w.x = cvt_pk_bf16(a[0], a[1]); w.y = cvt_pk_bf16(a[2], a[3]); w.z = cvt_pk_bf16(b[0], b[1]); w.w = cvt_pk_bf16(b[2], b[3]); return w; }
struct EpiRoute { static constexpr bool PERM = true, AFTER_DRAIN = false; bf16_t *Q, *K, *V, *A2, *XA;
    __device__ __forceinline__ void operator()(EPI_ARGS) const { EPI_PIN
        const int row0 = u.pm * 256 + wr * 64 + fr, cl = wc * 32 + 8 * fq;
        bf16_t* base; int ldc, coff = 0;
        if (u.pn == 0) { base = Q; ldc = 512; } else if (u.pn == 1) { base = Q; ldc = 512; coff = 256; } else if (u.pn == 2) { base = K; ldc = 256; } else if (u.pn == 3) { base = V; ldc = 256; } else { base = XA; ldc = 256; }
#pragma unroll
        for (int ai = 0; ai < 2; ++ai)
#pragma unroll
            for (int m = 0; m < 4; ++m) { const int row = row0 + ai * 128 + m * 16;
#pragma unroll
                for (int bj = 0; bj < 2; ++bj) { const u32x4 w = pack8(acc[ai][bj][m][0], acc[ai][bj][m][1]); const int c = bj * 128 + cl;
                    if (u.pn == 4) { const int g = c >> 4, h0 = c & 15; *(u32x4*)(A2 + ((size_t)g * S5ROWS + (row >> 5)) * S5K + (row & 31) * 16 + h0) = w; }
                    else *(u32x4*)(base + (size_t)row * ldc + coff + c) = w; } }
    }
};
struct EpiGate { static constexpr bool PERM = true, AFTER_DRAIN = false; bf16_t* GS;
    __device__ __forceinline__ void operator()(EPI_ARGS) const { EPI_PIN
        const int row0 = u.pm * 256 + wr * 64 + fr, col0 = u.pn * 256 + wc * 32 + 8 * fq;
#pragma unroll
        for (int ai = 0; ai < 2; ++ai)
#pragma unroll
            for (int m = 0; m < 4; ++m)
#pragma unroll
                for (int bj = 0; bj < 2; ++bj) { f32x4 a = acc[ai][bj][m][0], b = acc[ai][bj][m][1];
#pragma unroll
                    for (int j = 0; j < 4; ++j) { a[j] = sigm(a[j]); b[j] = sigm(b[j]); }
                    *(u32x4*)(GS + (size_t)(row0 + ai * 128 + m * 16) * DM + col0 + bj * 128) = pack8(a, b); }
    }
};
template <bool FIRST> struct EpiMerge { static constexpr bool PERM = true, AFTER_DRAIN = false; const bf16_t* GS; bf16_t* T;
    __device__ __forceinline__ void operator()(EPI_ARGS) const { EPI_PIN
        const int row0 = u.pm * 256 + wr * 64 + fr, col0 = u.pn * 256 + wc * 32 + 8 * fq;
#pragma unroll
        for (int ai = 0; ai < 2; ++ai)
#pragma unroll
            for (int m = 0; m < 4; ++m)
#pragma unroll
                for (int bj = 0; bj < 2; ++bj) { const size_t o = (size_t)(row0 + ai * 128 + m * 16) * DM + col0 + bj * 128;
                    const u32x4 g = *(const u32x4*)(GS + o); u32x4 t = {0u, 0u, 0u, 0u}; if (!FIRST) t = *(const u32x4*)(T + o);
                    f32x4 a = acc[ai][bj][m][0], b = acc[ai][bj][m][1];
#pragma unroll
                    for (int q = 0; q < 2; ++q) { const unsigned gw = g[q], tw = t[q], gw2 = g[q + 2], tw2 = t[q + 2];
                        a[2 * q] = __builtin_bit_cast(float, tw << 16) + (__builtin_bit_cast(float, gw << 16)) * a[2 * q]; a[2 * q + 1] = __builtin_bit_cast(float, tw & 0xffff0000u) + (__builtin_bit_cast(float, gw & 0xffff0000u)) * a[2 * q + 1];
                        b[2 * q] = __builtin_bit_cast(float, tw2 << 16) + (__builtin_bit_cast(float, gw2 << 16)) * b[2 * q]; b[2 * q + 1] = __builtin_bit_cast(float, tw2 & 0xffff0000u) + (__builtin_bit_cast(float, gw2 & 0xffff0000u)) * b[2 * q + 1]; }
                    *(u32x4*)(T + o) = pack8(a, b); }
    }
};
struct EpiPlain { static constexpr bool PERM = true, AFTER_DRAIN = false; bf16_t* O; int ldc;
    __device__ __forceinline__ void operator()(EPI_ARGS) const { EPI_PIN
        const int row0 = u.pm * 256 + wr * 64 + fr, col0 = u.pn * 256 + wc * 32 + 8 * fq;
#pragma unroll
        for (int ai = 0; ai < 2; ++ai)
#pragma unroll
            for (int m = 0; m < 4; ++m)
#pragma unroll
                for (int bj = 0; bj < 2; ++bj) *(u32x4*)(O + (size_t)(row0 + ai * 128 + m * 16) * ldc + col0 + bj * 128) = pack8(acc[ai][bj][m][0], acc[ai][bj][m][1]);
    }
};
struct EpiGlu { static constexpr bool PERM = true, AFTER_DRAIN = false; bf16_t* O;
    __device__ __forceinline__ void operator()(EPI_ARGS) const { EPI_PIN
        const int row0 = u.pm * 256 + wr * 64 + fr, col0 = u.pn * 128 + wc * 32 + 8 * fq;
#pragma unroll
        for (int ai = 0; ai < 2; ++ai)
#pragma unroll
            for (int m = 0; m < 4; ++m) { f32x4 a = acc[ai][0][m][0], b = acc[ai][0][m][1]; const f32x4 ga = acc[ai][1][m][0], gb = acc[ai][1][m][1];
#pragma unroll
                for (int j = 0; j < 4; ++j) { a[j] *= sigm(ga[j]); b[j] *= sigm(gb[j]); }
                *(u32x4*)(O + (size_t)(row0 + ai * 128 + m * 16) * 256 + col0) = pack8(a, b); }
    }
};
struct EpiF32 { static constexpr bool PERM = true, AFTER_DRAIN = false; float* O;
    __device__ __forceinline__ void operator()(EPI_ARGS) const { EPI_PIN
        const int row0 = u.pm * 256 + wr * 64 + fr, col0 = wc * 32 + 8 * fq;
#pragma unroll
        for (int ai = 0; ai < 2; ++ai)
#pragma unroll
            for (int m = 0; m < 4; ++m)
#pragma unroll
                for (int bj = 0; bj < 2; ++bj)
#pragma unroll
                    for (int n = 0; n < 2; ++n) *(f32x4*)(O + (size_t)(row0 + ai * 128 + m * 16) * 256 + col0 + bj * 128 + 4 * n) = acc[ai][bj][m][n];
    }
};
__device__ __forceinline__ float gelu_tanh(float x) { const float y = 0.7978845608028654f * (x + 0.044715f * x * x * x); return x * sigm(2.0f * y); }
struct EpiS5Y { static constexpr bool PERM = true, AFTER_DRAIN = false; bf16_t* Gb;
    __device__ __forceinline__ void operator()(EPI_ARGS) const { EPI_PIN
        const int g = u.pm / 5, i = u.pm - 5 * g, jn = u.pn & 1;
#pragma unroll
        for (int ai = 0; ai < 2; ++ai)
#pragma unroll
            for (int m = 0; m < 4; ++m) { const int cidx = i * 256 + ai * 128 + wr * 64 + m * 16 + fr;
                if (cidx < S5CH) {
#pragma unroll
                    for (int bj = 0; bj < 2; ++bj) { const int c = jn * 256 + bj * 128 + wc * 32 + 8 * fq, jo = c >> 4, h0 = c & 15; f32x4 a = acc[ai][bj][m][0], b = acc[ai][bj][m][1];
#pragma unroll
                        for (int j = 0; j < 4; ++j) { a[j] = gelu_tanh(a[j]); b[j] = gelu_tanh(b[j]); }
                        *(u32x4*)(Gb + (size_t)(cidx * S5L + jo) * 256 + g * 16 + h0) = pack8(a, b); } } }
    }
};
struct RowOrder { pg8::StaticOrder so; bool skip;
    __device__ void init(int N, int G, int c, bool skip_) { skip = skip_; so.init(skip_ ? NBATCH * SEQ : MR, N, G, c); }
    __device__ bool next(int i, Unit& u) const { if (!so.next(i, u)) return false; if (skip) u.pm = u.pm + 1 + (u.pm >> 6); return true; }
    __device__ __forceinline__ void a_ready(const Unit&) const {}
    __device__ __forceinline__ void done(const Unit&) const {}
};
struct S5Order { int ncol, G, c;
    __device__ bool next(int i, Unit& u) const { const int L = i * G + c; if (L >= 80 * ncol) return false; const int g = L / (5 * ncol), rem = L - g * 5 * ncol; u.pm = g * 5 + rem / ncol; u.pn = g * ncol + rem % ncol; return true; }
    __device__ __forceinline__ void a_ready(const Unit&) const {}
    __device__ __forceinline__ void done(const Unit&) const {}
};
__device__ __forceinline__ float shx(float v, int o, int lane) { return __builtin_bit_cast(float, __builtin_amdgcn_ds_bpermute((lane ^ o) << 2, __builtin_bit_cast(int, v))); }
__device__ __forceinline__ float wave_sum(float v, int lane) {
#pragma unroll
    for (int o = 1; o < 64; o <<= 1) v += shx(v, o, lane);
    return v;
}
__device__ __forceinline__ void tr_item(const float* W, int K, int ldw, int src_c0, bf16* WT, int dst_r0, int k0, LAS float* scr, int lane) {
#pragma unroll 16
    for (int i = 0; i < 32; ++i) { const int kk = 2 * i + (lane >> 5); scr[kk * 33 + (lane & 31)] = W[(size_t)(k0 + kk) * ldw + src_c0 + (lane & 31)]; }
    LDS_WAIT(); asm volatile("" ::: "memory");
    const int c = lane & 7;
#pragma unroll
    for (int j = 0; j < 4; ++j) { const int n = (lane >> 3) + 8 * j; const LAS float* s = scr + (8 * c) * 33 + n;
        v4u o; o.x = pk2(s[0 * 33], s[1 * 33]); o.y = pk2(s[2 * 33], s[3 * 33]); o.z = pk2(s[4 * 33], s[5 * 33]); o.w = pk2(s[6 * 33], s[7 * 33]);
        *(v4u*)(WT + (size_t)(dst_r0 + n) * K + k0 + 8 * c) = o; }
    LDS_WAIT(); asm volatile("" ::: "memory");
}
constexpr int CONV_ITEMS = 2 * 2816 + 2 * 1408 + 2816 + 4 * 128 + 512 + 64;
__device__ __forceinline__ void conv_item(Frame& F, int l, int it, LAS float* scr) {
    int r = it; const int lane = F.lane;
    if (r < 5632) { const int f = r / 2816; r -= f * 2816; const int kb = r / 176, n0 = (r % 176) * 32, pn = n0 >> 8, bj = (n0 >> 7) & 1, q = n0 & 127;
        tr_item(AIN(7) + (size_t)(l * 2 + f) * DM * 5632, DM, 5632, bj * DFF + 128 * pn + q, WSP(bf16, WS_W1T) + (size_t)f * 5632 * DM, n0, kb * 64, scr, lane); return; } r -= 5632;
    if (r < 2816) { const int f = r / 1408; r -= f * 1408; const int kb = r / 32, n0 = (r % 32) * 32;
        tr_item(AIN(8) + (size_t)(l * 2 + f) * DFF * DM, DFF, DM, n0, WSP(bf16, WS_W2T) + (size_t)f * DM * DFF, n0, kb * 64, scr, lane); return; } r -= 2816;
    if (r < 2816) { const int kb = r / 176, n0 = (r % 176) * 32; int src;
        if (n0 >= 1536) src = n0; else { const int t = n0 >> 8, off = n0 & 255;
            src = t == 0 ? 768 + off : t == 1 ? 1024 + off : t == 2 ? (off < 128 ? off : 512 + off - 128) : t == 3 ? (off < 128 ? 128 + off : 640 + off - 128) : t == 4 ? 256 + off : 1280 + off; }
        tr_item(AIN(9) + (size_t)l * DM * 5632, DM, 5632, src, WSP(bf16, WS_WINT), n0, kb * 64, scr, lane); return; } r -= 2816;
    if (r < 512) { const int k = r / 128; r -= k * 128; const int kb = r / 32, n0 = (r % 32) * 32;
        tr_item(AIN(23) + (size_t)(l * 4 + k) * 256 * DM, 256, DM, n0, WSP(bf16, WS_WBT) + (size_t)k * DM * 256, n0, kb * 64, scr, lane); return; } r -= 512;
    if (r < 512) { const int kb = r / 32, n0 = (r % 32) * 32;
        tr_item(AIN(24) + (size_t)l * DM * DM, DM, DM, n0, WSP(bf16, WS_WOT), n0, kb * 64, scr, lane); return; } r -= 512;
    { const int kb = r / 16, n0 = (r % 16) * 32, pn = n0 >> 8, bj = (n0 >> 7) & 1, q = n0 & 127;
        tr_item(AIN(22) + (size_t)l * 256 * 512, 256, 512, bj * 256 + 128 * pn + q, WSP(bf16, WS_WGT), n0, kb * 64, scr, lane); }
}
__device__ __forceinline__ void s5_table_item(Frame& F, int l, int item, LAS float* scr) {
    const int g = item >> 5, j = item & 31, lane = F.lane, p = lane;
    bf16* BtY = WSP(bf16, WS_BTY) + (size_t)g * 512 * S5K; bf16* BtE = WSP(bf16, WS_BTE) + (size_t)g * 256 * S5K;
    float lre[2], lim[2], cfr[2], cfi[2], are[2], aim[2], dtv[2];
#pragma unroll
    for (int d = 0; d < 2; ++d) { const int ix = ((l * 2 + d) * 16 + g) * 64 + p; are[d] = AIN(14)[ix]; aim[d] = AIN(15)[ix]; dtv[d] = expf(AIN(16)[(l * 2 + d) * 16 + g]);
        const float mg = expf(are[d] * dtv[d]); float sn, cs; sincosf(aim[d] * dtv[d], &sn, &cs); const float br = mg * cs - 1.0f, bi = mg * sn; const float den = 1.0f / (are[d] * are[d] + aim[d] * aim[d]);
        cfr[d] = (br * are[d] + bi * aim[d]) * den; cfi[d] = (bi * are[d] - br * aim[d]) * den; }
#define LAMPOW(d, e, outr, outi) do { const float mg_ = expf(are[d] * dtv[d] * (float)(e)); float sn_, cs_; sincosf(aim[d] * dtv[d] * (float)(e), &sn_, &cs_); outr = mg_ * cs_; outi = mg_ * sn_; } while (0)
#pragma unroll
    for (int d = 0; d < 2; ++d) { float pr, pi; LAMPOW(d, j, pr, pi); scr[(d * 64 + p) * 2] = pr * cfr[d] - pi * cfi[d]; scr[(d * 64 + p) * 2 + 1] = pr * cfi[d] + pi * cfr[d]; }
    LDS_WAIT(); asm volatile("" ::: "memory");
    const int hi_ = lane & 15;
#pragma unroll 1
    for (int i2 = 0; i2 < 4; ++i2) { const int ho = (lane >> 4) + 4 * i2; float kv[2];
#pragma unroll
        for (int d = 0; d < 2; ++d) { const float* cr = AIN(19) + (((size_t)(l * 2 + d) * 16 + g) * 16 + ho) * 64; const float* ci = AIN(20) + (((size_t)(l * 2 + d) * 16 + g) * 16 + ho) * 64;
            const float* br = AIN(17) + ((size_t)(l * 2 + d) * 16 + g) * 64 * 16 + hi_; const float* bi = AIN(18) + ((size_t)(l * 2 + d) * 16 + g) * 64 * 16 + hi_; float s = 0.f;
            for (int pp = 0; pp < 64; ++pp) { const float zr = scr[(d * 64 + pp) * 2], zi = scr[(d * 64 + pp) * 2 + 1], b_r = br[pp * 16], b_i = bi[pp * 16];
                const float wr_ = zr * b_r - zi * b_i, wi_ = zr * b_i + zi * b_r; s += cr[pp] * wr_ - ci[pp] * wi_; }
            kv[d] = s; }
        if (j == 0) { const float v = kv[0] + kv[1] + (ho == hi_ ? AIN(21)[l * 256 + g * 16 + ho] : 0.f);
            for (int q = 0; q < 32; ++q) BtY[(size_t)(q * 16 + ho) * S5K + q * 16 + hi_] = (bf16)f2bf(v); }
        else { const bf16 vf = (bf16)f2bf(kv[0]), vb = (bf16)f2bf(kv[1]);
            for (int q = 0; q + j < 32; ++q) { BtY[(size_t)((q + j) * 16 + ho) * S5K + q * 16 + hi_] = vf; BtY[(size_t)(q * 16 + ho) * S5K + (q + j) * 16 + hi_] = vb; } }
    }
#pragma unroll
    for (int d = 0; d < 2; ++d) { float pr, pi; LAMPOW(d, (d == 0 ? j + 1 : S5L - j), pr, pi);
        for (int ho = 0; ho < 16; ++ho) { const size_t ci_ = (((size_t)(l * 2 + d) * 16 + g) * 16 + ho) * 64 + p; const float c_r = AIN(19)[ci_], c_i = AIN(20)[ci_];
            bf16* row = BtY + (size_t)(j * 16 + ho) * S5K + 512 + d * 128; row[p] = (bf16)f2bf(c_r * pr - c_i * pi); row[64 + p] = (bf16)f2bf(-(c_r * pi + c_i * pr)); } }
#pragma unroll
    for (int d = 0; d < 2; ++d) { float pr, pi; LAMPOW(d, (d == 0 ? S5L - 1 - j : j), pr, pi); const float zr = pr * cfr[d] - pi * cfi[d], zi = pr * cfi[d] + pi * cfr[d];
        for (int h = 0; h < 16; ++h) { const size_t bi_ = (((size_t)(l * 2 + d) * 16 + g) * 64 + p) * 16 + h; const float b_r = AIN(17)[bi_], b_i = AIN(18)[bi_];
            BtE[(size_t)(d * 128 + p) * S5K + j * 16 + h] = (bf16)f2bf(zr * b_r - zi * b_i); BtE[(size_t)(d * 128 + 64 + p) * S5K + j * 16 + h] = (bf16)f2bf(zr * b_i + zi * b_r); } }
    for (int q = lane; q < 8 * 256; q += 64) BtE[(size_t)(8 * j + (q >> 8)) * S5K + 512 + (q & 255)] = 0;
#undef LAMPOW
    LDS_WAIT(); asm volatile("" ::: "memory");
}
__device__ __forceinline__ void prep_layer(Frame& F, int l) {
    LAS float* scr = (LAS float*)(F.lds + F.wave * 16384);
    const int gw = F.vcu * NWAVES + F.wave, NGW = F.G * NWAVES;
    for (int it = gw; it < CONV_ITEMS; it += NGW) conv_item(F, l, it, scr);
    for (int it = NGW - 1 - gw; it < 512; it += NGW) s5_table_item(F, l, it, scr);
    const int gt = gw * 64 + F.lane, NGT = NGW * 64;
    { bf16* Wp = WSP(bf16, WS_WPT); const float* pw = AIN(12) + (size_t)l * 4 * 64 * 64; const float* ps = AIN(13) + l * 256;
      for (int e = gt; e < 65536; e += NGT) { const int n = e >> 8, k = e & 255; Wp[e] = (bf16)(((n >> 6) == (k >> 6)) ? f2bf(pw[((n >> 6) * 64 + (k & 63)) * 64 + (n & 63)] * ps[n]) : 0u); } }
    { bf16* A2 = WSP(bf16, WS_A2); unsigned z_ = 0u; asm volatile("" : "+v"(z_)); for (int e = gt; e < 16 * S5ROWS * 32; e += NGT) { const int row = e >> 5, c8 = e & 31; *(v4u*)(A2 + (size_t)row * S5K + 512 + c8 * 8) = (v4u){z_, z_, z_, z_}; } }
}
__device__ __forceinline__ void mod_phase(Frame& F) {
    LAS float* red = (LAS float*)F.lds;
    for (int it = F.vcu; it < DEPTH * (NSUBMOD / 64); it += F.G) { const int l = it / (NSUBMOD / 64), n = (it % (NSUBMOD / 64)) * 64 + F.lane;
        const float* w = AIN(4) + ((size_t)l * DM + F.wave * 128) * NSUBMOD + n; float a0 = 0.f, a1 = 0.f, a2 = 0.f;
#pragma unroll 4
        for (int k = 0; k < 128; ++k) { const int kk = F.wave * 128 + k; const float c0 = AIN(1)[kk], c1 = AIN(1)[DM + kk], c2 = AIN(3)[kk]; const float wv = w[(size_t)k * NSUBMOD];
            a0 += c0 * sigm(c0) * wv; a1 += c1 * sigm(c1) * wv; a2 += c2 * sigm(c2) * wv; }
        red[(F.wave * 3 + 0) * 64 + F.lane] = a0; red[(F.wave * 3 + 1) * 64 + F.lane] = a1; red[(F.wave * 3 + 2) * 64 + F.lane] = a2;
        __syncthreads();
        if (F.wave < 3) { float s = AIN(5)[l * NSUBMOD + n];
#pragma unroll
            for (int w8 = 0; w8 < 8; ++w8) s += red[(w8 * 3 + F.wave) * 64 + F.lane];
            WSP(float, WS_MOD)[((size_t)l * 3 + F.wave) * NSUBMOD + n] = s; }
        __syncthreads();
    }
}
__device__ __forceinline__ void norm_phase(Frame& F, int l, int sub, const float* lat, const float* ctxp) {
    const int gw = F.vcu * NWAVES + F.wave, NGW = F.G * NWAVES; const float* gptr = AIN(6) + (size_t)(l * 3 + sub) * DM; bf16* HN = WSP(bf16, WS_HN);
    for (int r = gw; r < MR; r += NGW) { const int b = r / TOK, i = r - b * TOK; const float* xr = i < CTXL ? ctxp + (size_t)(b * CTXL + i) * DM : lat + (size_t)(b * SEQ + i - CTXL) * DM;
        const float* mod = WSP(float, WS_MOD) + ((size_t)l * 3 + (i < CTXL ? 2 : b)) * NSUBMOD + sub * 3072;
        f32x4 v[4]; float s = 0.f;
#pragma unroll
        for (int j = 0; j < 4; ++j) { v[j] = *((const f32x4*)xr + F.lane + 64 * j); s += (v[j].x * v[j].x + v[j].y * v[j].y) + (v[j].z * v[j].z + v[j].w * v[j].w); }
        const float rstd = 1.0f / sqrtf(wave_sum(s, F.lane) * (1.0f / DM) + EPS);
#pragma unroll
        for (int j = 0; j < 4; ++j) { const f32x4 gg = *((const f32x4*)gptr + F.lane + 64 * j), sh = *((const f32x4*)mod + F.lane + 64 * j), sc = *((const f32x4*)(mod + DM) + F.lane + 64 * j);
            const f32x4 o = (v[j] * rstd * gg) * (sc + 1.0f) + sh;
            *((unsigned long long*)(HN + (size_t)r * DM) + F.lane + 64 * j) = (unsigned long long)pk2(o.x, o.y) | ((unsigned long long)pk2(o.z, o.w) << 32); }
    }
}
__device__ __forceinline__ void final_norm_phase(Frame& F) {
    const int gw = F.vcu * NWAVES + F.wave, NGW = F.G * NWAVES; const float* gptr = AIN(25);
    for (int r = gw; r < NBATCH * SEQ; r += NGW) { float* xr = AOUT + (size_t)r * DM; f32x4 v[4]; float s = 0.f;
#pragma unroll
        for (int j = 0; j < 4; ++j) { v[j] = *((const f32x4*)xr + F.lane + 64 * j); s += (v[j].x * v[j].x + v[j].y * v[j].y) + (v[j].z * v[j].z + v[j].w * v[j].w); }
        const float rstd = 1.0f / sqrtf(wave_sum(s, F.lane) * (1.0f / DM) + EPS);
#pragma unroll
        for (int j = 0; j < 4; ++j) { const f32x4 gg = *((const f32x4*)gptr + F.lane + 64 * j); *((f32x4*)xr + F.lane + 64 * j) = v[j] * rstd * gg; }
    }
}
__device__ __forceinline__ void post_phase(Frame& F, int l) {
    const int gw = F.vcu * NWAVES + F.wave, NGW = F.G * NWAVES, lane = F.lane, hh = lane >> 4, d = lane & 15;
    bf16* Q = WSP(bf16, WS_Q); bf16* K = WSP(bf16, WS_K); const bf16* XA = WSP(bf16, WS_XA); bf16* DF = WSP(bf16, WS_DIFF);
    const float inv = exp2f(-(float)d * (13.287712379549449f / 16.0f));
    const float* qg = AIN(11) + (size_t)l * 128; const float* kg = qg + 64;
    for (int r = gw; r < MR; r += NGW) { const int b = r / TOK, i = r - b * TOK; const bool lat = i >= CTXL; const int t = i - CTXL;
        const int n = lat ? SEQ : CTXL, ts = lat ? t : i; const size_t seg0 = (size_t)(r - ts); float pd[4];
#pragma unroll
        for (int j = 0; j < 4; ++j) { const int w = 2 << j; int lo = ts - (w >> 1), hi2 = lo + w; lo = lo < 0 ? 0 : lo; hi2 = hi2 > n ? n : hi2; float s = 0.f;
            for (int q2 = lo; q2 < hi2; ++q2) s += bf2f(XA[(seg0 + q2) * 256 + j * 64 + lane]);
            pd[j] = s / (float)(hi2 - lo) - bf2f(XA[(size_t)r * 256 + j * 64 + lane]); }
        float x[3][4];
#pragma unroll
        for (int it = 0; it < 3; ++it) { const bf16* p = it < 2 ? Q + (size_t)r * 512 + (it * 4 + hh) * 64 + d : K + (size_t)r * 256 + hh * 64 + d;
            x[it][0] = bf2f(p[0]); x[it][1] = bf2f(p[16]); x[it][2] = bf2f(p[32]); x[it][3] = bf2f(p[48]); }
        float cr = 1.f, sr = 0.f, cc = 1.f, sc = 0.f;
        if (lat) { sincosf((float)(t >> 6) * inv, &sr, &cr); sincosf((float)(t & 63) * inv, &sc, &cc); }
#pragma unroll
        for (int it = 0; it < 3; ++it) { float x0 = x[it][0], x1 = x[it][1], x2 = x[it][2], x3 = x[it][3];
            const bool nrm = (it == 1) || (it == 2 && hh >= 2);
            float ss = (x0 * x0 + x1 * x1) + (x2 * x2 + x3 * x3);
            ss += shx(ss, 1, lane); ss += shx(ss, 2, lane); ss += shx(ss, 4, lane); ss += shx(ss, 8, lane);
            if (nrm) { const float rs = 1.0f / sqrtf(ss * (1.0f / 64.0f) + EPS); const float* gp = it == 1 ? qg : kg; x0 *= rs * gp[d]; x1 *= rs * gp[d + 16]; x2 *= rs * gp[d + 32]; x3 *= rs * gp[d + 48]; }
            float o0 = x0 * cr - x1 * sr, o1 = x1 * cr + x0 * sr, o2 = x2 * cc - x3 * sc, o3 = x3 * cc + x2 * sc;
            if (it < 2) { o0 *= attn_body::C2; o1 *= attn_body::C2; o2 *= attn_body::C2; o3 *= attn_body::C2; }
            x[it][0] = o0; x[it][1] = o1; x[it][2] = o2; x[it][3] = o3; }
#pragma unroll
        for (int it = 0; it < 3; ++it) { bf16* p = it < 2 ? Q + (size_t)r * 512 + (it * 4 + hh) * 64 + d : K + (size_t)r * 256 + hh * 64 + d;
            p[0] = (bf16)f2bf(x[it][0]); p[16] = (bf16)f2bf(x[it][1]); p[32] = (bf16)f2bf(x[it][2]); p[48] = (bf16)f2bf(x[it][3]); }
#pragma unroll
        for (int j = 0; j < 4; ++j) DF[(size_t)r * 256 + j * 64 + lane] = (bf16)f2bf(pd[j]);
    }
}
__device__ __forceinline__ void s5_carry_phase(Frame& F, int l) {
    if (F.wave != 0 || F.vcu >= 64) return;
    const int b = F.vcu >> 5, d = (F.vcu >> 4) & 1, g = F.vcu & 15, p = F.lane;
    const int ix = ((l * 2 + d) * 16 + g) * 64 + p; const float are = AIN(14)[ix], aim = AIN(15)[ix], dt = expf(AIN(16)[(l * 2 + d) * 16 + g]);
    const float mg = expf(are * dt * (float)S5L); float sn, cs; sincosf(aim * dt * (float)S5L, &sn, &cs); const float Lr = mg * cs, Li = mg * sn;
    const float* E = WSP(float, WS_E) + (size_t)g * S5ROWS * 256 + d * 128 + p; bf16* A2 = WSP(bf16, WS_A2) + (size_t)g * S5ROWS * S5K + 512 + d * 128 + p;
    float sr = 0.f, si = 0.f;
#pragma unroll 1
    for (int k0 = 0; k0 < 520; k0 += 65) { float er[65], ei[65];
#pragma unroll
        for (int k = 0; k < 65; ++k) { const int kk = k0 + k; const int ch = d == 0 ? kk : (kk < 8 ? 7 - kk : 527 - kk); const size_t row = (size_t)b * 520 + ch; er[k] = E[row * 256]; ei[k] = E[row * 256 + 64]; }
#pragma unroll
        for (int k = 0; k < 65; ++k) { const int kk = k0 + k; const int ch = d == 0 ? kk : (kk < 8 ? 7 - kk : 527 - kk); const size_t row = (size_t)b * 520 + ch;
            A2[row * S5K] = (bf16)f2bf(sr); A2[row * S5K + 64] = (bf16)f2bf(si);
            const float nr = Lr * sr - Li * si + er[k], ni = Lr * si + Li * sr + ei[k]; sr = nr; si = ni; } }
}
__device__ __forceinline__ void attn_one(Frame& F, int l, int kind, int b, int h, int qb, char* lds) {
    using namespace attn_body;
    const attn_body::bf16* Q = (const attn_body::bf16*)WSP(::bf16, WS_Q); const attn_body::bf16* K = (const attn_body::bf16*)WSP(::bf16, WS_K); const attn_body::bf16* V = (const attn_body::bf16*)WSP(::bf16, WS_V);
    attn_body::bf16* O = (attn_body::bf16*)WSP(::bf16, WS_Y4) + (size_t)(kind == 0 ? 1 : 3) * MR * 256;
    const size_t row0 = (size_t)b * TOK + (size_t)qb * 256;
    const attn_body::bf16* Qu = Q + row0 * 512 + kind * 256 + h * 64; const attn_body::bf16* Kh = K + (size_t)b * TOK * 256 + kind * 128 + (h >> 1) * 64; const attn_body::bf16* Vh = V + (size_t)b * TOK * 256 + kind * 128 + (h >> 1) * 64;
    attn_body::bf16* Ou = O + row0 * 256 + h * 64;
    if (kind == 0) { int NT = 4, shift = 0;
        if (qb > 0) { const int lo = (4 * qb - 2) < 4 ? 4 : (4 * qb - 2), hi = (4 * qb + 5) > 259 ? 259 : (4 * qb + 5); NT = 4 + hi - lo + 1; shift = lo - 4; }
        attn_unit<8, true>(Qu, Kh, Vh, Ou, NT, shift, (qb - 1) * 256, AIN(10)[l * 4 + h] * LOG2E, lds, F.wave * 64 + F.lane);
    } else attn_unit<8, false>(Qu, Kh, Vh, Ou, qb > 0 ? 260 : 4, 0, 0, 0.f, lds, F.wave * 64 + F.lane);
}
__device__ __forceinline__ void attn_phase(Frame& F, int l, char* lds) {
    const int c = F.vcu;
#pragma unroll 1
    for (int u = c; u < 512; u += F.G) attn_one(F, l, 0, u >> 8, (u >> 6) & 3, 1 + (u & 63), lds);
#pragma unroll 1
    for (int u = c; u < 16; u += F.G) attn_one(F, l, u >> 3, (u >> 2) & 1, u & 3, 0, lds);
#pragma unroll 1
    for (int u = c; u < 512; u += F.G) attn_one(F, l, 1, u >> 8, (u >> 6) & 3, 1 + (u & 63), lds);
}

#define XB_TMO      128
#define XB_XCNT(j)  (256  + 64 * (j))
#define XB_XSUB(j)  (1280 + 64 * (j))
#define XB_XGEN(j)  (2304 + 64 * (j))
#define XB_TOP      3328
#define XB_TOPGEN   3392
#define XCD_BAR_WORDS 3456
#define XB_SPIN_CAP (1u << 18)

__device__ __forceinline__ unsigned xb_ld(unsigned* p)              { return __hip_atomic_load(p, __ATOMIC_RELAXED, __HIP_MEMORY_SCOPE_AGENT); }
__device__ __forceinline__ unsigned xb_add(unsigned* p, unsigned v) { return __hip_atomic_fetch_add(p, v, __ATOMIC_RELAXED, __HIP_MEMORY_SCOPE_AGENT); }
__device__ __forceinline__ unsigned xb_xcc_id() { return (unsigned)__builtin_amdgcn_s_getreg((3 << 11) | 20) & 0xFu; }
#define XB_SPIN(cond, bar) do { unsigned _sp = 0; while (cond) { __builtin_amdgcn_s_sleep(1); \
    if ((++_sp & 255u) == 0u) { if (xb_ld(&(bar)[XB_TMO])) break; if (_sp > XB_SPIN_CAP) { atomicAdd(&(bar)[XB_TMO], 1u); break; } } } } while (0)

struct XcdBarrier {
    unsigned* bar; unsigned x;
    volatile LAS unsigned* st;
};

__device__ __forceinline__ XcdBarrier xcd_barrier_post(unsigned* bar, volatile LAS unsigned* st) {
    XcdBarrier b; b.bar = bar; b.x = xb_xcc_id(); b.st = st;
    if (threadIdx.x == 0) (void)xb_add(&bar[XB_XCNT(b.x)], 1u);
    return b;
}
__device__ __forceinline__ void xcd_barrier_complete(unsigned* bar, unsigned x, unsigned& nloc, unsigned& nx) {
    const unsigned G = gridDim.x * gridDim.y * gridDim.z;
    unsigned sum, cnt, mine, sp = 0u;
    for (;;) {
        sum = 0u; cnt = 0u; mine = 0u;
#pragma unroll
        for (unsigned j = 0; j < 16; ++j) { const unsigned c = xb_ld(&bar[XB_XCNT(j)]); sum += c; cnt += (c > 0u) ? 1u : 0u; mine = (j == x) ? c : mine; }
        if (sum == G) break;
        __builtin_amdgcn_s_sleep(1);
        if ((++sp & 255u) == 0u) { if (xb_ld(&bar[XB_TMO])) break; if (sp > XB_SPIN_CAP) { atomicAdd(&bar[XB_TMO], 1u); break; } }
    }
    nloc = mine > 0u ? mine : 1u; nx = cnt > 0u ? cnt : 1u;
}

__device__ __forceinline__ void xcd_barrier(const XcdBarrier& b) {
    asm volatile("s_waitcnt vmcnt(0)" ::: "memory");
    __syncthreads();
    if (threadIdx.x == 0) {
        unsigned* bar = b.bar;
        __builtin_amdgcn_s_waitcnt(0);
        unsigned nloc = b.st[0], nx = b.st[1];
        if (nloc == 0u) { xcd_barrier_complete(bar, b.x, nloc, nx); b.st[0] = nloc; b.st[1] = nx; }
        const unsigned old = xb_add(&bar[XB_XSUB(b.x)], 1u);
        const unsigned gen = old / nloc;
        if (old + 1u == (gen + 1u) * nloc) {
            __builtin_amdgcn_fence(__ATOMIC_RELEASE, "agent");
            asm volatile("s_waitcnt vmcnt(0)" ::: "memory");
            const unsigned og = xb_add(&bar[XB_TOP], 1u);
            const unsigned tg = og / nx;
            if (og + 1u == (tg + 1u) * nx) xb_add(&bar[XB_TOPGEN], 1u);
            else XB_SPIN(xb_ld(&bar[XB_TOPGEN]) == tg, bar);
            __builtin_amdgcn_fence(__ATOMIC_ACQUIRE, "agent");
            xb_add(&bar[XB_XGEN(b.x)], 1u);
            asm volatile("s_waitcnt vmcnt(0)" ::: "memory");
        } else {
            XB_SPIN(xb_ld(&bar[XB_XGEN(b.x)]) == gen, bar);
            __builtin_amdgcn_fence(__ATOMIC_ACQUIRE, "agent");
            asm volatile("s_waitcnt vmcnt(0)" ::: "memory");
        }
    }
    __syncthreads();
}

constexpr size_t WS_BAR = 16384;
#ifndef MK_SPLIT
#define MK_SPLIT 0
#endif
constexpr int N_PHASES = 2 + DEPTH * 14 + 1;
__global__ void __launch_bounds__(NWAVES * 64, 2) mk_fwd(Args args) {
    extern __shared__ __attribute__((aligned(16))) unsigned char lds[];
    Frame F;
    F.lds = (LAS unsigned char*)lds; F.lane = 0; F.wave = __builtin_amdgcn_readfirstlane(threadIdx.x >> 6);
    F.G = gridDim.x; { const int bx = blockIdx.x; F.vcu = (F.G % 8 == 0) ? (bx % 8) * (F.G / 8) + bx / 8 : bx; }
    { volatile LAS unsigned* st_ = (volatile LAS unsigned*)(F.lds + RING_BYTES + 512); if (threadIdx.x < 2) st_[threadIdx.x] = 0u; __syncthreads();
      (void)xcd_barrier_post((unsigned*)(AWS + WS_BAR), st_); }
    const int lo = args.ph_lo, hi = args.ph_hi; int ph = 0;
#ifndef ONLY_MASK
#define ONLY_MASK 0xffffffffu
#endif
#define SEL(n) ((ONLY_MASK >> (n)) & 1u)
#define PH_BEGIN if (lo <= ph && ph < hi) { { int l_; asm volatile("v_mbcnt_lo_u32_b32 %0, -1, 0\n\tv_mbcnt_hi_u32_b32 %0, -1, %0" : "=v"(l_)); F.lane = l_; }
#define PH_END   if (ph + 1 < hi) { asm volatile("s_waitcnt vmcnt(0) lgkmcnt(0)" ::: "memory");   \
        if (ph == 0) cg::this_grid().sync();   \
        else { XcdBarrier xb_; xb_.bar = (unsigned*)(AWS + WS_BAR); xb_.x = xb_xcc_id(); xb_.st = (volatile LAS unsigned*)(F.lds + RING_BYTES + 512); xcd_barrier(xb_); } } } ++ph;
#define GEMM(EPI, SCHEDT, A_, B_, K_, S_, E_) pg8::gemm_phase<EPI, SCHEDT, true, true>(F.lds, pg8::Gemm{(const pg8::bf16_t*)(A_), (const pg8::bf16_t*)(B_), 0, 0, (K_)}, S_, E_, F.wave * 64 + F.lane)
    float* XC = WSP(float, WS_XC);
    PH_BEGIN if (SEL(1)) { prep_layer(F, 0); __syncthreads(); mod_phase(F); } PH_END
#pragma unroll 1
    for (int l = 0; l < DEPTH; ++l) {
        const bool last = (l == DEPTH - 1);
        const float* MODl = WSP(float, WS_MOD) + (size_t)l * 3 * NSUBMOD;
        const float* srcL = l == 0 ? AIN(0) : AOUT; const float* srcC = l == 0 ? AIN(2) : XC;
        PH_BEGIN if (SEL(2)) { if (l > 0) { prep_layer(F, l); } norm_phase(F, l, 0, srcL, srcC); } PH_END
#pragma unroll 1
        for (int f = 0; f < 2; ++f) {
            if (f == 1) {
                PH_BEGIN if (SEL(3)) { { RowOrder S; S.init(1536, F.G, (int)blockIdx.x, false); EpiRoute E{WSP(bf16_t, WS_Q), WSP(bf16_t, WS_K), WSP(bf16_t, WS_V), WSP(bf16_t, WS_A2), WSP(bf16_t, WS_XA)};
                    GEMM(EpiRoute, RowOrder, WSP(bf16, WS_HN), WSP(bf16, WS_WINT), DM, S, E); } } PH_END
                PH_BEGIN if (SEL(4)) { { post_phase(F, l); S5Order S{1, F.G, (int)blockIdx.x}; EpiF32 E{WSP(float, WS_E)}; GEMM(EpiF32, S5Order, WSP(bf16, WS_A2), WSP(bf16, WS_BTE), S5K, S, E); } } PH_END
                PH_BEGIN if (SEL(5)) { { s5_carry_phase(F, l); RowOrder S; S.init(256, F.G, (int)blockIdx.x, last); EpiPlain E{WSP(bf16_t, WS_Y4), 256}; GEMM(EpiPlain, RowOrder, WSP(bf16, WS_DIFF), WSP(bf16, WS_WPT), 256, S, E); } } PH_END
                PH_BEGIN if (SEL(6)) { { S5Order S{2, F.G, (int)blockIdx.x}; EpiS5Y E{WSP(bf16_t, WS_G)}; GEMM(EpiS5Y, S5Order, WSP(bf16, WS_A2), WSP(bf16, WS_BTY), S5K, S, E); } } PH_END
                PH_BEGIN if (SEL(7)) { { RowOrder S; S.init(512, F.G, (int)blockIdx.x, last); EpiGlu E{WSP(bf16_t, WS_Y4) + (size_t)2 * MR * 256}; GEMM(EpiGlu, RowOrder, WSP(bf16, WS_G), WSP(bf16, WS_WGT), 256, S, E);
                    attn_phase(F, l, (char*)lds); } } PH_END
                PH_BEGIN if (SEL(8)) { { RowOrder S; S.init(DM, F.G, (int)blockIdx.x, last);
#pragma unroll 1
                    for (int k = 0; k < 4; ++k) { EpiGate Eg{WSP(bf16_t, WS_GS)}; GEMM(EpiGate, RowOrder, WSP(bf16, WS_HN), WSP(bf16, WS_WINT) + (size_t)(1536 + k * 1024) * DM, DM, S, Eg);
                        const bf16* Ak = WSP(bf16, WS_Y4) + (size_t)k * MR * 256; const bf16* Bk = WSP(bf16, WS_WBT) + (size_t)k * DM * 256;
                        if (k == 0) { EpiMerge<true> Em{WSP(bf16_t, WS_GS), WSP(bf16_t, WS_T)}; GEMM(EpiMerge<true>, RowOrder, Ak, Bk, 256, S, Em); }
                        else { EpiMerge<false> Em{WSP(bf16_t, WS_GS), WSP(bf16_t, WS_T)}; GEMM(EpiMerge<false>, RowOrder, Ak, Bk, 256, S, Em); } } } } PH_END
                PH_BEGIN if (SEL(9)) { { RowOrder S; S.init(DM, F.G, (int)blockIdx.x, last); EpiResid E{AOUT, XC, AOUT, XC, MODl + 1 * 3072 + 2048, 1.0f}; GEMM(EpiResid, RowOrder, WSP(bf16, WS_T), WSP(bf16, WS_WOT), DM, S, E); } } PH_END
                PH_BEGIN if (SEL(10)) { norm_phase(F, l, 2, AOUT, XC); } PH_END
            }
            PH_BEGIN if (SEL(11)) { { RowOrder S; S.init(5632, F.G, (int)blockIdx.x, last && f == 1); EpiSwiglu E{WSP(bf16_t, WS_HID)}; GEMM(EpiSwiglu, RowOrder, WSP(bf16, WS_HN), WSP(bf16, WS_W1T) + (size_t)f * 5632 * DM, DM, S, E); } } PH_END
            PH_BEGIN if (SEL(12)) { { RowOrder S; S.init(DM, F.G, (int)blockIdx.x, last && f == 1); const bool first = (l == 0 && f == 0);
                EpiResid E{first ? AIN(0) : AOUT, first ? AIN(2) : XC, AOUT, XC, MODl + (f == 0 ? 0 : 2) * 3072 + 2048, 0.5f};
                GEMM(EpiResid, RowOrder, WSP(bf16, WS_HID), WSP(bf16, WS_W2T) + (size_t)f * DM * DFF, DFF, S, E); } } PH_END
            if (f == 0) { PH_BEGIN if (SEL(13)) { norm_phase(F, l, 1, AOUT, XC); } PH_END }
        }
    }
    PH_BEGIN if (SEL(14)) { final_norm_phase(F); } PH_END
}

extern "C" void kernel_launch(void* const* d_in, const int* in_sizes, int n_in, void* d_out, int out_size, void* d_ws, size_t ws_size, hipStream_t stream) {
    static int grid = 0;
    if (grid == 0) {
        int dev = 0, cus = 0, per_cu = 0;
        if (n_in != 26 || ws_size < WS_END) { fprintf(stderr, "kernel_launch: unexpected inputs (n_in %d, ws %zu < %zu)\n", n_in, ws_size, (size_t)WS_END); grid = -1; return; }
        hipGetDevice(&dev); hipDeviceGetAttribute(&cus, hipDeviceAttributeMultiprocessorCount, dev);
        hipFuncSetAttribute((const void*)mk_fwd, hipFuncAttributeMaxDynamicSharedMemorySize, LDS_BYTES);
        hipOccupancyMaxActiveBlocksPerMultiprocessor(&per_cu, (const void*)mk_fwd, NWAVES * 64, LDS_BYTES);
        if (per_cu < 1) { fprintf(stderr, "kernel_launch: occupancy query says %d blocks per CU\n", per_cu); per_cu = 1; }
        (void)hipGetLastError();
        grid = cus * per_cu;
    }
    if (grid < 0) return;
    Args a{};
    for (int i = 0; i < 26; ++i) a.in[i] = (const float*)d_in[i];
    a.out = (float*)d_out; a.ws = (unsigned char*)d_ws;
#if MK_SPLIT
    for (int p = 0; p < N_PHASES; ++p) { a.ph_lo = p; a.ph_hi = p + 1; hipLaunchKernelGGL(mk_fwd, dim3(grid), dim3(NWAVES * 64), LDS_BYTES, stream, a); }
#else
    if (hipMemsetAsync((char*)d_ws + WS_BAR, 0, 65536, stream) != hipSuccess) { fprintf(stderr, "kernel_launch: memset of the barrier words failed\n"); return; }
    a.ph_lo = 0; a.ph_hi = N_PHASES;
    void* kargs[] = {&a};
    hipError_t e = hipLaunchCooperativeKernel((const void*)mk_fwd, dim3(grid), dim3(NWAVES * 64), kargs, LDS_BYTES, stream);
    if (e != hipSuccess) fprintf(stderr, "cooperative launch failed: %s (grid %d)\n", hipGetErrorString(e), grid);
#endif
}
```

```cpp
#include <hip/hip_cooperative_groups.h>
#include <hip/hip_runtime.h>
#include <cstdio>
#include <cstdint>
namespace pg8 {
#define PG8_LAS __attribute__((address_space(3)))
typedef unsigned short bf16_t;
typedef short bf16x8 __attribute__((ext_vector_type(8)));
typedef float f32x4 __attribute__((ext_vector_type(4)));
typedef unsigned u32x4 __attribute__((ext_vector_type(4)));
constexpr int BM = 256, BK = 64, HALF = 128, HTB = HALF * BK * 2  , STAGE_BYTES = 8 * HTB, NXCD = 8, WGM = 8;

__host__ __device__ __forceinline__ int lds_byte(int r, int c) { const int st = (r >> 4) * 2 + (c >> 5), rr = r & 15, cc = c & 31, ob = rr * 64 + cc * 2; return st * 1024 + (ob ^ (((ob >> 9) & 1) << 5)); }
__host__ __device__ __forceinline__ void stage_rc(int b, int& R, int& C) { const int st = b / 1024, sb = b % 1024, swz = sb ^ (((sb >> 9) & 1) << 5); R = (st >> 1) * 16 + swz / 64; C = (st & 1) * 32 + (swz % 64) / 2; }
__host__ __device__ __forceinline__ int perm32(int rho) { const int n = rho >> 4, i = rho & 15; return 8 * (i >> 2) + 4 * n + (i & 3); }

struct Unit { int pm, pn; };
struct Gemm { const bf16_t* A; const bf16_t* Bt; int M, N, K; };

struct StaticOrder {
    int nM, nN, nwg, G, c;
    __host__ __device__ void init(int M, int N, int G_, int c_) { nM = M / BM; nN = N / BM; nwg = nM * nN; G = G_; c = c_; }
    __host__ __device__ bool next(int i, Unit& u) const {
        const long L = (long)i * G + c; if (L >= nwg) return false;
        int wgid = (int)L; { const int q = nwg / NXCD, r = nwg % NXCD, xcd = wgid % NXCD, off = wgid / NXCD; wgid = (xcd < r ? xcd * (q + 1) : r * (q + 1) + (xcd - r) * q) + off; }
        const int nig = WGM * nN, gid = wgid / nig, fm = gid * WGM, gsz = (nM - fm) < WGM ? (nM - fm) : WGM;
        u.pm = fm + ((wgid % nig) % gsz); u.pn = (wgid % nig) / gsz; return true;
    }
    __device__ __forceinline__ void a_ready(const Unit&) const {}
    __device__ __forceinline__ void done(const Unit&) const {}
};

typedef float f32x2cv __attribute__((ext_vector_type(2))); typedef __bf16 bf16x2cv __attribute__((ext_vector_type(2)));
__device__ __forceinline__ unsigned cvt_pk_bf16(float lo, float hi) { f32x2cv v = {lo, hi}; bf16x2cv b = __builtin_convertvector(v, bf16x2cv); return __builtin_bit_cast(unsigned, b); }
typedef float f32x2 __attribute__((ext_vector_type(2)));
template <class Epi, class Sched, bool ALIGN_EPI = false, bool SP2 = false>
__device__ __forceinline__ void gemm_phase(PG8_LAS unsigned char* lds, const Gemm g, const Sched& S, const Epi& E, int tid) {
    float zf = 0.f; asm volatile("" : "+v"(zf));
    const int wid = __builtin_amdgcn_readfirstlane(tid >> 6), lane = tid & 63, wr = wid >> 2, wc = wid & 3, fr = lane & 15, fq = lane >> 4;
    const int K = g.K, nt = K / BK;
    unsigned voffA[2], voffB[2];
#pragma unroll
    for (int i = 0; i < 2; ++i) { int R, C; stage_rc(tid * 16 + i * 8192, R, C); const int Rb = Epi::PERM ? ((R & ~31) + perm32(R & 31)) : R;
        voffA[i] = (unsigned)(R * K + C) * 2u; voffB[i] = (unsigned)(Rb * K + C) * 2u; }
    const size_t kstep = (size_t)(BK * 2);
    const size_t hstep = (size_t)HALF * K * 2;
    const size_t tstep = 2 * hstep;
    const unsigned ldsw = (unsigned)wid * 1024u;
    const int aoff = lds_byte(wr * 64 + fr, fq * 8), boff = lds_byte(wc * 32 + fr, fq * 8);
#define PG8_SA(b, h) (((b) * 2 + (h)) * HTB)
#define PG8_SB(b, h) ((4 + (b) * 2 + (h)) * HTB)
#define PG8_STAGE(bufoff, gbase, voff) do { _Pragma("unroll") for (int _i = 0; _i < 2; ++_i) \
        __builtin_amdgcn_global_load_lds((const unsigned*)((const char*)(gbase) + (voff)[_i]), (PG8_LAS unsigned*)(lds + (bufoff) + ldsw + _i * 8192), 16, 0, 0); } while (0)
#define PG8_LDA(dst, b, h) do { _Pragma("unroll") for (int m = 0; m < 4; ++m) _Pragma("unroll") for (int k = 0; k < 2; ++k) dst[m][k] = *(const PG8_LAS bf16x8*)(lds + PG8_SA(b, h) + aoff + m * 2048 + k * 1024); } while (0)
#define PG8_LDB(dst, b, h) do { _Pragma("unroll") for (int n = 0; n < 2; ++n) _Pragma("unroll") for (int k = 0; k < 2; ++k) dst[n][k] = *(const PG8_LAS bf16x8*)(lds + PG8_SB(b, h) + boff + n * 2048 + k * 1024); } while (0)
#define PG8_MMA(ai, bj, At, Bt) do { __builtin_amdgcn_s_setprio(1); _Pragma("unroll") for (int m = 0; m < 4; ++m) _Pragma("unroll") for (int n = 0; n < 2; ++n) _Pragma("unroll") for (int k = 0; k < 2; ++k) \
        acc[ai][bj][m][n] = __builtin_amdgcn_mfma_f32_16x16x32_bf16(Bt[n][k], At[m][k], acc[ai][bj][m][n], 0, 0, 0); __builtin_amdgcn_s_setprio(0); } while (0)
#define PG8_WAIT_V(n) asm volatile("s_waitcnt vmcnt(" #n ")" ::: "memory")
#define PG8_WAIT_L(n) asm volatile("s_waitcnt lgkmcnt(" #n ")" ::: "memory")
#define PG8_BAR __builtin_amdgcn_s_barrier()
#define PG8_SCHED __builtin_amdgcn_sched_barrier(0)
    Unit cur, nxt; int ui = 0;
    if (!S.next(0, cur)) return;
    f32x4 acc[2][2][4][2];
#pragma unroll
    for (int a = 0; a < 2; ++a)
#pragma unroll
        for (int b = 0; b < 2; ++b)
#pragma unroll
            for (int m = 0; m < 4; ++m)
#pragma unroll
                for (int n = 0; n < 2; ++n) acc[a][b][m][n] = (f32x4){zf, zf, zf, zf};
    bf16x8 At[4][2], B0[2][2], B1[2][2];
    const char* cA = (const char*)g.A + (size_t)cur.pm * tstep; const char* cB = (const char*)g.Bt + (size_t)cur.pn * tstep;
    S.a_ready(cur);
    if constexpr (SP2) {
        PG8_STAGE(PG8_SB(0, 0), cB, voffB); PG8_STAGE(PG8_SB(0, 1), cB + hstep, voffB); PG8_STAGE(PG8_SA(0, 0), cA, voffA); PG8_STAGE(PG8_SA(0, 1), cA + hstep, voffA);
        if (wr == 1) PG8_BAR;
        PG8_WAIT_V(2); PG8_BAR;
        PG8_STAGE(PG8_SB(1, 0), cB + kstep, voffB); PG8_STAGE(PG8_SA(1, 0), cA + kstep, voffA); PG8_STAGE(PG8_SB(1, 1), cB + hstep + kstep, voffB);
        PG8_WAIT_V(6); PG8_BAR;
    } else {
        PG8_STAGE(PG8_SB(0, 0), cB, voffB); PG8_STAGE(PG8_SA(0, 0), cA, voffA); PG8_STAGE(PG8_SB(0, 1), cB + hstep, voffB); PG8_STAGE(PG8_SA(0, 1), cA + hstep, voffA);
        if (wr == 1) PG8_BAR;
        PG8_WAIT_V(4); PG8_BAR;
        PG8_STAGE(PG8_SB(1, 0), cB + kstep, voffB); PG8_STAGE(PG8_SA(1, 0), cA + kstep, voffA); PG8_STAGE(PG8_SB(1, 1), cB + hstep + kstep, voffB);
        PG8_WAIT_V(6); PG8_BAR;
    }
    for (;;) {
        const bool has_next = S.next(ui + 1, nxt);
        const char* nA = has_next ? (const char*)g.A + (size_t)nxt.pm * tstep : cA; const char* nB = has_next ? (const char*)g.Bt + (size_t)nxt.pn * tstep : cB;
#pragma nounroll
        for (int t = 0; t < nt; t += 2) {
            const bool last = (t == nt - 2);
            const char* a1 = cA + (size_t)(t + 1) * kstep;
            const char* a2 = last ? nA : cA + (size_t)(t + 2) * kstep; const char* b2 = last ? nB : cB + (size_t)(t + 2) * kstep;
            const char* a3 = a2 + kstep; const char* b3 = b2 + kstep;
            if (last && has_next) S.a_ready(nxt);
            if constexpr (SP2) {
            PG8_LDB(B0, 0, 0); PG8_LDB(B1, 0, 1); PG8_SCHED; PG8_LDA(At, 0, 0); PG8_STAGE(PG8_SA(1, 1), a1 + hstep, voffA);
            PG8_WAIT_V(8); PG8_WAIT_L(0); PG8_BAR; PG8_MMA(0, 0, At, B0); PG8_MMA(0, 1, At, B1); PG8_BAR; PG8_SCHED;
            PG8_LDA(At, 0, 1); PG8_STAGE(PG8_SB(0, 0), b2, voffB); PG8_STAGE(PG8_SB(0, 1), b2 + hstep, voffB); PG8_STAGE(PG8_SA(0, 0), a2, voffA);
            PG8_WAIT_V(8); PG8_WAIT_L(0); PG8_BAR; PG8_MMA(1, 0, At, B0); PG8_MMA(1, 1, At, B1); PG8_BAR; PG8_SCHED;
            PG8_LDB(B0, 1, 0); PG8_LDB(B1, 1, 1); PG8_SCHED; PG8_LDA(At, 1, 0); PG8_STAGE(PG8_SA(0, 1), a2 + hstep, voffA);
            PG8_WAIT_V(8); PG8_WAIT_L(0); PG8_BAR; PG8_MMA(0, 0, At, B0); PG8_MMA(0, 1, At, B1); PG8_BAR; PG8_SCHED;
            PG8_LDA(At, 1, 1); PG8_STAGE(PG8_SB(1, 0), b3, voffB); PG8_STAGE(PG8_SB(1, 1), b3 + hstep, voffB); PG8_STAGE(PG8_SA(1, 0), a3, voffA);
            PG8_WAIT_V(8); PG8_WAIT_L(0); PG8_BAR; PG8_MMA(1, 0, At, B0); PG8_MMA(1, 1, At, B1); PG8_BAR; PG8_SCHED;
            } else {
            PG8_LDB(B0, 0, 0); PG8_SCHED; PG8_LDA(At, 0, 0); PG8_STAGE(PG8_SA(1, 1), a1 + hstep, voffA);
            PG8_WAIT_L(8); PG8_BAR; PG8_WAIT_L(0); PG8_MMA(0, 0, At, B0); PG8_BAR; PG8_SCHED;
            PG8_LDB(B1, 0, 1); PG8_STAGE(PG8_SB(0, 0), b2, voffB);
            PG8_BAR; PG8_WAIT_L(0); PG8_MMA(0, 1, At, B1); PG8_BAR;
            PG8_LDA(At, 0, 1); PG8_STAGE(PG8_SA(0, 0), a2, voffA);
            PG8_BAR; PG8_WAIT_L(0); PG8_MMA(1, 0, At, B0); PG8_BAR; PG8_SCHED;
            PG8_STAGE(PG8_SB(0, 1), b2 + hstep, voffB);
            PG8_WAIT_V(6); PG8_BAR; PG8_MMA(1, 1, At, B1); PG8_BAR;
            PG8_LDB(B0, 1, 0); PG8_SCHED; PG8_LDA(At, 1, 0); PG8_STAGE(PG8_SA(0, 1), a2 + hstep, voffA);
            PG8_WAIT_L(8); PG8_BAR; PG8_WAIT_L(0); PG8_MMA(0, 0, At, B0); PG8_BAR; PG8_SCHED;
            PG8_LDB(B1, 1, 1); PG8_STAGE(PG8_SB(1, 0), b3, voffB);
            PG8_BAR; PG8_WAIT_L(0); PG8_MMA(0, 1, At, B1); PG8_BAR;
            PG8_LDA(At, 1, 1); PG8_STAGE(PG8_SA(1, 0), a3, voffA);
            PG8_BAR; PG8_WAIT_L(0); PG8_MMA(1, 0, At, B0); PG8_BAR; PG8_SCHED;
            PG8_STAGE(PG8_SB(1, 1), b3 + hstep, voffB);
            PG8_WAIT_V(6); PG8_BAR; PG8_MMA(1, 1, At, B1); PG8_BAR;
            }
        }
        if constexpr (ALIGN_EPI) { if (wr == 0) PG8_BAR; }
        if constexpr (!Epi::AFTER_DRAIN) { E(acc, cur, wr, wc, fr, fq); S.done(cur); }
        if (!has_next) break;
#pragma unroll
        for (int a = 0; a < 2; ++a)
#pragma unroll
            for (int b = 0; b < 2; ++b)
#pragma unroll
                for (int m = 0; m < 4; ++m)
#pragma unroll
                    for (int n = 0; n < 2; ++n) acc[a][b][m][n] = (f32x4){zf, zf, zf, zf};
        cur = nxt; cA = nA; cB = nB; ++ui;
        if constexpr (ALIGN_EPI) { if (wr == 1) PG8_BAR; }
    }
    PG8_WAIT_V(0);
    if constexpr (!ALIGN_EPI) { if (wr == 0) PG8_BAR; }
    PG8_BAR;
    if constexpr (Epi::AFTER_DRAIN) { E.fused(acc, cur, wr, wc, fr, fq, lds, wid, lane); S.done(cur); }
#undef PG8_SA
#undef PG8_SB
#undef PG8_STAGE
#undef PG8_LDA
#undef PG8_LDB
#undef PG8_MMA
#undef PG8_WAIT_V
#undef PG8_WAIT_L
#undef PG8_BAR
#undef PG8_SCHED
}
}
namespace cg = cooperative_groups;
#include <hip/hip_bf16.h>
#include <cmath>
namespace attn_body {
using bf16=__hip_bfloat16;
using bf16x8=__attribute__((ext_vector_type(8)))short;
using s16x4=__attribute__((ext_vector_type(4)))short;
using f32x16=__attribute__((ext_vector_type(16)))float;
using u32x4=__attribute__((ext_vector_type(4)))unsigned;
constexpr int D=64,QP=512,KP=256,OP=256;
constexpr int NW=8,QBLK=32,QB=QBLK*NW,KVBLK=64;
__device__ __forceinline__ int crow(int r,int hi){return (r&3)+8*(r>>2)+4*hi;}
#define SBAR() __builtin_amdgcn_sched_barrier(0)
__device__ __forceinline__ void wmask(f32x16&p0,f32x16&p1,int dbase){
  const float NEG=-INFINITY;
  #pragma unroll
  for(int r=0;r<16;++r){int d=dbase+(r&3)+8*(r>>2); if((unsigned)(d+128)>256u)p0[r]=NEG; if((unsigned)(d+160)>256u)p1[r]=NEG;}
}

constexpr int NSLOT=3, SLOTB=8192;
constexpr int LDS_K=0, LDS_V=NSLOT*SLOTB, LDS_WS=2*NSLOT*SLOTB, LDS_OST=LDS_WS+NW*64*4, LDS_BYTES=LDS_OST+NW*4096;
constexpr float C2=0.125f*1.4426950408889634f;
__device__ __forceinline__ void glds16(const void*gsrc,unsigned lds_dst){unsigned keep;
  asm volatile("s_mov_b32 %0, m0\n\ts_mov_b32 m0, %2\n\ts_nop 0\n\tglobal_load_lds_dwordx4 %1, off\n\ts_mov_b32 m0, %0":"=&s"(keep):"v"(gsrc),"s"(lds_dst):"memory");}
__device__ __forceinline__ float max3f(float a,float b,float c){float r;asm("v_max3_f32 %0, %1, %2, %3":"=v"(r):"v"(a),"v"(b),"v"(c));return r;}
__device__ __forceinline__ float max2f(float a,float b){float r;asm("v_max_f32_e32 %0, %1, %2":"=v"(r):"v"(a),"v"(b));return r;}
__device__ __forceinline__ float fadd_s(float a,float b){float r;asm("v_add_f32_e32 %0, %1, %2":"=v"(r):"v"(a),"v"(b));return r;}
__device__ __forceinline__ float fsub_s(float a,float b){float r;asm("v_sub_f32_e32 %0, %1, %2":"=v"(r):"v"(a),"v"(b));return r;}
typedef float f32x2_t __attribute__((ext_vector_type(2))); typedef __bf16 bf16x2_t __attribute__((ext_vector_type(2)));
__device__ __forceinline__ unsigned cvtpk_s(float lo,float hi){f32x2_t v={lo,hi};bf16x2_t b=__builtin_convertvector(v,bf16x2_t);return __builtin_bit_cast(unsigned,b);}
#define WAIT_BAR(N) asm volatile("s_waitcnt vmcnt(" #N ") lgkmcnt(0)\n\ts_barrier":::"memory")

__device__ __forceinline__ void qkt(f32x16&p0,f32x16&p1,const char*Kslot,const bf16x8*qr,const f32x16&negm,int r32,int hi){
  const char*kb=Kslot+hi*1024+r32*16;
  #pragma unroll
  for(int d0=0;d0<4;++d0){
    const bf16x8 b0=*reinterpret_cast<const bf16x8*>(kb+d0*2048);
    const bf16x8 b1=*reinterpret_cast<const bf16x8*>(kb+d0*2048+512);
    if(d0==0){p0=__builtin_amdgcn_mfma_f32_32x32x16_bf16(b0,qr[0],negm,0,0,0);p1=__builtin_amdgcn_mfma_f32_32x32x16_bf16(b1,qr[0],negm,0,0,0);}
    else{p0=__builtin_amdgcn_mfma_f32_32x32x16_bf16(b0,qr[d0],p0,0,0,0);p1=__builtin_amdgcn_mfma_f32_32x32x16_bf16(b1,qr[d0],p1,0,0,0);}}
}
typedef __attribute__((address_space(3))) const char* lds_cptr;
typedef short v4i16_t __attribute__((ext_vector_type(4)));
__device__ __forceinline__ void kload8(bf16x8*kf,lds_cptr kp){
  kf[0]=*(const __attribute__((address_space(3))) bf16x8*)(kp);      kf[1]=*(const __attribute__((address_space(3))) bf16x8*)(kp+512);
  kf[2]=*(const __attribute__((address_space(3))) bf16x8*)(kp+2048); kf[3]=*(const __attribute__((address_space(3))) bf16x8*)(kp+2560);
  kf[4]=*(const __attribute__((address_space(3))) bf16x8*)(kp+4096); kf[5]=*(const __attribute__((address_space(3))) bf16x8*)(kp+4608);
  kf[6]=*(const __attribute__((address_space(3))) bf16x8*)(kp+6144); kf[7]=*(const __attribute__((address_space(3))) bf16x8*)(kp+6656);
}
__device__ __forceinline__ void kload2(bf16x8*kf,lds_cptr kp,int j){ kf[2*j]=*(const __attribute__((address_space(3))) bf16x8*)(kp+j*2048); kf[2*j+1]=*(const __attribute__((address_space(3))) bf16x8*)(kp+j*2048+512); }
__device__ __forceinline__ s16x4 vtr(lds_cptr p){ return __builtin_bit_cast(s16x4,__builtin_amdgcn_ds_read_tr16_b64_v4i16((__attribute__((address_space(3))) v4i16_t*)p)); }
__device__ __forceinline__ float rowmax(const f32x16&p0,const f32x16&p1){
  float a=max3f(p0[0],p0[1],p1[0]),b=max3f(p0[2],p0[3],p1[1]);a=max3f(a,p1[2],p1[3]);
  #pragma unroll
  for(int r=4;r<16;r+=4){a=max3f(a,p0[r],p0[r+1]);b=max3f(b,p0[r+2],p0[r+3]);a=max3f(a,p1[r],p1[r+1]);b=max3f(b,p1[r+2],p1[r+3]);}
  const float m=max2f(a,b);
  auto rr=__builtin_amdgcn_permlane32_swap(__float_as_uint(m),__float_as_uint(m),false,false);
  return max2f(__uint_as_float(rr[0]),__uint_as_float(rr[1]));
}
__device__ __forceinline__ void pv(f32x16*o,int vb,bf16x8 pa0,bf16x8 pa1,bf16x8 pa2,bf16x8 pa3){
  #pragma unroll
  for(int d0=0;d0<2;++d0){s16x4 lo[4],hi[4];
    #pragma unroll
    for(int ks=0;ks<4;++ks){
      asm volatile("ds_read_b64_tr_b16 %0,%1 offset:%c2":"=&v"(lo[ks]):"v"(vb),"i"(d0*4096+ks*1024):"memory");
      asm volatile("ds_read_b64_tr_b16 %0,%1 offset:%c2":"=&v"(hi[ks]):"v"(vb),"i"(d0*4096+ks*1024+512):"memory");}
    asm volatile("s_waitcnt lgkmcnt(0)":::"memory");SBAR();
    #define PK(k) (bf16x8){lo[k][0],lo[k][1],lo[k][2],lo[k][3],hi[k][0],hi[k][1],hi[k][2],hi[k][3]}
    o[d0]=__builtin_amdgcn_mfma_f32_32x32x16_bf16(pa0,PK(0),o[d0],0,0,0);
    o[d0]=__builtin_amdgcn_mfma_f32_32x32x16_bf16(pa1,PK(1),o[d0],0,0,0);
    o[d0]=__builtin_amdgcn_mfma_f32_32x32x16_bf16(pa2,PK(2),o[d0],0,0,0);
    o[d0]=__builtin_amdgcn_mfma_f32_32x32x16_bf16(pa3,PK(3),o[d0],0,0,0);
    #undef PK
  }
}

#ifndef ATTN_STORE16
#define ATTN_STORE16(p,v) (*(u32x4*)(p)=(v))
#endif
template<int THRL,bool WIN> __device__ __forceinline__ void attn_unit(const bf16*Qu,const bf16*__restrict__ Kh,const bf16*__restrict__ Vh,bf16*Ou,int NT,int shift,int qpos0,float sinkl2,char*shm,int tid){
  const int lane=tid&63,r32=lane&31,hi=lane>>5; const int wid=__builtin_amdgcn_readfirstlane(tid>>6);
  const bf16*Qw=Qu+(long)(wid*QBLK)*QP;
  const unsigned lds0=(unsigned)(uintptr_t)shm;
  float*wsf=(float*)(shm+LDS_WS)+wid*64;
  const bf16*ksrc=Kh+(long)lane*KP+wid*8;
  const bf16*vsrc=Vh+(long)(16*(wid&3)+(lane>>2))*KP+(wid>>2)*32+(lane&3)*8;
  const unsigned kdst=lds0+LDS_K+wid*1024, vdst=lds0+LDS_V+wid*1024;
  #define KROW(t) ((long)(((t)<4)?(t):((t)+shift))*(KVBLK*KP))
  #define DMA_K(t,slot) glds16(ksrc+KROW(t),(unsigned)__builtin_amdgcn_readfirstlane(kdst+(slot)))
  #define DMA_V(t,slot) glds16(vsrc+KROW(t),(unsigned)__builtin_amdgcn_readfirstlane(vdst+(slot)))
  const int vb0=(int)(lds0+LDS_V)+((lane>>4)&1)*32+(lane&3)*8+(4*hi+((lane&15)>>2))*64;
  const char*Kbase=shm+LDS_K; bf16x8 kf[8];
  const lds_cptr shm3=(lds_cptr)shm; const lds_cptr kp0=shm3+LDS_K+hi*1024+r32*16; const lds_cptr vp0=shm3+LDS_V+((lane>>4)&1)*32+(lane&3)*8+(4*hi+((lane&15)>>2))*64;
  DMA_K(0,0);DMA_V(0,0);DMA_K(1,SLOTB);
  bf16x8 qr[4];
  #pragma unroll
  for(int d0=0;d0<4;++d0)qr[d0]=*reinterpret_cast<const bf16x8*>(&Qw[(long)r32*QP+d0*16+hi*8]);
  float zf_=0.f;asm volatile("":"+v"(zf_)); float mhat=zf_,l_reg=zf_;f32x16 o[2];
  #pragma unroll
  for(int r=0;r<16;++r){o[0][r]=zf_;o[1][r]=zf_;}
  f32x16 negm;
  #pragma unroll
  for(int r=0;r<16;++r)negm[r]=zf_;
  asm volatile("":"+v"(negm));
  const int qrel=wid*QBLK+r32;
  const int mbase=4*hi-256-qpos0-qrel;
  #define CMASK(P0,P1,t) do{ if(WIN){ if((t)>=4) wmask(P0,P1,mbase+64*((t)+shift)); } }while(0)
  bool resc=false;
  #define START(P0,P1) do{ const float rm=rowmax(P0,P1); resc=false; \
    { const float dl=rm; mhat=fadd_s(mhat,dl); \
      _Pragma("unroll") for(int r=0;r<16;++r){P0[r]=fsub_s(P0[r],dl);P1[r]=fsub_s(P1[r],dl);} \
      _Pragma("unroll") for(int r=0;r<16;++r)negm[r]=-mhat; asm volatile("":"+v"(negm)); } \
    _Pragma("unroll") for(int r=0;r<16;++r)P0[r]=__builtin_amdgcn_exp2f(P0[r]); }while(0)
  #define RESC() do{ if(resc){ asm volatile("s_waitcnt lgkmcnt(0)":::"memory"); \
      _Pragma("unroll") for(int d_=0;d_<2;++d_) _Pragma("unroll") for(int r=0;r<16;++r)o[d_][r]*=wsf[crow(r,hi)]; } }while(0)
  f32x16 pA0,pA1,pB0,pB1;
  int sl_prev=0,sl_cur=0,sl_next=SLOTB;
  #define ROT() do{sl_prev=sl_cur;sl_cur=sl_next;sl_next=(sl_next==(NSLOT-1)*SLOTB)?0:sl_next+SLOTB;}while(0)
  DMA_K(2,2*SLOTB);
  WAIT_BAR(3);
  qkt(pA0,pA1,Kbase,qr,negm,r32,hi);asm volatile("s_nop 15\n\ts_nop 7":"+v"(pA0),"+v"(pA1));CMASK(pA0,pA1,0);
  START(pA0,pA1);
  _Pragma("unroll") for(int r=0;r<16;++r)pA1[r]=__builtin_amdgcn_exp2f(pA1[r]);
  WAIT_BAR(0);
  DMA_K(3,0);DMA_V(1,SLOTB);
  ROT();
  kload8(kf,kp0+sl_cur);
  WAIT_BAR(2);
  s16x4 vlo[8],vhi[8]; u32x4 pw0,pw1,pw2,pw3;
  #define PKW(P,B) cvtpk_s(P[B],P[B+1])
  #define PAF(k) __builtin_bit_cast(bf16x8,pw##k)
  #define VFR(i) (bf16x8){vlo[i][0],vlo[i][1],vlo[i][2],vlo[i][3],vhi[i][0],vhi[i][1],vhi[i][2],vhi[i][3]}
  #define PIN(x) asm volatile("":"+v"(x))
  #define MX3(a,b,c) __builtin_fmaxf(__builtin_fmaxf((a),(b)),(c))
  #define GAPA(MF,A0,A1,A2,A3,W0,W1,PW) do{ MF; sacc+=A0; sacc+=A1; sacc+=A2; sacc+=A3; PIN(sacc); W0; W1; PIN(PW); SBAR(); }while(0)
  #define EX(v) __builtin_amdgcn_exp2f(v)
  #define GAPB(MF,X,B) do{ MF; X[B]=EX(X[B]); X[B+1]=EX(X[B+1]); X[B+2]=EX(X[B+2]); X[B+3]=EX(X[B+3]); PIN(X); SBAR(); }while(0)
  #define VRD(i) do{ vlo[i]=vtr(vp_+(((i)>>2)*4096+((i)&3)*1024)); vhi[i]=vtr(vp_+(((i)>>2)*4096+((i)&3)*1024+512)); }while(0)
  #define KRD(G,j) do{ if(G){ kload2(kf,kp0+sl_next,j); SBAR(); } }while(0)
  #define STEP(C0,C1,P0,P1,t,GK,GV,GL) do{ SBAR(); \
    const lds_cptr vp_=vp0+sl_prev; \
    VRD(0); SBAR(); float sacc=(P0[0]+P0[1]); \
    GAPA(C0=__builtin_amdgcn_mfma_f32_32x32x16_bf16(kf[0],qr[0],negm,0,0,0), P0[2],P0[3],P0[4],P0[5],     pw0[0]=PKW(P0,0), pw0[1]=PKW(P0,2), pw0); \
    VRD(4); SBAR(); GAPA(C1=__builtin_amdgcn_mfma_f32_32x32x16_bf16(kf[1],qr[0],negm,0,0,0), P0[6],P0[7],P0[8],P0[9],     pw0[2]=PKW(P0,4), pw0[3]=PKW(P0,6), pw0); \
    VRD(1); SBAR(); GAPA(C0=__builtin_amdgcn_mfma_f32_32x32x16_bf16(kf[2],qr[1],C0,0,0,0),   P0[10],P0[11],P0[12],P0[13], pw1[0]=PKW(P0,8), pw1[1]=PKW(P0,10), pw1); \
    VRD(5); SBAR(); GAPA(C1=__builtin_amdgcn_mfma_f32_32x32x16_bf16(kf[3],qr[1],C1,0,0,0),   P0[14],P0[15],P1[0],P1[1],   pw1[2]=PKW(P0,12),pw1[3]=PKW(P0,14), pw1); \
    VRD(2); SBAR(); GAPA(C0=__builtin_amdgcn_mfma_f32_32x32x16_bf16(kf[4],qr[2],C0,0,0,0),   P1[2],P1[3],P1[4],P1[5],     pw2[0]=PKW(P1,0), pw2[1]=PKW(P1,2), pw2); \
    VRD(6); SBAR(); GAPA(C1=__builtin_amdgcn_mfma_f32_32x32x16_bf16(kf[5],qr[2],C1,0,0,0),   P1[6],P1[7],P1[8],P1[9],     pw2[2]=PKW(P1,4), pw2[3]=PKW(P1,6), pw2); \
    VRD(3); SBAR(); GAPA(C0=__builtin_amdgcn_mfma_f32_32x32x16_bf16(kf[6],qr[3],C0,0,0,0),   P1[10],P1[11],P1[12],P1[13], pw3[0]=PKW(P1,8), pw3[1]=PKW(P1,10), pw3); \
    VRD(7); SBAR(); GAPA(C1=__builtin_amdgcn_mfma_f32_32x32x16_bf16(kf[7],qr[3],C1,0,0,0),   P1[14],P1[15],0.f,0.f,       pw3[2]=PKW(P1,12),pw3[3]=PKW(P1,14), pw3); \
    l_reg+=sacc; \
    if(GK){DMA_K((t)+3,sl_cur);} if(GV){DMA_V((t)+1,sl_next);} \
    CMASK(C0,C1,t); \
    { float a=MX3(C0[0],C0[1],C1[0]),b=MX3(C0[2],C0[3],C1[1]); a=MX3(a,C1[2],C1[3]); \
      _Pragma("unroll") for(int r=4;r<16;r+=4){a=MX3(a,C0[r],C0[r+1]);b=MX3(b,C0[r+2],C0[r+3]);a=MX3(a,C1[r],C1[r+1]);b=MX3(b,C1[r+2],C1[r+3]);} \
      float rm=__builtin_fmaxf(a,b); { auto rr=__builtin_amdgcn_permlane32_swap(__float_as_uint(rm),__float_as_uint(rm),false,false); rm=__builtin_fmaxf(__uint_as_float(rr[0]),__uint_as_float(rr[1])); } \
      resc=false; \
      if(__builtin_expect(__any(rm>(float)THRL),0)){ const float dl=__builtin_fmaxf(rm,0.f); mhat+=dl; \
        _Pragma("unroll") for(int r=0;r<16;++r){C0[r]-=dl;C1[r]-=dl;} \
        _Pragma("unroll") for(int r=0;r<16;++r)negm[r]=-mhat; asm volatile("":"+v"(negm)); \
        const float f=__builtin_amdgcn_exp2f(-dl); l_reg*=f; if(hi==0)wsf[r32]=f; resc=true; } } \
    SBAR(); \
    GAPB(o[0]=__builtin_amdgcn_mfma_f32_32x32x16_bf16(PAF(0),VFR(0),o[0],0,0,0), C0,0); \
    GAPB(o[1]=__builtin_amdgcn_mfma_f32_32x32x16_bf16(PAF(0),VFR(4),o[1],0,0,0), C0,4); \
    KRD(GL,0); GAPB(o[0]=__builtin_amdgcn_mfma_f32_32x32x16_bf16(PAF(1),VFR(1),o[0],0,0,0), C0,8); \
    KRD(GL,1); GAPB(o[1]=__builtin_amdgcn_mfma_f32_32x32x16_bf16(PAF(1),VFR(5),o[1],0,0,0), C0,12); \
    KRD(GL,2); GAPB(o[0]=__builtin_amdgcn_mfma_f32_32x32x16_bf16(PAF(2),VFR(2),o[0],0,0,0), C1,0); \
    KRD(GL,3); GAPB(o[1]=__builtin_amdgcn_mfma_f32_32x32x16_bf16(PAF(2),VFR(6),o[1],0,0,0), C1,4); \
    GAPB(o[0]=__builtin_amdgcn_mfma_f32_32x32x16_bf16(PAF(3),VFR(3),o[0],0,0,0), C1,8); \
    GAPB(o[1]=__builtin_amdgcn_mfma_f32_32x32x16_bf16(PAF(3),VFR(7),o[1],0,0,0), C1,12); \
    }while(0)
  int t=1;
  for(;t+5<NT;t+=2){
    STEP(pB0,pB1,pA0,pA1,t,true,true,true);     WAIT_BAR(2); RESC(); ROT();
    STEP(pA0,pA1,pB0,pB1,t+1,true,true,true);   WAIT_BAR(2); RESC(); ROT();
  }
  #define ENDW(tt) do{ if((tt)+3<NT){WAIT_BAR(2);} else if((tt)+2<NT){WAIT_BAR(1);} else {WAIT_BAR(0);} }while(0)
  for(;t+1<NT;t+=2){
    STEP(pB0,pB1,pA0,pA1,t,(t+3<NT),(t+1<NT),(t+1<NT));       ENDW(t);   RESC(); ROT();
    STEP(pA0,pA1,pB0,pB1,t+1,(t+4<NT),(t+2<NT),(t+2<NT));     ENDW(t+1); RESC(); ROT();
  }
  STEP(pB0,pB1,pA0,pA1,NT-1,false,false,false); RESC();
  { float sacc=pB0[0]+pB0[1]; _Pragma("unroll") for(int r=2;r<16;++r)sacc+=pB0[r]; _Pragma("unroll") for(int r=0;r<16;++r)sacc+=pB1[r]; l_reg+=sacc;
    pw0=(u32x4){PKW(pB0,0),PKW(pB0,2),PKW(pB0,4),PKW(pB0,6)};pw1=(u32x4){PKW(pB0,8),PKW(pB0,10),PKW(pB0,12),PKW(pB0,14)};pw2=(u32x4){PKW(pB1,0),PKW(pB1,2),PKW(pB1,4),PKW(pB1,6)};pw3=(u32x4){PKW(pB1,8),PKW(pB1,10),PKW(pB1,12),PKW(pB1,14)};
    SBAR(); pv(o,vb0+sl_cur,PAF(0),PAF(1),PAF(2),PAF(3)); }
  #undef PKW
  #undef PAF
  #undef VFR
  #undef PIN
  #undef MX3
  #undef GAPA
  #undef GAPB
  #undef EX
  #undef VRD
  #undef KRD
  #undef STEP
  #undef ENDW
  {auto rr=__builtin_amdgcn_permlane32_swap(__float_as_uint(l_reg),__float_as_uint(l_reg),false,false);l_reg=__uint_as_float(rr[0])+__uint_as_float(rr[1]);}
  if(WIN)l_reg+=__builtin_amdgcn_exp2f(sinkl2-mhat);
  if(hi==0)wsf[32+r32]=l_reg;asm volatile("s_waitcnt lgkmcnt(0)":::"memory");
  float rli[16];
  #pragma unroll
  for(int r=0;r<16;++r)rli[r]=__builtin_amdgcn_rcpf(wsf[32+crow(r,hi)]);
  bf16*Ow=Ou+(long)(wid*QBLK)*OP;
  { bf16*stg=(bf16*)(shm+LDS_OST)+wid*2048;
    #pragma unroll
    for(int r=0;r<16;++r){const int orow=crow(r,hi);
      #pragma unroll
      for(int d0=0;d0<2;++d0)stg[orow*64+d0*32+r32]=__float2bfloat16(o[d0][r]*rli[r]);}
    asm volatile("s_waitcnt lgkmcnt(0)":::"memory");
    #pragma unroll
    for(int i=0;i<4;++i){const int row=i*8+(lane>>3),ch=lane&7; const u32x4 v=*(const u32x4*)(stg+row*64+ch*8); ATTN_STORE16(Ow+(long)row*OP+ch*8,v);} }
  asm volatile("s_waitcnt lgkmcnt(0)\n\ts_barrier":::"memory");
  #undef DMA_K
  #undef KROW
  #undef DMA_V
  #undef CMASK
  #undef START
  #undef RESC
  #undef ROT
}
constexpr int ATTN_LDS_BYTES=LDS_BYTES;
#undef SBAR
#undef WAIT_BAR
}
constexpr int NWAVES = 8;
constexpr int DM = 1024, NBATCH = 2, SEQ = 16384, CTXL = 256, TOK = SEQ + CTXL  , MR = NBATCH * TOK  ;
constexpr int DFF = 2816, NSUBMOD = 9216, DEPTH = 2;
constexpr float EPS = 1e-6f, LOG2E = 1.4426950408889634f;
constexpr int S5L = 32, S5ROWS = 1280  , S5CH = MR / S5L  , S5K = 768;

typedef unsigned short bf16;
typedef unsigned v4u __attribute__((ext_vector_type(4)));
typedef float f32x4 __attribute__((ext_vector_type(4)));
#define LAS __attribute__((address_space(3)))
#define LDS_WAIT() asm volatile("s_waitcnt lgkmcnt(0)" ::: "memory")
__device__ __forceinline__ unsigned f2bf(float f) { unsigned u = __builtin_bit_cast(unsigned, f); return (u + 0x7fffu + ((u >> 16) & 1u)) >> 16; }
__device__ __forceinline__ unsigned pk2(float lo, float hi) { return f2bf(lo) | (f2bf(hi) << 16); }
__device__ __forceinline__ float bf2f(unsigned short h) { return __builtin_bit_cast(float, (unsigned)h << 16); }
__device__ __forceinline__ float sigm(float x) { return __builtin_amdgcn_rcpf(1.0f + __builtin_amdgcn_exp2f(-x * LOG2E)); }

constexpr size_t MiB = 1u << 20;
constexpr size_t WS_MOD = 1 * MiB, WS_XC = 2 * MiB;
constexpr size_t WS_W1T = 4 * MiB, WS_W2T = 26 * MiB, WS_WINT = 37 * MiB, WS_WBT = 48 * MiB, WS_WOT = 50 * MiB, WS_WGT = 52 * MiB, WS_WPT = 52 * MiB + 256 * 1024;
constexpr size_t WS_BTY = 53 * MiB, WS_BTE = 65 * MiB, WS_E = 71 * MiB, WS_A2 = 91 * MiB, WS_HN = 121 * MiB, WS_T = 186 * MiB;
constexpr size_t WS_R = 251 * MiB;
constexpr size_t WS_HID = WS_R, WS_GS = WS_R, WS_Q = WS_R + 65 * MiB, WS_K = WS_Q + 65 * MiB / 2, WS_V = WS_K + 65 * MiB / 4, WS_XA = WS_V + 65 * MiB / 4, WS_G = WS_XA + 65 * MiB / 4,
                 WS_DIFF = WS_G + 65 * MiB / 4, WS_Y4 = WS_DIFF + 65 * MiB / 4, WS_END = WS_Y4 + 65 * MiB;
static_assert(WS_END <= 512 * MiB && WS_HID + (size_t)MR * DFF * 2 <= WS_Y4 + 65 * MiB, "ws map");
constexpr int RING_BYTES = 131072, LDS_BYTES = 147456;

struct Args { const float* in[26]; float* out; unsigned char* ws; int ph_lo, ph_hi; };
struct Frame { LAS unsigned char* lds; int lane, wave, vcu, G; };
typedef const volatile __attribute__((address_space(4))) unsigned long long karg_t;
__device__ __forceinline__ unsigned long long karg(int i) { return ((karg_t*)__builtin_amdgcn_kernarg_segment_ptr())[i]; }
#define AIN(i) ((const float*)karg(i))
#define AOUT ((float*)karg(26))
#define AWS ((unsigned char*)karg(27))
#define WSP(T, off) ((T*)(AWS + (off)))

__device__ __forceinline__ float* xrow_ptr(float* lat, float* ctxp, int r) { const int b = r / TOK, i = r - b * TOK; return i < CTXL ? ctxp + (size_t)(b * CTXL + i) * DM : lat + (size_t)(b * SEQ + i - CTXL) * DM; }

using pg8::f32x4; using pg8::Unit; using pg8::bf16_t; using pg8::cvt_pk_bf16; using pg8::u32x4;
#define EPI_ARGS const pg8::f32x4 (&acc)[2][2][4][2], const pg8::Unit& u, int wr, int wc, int fr_, int fq_
#define EPI_PIN int fr = fr_, fq = fq_; asm volatile("" : "+v"(fr), "+v"(fq));
struct EpiSwiglu { static constexpr bool PERM = true, AFTER_DRAIN = false; bf16_t* H;
    __device__ __forceinline__ void operator()(EPI_ARGS) const { EPI_PIN
        const int row0 = u.pm * 256 + wr * 64 + fr, hc = u.pn * 128 + wc * 32 + 8 * fq;
#pragma unroll
        for (int ai = 0; ai < 2; ++ai)
#pragma unroll
            for (int m = 0; m < 4; ++m) { bf16_t* rowp = H + (size_t)(row0 + ai * 128 + m * 16) * DFF + hc; float v[8];
#pragma unroll
                for (int n = 0; n < 2; ++n)
#pragma unroll
                    for (int j = 0; j < 4; ++j) { const float g = acc[ai][0][m][n][j], up = acc[ai][1][m][n][j]; v[n * 4 + j] = g * sigm(g) * up; }
                u32x4 w; w.x = cvt_pk_bf16(v[0], v[1]); w.y = cvt_pk_bf16(v[2], v[3]); w.z = cvt_pk_bf16(v[4], v[5]); w.w = cvt_pk_bf16(v[6], v[7]); *(u32x4*)rowp = w; }
    }
};
struct EpiResid { static constexpr bool PERM = true, AFTER_DRAIN = false; const float* src_lat; const float* src_ctx; float* dst_lat; float* dst_ctx; const float* gate; float sc;
    __device__ __forceinline__ void operator()(EPI_ARGS) const { EPI_PIN
        const int b = u.pm / 65, tq = u.pm - b * 65; const bool isc = tq == 0;
        const size_t off = isc ? (size_t)b * CTXL * DM : ((size_t)b * SEQ + (size_t)(tq - 1) * 256) * DM;
        const float* sp = (isc ? src_ctx : src_lat) + off; float* dp = (isc ? dst_ctx : dst_lat) + off;
        const float* gp = gate + (isc ? 2 : b) * NSUBMOD; const int col0 = u.pn * 256 + wc * 32 + 8 * fq;
        f32x4 gv[2][2];
#pragma unroll
        for (int bj = 0; bj < 2; ++bj)
#pragma unroll
            for (int n = 0; n < 2; ++n) gv[bj][n] = *(const f32x4*)(gp + col0 + bj * 128 + 4 * n) * sc;
#pragma unroll
        for (int ai = 0; ai < 2; ++ai)
#pragma unroll
            for (int m = 0; m < 4; ++m) { const size_t ro = (size_t)(ai * 128 + wr * 64 + m * 16 + fr) * DM + col0;
#pragma unroll
                for (int bj = 0; bj < 2; ++bj)
#pragma unroll
                    for (int n = 0; n < 2; ++n) { const f32x4 xv = *(const f32x4*)(sp + ro + bj * 128 + 4 * n); *(f32x4*)(dp + ro + bj * 128 + 4 * n) = xv + gv[bj][n] * acc[ai][bj][m][n]; } }
    }
};
__device__ __forceinline__ u32x4 pack8(const f32x4& a, const f32x4& b) { u32x4 w; w.x = cvt_pk_bf16(a[0], a[1]); w.y = cvt_pk_bf16(a[2], a[3]); w.z = cvt_pk_bf16(b[0], b[1]); w.w = cvt_pk_bf16(b[2], b[3]); return w; }
struct EpiRoute { static constexpr bool PERM = true, AFTER_DRAIN = false; bf16_t *Q, *K, *V, *A2, *XA;
    __device__ __forceinline__ void operator()(EPI_ARGS) const { EPI_PIN
        const int row0 = u.pm * 256 + wr * 64 + fr, cl = wc * 32 + 8 * fq;
        bf16_t* base; int ldc, coff = 0;
        if (u.pn == 0) { base = Q; ldc = 512; } else if (u.pn == 1) { base = Q; ldc = 512; coff = 256; } else if (u.pn == 2) { base = K; ldc = 256; } else if (u.pn == 3) { base = V; ldc = 256; } else { base = XA; ldc = 256; }
#pragma unroll
        for (int ai = 0; ai < 2; ++ai)
#pragma unroll
            for (int m = 0; m < 4; ++m) { const int row = row0 + ai * 128 + m * 16;
#pragma unroll
                for (int bj = 0; bj < 2; ++bj) { const u32x4 w = pack8(acc[ai][bj][m][0], acc[ai][bj][m][1]); const int c = bj * 128 + cl;
                    if (u.pn == 4) { const int g = c >> 4, h0 = c & 15; *(u32x4*)(A2 + ((size_t)g * S5ROWS + (row >> 5)) * S5K + (row & 31) * 16 + h0) = w; }
                    else *(u32x4*)(base + (size_t)row * ldc + coff + c) = w; } }
    }
};
struct EpiGate { static constexpr bool PERM = true, AFTER_DRAIN = false; bf16_t* GS;
    __device__ __forceinline__ void operator()(EPI_ARGS) const { EPI_PIN
        const int row0 = u.pm * 256 + wr * 64 + fr, col0 = u.pn * 256 + wc * 32 + 8 * fq;
#pragma unroll
        for (int ai = 0; ai < 2; ++ai)
#pragma unroll
            for (int m = 0; m < 4; ++m)
#pragma unroll
                for (int bj = 0; bj < 2; ++bj) { f32x4 a = acc[ai][bj][m][0], b = acc[ai][bj][m][1];
#pragma unroll
                    for (int j = 0; j < 4; ++j) { a[j] = sigm(a[j]); b[j] = sigm(b[j]); }
                    *(u32x4*)(GS + (size_t)(row0 + ai * 128 + m * 16) * DM + col0 + bj * 128) = pack8(a, b); }
    }
};
template <bool FIRST> struct EpiMerge { static constexpr bool PERM = true, AFTER_DRAIN = false; const bf16_t* GS; bf16_t* T;
    __device__ __forceinline__ void operator()(EPI_ARGS) const { EPI_PIN
        const int row0 = u.pm * 256 + wr * 64 + fr, col0 = u.pn * 256 + wc * 32 + 8 * fq;
#pragma unroll
        for (int ai = 0; ai < 2; ++ai)
#pragma unroll
            for (int m = 0; m < 4; ++m)
#pragma unroll
                for (int bj = 0; bj < 2; ++bj) { const size_t o = (size_t)(row0 + ai * 128 + m * 16) * DM + col0 + bj * 128;
                    const u32x4 g = *(const u32x4*)(GS + o); u32x4 t = {0u, 0u, 0u, 0u}; if (!FIRST) t = *(const u32x4*)(T + o);
                    f32x4 a = acc[ai][bj][m][0], b = acc[ai][bj][m][1];
#pragma unroll
                    for (int q = 0; q < 2; ++q) { const unsigned gw = g[q], tw = t[q], gw2 = g[q + 2], tw2 = t[q + 2];
                        a[2 * q] = __builtin_bit_cast(float, tw << 16) + (__builtin_bit_cast(float, gw << 16)) * a[2 * q]; a[2 * q + 1] = __builtin_bit_cast(float, tw & 0xffff0000u) + (__builtin_bit_cast(float, gw & 0xffff0000u)) * a[2 * q + 1];
                        b[2 * q] = __builtin_bit_cast(float, tw2 << 16) + (__builtin_bit_cast(float, gw2 << 16)) * b[2 * q]; b[2 * q + 1] = __builtin_bit_cast(float, tw2 & 0xffff0000u) + (__builtin_bit_cast(float, gw2 & 0xffff0000u)) * b[2 * q + 1]; }
                    *(u32x4*)(T + o) = pack8(a, b); }
    }
};
struct EpiPlain { static constexpr bool PERM = true, AFTER_DRAIN = false; bf16_t* O; int ldc;
    __device__ __forceinline__ void operator()(EPI_ARGS) const { EPI_PIN
        const int row0 = u.pm * 256 + wr * 64 + fr, col0 = u.pn * 256 + wc * 32 + 8 * fq;
#pragma unroll
        for (int ai = 0; ai < 2; ++ai)
#pragma unroll
            for (int m = 0; m < 4; ++m)
#pragma unroll
                for (int bj = 0; bj < 2; ++bj) *(u32x4*)(O + (size_t)(row0 + ai * 128 + m * 16) * ldc + col0 + bj * 128) = pack8(acc[ai][bj][m][0], acc[ai][bj][m][1]);
    }
};
struct EpiGlu { static constexpr bool PERM = true, AFTER_DRAIN = false; bf16_t* O;
    __device__ __forceinline__ void operator()(EPI_ARGS) const { EPI_PIN
        const int row0 = u.pm * 256 + wr * 64 + fr, col0 = u.pn * 128 + wc * 32 + 8 * fq;
#pragma unroll
        for (int ai = 0; ai < 2; ++ai)
#pragma unroll
            for (int m = 0; m < 4; ++m) { f32x4 a = acc[ai][0][m][0], b = acc[ai][0][m][1]; const f32x4 ga = acc[ai][1][m][0], gb = acc[ai][1][m][1];
#pragma unroll
                for (int j = 0; j < 4; ++j) { a[j] *= sigm(ga[j]); b[j] *= sigm(gb[j]); }
                *(u32x4*)(O + (size_t)(row0 + ai * 128 + m * 16) * 256 + col0) = pack8(a, b); }
    }
};
struct EpiF32 { static constexpr bool PERM = true, AFTER_DRAIN = false; float* O;
    __device__ __forceinline__ void operator()(EPI_ARGS) const { EPI_PIN
        const int row0 = u.pm * 256 + wr * 64 + fr, col0 = wc * 32 + 8 * fq;
#pragma unroll
        for (int ai = 0; ai < 2; ++ai)
#pragma unroll
            for (int m = 0; m < 4; ++m)
#pragma unroll
                for (int bj = 0; bj < 2; ++bj)
#pragma unroll
                    for (int n = 0; n < 2; ++n) *(f32x4*)(O + (size_t)(row0 + ai * 128 + m * 16) * 256 + col0 + bj * 128 + 4 * n) = acc[ai][bj][m][n];
    }
};
__device__ __forceinline__ float gelu_tanh(float x) { const float y = 0.7978845608028654f * (x + 0.044715f * x * x * x); return x * sigm(2.0f * y); }
struct EpiS5Y { static constexpr bool PERM = true, AFTER_DRAIN = false; bf16_t* Gb;
    __device__ __forceinline__ void operator()(EPI_ARGS) const { EPI_PIN
        const int g = u.pm / 5, i = u.pm - 5 * g, jn = u.pn & 1;
#pragma unroll
        for (int ai = 0; ai < 2; ++ai)
#pragma unroll
            for (int m = 0; m < 4; ++m) { const int cidx = i * 256 + ai * 128 + wr * 64 + m * 16 + fr;
                if (cidx < S5CH) {
#pragma unroll
                    for (int bj = 0; bj < 2; ++bj) { const int c = jn * 256 + bj * 128 + wc * 32 + 8 * fq, jo = c >> 4, h0 = c & 15; f32x4 a = acc[ai][bj][m][0], b = acc[ai][bj][m][1];
#pragma unroll
                        for (int j = 0; j < 4; ++j) { a[j] = gelu_tanh(a[j]); b[j] = gelu_tanh(b[j]); }
                        *(u32x4*)(Gb + (size_t)(cidx * S5L + jo) * 256 + g * 16 + h0) = pack8(a, b); } } }
    }
};
struct RowOrder { pg8::StaticOrder so; bool skip;
    __device__ void init(int N, int G, int c, bool skip_) { skip = skip_; so.init(skip_ ? NBATCH * SEQ : MR, N, G, c); }
    __device__ bool next(int i, Unit& u) const { if (!so.next(i, u)) return false; if (skip) u.pm = u.pm + 1 + (u.pm >> 6); return true; }
    __device__ __forceinline__ void a_ready(const Unit&) const {}
    __device__ __forceinline__ void done(const Unit&) const {}
};
struct S5Order { int ncol, G, c;
    __device__ bool next(int i, Unit& u) const { const int L = i * G + c; if (L >= 80 * ncol) return false; const int g = L / (5 * ncol), rem = L - g * 5 * ncol; u.pm = g * 5 + rem / ncol; u.pn = g * ncol + rem % ncol; return true; }
    __device__ __forceinline__ void a_ready(const Unit&) const {}
    __device__ __forceinline__ void done(const Unit&) const {}
};
__device__ __forceinline__ float shx(float v, int o, int lane) { return __builtin_bit_cast(float, __builtin_amdgcn_ds_bpermute((lane ^ o) << 2, __builtin_bit_cast(int, v))); }
__device__ __forceinline__ float wave_sum(float v, int lane) {
#pragma unroll
    for (int o = 1; o < 64; o <<= 1) v += shx(v, o, lane);
    return v;
}
__device__ __forceinline__ void tr_item(const float* W, int K, int ldw, int src_c0, bf16* WT, int dst_r0, int k0, LAS float* scr, int lane) {
#pragma unroll 16
    for (int i = 0; i < 32; ++i) { const int kk = 2 * i + (lane >> 5); scr[kk * 33 + (lane & 31)] = W[(size_t)(k0 + kk) * ldw + src_c0 + (lane & 31)]; }
    LDS_WAIT(); asm volatile("" ::: "memory");
    const int c = lane & 7;
#pragma unroll
    for (int j = 0; j < 4; ++j) { const int n = (lane >> 3) + 8 * j; const LAS float* s = scr + (8 * c) * 33 + n;
        v4u o; o.x = pk2(s[0 * 33], s[1 * 33]); o.y = pk2(s[2 * 33], s[3 * 33]); o.z = pk2(s[4 * 33], s[5 * 33]); o.w = pk2(s[6 * 33], s[7 * 33]);
        *(v4u*)(WT + (size_t)(dst_r0 + n) * K + k0 + 8 * c) = o; }
    LDS_WAIT(); asm volatile("" ::: "memory");
}
constexpr int CONV_ITEMS = 2 * 2816 + 2 * 1408 + 2816 + 4 * 128 + 512 + 64;
__device__ __forceinline__ void conv_item(Frame& F, int l, int it, LAS float* scr) {
    int r = it; const int lane = F.lane;
    if (r < 5632) { const int f = r / 2816; r -= f * 2816; const int kb = r / 176, n0 = (r % 176) * 32, pn = n0 >> 8, bj = (n0 >> 7) & 1, q = n0 & 127;
        tr_item(AIN(7) + (size_t)(l * 2 + f) * DM * 5632, DM, 5632, bj * DFF + 128 * pn + q, WSP(bf16, WS_W1T) + (size_t)f * 5632 * DM, n0, kb * 64, scr, lane); return; } r -= 5632;
    if (r < 2816) { const int f = r / 1408; r -= f * 1408; const int kb = r / 32, n0 = (r % 32) * 32;
        tr_item(AIN(8) + (size_t)(l * 2 + f) * DFF * DM, DFF, DM, n0, WSP(bf16, WS_W2T) + (size_t)f * DM * DFF, n0, kb * 64, scr, lane); return; } r -= 2816;
    if (r < 2816) { const int kb = r / 176, n0 = (r % 176) * 32; int src;
        if (n0 >= 1536) src = n0; else { const int t = n0 >> 8, off = n0 & 255;
            src = t == 0 ? 768 + off : t == 1 ? 1024 + off : t == 2 ? (off < 128 ? off : 512 + off - 128) : t == 3 ? (off < 128 ? 128 + off : 640 + off - 128) : t == 4 ? 256 + off : 1280 + off; }
        tr_item(AIN(9) + (size_t)l * DM * 5632, DM, 5632, src, WSP(bf16, WS_WINT), n0, kb * 64, scr, lane); return; } r -= 2816;
    if (r < 512) { const int k = r / 128; r -= k * 128; const int kb = r / 32, n0 = (r % 32) * 32;
        tr_item(AIN(23) + (size_t)(l * 4 + k) * 256 * DM, 256, DM, n0, WSP(bf16, WS_WBT) + (size_t)k * DM * 256, n0, kb * 64, scr, lane); return; } r -= 512;
    if (r < 512) { const int kb = r / 32, n0 = (r % 32) * 32;
        tr_item(AIN(24) + (size_t)l * DM * DM, DM, DM, n0, WSP(bf16, WS_WOT), n0, kb * 64, scr, lane); return; } r -= 512;
    { const int kb = r / 16, n0 = (r % 16) * 32, pn = n0 >> 8, bj = (n0 >> 7) & 1, q = n0 & 127;
        tr_item(AIN(22) + (size_t)l * 256 * 512, 256, 512, bj * 256 + 128 * pn + q, WSP(bf16, WS_WGT), n0, kb * 64, scr, lane); }
}
__device__ __forceinline__ void s5_table_item(Frame& F, int l, int item, LAS float* scr) {
    const int g = item >> 5, j = item & 31, lane = F.lane, p = lane;
    bf16* BtY = WSP(bf16, WS_BTY) + (size_t)g * 512 * S5K; bf16* BtE = WSP(bf16, WS_BTE) + (size_t)g * 256 * S5K;
    float lre[2], lim[2], cfr[2], cfi[2], are[2], aim[2], dtv[2];
#pragma unroll
    for (int d = 0; d < 2; ++d) { const int ix = ((l * 2 + d) * 16 + g) * 64 + p; are[d] = AIN(14)[ix]; aim[d] = AIN(15)[ix]; dtv[d] = expf(AIN(16)[(l * 2 + d) * 16 + g]);
        const float mg = expf(are[d] * dtv[d]); float sn, cs; sincosf(aim[d] * dtv[d], &sn, &cs); const float br = mg * cs - 1.0f, bi = mg * sn; const float den = 1.0f / (are[d] * are[d] + aim[d] * aim[d]);
        cfr[d] = (br * are[d] + bi * aim[d]) * den; cfi[d] = (bi * are[d] - br * aim[d]) * den; }
#define LAMPOW(d, e, outr, outi) do { const float mg_ = expf(are[d] * dtv[d] * (float)(e)); float sn_, cs_; sincosf(aim[d] * dtv[d] * (float)(e), &sn_, &cs_); outr = mg_ * cs_; outi = mg_ * sn_; } while (0)
#pragma unroll
    for (int d = 0; d < 2; ++d) { float pr, pi; LAMPOW(d, j, pr, pi); scr[(d * 64 + p) * 2] = pr * cfr[d] - pi * cfi[d]; scr[(d * 64 + p) * 2 + 1] = pr * cfi[d] + pi * cfr[d]; }
    LDS_WAIT(); asm volatile("" ::: "memory");
    const int hi_ = lane & 15;
#pragma unroll 1
    for (int i2 = 0; i2 < 4; ++i2) { const int ho = (lane >> 4) + 4 * i2; float kv[2];
#pragma unroll
        for (int d = 0; d < 2; ++d) { const float* cr = AIN(19) + (((size_t)(l * 2 + d) * 16 + g) * 16 + ho) * 64; const float* ci = AIN(20) + (((size_t)(l * 2 + d) * 16 + g) * 16 + ho) * 64;
            const float* br = AIN(17) + ((size_t)(l * 2 + d) * 16 + g) * 64 * 16 + hi_; const float* bi = AIN(18) + ((size_t)(l * 2 + d) * 16 + g) * 64 * 16 + hi_; float s = 0.f;
#pragma unroll 16
            for (int pp = 0; pp < 64; ++pp) { const float zr = scr[(d * 64 + pp) * 2], zi = scr[(d * 64 + pp) * 2 + 1], b_r = br[pp * 16], b_i = bi[pp * 16];
                const float wr_ = zr * b_r - zi * b_i, wi_ = zr * b_i + zi * b_r; s += cr[pp] * wr_ - ci[pp] * wi_; }
            kv[d] = s; }
        if (j == 0) { const float v = kv[0] + kv[1] + (ho == hi_ ? AIN(21)[l * 256 + g * 16 + ho] : 0.f);
            for (int q = 0; q < 32; ++q) BtY[(size_t)(q * 16 + ho) * S5K + q * 16 + hi_] = (bf16)f2bf(v); }
        else { const bf16 vf = (bf16)f2bf(kv[0]), vb = (bf16)f2bf(kv[1]);
            for (int q = 0; q + j < 32; ++q) { BtY[(size_t)((q + j) * 16 + ho) * S5K + q * 16 + hi_] = vf; BtY[(size_t)(q * 16 + ho) * S5K + (q + j) * 16 + hi_] = vb; } }
    }
#pragma unroll
    for (int d = 0; d < 2; ++d) { float pr, pi; LAMPOW(d, (d == 0 ? j + 1 : S5L - j), pr, pi);
#pragma unroll
        for (int ho = 0; ho < 16; ++ho) { const size_t ci_ = (((size_t)(l * 2 + d) * 16 + g) * 16 + ho) * 64 + p; const float c_r = AIN(19)[ci_], c_i = AIN(20)[ci_];
            bf16* row = BtY + (size_t)(j * 16 + ho) * S5K + 512 + d * 128; row[p] = (bf16)f2bf(c_r * pr - c_i * pi); row[64 + p] = (bf16)f2bf(-(c_r * pi + c_i * pr)); } }
#pragma unroll
    for (int d = 0; d < 2; ++d) { float pr, pi; LAMPOW(d, (d == 0 ? S5L - 1 - j : j), pr, pi); const float zr = pr * cfr[d] - pi * cfi[d], zi = pr * cfi[d] + pi * cfr[d];
#pragma unroll
        for (int h = 0; h < 16; ++h) { const size_t bi_ = (((size_t)(l * 2 + d) * 16 + g) * 64 + p) * 16 + h; const float b_r = AIN(17)[bi_], b_i = AIN(18)[bi_];
            BtE[(size_t)(d * 128 + p) * S5K + j * 16 + h] = (bf16)f2bf(zr * b_r - zi * b_i); BtE[(size_t)(d * 128 + 64 + p) * S5K + j * 16 + h] = (bf16)f2bf(zr * b_i + zi * b_r); } }
    for (int q = lane; q < 8 * 256; q += 64) BtE[(size_t)(8 * j + (q >> 8)) * S5K + 512 + (q & 255)] = 0;
#undef LAMPOW
    LDS_WAIT(); asm volatile("" ::: "memory");
}
__device__ __forceinline__ void prep_layer(Frame& F, int l) {
    LAS float* scr = (LAS float*)(F.lds + F.wave * 16384);
    const int gw = F.vcu * NWAVES + F.wave, NGW = F.G * NWAVES;
    for (int it = gw; it < CONV_ITEMS; it += NGW) conv_item(F, l, it, scr);
    for (int it = NGW - 1 - gw; it < 512; it += NGW) s5_table_item(F, l, it, scr);
    const int gt = gw * 64 + F.lane, NGT = NGW * 64;
    { bf16* Wp = WSP(bf16, WS_WPT); const float* pw = AIN(12) + (size_t)l * 4 * 64 * 64; const float* ps = AIN(13) + l * 256;
      for (int e = gt; e < 65536; e += NGT) { const int n = e >> 8, k = e & 255; Wp[e] = (bf16)(((n >> 6) == (k >> 6)) ? f2bf(pw[((n >> 6) * 64 + (k & 63)) * 64 + (n & 63)] * ps[n]) : 0u); } }
    { bf16* A2 = WSP(bf16, WS_A2); unsigned z_ = 0u; asm volatile("" : "+v"(z_)); for (int e = gt; e < 16 * S5ROWS * 32; e += NGT) { const int row = e >> 5, c8 = e & 31; *(v4u*)(A2 + (size_t)row * S5K + 512 + c8 * 8) = (v4u){z_, z_, z_, z_}; } }
}
__device__ __forceinline__ void mod_phase(Frame& F) {
    LAS float* red = (LAS float*)F.lds;
    for (int it = F.vcu; it < DEPTH * (NSUBMOD / 64); it += F.G) { const int l = it / (NSUBMOD / 64), n = (it % (NSUBMOD / 64)) * 64 + F.lane;
        const float* w = AIN(4) + ((size_t)l * DM + F.wave * 128) * NSUBMOD + n; float a0 = 0.f, a1 = 0.f, a2 = 0.f;
#pragma unroll 16
        for (int k = 0; k < 128; ++k) { const int kk = F.wave * 128 + k; const float c0 = AIN(1)[kk], c1 = AIN(1)[DM + kk], c2 = AIN(3)[kk]; const float wv = w[(size_t)k * NSUBMOD];
            a0 += c0 * sigm(c0) * wv; a1 += c1 * sigm(c1) * wv; a2 += c2 * sigm(c2) * wv; }
        red[(F.wave * 3 + 0) * 64 + F.lane] = a0; red[(F.wave * 3 + 1) * 64 + F.lane] = a1; red[(F.wave * 3 + 2) * 64 + F.lane] = a2;
        __syncthreads();
        if (F.wave < 3) { float s = AIN(5)[l * NSUBMOD + n];
#pragma unroll
            for (int w8 = 0; w8 < 8; ++w8) s += red[(w8 * 3 + F.wave) * 64 + F.lane];
            WSP(float, WS_MOD)[((size_t)l * 3 + F.wave) * NSUBMOD + n] = s; }
        __syncthreads();
    }
}
__device__ __forceinline__ void norm_phase(Frame& F, int l, int sub, const float* lat, const float* ctxp) {
    const int gw = F.vcu * NWAVES + F.wave, NGW = F.G * NWAVES; const float* gptr = AIN(6) + (size_t)(l * 3 + sub) * DM; bf16* HN = WSP(bf16, WS_HN);
    for (int r0 = gw; r0 < MR; r0 += 2 * NGW) { f32x4 v[2][4]; float s[2]; const float* mod[2]; int rr[2];
#pragma unroll
        for (int q2 = 0; q2 < 2; ++q2) { int r = r0 + q2 * NGW; if (r >= MR) r = r0; rr[q2] = r; const int b = r / TOK, i = r - b * TOK;
            const float* xr = i < CTXL ? ctxp + (size_t)(b * CTXL + i) * DM : lat + (size_t)(b * SEQ + i - CTXL) * DM;
            mod[q2] = WSP(float, WS_MOD) + ((size_t)l * 3 + (i < CTXL ? 2 : b)) * NSUBMOD + sub * 3072; s[q2] = 0.f;
#pragma unroll
            for (int j = 0; j < 4; ++j) v[q2][j] = *((const f32x4*)xr + F.lane + 64 * j); }
#pragma unroll
        for (int q2 = 0; q2 < 2; ++q2) {
#pragma unroll
            for (int j = 0; j < 4; ++j) s[q2] += (v[q2][j].x * v[q2][j].x + v[q2][j].y * v[q2][j].y) + (v[q2][j].z * v[q2][j].z + v[q2][j].w * v[q2][j].w);
            const float rstd = 1.0f / sqrtf(wave_sum(s[q2], F.lane) * (1.0f / DM) + EPS);
            if (q2 == 0 || rr[1] != rr[0]) {
#pragma unroll
                for (int j = 0; j < 4; ++j) { const f32x4 gg = *((const f32x4*)gptr + F.lane + 64 * j), sh = *((const f32x4*)mod[q2] + F.lane + 64 * j), sc = *((const f32x4*)(mod[q2] + DM) + F.lane + 64 * j);
                    const f32x4 o = (v[q2][j] * rstd * gg) * (sc + 1.0f) + sh;
                    *((unsigned long long*)(HN + (size_t)rr[q2] * DM) + F.lane + 64 * j) = (unsigned long long)pk2(o.x, o.y) | ((unsigned long long)pk2(o.z, o.w) << 32); } } }
    }
}
__device__ __forceinline__ void final_norm_phase(Frame& F) {
    const int gw = F.vcu * NWAVES + F.wave, NGW = F.G * NWAVES; const float* gptr = AIN(25);
    for (int r = gw; r < NBATCH * SEQ; r += NGW) { float* xr = AOUT + (size_t)r * DM; f32x4 v[4]; float s = 0.f;
#pragma unroll
        for (int j = 0; j < 4; ++j) { v[j] = *((const f32x4*)xr + F.lane + 64 * j); s += (v[j].x * v[j].x + v[j].y * v[j].y) + (v[j].z * v[j].z + v[j].w * v[j].w); }
        const float rstd = 1.0f / sqrtf(wave_sum(s, F.lane) * (1.0f / DM) + EPS);
#pragma unroll
        for (int j = 0; j < 4; ++j) { const f32x4 gg = *((const f32x4*)gptr + F.lane + 64 * j); *((f32x4*)xr + F.lane + 64 * j) = v[j] * rstd * gg; }
    }
}
__device__ __forceinline__ void post_phase(Frame& F, int l) {
    const int gw = F.vcu * NWAVES + F.wave, NGW = F.G * NWAVES, lane = F.lane, hh = lane >> 4, d = lane & 15;
    bf16* Q = WSP(bf16, WS_Q); bf16* K = WSP(bf16, WS_K); const bf16* XA = WSP(bf16, WS_XA); bf16* DF = WSP(bf16, WS_DIFF);
    const float inv = exp2f(-(float)d * (13.287712379549449f / 16.0f));
    const float* qg = AIN(11) + (size_t)l * 128; const float* kg = qg + 64;
    for (int r = gw; r < MR; r += NGW) { const int b = r / TOK, i = r - b * TOK; const bool lat = i >= CTXL; const int t = i - CTXL;
        const int n = lat ? SEQ : CTXL, ts = lat ? t : i; const size_t seg0 = (size_t)(r - ts); float pd[4];
#pragma unroll
        for (int j = 0; j < 4; ++j) { const int w = 2 << j; int lo = ts - (w >> 1), hi2 = lo + w; lo = lo < 0 ? 0 : lo; hi2 = hi2 > n ? n : hi2; float s = 0.f;
            for (int q2 = lo; q2 < hi2; ++q2) s += bf2f(XA[(seg0 + q2) * 256 + j * 64 + lane]);
            pd[j] = s / (float)(hi2 - lo) - bf2f(XA[(size_t)r * 256 + j * 64 + lane]); }
        float x[3][4];
#pragma unroll
        for (int it = 0; it < 3; ++it) { const bf16* p = it < 2 ? Q + (size_t)r * 512 + (it * 4 + hh) * 64 + d : K + (size_t)r * 256 + hh * 64 + d;
            x[it][0] = bf2f(p[0]); x[it][1] = bf2f(p[16]); x[it][2] = bf2f(p[32]); x[it][3] = bf2f(p[48]); }
        float cr = 1.f, sr = 0.f, cc = 1.f, sc = 0.f;
        if (lat) { sincosf((float)(t >> 6) * inv, &sr, &cr); sincosf((float)(t & 63) * inv, &sc, &cc); }
#pragma unroll
        for (int it = 0; it < 3; ++it) { float x0 = x[it][0], x1 = x[it][1], x2 = x[it][2], x3 = x[it][3];
            const bool nrm = (it == 1) || (it == 2 && hh >= 2);
            float ss = (x0 * x0 + x1 * x1) + (x2 * x2 + x3 * x3);
            ss += shx(ss, 1, lane); ss += shx(ss, 2, lane); ss += shx(ss, 4, lane); ss += shx(ss, 8, lane);
            if (nrm) { const float rs = 1.0f / sqrtf(ss * (1.0f / 64.0f) + EPS); const float* gp = it == 1 ? qg : kg; x0 *= rs * gp[d]; x1 *= rs * gp[d + 16]; x2 *= rs * gp[d + 32]; x3 *= rs * gp[d + 48]; }
            float o0 = x0 * cr - x1 * sr, o1 = x1 * cr + x0 * sr, o2 = x2 * cc - x3 * sc, o3 = x3 * cc + x2 * sc;
            if (it < 2) { o0 *= attn_body::C2; o1 *= attn_body::C2; o2 *= attn_body::C2; o3 *= attn_body::C2; }
            x[it][0] = o0; x[it][1] = o1; x[it][2] = o2; x[it][3] = o3; }
#pragma unroll
        for (int it = 0; it < 3; ++it) { bf16* p = it < 2 ? Q + (size_t)r * 512 + (it * 4 + hh) * 64 + d : K + (size_t)r * 256 + hh * 64 + d;
            p[0] = (bf16)f2bf(x[it][0]); p[16] = (bf16)f2bf(x[it][1]); p[32] = (bf16)f2bf(x[it][2]); p[48] = (bf16)f2bf(x[it][3]); }
#pragma unroll
        for (int j = 0; j < 4; ++j) DF[(size_t)r * 256 + j * 64 + lane] = (bf16)f2bf(pd[j]);
    }
}
__device__ __forceinline__ void s5_carry_phase(Frame& F, int l) {
    if (F.wave != 0 || F.vcu >= 64) return;
    const int b = F.vcu >> 5, d = (F.vcu >> 4) & 1, g = F.vcu & 15, p = F.lane;
    const int ix = ((l * 2 + d) * 16 + g) * 64 + p; const float are = AIN(14)[ix], aim = AIN(15)[ix], dt = expf(AIN(16)[(l * 2 + d) * 16 + g]);
    const float mg = expf(are * dt * (float)S5L); float sn, cs; sincosf(aim * dt * (float)S5L, &sn, &cs); const float Lr = mg * cs, Li = mg * sn;
    const float* E = WSP(float, WS_E) + (size_t)g * S5ROWS * 256 + d * 128 + p; bf16* A2 = WSP(bf16, WS_A2) + (size_t)g * S5ROWS * S5K + 512 + d * 128 + p;
    float sr = 0.f, si = 0.f;
#pragma unroll 1
    for (int k0 = 0; k0 < 520; k0 += 65) { float er[65], ei[65];
#pragma unroll
        for (int k = 0; k < 65; ++k) { const int kk = k0 + k; const int ch = d == 0 ? kk : (kk < 8 ? 7 - kk : 527 - kk); const size_t row = (size_t)b * 520 + ch; er[k] = E[row * 256]; ei[k] = E[row * 256 + 64]; }
#pragma unroll
        for (int k = 0; k < 65; ++k) { const int kk = k0 + k; const int ch = d == 0 ? kk : (kk < 8 ? 7 - kk : 527 - kk); const size_t row = (size_t)b * 520 + ch;
            A2[row * S5K] = (bf16)f2bf(sr); A2[row * S5K + 64] = (bf16)f2bf(si);
            const float nr = Lr * sr - Li * si + er[k], ni = Lr * si + Li * sr + ei[k]; sr = nr; si = ni; } }
}
__device__ __forceinline__ void attn_one(Frame& F, int l, int kind, int b, int h, int qb, char* lds) {
    using namespace attn_body;
    const attn_body::bf16* Q = (const attn_body::bf16*)WSP(::bf16, WS_Q); const attn_body::bf16* K = (const attn_body::bf16*)WSP(::bf16, WS_K); const attn_body::bf16* V = (const attn_body::bf16*)WSP(::bf16, WS_V);
    attn_body::bf16* O = (attn_body::bf16*)WSP(::bf16, WS_Y4) + (size_t)(kind == 0 ? 1 : 3) * MR * 256;
    const size_t row0 = (size_t)b * TOK + (size_t)qb * 256;
    const attn_body::bf16* Qu = Q + row0 * 512 + kind * 256 + h * 64; const attn_body::bf16* Kh = K + (size_t)b * TOK * 256 + kind * 128 + (h >> 1) * 64; const attn_body::bf16* Vh = V + (size_t)b * TOK * 256 + kind * 128 + (h >> 1) * 64;
    attn_body::bf16* Ou = O + row0 * 256 + h * 64;
    if (kind == 0) { int NT = 4, shift = 0;
        if (qb > 0) { const int lo = (4 * qb - 2) < 4 ? 4 : (4 * qb - 2), hi = (4 * qb + 5) > 259 ? 259 : (4 * qb + 5); NT = 4 + hi - lo + 1; shift = lo - 4; }
        attn_unit<8, true>(Qu, Kh, Vh, Ou, NT, shift, (qb - 1) * 256, AIN(10)[l * 4 + h] * LOG2E, lds, F.wave * 64 + F.lane);
    } else attn_unit<8, false>(Qu, Kh, Vh, Ou, qb > 0 ? 260 : 4, 0, 0, 0.f, lds, F.wave * 64 + F.lane);
}
__device__ __forceinline__ void attn_phase(Frame& F, int l, char* lds) {
    const int c = F.vcu;
#pragma unroll 1
    for (int u = c; u < 512; u += F.G) attn_one(F, l, 0, u >> 8, (u >> 6) & 3, 1 + (u & 63), lds);
#pragma unroll 1
    for (int u = c; u < 16; u += F.G) attn_one(F, l, u >> 3, (u >> 2) & 1, u & 3, 0, lds);
#pragma unroll 1
    for (int u = c; u < 512; u += F.G) attn_one(F, l, 1, u >> 8, (u >> 6) & 3, 1 + (u & 63), lds);
}

#define XB_TMO      128
#define XB_XCNT(j)  (256  + 64 * (j))
#define XB_XSUB(j)  (1280 + 64 * (j))
#define XB_XGEN(j)  (2304 + 64 * (j))
#define XB_TOP      3328
#define XB_TOPGEN   3392
#define XCD_BAR_WORDS 3456
#define XB_SPIN_CAP (1u << 18)

__device__ __forceinline__ unsigned xb_ld(unsigned* p)              { return __hip_atomic_load(p, __ATOMIC_RELAXED, __HIP_MEMORY_SCOPE_AGENT); }
__device__ __forceinline__ unsigned xb_add(unsigned* p, unsigned v) { return __hip_atomic_fetch_add(p, v, __ATOMIC_RELAXED, __HIP_MEMORY_SCOPE_AGENT); }
__device__ __forceinline__ unsigned xb_xcc_id() { return (unsigned)__builtin_amdgcn_s_getreg((3 << 11) | 20) & 0xFu; }
#define XB_SPIN(cond, bar) do { unsigned _sp = 0; while (cond) { __builtin_amdgcn_s_sleep(1); \
    if ((++_sp & 255u) == 0u) { if (xb_ld(&(bar)[XB_TMO])) break; if (_sp > XB_SPIN_CAP) { atomicAdd(&(bar)[XB_TMO], 1u); break; } } } } while (0)

struct XcdBarrier {
    unsigned* bar; unsigned x;
    volatile LAS unsigned* st;
};

__device__ __forceinline__ XcdBarrier xcd_barrier_post(unsigned* bar, volatile LAS unsigned* st) {
    XcdBarrier b; b.bar = bar; b.x = xb_xcc_id(); b.st = st;
    if (threadIdx.x == 0) (void)xb_add(&bar[XB_XCNT(b.x)], 1u);
    return b;
}
__device__ __forceinline__ void xcd_barrier_complete(unsigned* bar, unsigned x, unsigned& nloc, unsigned& nx) {
    const unsigned G = gridDim.x * gridDim.y * gridDim.z;
    unsigned sum, cnt, mine, sp = 0u;
    for (;;) {
        sum = 0u; cnt = 0u; mine = 0u;
#pragma unroll
        for (unsigned j = 0; j < 16; ++j) { const unsigned c = xb_ld(&bar[XB_XCNT(j)]); sum += c; cnt += (c > 0u) ? 1u : 0u; mine = (j == x) ? c : mine; }
        if (sum == G) break;
        __builtin_amdgcn_s_sleep(1);
        if ((++sp & 255u) == 0u) { if (xb_ld(&bar[XB_TMO])) break; if (sp > XB_SPIN_CAP) { atomicAdd(&bar[XB_TMO], 1u); break; } }
    }
    nloc = mine > 0u ? mine : 1u; nx = cnt > 0u ? cnt : 1u;
}

__device__ __forceinline__ void xcd_barrier(const XcdBarrier& b) {
    asm volatile("s_waitcnt vmcnt(0)" ::: "memory");
    __syncthreads();
    if (threadIdx.x == 0) {
        unsigned* bar = b.bar;
        __builtin_amdgcn_s_waitcnt(0);
        unsigned nloc = b.st[0], nx = b.st[1];
        if (nloc == 0u) { xcd_barrier_complete(bar, b.x, nloc, nx); b.st[0] = nloc; b.st[1] = nx; }
        const unsigned old = xb_add(&bar[XB_XSUB(b.x)], 1u);
        const unsigned gen = old / nloc;
        if (old + 1u == (gen + 1u) * nloc) {
            __builtin_amdgcn_fence(__ATOMIC_RELEASE, "agent");
            asm volatile("s_waitcnt vmcnt(0)" ::: "memory");
            const unsigned og = xb_add(&bar[XB_TOP], 1u);
            const unsigned tg = og / nx;
            if (og + 1u == (tg + 1u) * nx) xb_add(&bar[XB_TOPGEN], 1u);
            else XB_SPIN(xb_ld(&bar[XB_TOPGEN]) == tg, bar);
            __builtin_amdgcn_fence(__ATOMIC_ACQUIRE, "agent");
            xb_add(&bar[XB_XGEN(b.x)], 1u);
            asm volatile("s_waitcnt vmcnt(0)" ::: "memory");
        } else {
            XB_SPIN(xb_ld(&bar[XB_XGEN(b.x)]) == gen, bar);
            __builtin_amdgcn_fence(__ATOMIC_ACQUIRE, "agent");
            asm volatile("s_waitcnt vmcnt(0)" ::: "memory");
        }
    }
    __syncthreads();
}

constexpr size_t WS_BAR = 16384;
#ifndef MK_SPLIT
#define MK_SPLIT 0
#endif
constexpr int N_PHASES = 2 + DEPTH * 14 + 1;
__global__ void __launch_bounds__(NWAVES * 64, 2) mk_fwd(Args args) {
    extern __shared__ __attribute__((aligned(16))) unsigned char lds[];
    Frame F;
    F.lds = (LAS unsigned char*)lds; F.lane = 0; F.wave = __builtin_amdgcn_readfirstlane(threadIdx.x >> 6);
    F.G = gridDim.x; { const int bx = blockIdx.x; F.vcu = (F.G % 8 == 0) ? (bx % 8) * (F.G / 8) + bx / 8 : bx; }
    { volatile LAS unsigned* st_ = (volatile LAS unsigned*)(F.lds + RING_BYTES + 512); if (threadIdx.x < 2) st_[threadIdx.x] = 0u; __syncthreads();
      (void)xcd_barrier_post((unsigned*)(AWS + WS_BAR), st_); }
    const int lo = args.ph_lo, hi = args.ph_hi; int ph = 0;
#ifndef ONLY_MASK
#define ONLY_MASK 0xffffffffu
#endif
#define SEL(n) ((ONLY_MASK >> (n)) & 1u)
#define PH_BEGIN if (lo <= ph && ph < hi) { { int l_; asm volatile("v_mbcnt_lo_u32_b32 %0, -1, 0\n\tv_mbcnt_hi_u32_b32 %0, -1, %0" : "=v"(l_)); F.lane = l_; }
#define PH_END   if (ph + 1 < hi) { asm volatile("s_waitcnt vmcnt(0) lgkmcnt(0)" ::: "memory");   \
        if (ph == 0) cg::this_grid().sync();   \
        else { XcdBarrier xb_; xb_.bar = (unsigned*)(AWS + WS_BAR); xb_.x = xb_xcc_id(); xb_.st = (volatile LAS unsigned*)(F.lds + RING_BYTES + 512); xcd_barrier(xb_); } } } ++ph;
#define GEMM(EPI, SCHEDT, A_, B_, K_, S_, E_) pg8::gemm_phase<EPI, SCHEDT, true, true>(F.lds, pg8::Gemm{(const pg8::bf16_t*)(A_), (const pg8::bf16_t*)(B_), 0, 0, (K_)}, S_, E_, F.wave * 64 + F.lane)
    float* XC = WSP(float, WS_XC);
    PH_BEGIN if (SEL(1)) { prep_layer(F, 0); __syncthreads(); mod_phase(F); } PH_END
#pragma unroll 1
    for (int l = 0; l < DEPTH; ++l) {
        const bool last = (l == DEPTH - 1);
        const float* MODl = WSP(float, WS_MOD) + (size_t)l * 3 * NSUBMOD;
        const float* srcL = l == 0 ? AIN(0) : AOUT; const float* srcC = l == 0 ? AIN(2) : XC;
        PH_BEGIN if (SEL(2)) { if (l > 0) { prep_layer(F, l); } norm_phase(F, l, 0, srcL, srcC); } PH_END
#pragma unroll 1
        for (int f = 0; f < 2; ++f) {
            if (f == 1) {
                PH_BEGIN if (SEL(3)) { { RowOrder S; S.init(1536, F.G, (int)blockIdx.x, false); EpiRoute E{WSP(bf16_t, WS_Q), WSP(bf16_t, WS_K), WSP(bf16_t, WS_V), WSP(bf16_t, WS_A2), WSP(bf16_t, WS_XA)};
                    GEMM(EpiRoute, RowOrder, WSP(bf16, WS_HN), WSP(bf16, WS_WINT), DM, S, E); } } PH_END
                PH_BEGIN if (SEL(4)) { { post_phase(F, l); S5Order S{1, F.G, (int)blockIdx.x}; EpiF32 E{WSP(float, WS_E)}; GEMM(EpiF32, S5Order, WSP(bf16, WS_A2), WSP(bf16, WS_BTE), S5K, S, E); } } PH_END
                PH_BEGIN if (SEL(5)) { { s5_carry_phase(F, l); RowOrder S; S.init(256, F.G, (int)blockIdx.x, last); EpiPlain E{WSP(bf16_t, WS_Y4), 256}; GEMM(EpiPlain, RowOrder, WSP(bf16, WS_DIFF), WSP(bf16, WS_WPT), 256, S, E); } } PH_END
                PH_BEGIN if (SEL(6)) { { S5Order S{2, F.G, (int)blockIdx.x}; EpiS5Y E{WSP(bf16_t, WS_G)}; GEMM(EpiS5Y, S5Order, WSP(bf16, WS_A2), WSP(bf16, WS_BTY), S5K, S, E); } } PH_END
                PH_BEGIN if (SEL(7)) { { RowOrder S; S.init(512, F.G, (int)blockIdx.x, last); EpiGlu E{WSP(bf16_t, WS_Y4) + (size_t)2 * MR * 256}; GEMM(EpiGlu, RowOrder, WSP(bf16, WS_G), WSP(bf16, WS_WGT), 256, S, E);
                    attn_phase(F, l, (char*)lds); } } PH_END
                PH_BEGIN if (SEL(8)) { { RowOrder S; S.init(DM, F.G, (int)blockIdx.x, last);
#pragma unroll 1
                    for (int k = 0; k < 4; ++k) { EpiGate Eg{WSP(bf16_t, WS_GS)}; GEMM(EpiGate, RowOrder, WSP(bf16, WS_HN), WSP(bf16, WS_WINT) + (size_t)(1536 + k * 1024) * DM, DM, S, Eg);
                        const bf16* Ak = WSP(bf16, WS_Y4) + (size_t)k * MR * 256; const bf16* Bk = WSP(bf16, WS_WBT) + (size_t)k * DM * 256;
                        if (k == 0) { EpiMerge<true> Em{WSP(bf16_t, WS_GS), WSP(bf16_t, WS_T)}; GEMM(EpiMerge<true>, RowOrder, Ak, Bk, 256, S, Em); }
                        else { EpiMerge<false> Em{WSP(bf16_t, WS_GS), WSP(bf16_t, WS_T)}; GEMM(EpiMerge<false>, RowOrder, Ak, Bk, 256, S, Em); } } } } PH_END
                PH_BEGIN if (SEL(9)) { { RowOrder S; S.init(DM, F.G, (int)blockIdx.x, last); EpiResid E{AOUT, XC, AOUT, XC, MODl + 1 * 3072 + 2048, 1.0f}; GEMM(EpiResid, RowOrder, WSP(bf16, WS_T), WSP(bf16, WS_WOT), DM, S, E); } } PH_END
                PH_BEGIN if (SEL(10)) { norm_phase(F, l, 2, AOUT, XC); } PH_END
            }
            PH_BEGIN if (SEL(11)) { { RowOrder S; S.init(5632, F.G, (int)blockIdx.x, last && f == 1); EpiSwiglu E{WSP(bf16_t, WS_HID)}; GEMM(EpiSwiglu, RowOrder, WSP(bf16, WS_HN), WSP(bf16, WS_W1T) + (size_t)f * 5632 * DM, DM, S, E); } } PH_END
            PH_BEGIN if (SEL(12)) { { RowOrder S; S.init(DM, F.G, (int)blockIdx.x, last && f == 1); const bool first = (l == 0 && f == 0);
                EpiResid E{first ? AIN(0) : AOUT, first ? AIN(2) : XC, AOUT, XC, MODl + (f == 0 ? 0 : 2) * 3072 + 2048, 0.5f};
                GEMM(EpiResid, RowOrder, WSP(bf16, WS_HID), WSP(bf16, WS_W2T) + (size_t)f * DM * DFF, DFF, S, E); } } PH_END
            if (f == 0) { PH_BEGIN if (SEL(13)) { norm_phase(F, l, 1, AOUT, XC); } PH_END }
        }
    }
    PH_BEGIN if (SEL(14)) { final_norm_phase(F); } PH_END
}

extern "C" void kernel_launch(void* const* d_in, const int* in_sizes, int n_in, void* d_out, int out_size, void* d_ws, size_t ws_size, hipStream_t stream) {
    static int grid = 0;
    if (grid == 0) {
        int dev = 0, cus = 0, per_cu = 0;
        if (n_in != 26 || ws_size < WS_END) { fprintf(stderr, "kernel_launch: unexpected inputs (n_in %d, ws %zu < %zu)\n", n_in, ws_size, (size_t)WS_END); grid = -1; return; }
        hipGetDevice(&dev); hipDeviceGetAttribute(&cus, hipDeviceAttributeMultiprocessorCount, dev);
        hipFuncSetAttribute((const void*)mk_fwd, hipFuncAttributeMaxDynamicSharedMemorySize, LDS_BYTES);
        hipOccupancyMaxActiveBlocksPerMultiprocessor(&per_cu, (const void*)mk_fwd, NWAVES * 64, LDS_BYTES);
        if (per_cu < 1) { fprintf(stderr, "kernel_launch: occupancy query says %d blocks per CU\n", per_cu); per_cu = 1; }
        (void)hipGetLastError();
        grid = cus * per_cu;
    }
    if (grid < 0) return;
    Args a{};
    for (int i = 0; i < 26; ++i) a.in[i] = (const float*)d_in[i];
    a.out = (float*)d_out; a.ws = (unsigned char*)d_ws;
#if MK_SPLIT
    for (int p = 0; p < N_PHASES; ++p) { a.ph_lo = p; a.ph_hi = p + 1; hipLaunchKernelGGL(mk_fwd, dim3(grid), dim3(NWAVES * 64), LDS_BYTES, stream, a); }
#else
    if (hipMemsetAsync((char*)d_ws + WS_BAR, 0, 65536, stream) != hipSuccess) { fprintf(stderr, "kernel_launch: memset of the barrier words failed\n"); return; }
    a.ph_lo = 0; a.ph_hi = N_PHASES;
    void* kargs[] = {&a};
    hipError_t e = hipLaunchCooperativeKernel((const void*)mk_fwd, dim3(grid), dim3(NWAVES * 64), kargs, LDS_BYTES, stream);
    if (e != hipSuccess) fprintf(stderr, "cooperative launch failed: %s (grid %d)\n", hipGetErrorString(e), grid);
#endif
}
```

```cpp
#include <hip/hip_cooperative_groups.h>
#include <hip/hip_runtime.h>
#include <cstdio>
#include <cstdint>
namespace pg8 {
#define PG8_LAS __attribute__((address_space(3)))
typedef unsigned short bf16_t;
typedef short bf16x8 __attribute__((ext_vector_type(8)));
typedef float f32x4 __attribute__((ext_vector_type(4)));
typedef unsigned u32x4 __attribute__((ext_vector_type(4)));
constexpr int BM = 256, BK = 64, HALF = 128, HTB = HALF * BK * 2  , STAGE_BYTES = 8 * HTB, NXCD = 8, WGM = 8;

__host__ __device__ __forceinline__ int lds_byte(int r, int c) { const int st = (r >> 4) * 2 + (c >> 5), rr = r & 15, cc = c & 31, ob = rr * 64 + cc * 2; return st * 1024 + (ob ^ (((ob >> 9) & 1) << 5)); }
__host__ __device__ __forceinline__ void stage_rc(int b, int& R, int& C) { const int st = b / 1024, sb = b % 1024, swz = sb ^ (((sb >> 9) & 1) << 5); R = (st >> 1) * 16 + swz / 64; C = (st & 1) * 32 + (swz % 64) / 2; }
__host__ __device__ __forceinline__ int perm32(int rho) { const int n = rho >> 4, i = rho & 15; return 8 * (i >> 2) + 4 * n + (i & 3); }

struct Unit { int pm, pn, k0; };
struct Gemm { const bf16_t* A; const bf16_t* Bt; int M, N, K, ld; };

struct StaticOrder {
    int nM, nN, nwg, G, c;
    __host__ __device__ void init(int M, int N, int G_, int c_) { nM = M / BM; nN = N / BM; nwg = nM * nN; G = G_; c = c_; }
    __host__ __device__ bool next(int i, Unit& u) const {
        const long L = (long)i * G + c; if (L >= nwg) return false;
        int wgid = (int)L; { const int q = nwg / NXCD, r = nwg % NXCD, xcd = wgid % NXCD, off = wgid / NXCD; wgid = (xcd < r ? xcd * (q + 1) : r * (q + 1) + (xcd - r) * q) + off; }
        const int nig = WGM * nN, gid = wgid / nig, fm = gid * WGM, gsz = (nM - fm) < WGM ? (nM - fm) : WGM;
        u.pm = fm + ((wgid % nig) % gsz); u.pn = (wgid % nig) / gsz; u.k0 = 0; return true;
    }
    __device__ __forceinline__ void a_ready(const Unit&) const {}
    __device__ __forceinline__ void done(const Unit&) const {}
};

typedef float f32x2cv __attribute__((ext_vector_type(2))); typedef __bf16 bf16x2cv __attribute__((ext_vector_type(2)));
__device__ __forceinline__ unsigned cvt_pk_bf16(float lo, float hi) { f32x2cv v = {lo, hi}; bf16x2cv b = __builtin_convertvector(v, bf16x2cv); return __builtin_bit_cast(unsigned, b); }
typedef float f32x2 __attribute__((ext_vector_type(2)));
template <class Epi, class Sched, bool ALIGN_EPI = false, bool SP2 = false>
__device__ __forceinline__ void gemm_phase(PG8_LAS unsigned char* lds, const Gemm g, const Sched& S, const Epi& E, int tid) {
    float zf = 0.f; asm volatile("" : "+v"(zf));
    const int wid = __builtin_amdgcn_readfirstlane(tid >> 6), lane = tid & 63, wr = wid >> 2, wc = wid & 3, fr = lane & 15, fq = lane >> 4;
    const int K = g.K, nt = K / BK;
    unsigned voffA[2], voffB[2];
#pragma unroll
    for (int i = 0; i < 2; ++i) { int R, C; stage_rc(tid * 16 + i * 8192, R, C); const int Rb = Epi::PERM ? ((R & ~31) + perm32(R & 31)) : R;
        voffA[i] = (unsigned)(R * g.ld + C) * 2u; voffB[i] = (unsigned)(Rb * g.ld + C) * 2u; }
    const size_t kstep = (size_t)(BK * 2);
    const size_t hstep = (size_t)HALF * g.ld * 2;
    const size_t tstep = 2 * hstep;
    const unsigned ldsw = (unsigned)wid * 1024u;
    const int aoff = lds_byte(wr * 64 + fr, fq * 8), boff = lds_byte(wc * 32 + fr, fq * 8);
#define PG8_SA(b, h) (((b) * 2 + (h)) * HTB)
#define PG8_SB(b, h) ((4 + (b) * 2 + (h)) * HTB)
#define PG8_STAGE(bufoff, gbase, voff) do { _Pragma("unroll") for (int _i = 0; _i < 2; ++_i) \
        __builtin_amdgcn_global_load_lds((const unsigned*)((const char*)(gbase) + (voff)[_i]), (PG8_LAS unsigned*)(lds + (bufoff) + ldsw + _i * 8192), 16, 0, 0); } while (0)
#define PG8_LDA(dst, b, h) do { _Pragma("unroll") for (int m = 0; m < 4; ++m) _Pragma("unroll") for (int k = 0; k < 2; ++k) dst[m][k] = *(const PG8_LAS bf16x8*)(lds + PG8_SA(b, h) + aoff + m * 2048 + k * 1024); } while (0)
#define PG8_LDB(dst, b, h) do { _Pragma("unroll") for (int n = 0; n < 2; ++n) _Pragma("unroll") for (int k = 0; k < 2; ++k) dst[n][k] = *(const PG8_LAS bf16x8*)(lds + PG8_SB(b, h) + boff + n * 2048 + k * 1024); } while (0)
#define PG8_MMA(ai, bj, At, Bt) do { __builtin_amdgcn_s_setprio(1); _Pragma("unroll") for (int m = 0; m < 4; ++m) _Pragma("unroll") for (int n = 0; n < 2; ++n) _Pragma("unroll") for (int k = 0; k < 2; ++k) \
        acc[ai][bj][m][n] = __builtin_amdgcn_mfma_f32_16x16x32_bf16(Bt[n][k], At[m][k], acc[ai][bj][m][n], 0, 0, 0); __builtin_amdgcn_s_setprio(0); } while (0)
#define PG8_WAIT_V(n) asm volatile("s_waitcnt vmcnt(" #n ")" ::: "memory")
#define PG8_WAIT_L(n) asm volatile("s_waitcnt lgkmcnt(" #n ")" ::: "memory")
#define PG8_BAR __builtin_amdgcn_s_barrier()
#define PG8_SCHED __builtin_amdgcn_sched_barrier(0)
    Unit cur, nxt; int ui = 0;
    if (!S.next(0, cur)) return;
    f32x4 acc[2][2][4][2];
#pragma unroll
    for (int a = 0; a < 2; ++a)
#pragma unroll
        for (int b = 0; b < 2; ++b)
#pragma unroll
            for (int m = 0; m < 4; ++m)
#pragma unroll
                for (int n = 0; n < 2; ++n) acc[a][b][m][n] = (f32x4){zf, zf, zf, zf};
    bf16x8 At[4][2], B0[2][2], B1[2][2];
    const char* cA = (const char*)g.A + (size_t)cur.pm * tstep + (size_t)cur.k0 * 2; const char* cB = (const char*)g.Bt + (size_t)cur.pn * tstep + (size_t)cur.k0 * 2;
    S.a_ready(cur);
    if constexpr (SP2) {
        PG8_STAGE(PG8_SB(0, 0), cB, voffB); PG8_STAGE(PG8_SB(0, 1), cB + hstep, voffB); PG8_STAGE(PG8_SA(0, 0), cA, voffA); PG8_STAGE(PG8_SA(0, 1), cA + hstep, voffA);
        if (wr == 1) PG8_BAR;
        PG8_WAIT_V(2); PG8_BAR;
        PG8_STAGE(PG8_SB(1, 0), cB + kstep, voffB); PG8_STAGE(PG8_SA(1, 0), cA + kstep, voffA); PG8_STAGE(PG8_SB(1, 1), cB + hstep + kstep, voffB);
        PG8_WAIT_V(6); PG8_BAR;
    } else {
        PG8_STAGE(PG8_SB(0, 0), cB, voffB); PG8_STAGE(PG8_SA(0, 0), cA, voffA); PG8_STAGE(PG8_SB(0, 1), cB + hstep, voffB); PG8_STAGE(PG8_SA(0, 1), cA + hstep, voffA);
        if (wr == 1) PG8_BAR;
        PG8_WAIT_V(4); PG8_BAR;
        PG8_STAGE(PG8_SB(1, 0), cB + kstep, voffB); PG8_STAGE(PG8_SA(1, 0), cA + kstep, voffA); PG8_STAGE(PG8_SB(1, 1), cB + hstep + kstep, voffB);
        PG8_WAIT_V(6); PG8_BAR;
    }
    for (;;) {
        const bool has_next = S.next(ui + 1, nxt);
        const char* nA = has_next ? (const char*)g.A + (size_t)nxt.pm * tstep + (size_t)nxt.k0 * 2 : cA; const char* nB = has_next ? (const char*)g.Bt + (size_t)nxt.pn * tstep + (size_t)nxt.k0 * 2 : cB;
#pragma nounroll
        for (int t = 0; t < nt; t += 2) {
            const bool last = (t == nt - 2);
            const char* a1 = cA + (size_t)(t + 1) * kstep;
            const char* a2 = last ? nA : cA + (size_t)(t + 2) * kstep; const char* b2 = last ? nB : cB + (size_t)(t + 2) * kstep;
            const char* a3 = a2 + kstep; const char* b3 = b2 + kstep;
            if (last && has_next) S.a_ready(nxt);
            if constexpr (SP2) {
            PG8_LDB(B0, 0, 0); PG8_LDB(B1, 0, 1); PG8_SCHED; PG8_LDA(At, 0, 0); PG8_STAGE(PG8_SA(1, 1), a1 + hstep, voffA);
            PG8_WAIT_V(8); PG8_WAIT_L(0); PG8_BAR; PG8_MMA(0, 0, At, B0); PG8_MMA(0, 1, At, B1); PG8_BAR; PG8_SCHED;
            PG8_LDA(At, 0, 1); PG8_STAGE(PG8_SB(0, 0), b2, voffB); PG8_STAGE(PG8_SB(0, 1), b2 + hstep, voffB); PG8_STAGE(PG8_SA(0, 0), a2, voffA);
            PG8_WAIT_V(8); PG8_WAIT_L(0); PG8_BAR; PG8_MMA(1, 0, At, B0); PG8_MMA(1, 1, At, B1); PG8_BAR; PG8_SCHED;
            PG8_LDB(B0, 1, 0); PG8_LDB(B1, 1, 1); PG8_SCHED; PG8_LDA(At, 1, 0); PG8_STAGE(PG8_SA(0, 1), a2 + hstep, voffA);
            PG8_WAIT_V(8); PG8_WAIT_L(0); PG8_BAR; PG8_MMA(0, 0, At, B0); PG8_MMA(0, 1, At, B1); PG8_BAR; PG8_SCHED;
            PG8_LDA(At, 1, 1); PG8_STAGE(PG8_SB(1, 0), b3, voffB); PG8_STAGE(PG8_SB(1, 1), b3 + hstep, voffB); PG8_STAGE(PG8_SA(1, 0), a3, voffA);
            PG8_WAIT_V(8); PG8_WAIT_L(0); PG8_BAR; PG8_MMA(1, 0, At, B0); PG8_MMA(1, 1, At, B1); PG8_BAR; PG8_SCHED;
            } else {
            PG8_LDB(B0, 0, 0); PG8_SCHED; PG8_LDA(At, 0, 0); PG8_STAGE(PG8_SA(1, 1), a1 + hstep, voffA);
            PG8_WAIT_L(8); PG8_BAR; PG8_WAIT_L(0); PG8_MMA(0, 0, At, B0); PG8_BAR; PG8_SCHED;
            PG8_LDB(B1, 0, 1); PG8_STAGE(PG8_SB(0, 0), b2, voffB);
            PG8_BAR; PG8_WAIT_L(0); PG8_MMA(0, 1, At, B1); PG8_BAR;
            PG8_LDA(At, 0, 1); PG8_STAGE(PG8_SA(0, 0), a2, voffA);
            PG8_BAR; PG8_WAIT_L(0); PG8_MMA(1, 0, At, B0); PG8_BAR; PG8_SCHED;
            PG8_STAGE(PG8_SB(0, 1), b2 + hstep, voffB);
            PG8_WAIT_V(6); PG8_BAR; PG8_MMA(1, 1, At, B1); PG8_BAR;
            PG8_LDB(B0, 1, 0); PG8_SCHED; PG8_LDA(At, 1, 0); PG8_STAGE(PG8_SA(0, 1), a2 + hstep, voffA);
            PG8_WAIT_L(8); PG8_BAR; PG8_WAIT_L(0); PG8_MMA(0, 0, At, B0); PG8_BAR; PG8_SCHED;
            PG8_LDB(B1, 1, 1); PG8_STAGE(PG8_SB(1, 0), b3, voffB);
            PG8_BAR; PG8_WAIT_L(0); PG8_MMA(0, 1, At, B1); PG8_BAR;
            PG8_LDA(At, 1, 1); PG8_STAGE(PG8_SA(1, 0), a3, voffA);
            PG8_BAR; PG8_WAIT_L(0); PG8_MMA(1, 0, At, B0); PG8_BAR; PG8_SCHED;
            PG8_STAGE(PG8_SB(1, 1), b3 + hstep, voffB);
            PG8_WAIT_V(6); PG8_BAR; PG8_MMA(1, 1, At, B1); PG8_BAR;
            }
        }
        if constexpr (ALIGN_EPI) { if (wr == 0) PG8_BAR; }
        if constexpr (!Epi::AFTER_DRAIN) { E(acc, cur, wr, wc, fr, fq); S.done(cur); }
        if (!has_next) break;
#pragma unroll
        for (int a = 0; a < 2; ++a)
#pragma unroll
            for (int b = 0; b < 2; ++b)
#pragma unroll
                for (int m = 0; m < 4; ++m)
#pragma unroll
                    for (int n = 0; n < 2; ++n) acc[a][b][m][n] = (f32x4){zf, zf, zf, zf};
        cur = nxt; cA = nA; cB = nB; ++ui;
        if constexpr (ALIGN_EPI) { if (wr == 1) PG8_BAR; }
    }
    PG8_WAIT_V(0);
    if constexpr (!ALIGN_EPI) { if (wr == 0) PG8_BAR; }
    PG8_BAR;
    if constexpr (Epi::AFTER_DRAIN) { E.fused(acc, cur, wr, wc, fr, fq, lds, wid, lane); S.done(cur); }
#undef PG8_SA
#undef PG8_SB
#undef PG8_STAGE
#undef PG8_LDA
#undef PG8_LDB
#undef PG8_MMA
#undef PG8_WAIT_V
#undef PG8_WAIT_L
#undef PG8_BAR
#undef PG8_SCHED
}
}
namespace cg = cooperative_groups;
#include <hip/hip_bf16.h>
#include <cmath>
namespace attn_body {
using bf16=__hip_bfloat16;
using bf16x8=__attribute__((ext_vector_type(8)))short;
using s16x4=__attribute__((ext_vector_type(4)))short;
using f32x16=__attribute__((ext_vector_type(16)))float;
using u32x4=__attribute__((ext_vector_type(4)))unsigned;
constexpr int D=64,QP=512,KP=256,OP=256;
constexpr int NW=8,QBLK=32,QB=QBLK*NW,KVBLK=64;
__device__ __forceinline__ int crow(int r,int hi){return (r&3)+8*(r>>2)+4*hi;}
#define SBAR() __builtin_amdgcn_sched_barrier(0)
__device__ __forceinline__ void wmask(f32x16&p0,f32x16&p1,int dbase){
  const float NEG=-INFINITY;
  #pragma unroll
  for(int r=0;r<16;++r){int d=dbase+(r&3)+8*(r>>2); if((unsigned)(d+128)>256u)p0[r]=NEG; if((unsigned)(d+160)>256u)p1[r]=NEG;}
}

constexpr int NSLOT=3, SLOTB=8192;
constexpr int LDS_K=0, LDS_V=NSLOT*SLOTB, LDS_WS=2*NSLOT*SLOTB, LDS_OST=LDS_WS+NW*64*4, LDS_BYTES=LDS_OST+NW*4096;
constexpr float C2=0.125f*1.4426950408889634f;
__device__ __forceinline__ void glds16(const void*gsrc,unsigned lds_dst){unsigned keep;
  asm volatile("s_mov_b32 %0, m0\n\ts_mov_b32 m0, %2\n\ts_nop 0\n\tglobal_load_lds_dwordx4 %1, off\n\ts_mov_b32 m0, %0":"=&s"(keep):"v"(gsrc),"s"(lds_dst):"memory");}
__device__ __forceinline__ float max3f(float a,float b,float c){float r;asm("v_max3_f32 %0, %1, %2, %3":"=v"(r):"v"(a),"v"(b),"v"(c));return r;}
__device__ __forceinline__ float max2f(float a,float b){float r;asm("v_max_f32_e32 %0, %1, %2":"=v"(r):"v"(a),"v"(b));return r;}
__device__ __forceinline__ float fadd_s(float a,float b){float r;asm("v_add_f32_e32 %0, %1, %2":"=v"(r):"v"(a),"v"(b));return r;}
__device__ __forceinline__ float fsub_s(float a,float b){float r;asm("v_sub_f32_e32 %0, %1, %2":"=v"(r):"v"(a),"v"(b));return r;}
typedef float f32x2_t __attribute__((ext_vector_type(2))); typedef __bf16 bf16x2_t __attribute__((ext_vector_type(2)));
__device__ __forceinline__ unsigned cvtpk_s(float lo,float hi){f32x2_t v={lo,hi};bf16x2_t b=__builtin_convertvector(v,bf16x2_t);return __builtin_bit_cast(unsigned,b);}
#define WAIT_BAR(N) asm volatile("s_waitcnt vmcnt(" #N ") lgkmcnt(0)\n\ts_barrier":::"memory")

__device__ __forceinline__ void qkt(f32x16&p0,f32x16&p1,const char*Kslot,const bf16x8*qr,const f32x16&negm,int r32,int hi){
  const char*kb=Kslot+hi*1024+r32*16;
  #pragma unroll
  for(int d0=0;d0<4;++d0){
    const bf16x8 b0=*reinterpret_cast<const bf16x8*>(kb+d0*2048);
    const bf16x8 b1=*reinterpret_cast<const bf16x8*>(kb+d0*2048+512);
    if(d0==0){p0=__builtin_amdgcn_mfma_f32_32x32x16_bf16(b0,qr[0],negm,0,0,0);p1=__builtin_amdgcn_mfma_f32_32x32x16_bf16(b1,qr[0],negm,0,0,0);}
    else{p0=__builtin_amdgcn_mfma_f32_32x32x16_bf16(b0,qr[d0],p0,0,0,0);p1=__builtin_amdgcn_mfma_f32_32x32x16_bf16(b1,qr[d0],p1,0,0,0);}}
}
typedef __attribute__((address_space(3))) const char* lds_cptr;
typedef short v4i16_t __attribute__((ext_vector_type(4)));
__device__ __forceinline__ void kload8(bf16x8*kf,lds_cptr kp){
  kf[0]=*(const __attribute__((address_space(3))) bf16x8*)(kp);      kf[1]=*(const __attribute__((address_space(3))) bf16x8*)(kp+512);
  kf[2]=*(const __attribute__((address_space(3))) bf16x8*)(kp+2048); kf[3]=*(const __attribute__((address_space(3))) bf16x8*)(kp+2560);
  kf[4]=*(const __attribute__((address_space(3))) bf16x8*)(kp+4096); kf[5]=*(const __attribute__((address_space(3))) bf16x8*)(kp+4608);
  kf[6]=*(const __attribute__((address_space(3))) bf16x8*)(kp+6144); kf[7]=*(const __attribute__((address_space(3))) bf16x8*)(kp+6656);
}
__device__ __forceinline__ void kload2(bf16x8*kf,lds_cptr kp,int j){ kf[2*j]=*(const __attribute__((address_space(3))) bf16x8*)(kp+j*2048); kf[2*j+1]=*(const __attribute__((address_space(3))) bf16x8*)(kp+j*2048+512); }
__device__ __forceinline__ s16x4 vtr(lds_cptr p){ return __builtin_bit_cast(s16x4,__builtin_amdgcn_ds_read_tr16_b64_v4i16((__attribute__((address_space(3))) v4i16_t*)p)); }
__device__ __forceinline__ float rowmax(const f32x16&p0,const f32x16&p1){
  float a=max3f(p0[0],p0[1],p1[0]),b=max3f(p0[2],p0[3],p1[1]);a=max3f(a,p1[2],p1[3]);
  #pragma unroll
  for(int r=4;r<16;r+=4){a=max3f(a,p0[r],p0[r+1]);b=max3f(b,p0[r+2],p0[r+3]);a=max3f(a,p1[r],p1[r+1]);b=max3f(b,p1[r+2],p1[r+3]);}
  const float m=max2f(a,b);
  auto rr=__builtin_amdgcn_permlane32_swap(__float_as_uint(m),__float_as_uint(m),false,false);
  return max2f(__uint_as_float(rr[0]),__uint_as_float(rr[1]));
}
__device__ __forceinline__ void pv(f32x16*o,int vb,bf16x8 pa0,bf16x8 pa1,bf16x8 pa2,bf16x8 pa3){
  #pragma unroll
  for(int d0=0;d0<2;++d0){s16x4 lo[4],hi[4];
    #pragma unroll
    for(int ks=0;ks<4;++ks){
      asm volatile("ds_read_b64_tr_b16 %0,%1 offset:%c2":"=&v"(lo[ks]):"v"(vb),"i"(d0*4096+ks*1024):"memory");
      asm volatile("ds_read_b64_tr_b16 %0,%1 offset:%c2":"=&v"(hi[ks]):"v"(vb),"i"(d0*4096+ks*1024+512):"memory");}
    asm volatile("s_waitcnt lgkmcnt(0)":::"memory");SBAR();
    #define PK(k) (bf16x8){lo[k][0],lo[k][1],lo[k][2],lo[k][3],hi[k][0],hi[k][1],hi[k][2],hi[k][3]}
    o[d0]=__builtin_amdgcn_mfma_f32_32x32x16_bf16(pa0,PK(0),o[d0],0,0,0);
    o[d0]=__builtin_amdgcn_mfma_f32_32x32x16_bf16(pa1,PK(1),o[d0],0,0,0);
    o[d0]=__builtin_amdgcn_mfma_f32_32x32x16_bf16(pa2,PK(2),o[d0],0,0,0);
    o[d0]=__builtin_amdgcn_mfma_f32_32x32x16_bf16(pa3,PK(3),o[d0],0,0,0);
    #undef PK
  }
}

#ifndef ATTN_STORE16
#define ATTN_STORE16(p,v) (*(u32x4*)(p)=(v))
#endif
template<int THRL,bool WIN> __device__ __forceinline__ void attn_unit(const bf16*Qu,const bf16*__restrict__ Kh,const bf16*__restrict__ Vh,bf16*Ou,int NT,int shift,int qpos0,float sinkl2,char*shm,int tid){
  const int lane=tid&63,r32=lane&31,hi=lane>>5; const int wid=__builtin_amdgcn_readfirstlane(tid>>6);
  const bf16*Qw=Qu+(long)(wid*QBLK)*QP;
  const unsigned lds0=(unsigned)(uintptr_t)shm;
  float*wsf=(float*)(shm+LDS_WS)+wid*64;
  const bf16*ksrc=Kh+(long)lane*KP+wid*8;
  const bf16*vsrc=Vh+(long)(16*(wid&3)+(lane>>2))*KP+(wid>>2)*32+(lane&3)*8;
  const unsigned kdst=lds0+LDS_K+wid*1024, vdst=lds0+LDS_V+wid*1024;
  #define KROW(t) ((long)(((t)<4)?(t):((t)+shift))*(KVBLK*KP))
  #define DMA_K(t,slot) glds16(ksrc+KROW(t),(unsigned)__builtin_amdgcn_readfirstlane(kdst+(slot)))
  #define DMA_V(t,slot) glds16(vsrc+KROW(t),(unsigned)__builtin_amdgcn_readfirstlane(vdst+(slot)))
  const int vb0=(int)(lds0+LDS_V)+((lane>>4)&1)*32+(lane&3)*8+(4*hi+((lane&15)>>2))*64;
  const char*Kbase=shm+LDS_K; bf16x8 kf[8];
  const lds_cptr shm3=(lds_cptr)shm; const lds_cptr kp0=shm3+LDS_K+hi*1024+r32*16; const lds_cptr vp0=shm3+LDS_V+((lane>>4)&1)*32+(lane&3)*8+(4*hi+((lane&15)>>2))*64;
  DMA_K(0,0);DMA_V(0,0);DMA_K(1,SLOTB);
  bf16x8 qr[4];
  #pragma unroll
  for(int d0=0;d0<4;++d0)qr[d0]=*reinterpret_cast<const bf16x8*>(&Qw[(long)r32*QP+d0*16+hi*8]);
  float zf_=0.f;asm volatile("":"+v"(zf_)); float mhat=zf_,l_reg=zf_;f32x16 o[2];
  #pragma unroll
  for(int r=0;r<16;++r){o[0][r]=zf_;o[1][r]=zf_;}
  f32x16 negm;
  #pragma unroll
  for(int r=0;r<16;++r)negm[r]=zf_;
  asm volatile("":"+v"(negm));
  const int qrel=wid*QBLK+r32;
  const int mbase=4*hi-256-qpos0-qrel;
  #define CMASK(P0,P1,t) do{ if(WIN){ if((t)>=4) wmask(P0,P1,mbase+64*((t)+shift)); } }while(0)
  bool resc=false;
  #define START(P0,P1) do{ const float rm=rowmax(P0,P1); resc=false; \
    { const float dl=rm; mhat=fadd_s(mhat,dl); \
      _Pragma("unroll") for(int r=0;r<16;++r){P0[r]=fsub_s(P0[r],dl);P1[r]=fsub_s(P1[r],dl);} \
      _Pragma("unroll") for(int r=0;r<16;++r)negm[r]=-mhat; asm volatile("":"+v"(negm)); } \
    _Pragma("unroll") for(int r=0;r<16;++r)P0[r]=__builtin_amdgcn_exp2f(P0[r]); }while(0)
  #define RESC() do{ if(resc){ asm volatile("s_waitcnt lgkmcnt(0)":::"memory"); \
      _Pragma("unroll") for(int d_=0;d_<2;++d_) _Pragma("unroll") for(int r=0;r<16;++r)o[d_][r]*=wsf[crow(r,hi)]; } }while(0)
  f32x16 pA0,pA1,pB0,pB1;
  int sl_prev=0,sl_cur=0,sl_next=SLOTB;
  #define ROT() do{sl_prev=sl_cur;sl_cur=sl_next;sl_next=(sl_next==(NSLOT-1)*SLOTB)?0:sl_next+SLOTB;}while(0)
  DMA_K(2,2*SLOTB);
  WAIT_BAR(3);
  qkt(pA0,pA1,Kbase,qr,negm,r32,hi);asm volatile("s_nop 15\n\ts_nop 7":"+v"(pA0),"+v"(pA1));CMASK(pA0,pA1,0);
  START(pA0,pA1);
  _Pragma("unroll") for(int r=0;r<16;++r)pA1[r]=__builtin_amdgcn_exp2f(pA1[r]);
  WAIT_BAR(0);
  DMA_K(3,0);DMA_V(1,SLOTB);
  ROT();
  kload8(kf,kp0+sl_cur);
  WAIT_BAR(2);
  s16x4 vlo[8],vhi[8]; u32x4 pw0,pw1,pw2,pw3;
  #define PKW(P,B) cvtpk_s(P[B],P[B+1])
  #define PAF(k) __builtin_bit_cast(bf16x8,pw##k)
  #define VFR(i) (bf16x8){vlo[i][0],vlo[i][1],vlo[i][2],vlo[i][3],vhi[i][0],vhi[i][1],vhi[i][2],vhi[i][3]}
  #define PIN(x) asm volatile("":"+v"(x))
  #define MX3(a,b,c) __builtin_fmaxf(__builtin_fmaxf((a),(b)),(c))
  #define GAPA(MF,A0,A1,A2,A3,W0,W1,PW) do{ MF; sacc+=A0; sacc+=A1; sacc+=A2; sacc+=A3; PIN(sacc); W0; W1; PIN(PW); SBAR(); }while(0)
  #define EX(v) __builtin_amdgcn_exp2f(v)
  #define GAPB(MF,X,B) do{ MF; X[B]=EX(X[B]); X[B+1]=EX(X[B+1]); X[B+2]=EX(X[B+2]); X[B+3]=EX(X[B+3]); PIN(X); SBAR(); }while(0)
  #define VRD(i) do{ vlo[i]=vtr(vp_+(((i)>>2)*4096+((i)&3)*1024)); vhi[i]=vtr(vp_+(((i)>>2)*4096+((i)&3)*1024+512)); }while(0)
  #define KRD(G,j) do{ if(G){ kload2(kf,kp0+sl_next,j); SBAR(); } }while(0)
  #define STEP(C0,C1,P0,P1,t,GK,GV,GL) do{ SBAR(); \
    const lds_cptr vp_=vp0+sl_prev; \
    VRD(0); SBAR(); float sacc=(P0[0]+P0[1]); \
    GAPA(C0=__builtin_amdgcn_mfma_f32_32x32x16_bf16(kf[0],qr[0],negm,0,0,0), P0[2],P0[3],P0[4],P0[5],     pw0[0]=PKW(P0,0), pw0[1]=PKW(P0,2), pw0); \
    VRD(4); SBAR(); GAPA(C1=__builtin_amdgcn_mfma_f32_32x32x16_bf16(kf[1],qr[0],negm,0,0,0), P0[6],P0[7],P0[8],P0[9],     pw0[2]=PKW(P0,4), pw0[3]=PKW(P0,6), pw0); \
    VRD(1); SBAR(); GAPA(C0=__builtin_amdgcn_mfma_f32_32x32x16_bf16(kf[2],qr[1],C0,0,0,0),   P0[10],P0[11],P0[12],P0[13], pw1[0]=PKW(P0,8), pw1[1]=PKW(P0,10), pw1); \
    VRD(5); SBAR(); GAPA(C1=__builtin_amdgcn_mfma_f32_32x32x16_bf16(kf[3],qr[1],C1,0,0,0),   P0[14],P0[15],P1[0],P1[1],   pw1[2]=PKW(P0,12),pw1[3]=PKW(P0,14), pw1); \
    VRD(2); SBAR(); GAPA(C0=__builtin_amdgcn_mfma_f32_32x32x16_bf16(kf[4],qr[2],C0,0,0,0),   P1[2],P1[3],P1[4],P1[5],     pw2[0]=PKW(P1,0), pw2[1]=PKW(P1,2), pw2); \
    VRD(6); SBAR(); GAPA(C1=__builtin_amdgcn_mfma_f32_32x32x16_bf16(kf[5],qr[2],C1,0,0,0),   P1[6],P1[7],P1[8],P1[9],     pw2[2]=PKW(P1,4), pw2[3]=PKW(P1,6), pw2); \
    VRD(3); SBAR(); GAPA(C0=__builtin_amdgcn_mfma_f32_32x32x16_bf16(kf[6],qr[3],C0,0,0,0),   P1[10],P1[11],P1[12],P1[13], pw3[0]=PKW(P1,8), pw3[1]=PKW(P1,10), pw3); \
    VRD(7); SBAR(); GAPA(C1=__builtin_amdgcn_mfma_f32_32x32x16_bf16(kf[7],qr[3],C1,0,0,0),   P1[14],P1[15],0.f,0.f,       pw3[2]=PKW(P1,12),pw3[3]=PKW(P1,14), pw3); \
    l_reg+=sacc; \
    if(GK){DMA_K((t)+3,sl_cur);} if(GV){DMA_V((t)+1,sl_next);} \
    CMASK(C0,C1,t); \
    { float a=MX3(C0[0],C0[1],C1[0]),b=MX3(C0[2],C0[3],C1[1]); a=MX3(a,C1[2],C1[3]); \
      _Pragma("unroll") for(int r=4;r<16;r+=4){a=MX3(a,C0[r],C0[r+1]);b=MX3(b,C0[r+2],C0[r+3]);a=MX3(a,C1[r],C1[r+1]);b=MX3(b,C1[r+2],C1[r+3]);} \
      float rm=__builtin_fmaxf(a,b); { auto rr=__builtin_amdgcn_permlane32_swap(__float_as_uint(rm),__float_as_uint(rm),false,false); rm=__builtin_fmaxf(__uint_as_float(rr[0]),__uint_as_float(rr[1])); } \
      resc=false; \
      if(__builtin_expect(__any(rm>(float)THRL),0)){ const float dl=__builtin_fmaxf(rm,0.f); mhat+=dl; \
        _Pragma("unroll") for(int r=0;r<16;++r){C0[r]-=dl;C1[r]-=dl;} \
        _Pragma("unroll") for(int r=0;r<16;++r)negm[r]=-mhat; asm volatile("":"+v"(negm)); \
        const float f=__builtin_amdgcn_exp2f(-dl); l_reg*=f; if(hi==0)wsf[r32]=f; resc=true; } } \
    SBAR(); \
    GAPB(o[0]=__builtin_amdgcn_mfma_f32_32x32x16_bf16(PAF(0),VFR(0),o[0],0,0,0), C0,0); \
    GAPB(o[1]=__builtin_amdgcn_mfma_f32_32x32x16_bf16(PAF(0),VFR(4),o[1],0,0,0), C0,4); \
    KRD(GL,0); GAPB(o[0]=__builtin_amdgcn_mfma_f32_32x32x16_bf16(PAF(1),VFR(1),o[0],0,0,0), C0,8); \
    KRD(GL,1); GAPB(o[1]=__builtin_amdgcn_mfma_f32_32x32x16_bf16(PAF(1),VFR(5),o[1],0,0,0), C0,12); \
    KRD(GL,2); GAPB(o[0]=__builtin_amdgcn_mfma_f32_32x32x16_bf16(PAF(2),VFR(2),o[0],0,0,0), C1,0); \
    KRD(GL,3); GAPB(o[1]=__builtin_amdgcn_mfma_f32_32x32x16_bf16(PAF(2),VFR(6),o[1],0,0,0), C1,4); \
    GAPB(o[0]=__builtin_amdgcn_mfma_f32_32x32x16_bf16(PAF(3),VFR(3),o[0],0,0,0), C1,8); \
    GAPB(o[1]=__builtin_amdgcn_mfma_f32_32x32x16_bf16(PAF(3),VFR(7),o[1],0,0,0), C1,12); \
    }while(0)
  int t=1;
  for(;t+5<NT;t+=2){
    STEP(pB0,pB1,pA0,pA1,t,true,true,true);     WAIT_BAR(2); RESC(); ROT();
    STEP(pA0,pA1,pB0,pB1,t+1,true,true,true);   WAIT_BAR(2); RESC(); ROT();
  }
  #define ENDW(tt) do{ if((tt)+3<NT){WAIT_BAR(2);} else if((tt)+2<NT){WAIT_BAR(1);} else {WAIT_BAR(0);} }while(0)
  for(;t+1<NT;t+=2){
    STEP(pB0,pB1,pA0,pA1,t,(t+3<NT),(t+1<NT),(t+1<NT));       ENDW(t);   RESC(); ROT();
    STEP(pA0,pA1,pB0,pB1,t+1,(t+4<NT),(t+2<NT),(t+2<NT));     ENDW(t+1); RESC(); ROT();
  }
  STEP(pB0,pB1,pA0,pA1,NT-1,false,false,false); RESC();
  { float sacc=pB0[0]+pB0[1]; _Pragma("unroll") for(int r=2;r<16;++r)sacc+=pB0[r]; _Pragma("unroll") for(int r=0;r<16;++r)sacc+=pB1[r]; l_reg+=sacc;
    pw0=(u32x4){PKW(pB0,0),PKW(pB0,2),PKW(pB0,4),PKW(pB0,6)};pw1=(u32x4){PKW(pB0,8),PKW(pB0,10),PKW(pB0,12),PKW(pB0,14)};pw2=(u32x4){PKW(pB1,0),PKW(pB1,2),PKW(pB1,4),PKW(pB1,6)};pw3=(u32x4){PKW(pB1,8),PKW(pB1,10),PKW(pB1,12),PKW(pB1,14)};
    SBAR(); pv(o,vb0+sl_cur,PAF(0),PAF(1),PAF(2),PAF(3)); }
  #undef PKW
  #undef PAF
  #undef VFR
  #undef PIN
  #undef MX3
  #undef GAPA
  #undef GAPB
  #undef EX
  #undef VRD
  #undef KRD
  #undef STEP
  #undef ENDW
  {auto rr=__builtin_amdgcn_permlane32_swap(__float_as_uint(l_reg),__float_as_uint(l_reg),false,false);l_reg=__uint_as_float(rr[0])+__uint_as_float(rr[1]);}
  if(WIN)l_reg+=__builtin_amdgcn_exp2f(sinkl2-mhat);
  if(hi==0)wsf[32+r32]=l_reg;asm volatile("s_waitcnt lgkmcnt(0)":::"memory");
  float rli[16];
  #pragma unroll
  for(int r=0;r<16;++r)rli[r]=__builtin_amdgcn_rcpf(wsf[32+crow(r,hi)]);
  bf16*Ow=Ou+(long)(wid*QBLK)*OP;
  { bf16*stg=(bf16*)(shm+LDS_OST)+wid*2048;
    #pragma unroll
    for(int r=0;r<16;++r){const int orow=crow(r,hi);
      #pragma unroll
      for(int d0=0;d0<2;++d0)stg[orow*64+d0*32+r32]=__float2bfloat16(o[d0][r]*rli[r]);}
    asm volatile("s_waitcnt lgkmcnt(0)":::"memory");
    #pragma unroll
    for(int i=0;i<4;++i){const int row=i*8+(lane>>3),ch=lane&7; const u32x4 v=*(const u32x4*)(stg+row*64+ch*8); ATTN_STORE16(Ow+(long)row*OP+ch*8,v);} }
  asm volatile("s_waitcnt lgkmcnt(0)\n\ts_barrier":::"memory");
  #undef DMA_K
  #undef KROW
  #undef DMA_V
  #undef CMASK
  #undef START
  #undef RESC
  #undef ROT
}
constexpr int ATTN_LDS_BYTES=LDS_BYTES;
#undef SBAR
#undef WAIT_BAR
}
constexpr int NWAVES = 8;
constexpr int DM = 1024, NBATCH = 2, SEQ = 16384, CTXL = 256, TOK = SEQ + CTXL  , MR = NBATCH * TOK  ;
constexpr int DFF = 2816, NSUBMOD = 9216, DEPTH = 2;
constexpr float EPS = 1e-6f, LOG2E = 1.4426950408889634f;
constexpr int S5L = 32, S5ROWS = 1280  , S5CH = MR / S5L  , S5K = 768;

typedef unsigned short bf16;
typedef unsigned v4u __attribute__((ext_vector_type(4)));
typedef float f32x4 __attribute__((ext_vector_type(4)));
#define LAS __attribute__((address_space(3)))
#define LDS_WAIT() asm volatile("s_waitcnt lgkmcnt(0)" ::: "memory")
__device__ __forceinline__ unsigned f2bf(float f) { unsigned u = __builtin_bit_cast(unsigned, f); return (u + 0x7fffu + ((u >> 16) & 1u)) >> 16; }
__device__ __forceinline__ unsigned pk2(float lo, float hi) { return f2bf(lo) | (f2bf(hi) << 16); }
__device__ __forceinline__ float bf2f(unsigned short h) { return __builtin_bit_cast(float, (unsigned)h << 16); }
__device__ __forceinline__ float sigm(float x) { return __builtin_amdgcn_rcpf(1.0f + __builtin_amdgcn_exp2f(-x * LOG2E)); }

constexpr size_t MiB = 1u << 20;
constexpr size_t WS_MOD = 1 * MiB, WS_XC = 2 * MiB;
constexpr size_t WS_W1T = 4 * MiB, WS_W2T = 26 * MiB, WS_WINT = 37 * MiB, WS_WBT = 48 * MiB, WS_WOT = 50 * MiB, WS_WGT = 52 * MiB, WS_WPT = 52 * MiB + 256 * 1024;
constexpr size_t WS_BTY = 53 * MiB, WS_BTE = 65 * MiB, WS_E = 71 * MiB, WS_A2 = 91 * MiB, WS_HN = 121 * MiB, WS_T = 186 * MiB;
constexpr size_t WS_R = 251 * MiB;
constexpr size_t WS_HID = WS_R, WS_GS = WS_R, WS_Q = WS_R + 65 * MiB, WS_K = WS_Q + 65 * MiB / 2, WS_V = WS_K + 65 * MiB / 4, WS_XA = WS_V + 65 * MiB / 4, WS_G = WS_XA + 65 * MiB / 4,
                 WS_DIFF = WS_G + 65 * MiB / 4, WS_Y4 = WS_DIFF + 65 * MiB / 4, WS_END = WS_Y4 + 65 * MiB;
static_assert(WS_END <= 512 * MiB && WS_HID + (size_t)MR * DFF * 2 <= WS_Y4 + 65 * MiB, "ws map");
constexpr int RING_BYTES = 131072, LDS_BYTES = 147456;

struct Args { const float* in[26]; float* out; unsigned char* ws; int ph_lo, ph_hi; };
struct Frame { LAS unsigned char* lds; int lane, wave, vcu, G; };
typedef const volatile __attribute__((address_space(4))) unsigned long long karg_t;
__device__ __forceinline__ unsigned long long karg(int i) { return ((karg_t*)__builtin_amdgcn_kernarg_segment_ptr())[i]; }
#define AIN(i) ((const float*)karg(i))
#define AOUT ((float*)karg(26))
#define AWS ((unsigned char*)karg(27))
#define WSP(T, off) ((T*)(AWS + (off)))

__device__ __forceinline__ float* xrow_ptr(float* lat, float* ctxp, int r) { const int b = r / TOK, i = r - b * TOK; return i < CTXL ? ctxp + (size_t)(b * CTXL + i) * DM : lat + (size_t)(b * SEQ + i - CTXL) * DM; }

using pg8::f32x4; using pg8::Unit; using pg8::bf16_t; using pg8::cvt_pk_bf16; using pg8::u32x4;
#define EPI_ARGS const pg8::f32x4 (&acc)[2][2][4][2], const pg8::Unit& u, int wr, int wc, int fr_, int fq_
#define EPI_PIN int fr = fr_, fq = fq_; asm volatile("" : "+v"(fr), "+v"(fq));
struct EpiSwiglu { static constexpr bool PERM = true, AFTER_DRAIN = false; bf16_t* H;
    __device__ __forceinline__ void operator()(EPI_ARGS) const { EPI_PIN
        const int row0 = u.pm * 256 + wr * 64 + fr, hc = u.pn * 128 + wc * 32 + 8 * fq;
#pragma unroll
        for (int ai = 0; ai < 2; ++ai)
#pragma unroll
            for (int m = 0; m < 4; ++m) { bf16_t* rowp = H + (size_t)(row0 + ai * 128 + m * 16) * DFF + hc; float v[8];
#pragma unroll
                for (int n = 0; n < 2; ++n)
#pragma unroll
                    for (int j = 0; j < 4; ++j) { const float g = acc[ai][0][m][n][j], up = acc[ai][1][m][n][j]; v[n * 4 + j] = g * sigm(g) * up; }
                u32x4 w; w.x = cvt_pk_bf16(v[0], v[1]); w.y = cvt_pk_bf16(v[2], v[3]); w.z = cvt_pk_bf16(v[4], v[5]); w.w = cvt_pk_bf16(v[6], v[7]); *(u32x4*)rowp = w; }
    }
};
struct EpiResid { static constexpr bool PERM = true, AFTER_DRAIN = false; const float* src_lat; const float* src_ctx; float* dst_lat; float* dst_ctx; const float* gate; float sc;
    __device__ __forceinline__ void operator()(EPI_ARGS) const { EPI_PIN
        const int b = u.pm / 65, tq = u.pm - b * 65; const bool isc = tq == 0;
        const size_t off = isc ? (size_t)b * CTXL * DM : ((size_t)b * SEQ + (size_t)(tq - 1) * 256) * DM;
        const float* sp = (isc ? src_ctx : src_lat) + off; float* dp = (isc ? dst_ctx : dst_lat) + off;
        const float* gp = gate + (isc ? 2 : b) * NSUBMOD; const int col0 = u.pn * 256 + wc * 32 + 8 * fq;
        f32x4 gv[2][2];
#pragma unroll
        for (int bj = 0; bj < 2; ++bj)
#pragma unroll
            for (int n = 0; n < 2; ++n) gv[bj][n] = *(const f32x4*)(gp + col0 + bj * 128 + 4 * n) * sc;
#pragma unroll
        for (int ai = 0; ai < 2; ++ai)
#pragma unroll
            for (int m = 0; m < 4; ++m) { const size_t ro = (size_t)(ai * 128 + wr * 64 + m * 16 + fr) * DM + col0;
#pragma unroll
                for (int bj = 0; bj < 2; ++bj)
#pragma unroll
                    for (int n = 0; n < 2; ++n) { const f32x4 xv = *(const f32x4*)(sp + ro + bj * 128 + 4 * n); *(f32x4*)(dp + ro + bj * 128 + 4 * n) = xv + gv[bj][n] * acc[ai][bj][m][n]; } }
    }
};
__device__ __forceinline__ u32x4 pack8(const f32x4& a, const f32x4& b) { u32x4 w; w.x = cvt_pk_bf16(a[0], a[1]); w.y = cvt_pk_bf16(a[2], a[3]); w.z = cvt_pk_bf16(b[0], b[1]); w.w = cvt_pk_bf16(b[2], b[3]); return w; }
struct EpiRoute { static constexpr bool PERM = true, AFTER_DRAIN = false; bf16_t *Q, *K, *V, *A2, *XA;
    __device__ __forceinline__ void operator()(EPI_ARGS) const { EPI_PIN
        const int row0 = u.pm * 256 + wr * 64 + fr, cl = wc * 32 + 8 * fq;
        bf16_t* base; int ldc, coff = 0;
        if (u.pn == 0) { base = Q; ldc = 512; } else if (u.pn == 1) { base = Q; ldc = 512; coff = 256; } else if (u.pn == 2) { base = K; ldc = 256; } else if (u.pn == 3) { base = V; ldc = 256; } else { base = XA; ldc = 256; }
#pragma unroll
        for (int ai = 0; ai < 2; ++ai)
#pragma unroll
            for (int m = 0; m < 4; ++m) { const int row = row0 + ai * 128 + m * 16;
#pragma unroll
                for (int bj = 0; bj < 2; ++bj) { const u32x4 w = pack8(acc[ai][bj][m][0], acc[ai][bj][m][1]); const int c = bj * 128 + cl;
                    if (u.pn == 4) { const int g = c >> 4, h0 = c & 15; *(u32x4*)(A2 + ((size_t)g * S5ROWS + (row >> 5)) * S5K + (row & 31) * 16 + h0) = w; }
                    else *(u32x4*)(base + (size_t)row * ldc + coff + c) = w; } }
    }
};
struct EpiGate { static constexpr bool PERM = true, AFTER_DRAIN = false; bf16_t* GS;
    __device__ __forceinline__ void operator()(EPI_ARGS) const { EPI_PIN
        const int row0 = u.pm * 256 + wr * 64 + fr, col0 = u.pn * 256 + wc * 32 + 8 * fq;
#pragma unroll
        for (int ai = 0; ai < 2; ++ai)
#pragma unroll
            for (int m = 0; m < 4; ++m)
#pragma unroll
                for (int bj = 0; bj < 2; ++bj) { f32x4 a = acc[ai][bj][m][0], b = acc[ai][bj][m][1];
#pragma unroll
                    for (int j = 0; j < 4; ++j) { a[j] = sigm(a[j]); b[j] = sigm(b[j]); }
                    *(u32x4*)(GS + (size_t)(row0 + ai * 128 + m * 16) * DM + col0 + bj * 128) = pack8(a, b); }
    }
};
template <bool FIRST> struct EpiMerge { static constexpr bool PERM = true, AFTER_DRAIN = false; const bf16_t* GS; bf16_t* T;
    __device__ __forceinline__ void operator()(EPI_ARGS) const { EPI_PIN
        const int row0 = u.pm * 256 + wr * 64 + fr, col0 = u.pn * 256 + wc * 32 + 8 * fq;
#pragma unroll
        for (int ai = 0; ai < 2; ++ai)
#pragma unroll
            for (int m = 0; m < 4; ++m)
#pragma unroll
                for (int bj = 0; bj < 2; ++bj) { const size_t o = (size_t)(row0 + ai * 128 + m * 16) * DM + col0 + bj * 128;
                    const u32x4 g = *(const u32x4*)(GS + o); u32x4 t = {0u, 0u, 0u, 0u}; if (!FIRST) t = *(const u32x4*)(T + o);
                    f32x4 a = acc[ai][bj][m][0], b = acc[ai][bj][m][1];
#pragma unroll
                    for (int q = 0; q < 2; ++q) { const unsigned gw = g[q], tw = t[q], gw2 = g[q + 2], tw2 = t[q + 2];
                        a[2 * q] = __builtin_bit_cast(float, tw << 16) + (__builtin_bit_cast(float, gw << 16)) * a[2 * q]; a[2 * q + 1] = __builtin_bit_cast(float, tw & 0xffff0000u) + (__builtin_bit_cast(float, gw & 0xffff0000u)) * a[2 * q + 1];
                        b[2 * q] = __builtin_bit_cast(float, tw2 << 16) + (__builtin_bit_cast(float, gw2 << 16)) * b[2 * q]; b[2 * q + 1] = __builtin_bit_cast(float, tw2 & 0xffff0000u) + (__builtin_bit_cast(float, gw2 & 0xffff0000u)) * b[2 * q + 1]; }
                    *(u32x4*)(T + o) = pack8(a, b); }
    }
};
struct EpiPlain { static constexpr bool PERM = true, AFTER_DRAIN = false; bf16_t* O; int ldc;
    __device__ __forceinline__ void operator()(EPI_ARGS) const { EPI_PIN
        const int row0 = u.pm * 256 + wr * 64 + fr, col0 = u.pn * 256 + wc * 32 + 8 * fq;
#pragma unroll
        for (int ai = 0; ai < 2; ++ai)
#pragma unroll
            for (int m = 0; m < 4; ++m)
#pragma unroll
                for (int bj = 0; bj < 2; ++bj) *(u32x4*)(O + (size_t)(row0 + ai * 128 + m * 16) * ldc + col0 + bj * 128) = pack8(acc[ai][bj][m][0], acc[ai][bj][m][1]);
    }
};
struct EpiGlu { static constexpr bool PERM = true, AFTER_DRAIN = false; bf16_t* O;
    __device__ __forceinline__ void operator()(EPI_ARGS) const { EPI_PIN
        const int row0 = u.pm * 256 + wr * 64 + fr, col0 = u.pn * 128 + wc * 32 + 8 * fq;
#pragma unroll
        for (int ai = 0; ai < 2; ++ai)
#pragma unroll
            for (int m = 0; m < 4; ++m) { f32x4 a = acc[ai][0][m][0], b = acc[ai][0][m][1]; const f32x4 ga = acc[ai][1][m][0], gb = acc[ai][1][m][1];
#pragma unroll
                for (int j = 0; j < 4; ++j) { a[j] *= sigm(ga[j]); b[j] *= sigm(gb[j]); }
                *(u32x4*)(O + (size_t)(row0 + ai * 128 + m * 16) * 256 + col0) = pack8(a, b); }
    }
};
struct EpiF32 { static constexpr bool PERM = true, AFTER_DRAIN = false; float* O;
    __device__ __forceinline__ void operator()(EPI_ARGS) const { EPI_PIN
        const int row0 = u.pm * 256 + wr * 64 + fr, col0 = wc * 32 + 8 * fq;
#pragma unroll
        for (int ai = 0; ai < 2; ++ai)
#pragma unroll
            for (int m = 0; m < 4; ++m)
#pragma unroll
                for (int bj = 0; bj < 2; ++bj)
#pragma unroll
                    for (int n = 0; n < 2; ++n) *(f32x4*)(O + (size_t)(row0 + ai * 128 + m * 16) * 256 + col0 + bj * 128 + 4 * n) = acc[ai][bj][m][n];
    }
};
__device__ __forceinline__ float gelu_tanh(float x) { const float y = 0.7978845608028654f * (x + 0.044715f * x * x * x); return x * sigm(2.0f * y); }
struct EpiS5Y { static constexpr bool PERM = true, AFTER_DRAIN = false; bf16_t* Gb;
    __device__ __forceinline__ void operator()(EPI_ARGS) const { EPI_PIN
        const int g = u.pm / 5, i = u.pm - 5 * g, jn = u.pn & 1;
#pragma unroll
        for (int ai = 0; ai < 2; ++ai)
#pragma unroll
            for (int m = 0; m < 4; ++m) { const int cidx = i * 256 + ai * 128 + wr * 64 + m * 16 + fr;
                if (cidx < S5CH) {
#pragma unroll
                    for (int bj = 0; bj < 2; ++bj) { const int c = jn * 256 + bj * 128 + wc * 32 + 8 * fq, jo = c >> 4, h0 = c & 15; f32x4 a = acc[ai][bj][m][0], b = acc[ai][bj][m][1];
#pragma unroll
                        for (int j = 0; j < 4; ++j) { a[j] = gelu_tanh(a[j]); b[j] = gelu_tanh(b[j]); }
                        *(u32x4*)(Gb + (size_t)(cidx * S5L + jo) * 256 + g * 16 + h0) = pack8(a, b); } } }
    }
};
struct RowOrder { pg8::StaticOrder so; bool skip;
    __device__ void init(int N, int G, int c, bool skip_) { skip = skip_; so.init(skip_ ? NBATCH * SEQ : MR, N, G, c); }
    __device__ bool next(int i, Unit& u) const { if (!so.next(i, u)) return false; if (skip) u.pm = u.pm + 1 + (u.pm >> 6); return true; }
    __device__ __forceinline__ void a_ready(const Unit&) const {}
    __device__ __forceinline__ void done(const Unit&) const {}
};
struct CtxSliceOrder { int nsl, G, c;
    __device__ bool next(int i, Unit& u) const { const int L = i * G + c; if (L >= 8 * nsl) return false; const int t = L / nsl, sl = L - t * nsl; u.pm = (t >> 2) ? 65 : 0; u.pn = t & 3; u.k0 = sl * 256; return true; }
    __device__ __forceinline__ void a_ready(const Unit&) const {}
    __device__ __forceinline__ void done(const Unit&) const {}
};
struct EpiPart { static constexpr bool PERM = true, AFTER_DRAIN = false; float* P;
    __device__ __forceinline__ void operator()(EPI_ARGS) const { EPI_PIN
        const int sl = u.k0 >> 8, bb = u.pm ? 1 : 0; float* base = P + ((size_t)(sl * 2 + bb) * 256 + wr * 64 + fr) * DM + u.pn * 256 + wc * 32 + 8 * fq;
#pragma unroll
        for (int ai = 0; ai < 2; ++ai)
#pragma unroll
            for (int m = 0; m < 4; ++m)
#pragma unroll
                for (int bj = 0; bj < 2; ++bj)
#pragma unroll
                    for (int n = 0; n < 2; ++n) *(f32x4*)(base + (size_t)(ai * 128 + m * 16) * DM + bj * 128 + 4 * n) = acc[ai][bj][m][n];
    }
};
struct S5Order { int ncol, G, c;
    __device__ bool next(int i, Unit& u) const { const int L = i * G + c; if (L >= 80 * ncol) return false; const int g = L / (5 * ncol), rem = L - g * 5 * ncol; u.pm = g * 5 + rem / ncol; u.pn = g * ncol + rem % ncol; u.k0 = 0; return true; }
    __device__ __forceinline__ void a_ready(const Unit&) const {}
    __device__ __forceinline__ void done(const Unit&) const {}
};
__device__ __forceinline__ float shx(float v, int o, int lane) { return __builtin_bit_cast(float, __builtin_amdgcn_ds_bpermute((lane ^ o) << 2, __builtin_bit_cast(int, v))); }
__device__ __forceinline__ float wave_sum(float v, int lane) {
#pragma unroll
    for (int o = 1; o < 64; o <<= 1) v += shx(v, o, lane);
    return v;
}
__device__ __forceinline__ void tr_item(const float* W, int K, int ldw, int src_c0, bf16* WT, int dst_r0, int k0, LAS float* scr, int lane) {
#pragma unroll 16
    for (int i = 0; i < 32; ++i) { const int kk = 2 * i + (lane >> 5); scr[kk * 33 + (lane & 31)] = W[(size_t)(k0 + kk) * ldw + src_c0 + (lane & 31)]; }
    LDS_WAIT(); asm volatile("" ::: "memory");
    const int c = lane & 7;
#pragma unroll
    for (int j = 0; j < 4; ++j) { const int n = (lane >> 3) + 8 * j; const LAS float* s = scr + (8 * c) * 33 + n;
        v4u o; o.x = pk2(s[0 * 33], s[1 * 33]); o.y = pk2(s[2 * 33], s[3 * 33]); o.z = pk2(s[4 * 33], s[5 * 33]); o.w = pk2(s[6 * 33], s[7 * 33]);
        *(v4u*)(WT + (size_t)(dst_r0 + n) * K + k0 + 8 * c) = o; }
    LDS_WAIT(); asm volatile("" ::: "memory");
}
constexpr int CONV_ITEMS = 2 * 2816 + 2 * 1408 + 2816 + 4 * 128 + 512 + 64;
__device__ __forceinline__ void conv_item(Frame& F, int l, int it, LAS float* scr) {
    int r = it; const int lane = F.lane;
    if (r < 5632) { const int f = r / 2816; r -= f * 2816; const int kb = r / 176, n0 = (r % 176) * 32, pn = n0 >> 8, bj = (n0 >> 7) & 1, q = n0 & 127;
        tr_item(AIN(7) + (size_t)(l * 2 + f) * DM * 5632, DM, 5632, bj * DFF + 128 * pn + q, WSP(bf16, WS_W1T) + (size_t)f * 5632 * DM, n0, kb * 64, scr, lane); return; } r -= 5632;
    if (r < 2816) { const int f = r / 1408; r -= f * 1408; const int kb = r / 32, n0 = (r % 32) * 32;
        tr_item(AIN(8) + (size_t)(l * 2 + f) * DFF * DM, DFF, DM, n0, WSP(bf16, WS_W2T) + (size_t)f * DM * DFF, n0, kb * 64, scr, lane); return; } r -= 2816;
    if (r < 2816) { const int kb = r / 176, n0 = (r % 176) * 32; int src;
        if (n0 >= 1536) src = n0; else { const int t = n0 >> 8, off = n0 & 255;
            src = t == 0 ? 768 + off : t == 1 ? 1024 + off : t == 2 ? (off < 128 ? off : 512 + off - 128) : t == 3 ? (off < 128 ? 128 + off : 640 + off - 128) : t == 4 ? 256 + off : 1280 + off; }
        tr_item(AIN(9) + (size_t)l * DM * 5632, DM, 5632, src, WSP(bf16, WS_WINT), n0, kb * 64, scr, lane); return; } r -= 2816;
    if (r < 512) { const int k = r / 128; r -= k * 128; const int kb = r / 32, n0 = (r % 32) * 32;
        tr_item(AIN(23) + (size_t)(l * 4 + k) * 256 * DM, 256, DM, n0, WSP(bf16, WS_WBT) + (size_t)k * DM * 256, n0, kb * 64, scr, lane); return; } r -= 512;
    if (r < 512) { const int kb = r / 32, n0 = (r % 32) * 32;
        tr_item(AIN(24) + (size_t)l * DM * DM, DM, DM, n0, WSP(bf16, WS_WOT), n0, kb * 64, scr, lane); return; } r -= 512;
    { const int kb = r / 16, n0 = (r % 16) * 32, pn = n0 >> 8, bj = (n0 >> 7) & 1, q = n0 & 127;
        tr_item(AIN(22) + (size_t)l * 256 * 512, 256, 512, bj * 256 + 128 * pn + q, WSP(bf16, WS_WGT), n0, kb * 64, scr, lane); }
}
__device__ __forceinline__ void s5_table_item(Frame& F, int l, int item, LAS float* scr) {
    const int g = item >> 5, j = item & 31, lane = F.lane, p = lane;
    bf16* BtY = WSP(bf16, WS_BTY) + (size_t)g * 512 * S5K; bf16* BtE = WSP(bf16, WS_BTE) + (size_t)g * 256 * S5K;
    float lre[2], lim[2], cfr[2], cfi[2], are[2], aim[2], dtv[2];
#pragma unroll
    for (int d = 0; d < 2; ++d) { const int ix = ((l * 2 + d) * 16 + g) * 64 + p; are[d] = AIN(14)[ix]; aim[d] = AIN(15)[ix]; dtv[d] = expf(AIN(16)[(l * 2 + d) * 16 + g]);
        const float mg = expf(are[d] * dtv[d]); float sn, cs; sincosf(aim[d] * dtv[d], &sn, &cs); const float br = mg * cs - 1.0f, bi = mg * sn; const float den = 1.0f / (are[d] * are[d] + aim[d] * aim[d]);
        cfr[d] = (br * are[d] + bi * aim[d]) * den; cfi[d] = (bi * are[d] - br * aim[d]) * den; }
#define LAMPOW(d, e, outr, outi) do { const float mg_ = expf(are[d] * dtv[d] * (float)(e)); float sn_, cs_; sincosf(aim[d] * dtv[d] * (float)(e), &sn_, &cs_); outr = mg_ * cs_; outi = mg_ * sn_; } while (0)
#pragma unroll
    for (int d = 0; d < 2; ++d) { float pr, pi; LAMPOW(d, j, pr, pi); scr[(d * 64 + p) * 2] = pr * cfr[d] - pi * cfi[d]; scr[(d * 64 + p) * 2 + 1] = pr * cfi[d] + pi * cfr[d]; }
    LDS_WAIT(); asm volatile("" ::: "memory");
    const int hi_ = lane & 15;
#pragma unroll 1
    for (int i2 = 0; i2 < 4; ++i2) { const int ho = (lane >> 4) + 4 * i2; float kv[2];
#pragma unroll
        for (int d = 0; d < 2; ++d) { const float* cr = AIN(19) + (((size_t)(l * 2 + d) * 16 + g) * 16 + ho) * 64; const float* ci = AIN(20) + (((size_t)(l * 2 + d) * 16 + g) * 16 + ho) * 64;
            const float* br = AIN(17) + ((size_t)(l * 2 + d) * 16 + g) * 64 * 16 + hi_; const float* bi = AIN(18) + ((size_t)(l * 2 + d) * 16 + g) * 64 * 16 + hi_; float s = 0.f;
#pragma unroll 16
            for (int pp = 0; pp < 64; ++pp) { const float zr = scr[(d * 64 + pp) * 2], zi = scr[(d * 64 + pp) * 2 + 1], b_r = br[pp * 16], b_i = bi[pp * 16];
                const float wr_ = zr * b_r - zi * b_i, wi_ = zr * b_i + zi * b_r; s += cr[pp] * wr_ - ci[pp] * wi_; }
            kv[d] = s; }
        if (j == 0) { const float v = kv[0] + kv[1] + (ho == hi_ ? AIN(21)[l * 256 + g * 16 + ho] : 0.f);
            for (int q = 0; q < 32; ++q) BtY[(size_t)(q * 16 + ho) * S5K + q * 16 + hi_] = (bf16)f2bf(v); }
        else { const bf16 vf = (bf16)f2bf(kv[0]), vb = (bf16)f2bf(kv[1]);
            for (int q = 0; q + j < 32; ++q) { BtY[(size_t)((q + j) * 16 + ho) * S5K + q * 16 + hi_] = vf; BtY[(size_t)(q * 16 + ho) * S5K + (q + j) * 16 + hi_] = vb; } }
    }
#pragma unroll
    for (int d = 0; d < 2; ++d) { float pr, pi; LAMPOW(d, (d == 0 ? j + 1 : S5L - j), pr, pi);
#pragma unroll
        for (int ho = 0; ho < 16; ++ho) { const size_t ci_ = (((size_t)(l * 2 + d) * 16 + g) * 16 + ho) * 64 + p; const float c_r = AIN(19)[ci_], c_i = AIN(20)[ci_];
            bf16* row = BtY + (size_t)(j * 16 + ho) * S5K + 512 + d * 128; row[p] = (bf16)f2bf(c_r * pr - c_i * pi); row[64 + p] = (bf16)f2bf(-(c_r * pi + c_i * pr)); } }
#pragma unroll
    for (int d = 0; d < 2; ++d) { float pr, pi; LAMPOW(d, (d == 0 ? S5L - 1 - j : j), pr, pi); const float zr = pr * cfr[d] - pi * cfi[d], zi = pr * cfi[d] + pi * cfr[d];
#pragma unroll
        for (int h = 0; h < 16; ++h) { const size_t bi_ = (((size_t)(l * 2 + d) * 16 + g) * 64 + p) * 16 + h; const float b_r = AIN(17)[bi_], b_i = AIN(18)[bi_];
            BtE[(size_t)(d * 128 + p) * S5K + j * 16 + h] = (bf16)f2bf(zr * b_r - zi * b_i); BtE[(size_t)(d * 128 + 64 + p) * S5K + j * 16 + h] = (bf16)f2bf(zr * b_i + zi * b_r); } }
    for (int q = lane; q < 8 * 256; q += 64) BtE[(size_t)(8 * j + (q >> 8)) * S5K + 512 + (q & 255)] = 0;
#undef LAMPOW
    LDS_WAIT(); asm volatile("" ::: "memory");
}
__device__ __forceinline__ void prep_layer(Frame& F, int l) {
    LAS float* scr = (LAS float*)(F.lds + F.wave * 16384);
    const int gw = F.vcu * NWAVES + F.wave, NGW = F.G * NWAVES;
    for (int it = gw; it < CONV_ITEMS; it += NGW) conv_item(F, l, it, scr);
    for (int it = NGW - 1 - gw; it < 512; it += NGW) s5_table_item(F, l, it, scr);
    const int gt = gw * 64 + F.lane, NGT = NGW * 64;
    { bf16* Wp = WSP(bf16, WS_WPT); const float* pw = AIN(12) + (size_t)l * 4 * 64 * 64; const float* ps = AIN(13) + l * 256;
      for (int e = gt; e < 65536; e += NGT) { const int n = e >> 8, k = e & 255; Wp[e] = (bf16)(((n >> 6) == (k >> 6)) ? f2bf(pw[((n >> 6) * 64 + (k & 63)) * 64 + (n & 63)] * ps[n]) : 0u); } }
    { bf16* A2 = WSP(bf16, WS_A2); unsigned z_ = 0u; asm volatile("" : "+v"(z_)); for (int e = gt; e < 16 * S5ROWS * 32; e += NGT) { const int row = e >> 5, c8 = e & 31; *(v4u*)(A2 + (size_t)row * S5K + 512 + c8 * 8) = (v4u){z_, z_, z_, z_}; } }
}
__device__ __forceinline__ void mod_phase(Frame& F) {
    LAS float* red = (LAS float*)F.lds;
    for (int it = F.vcu; it < DEPTH * (NSUBMOD / 64); it += F.G) { const int l = it / (NSUBMOD / 64), n = (it % (NSUBMOD / 64)) * 64 + F.lane;
        const float* w = AIN(4) + ((size_t)l * DM + F.wave * 128) * NSUBMOD + n; float a0 = 0.f, a1 = 0.f, a2 = 0.f;
#pragma unroll 16
        for (int k = 0; k < 128; ++k) { const int kk = F.wave * 128 + k; const float c0 = AIN(1)[kk], c1 = AIN(1)[DM + kk], c2 = AIN(3)[kk]; const float wv = w[(size_t)k * NSUBMOD];
            a0 += c0 * sigm(c0) * wv; a1 += c1 * sigm(c1) * wv; a2 += c2 * sigm(c2) * wv; }
        red[(F.wave * 3 + 0) * 64 + F.lane] = a0; red[(F.wave * 3 + 1) * 64 + F.lane] = a1; red[(F.wave * 3 + 2) * 64 + F.lane] = a2;
        __syncthreads();
        if (F.wave < 3) { float s = AIN(5)[l * NSUBMOD + n];
#pragma unroll
            for (int w8 = 0; w8 < 8; ++w8) s += red[(w8 * 3 + F.wave) * 64 + F.lane];
            WSP(float, WS_MOD)[((size_t)l * 3 + F.wave) * NSUBMOD + n] = s; }
        __syncthreads();
    }
}
__device__ __forceinline__ void norm_phase(Frame& F, int l, int sub, const float* lat, const float* ctxp, const float* part = nullptr, int nsl = 0, const float* pgate = nullptr, float psc = 0.f, const float* psrc = nullptr, float* pdst = nullptr) {
    const int gw = F.vcu * NWAVES + F.wave, NGW = F.G * NWAVES; const float* gptr = AIN(6) + (size_t)(l * 3 + sub) * DM; bf16* HN = WSP(bf16, WS_HN);
    for (int r0 = gw; r0 < MR; r0 += 2 * NGW) { f32x4 v[2][4]; float s[2]; const float* mod[2]; int rr[2];
#pragma unroll
        for (int q2 = 0; q2 < 2; ++q2) { int r = r0 + q2 * NGW; if (r >= MR) r = r0; rr[q2] = r; const int b = r / TOK, i = r - b * TOK;
            const float* xr = i < CTXL ? ctxp + (size_t)(b * CTXL + i) * DM : lat + (size_t)(b * SEQ + i - CTXL) * DM;
            mod[q2] = WSP(float, WS_MOD) + ((size_t)l * 3 + (i < CTXL ? 2 : b)) * NSUBMOD + sub * 3072; s[q2] = 0.f;
            if (part != nullptr && i < CTXL) { const size_t ro = (size_t)(b * CTXL + i) * DM;
#pragma unroll
                for (int j = 0; j < 4; ++j) { f32x4 a = {0.f, 0.f, 0.f, 0.f};
                    for (int sl = 0; sl < nsl; ++sl) a += *((const f32x4*)(part + (size_t)sl * 2 * CTXL * DM + ro) + F.lane + 64 * j);
                    const f32x4 o = *((const f32x4*)(psrc + ro) + F.lane + 64 * j) + (*((const f32x4*)pgate + F.lane + 64 * j) * psc) * a;
                    if (q2 == 0 || r != r0) *((f32x4*)(pdst + ro) + F.lane + 64 * j) = o; v[q2][j] = o; } }
            else {
#pragma unroll
                for (int j = 0; j < 4; ++j) v[q2][j] = *((const f32x4*)xr + F.lane + 64 * j); } }
#pragma unroll
        for (int q2 = 0; q2 < 2; ++q2) {
#pragma unroll
            for (int j = 0; j < 4; ++j) s[q2] += (v[q2][j].x * v[q2][j].x + v[q2][j].y * v[q2][j].y) + (v[q2][j].z * v[q2][j].z + v[q2][j].w * v[q2][j].w);
            const float rstd = 1.0f / sqrtf(wave_sum(s[q2], F.lane) * (1.0f / DM) + EPS);
            if (q2 == 0 || rr[1] != rr[0]) {
#pragma unroll
                for (int j = 0; j < 4; ++j) { const f32x4 gg = *((const f32x4*)gptr + F.lane + 64 * j), sh = *((const f32x4*)mod[q2] + F.lane + 64 * j), sc = *((const f32x4*)(mod[q2] + DM) + F.lane + 64 * j);
                    const f32x4 o = (v[q2][j] * rstd * gg) * (sc + 1.0f) + sh;
                    *((unsigned long long*)(HN + (size_t)rr[q2] * DM) + F.lane + 64 * j) = (unsigned long long)pk2(o.x, o.y) | ((unsigned long long)pk2(o.z, o.w) << 32); } } }
    }
}
__device__ __forceinline__ void final_norm_phase(Frame& F) {
    const int gw = F.vcu * NWAVES + F.wave, NGW = F.G * NWAVES; const float* gptr = AIN(25);
    for (int r = gw; r < NBATCH * SEQ; r += NGW) { float* xr = AOUT + (size_t)r * DM; f32x4 v[4]; float s = 0.f;
#pragma unroll
        for (int j = 0; j < 4; ++j) { v[j] = *((const f32x4*)xr + F.lane + 64 * j); s += (v[j].x * v[j].x + v[j].y * v[j].y) + (v[j].z * v[j].z + v[j].w * v[j].w); }
        const float rstd = 1.0f / sqrtf(wave_sum(s, F.lane) * (1.0f / DM) + EPS);
#pragma unroll
        for (int j = 0; j < 4; ++j) { const f32x4 gg = *((const f32x4*)gptr + F.lane + 64 * j); *((f32x4*)xr + F.lane + 64 * j) = v[j] * rstd * gg; }
    }
}
__device__ __forceinline__ void post_phase(Frame& F, int l) {
    const int gw = F.vcu * NWAVES + F.wave, NGW = F.G * NWAVES, lane = F.lane, hh = lane >> 4, d = lane & 15;
    bf16* Q = WSP(bf16, WS_Q); bf16* K = WSP(bf16, WS_K); const bf16* XA = WSP(bf16, WS_XA); bf16* DF = WSP(bf16, WS_DIFF);
    const float inv = exp2f(-(float)d * (13.287712379549449f / 16.0f));
    const float* qg = AIN(11) + (size_t)l * 128; const float* kg = qg + 64;
    for (int r = gw; r < MR; r += NGW) { const int b = r / TOK, i = r - b * TOK; const bool lat = i >= CTXL; const int t = i - CTXL;
        const int n = lat ? SEQ : CTXL, ts = lat ? t : i; const size_t seg0 = (size_t)(r - ts); float pd[4];
#pragma unroll
        for (int j = 0; j < 4; ++j) { const int w = 2 << j; int lo = ts - (w >> 1), hi2 = lo + w; lo = lo < 0 ? 0 : lo; hi2 = hi2 > n ? n : hi2; float s = 0.f;
            for (int q2 = lo; q2 < hi2; ++q2) s += bf2f(XA[(seg0 + q2) * 256 + j * 64 + lane]);
            pd[j] = s / (float)(hi2 - lo) - bf2f(XA[(size_t)r * 256 + j * 64 + lane]); }
        float x[3][4];
#pragma unroll
        for (int it = 0; it < 3; ++it) { const bf16* p = it < 2 ? Q + (size_t)r * 512 + (it * 4 + hh) * 64 + d : K + (size_t)r * 256 + hh * 64 + d;
            x[it][0] = bf2f(p[0]); x[it][1] = bf2f(p[16]); x[it][2] = bf2f(p[32]); x[it][3] = bf2f(p[48]); }
        float cr = 1.f, sr = 0.f, cc = 1.f, sc = 0.f;
        if (lat) { sincosf((float)(t >> 6) * inv, &sr, &cr); sincosf((float)(t & 63) * inv, &sc, &cc); }
#pragma unroll
        for (int it = 0; it < 3; ++it) { float x0 = x[it][0], x1 = x[it][1], x2 = x[it][2], x3 = x[it][3];
            const bool nrm = (it == 1) || (it == 2 && hh >= 2);
            float ss = (x0 * x0 + x1 * x1) + (x2 * x2 + x3 * x3);
            ss += shx(ss, 1, lane); ss += shx(ss, 2, lane); ss += shx(ss, 4, lane); ss += shx(ss, 8, lane);
            if (nrm) { const float rs = 1.0f / sqrtf(ss * (1.0f / 64.0f) + EPS); const float* gp = it == 1 ? qg : kg; x0 *= rs * gp[d]; x1 *= rs * gp[d + 16]; x2 *= rs * gp[d + 32]; x3 *= rs * gp[d + 48]; }
            float o0 = x0 * cr - x1 * sr, o1 = x1 * cr + x0 * sr, o2 = x2 * cc - x3 * sc, o3 = x3 * cc + x2 * sc;
            if (it < 2) { o0 *= attn_body::C2; o1 *= attn_body::C2; o2 *= attn_body::C2; o3 *= attn_body::C2; }
            x[it][0] = o0; x[it][1] = o1; x[it][2] = o2; x[it][3] = o3; }
#pragma unroll
        for (int it = 0; it < 3; ++it) { bf16* p = it < 2 ? Q + (size_t)r * 512 + (it * 4 + hh) * 64 + d : K + (size_t)r * 256 + hh * 64 + d;
            p[0] = (bf16)f2bf(x[it][0]); p[16] = (bf16)f2bf(x[it][1]); p[32] = (bf16)f2bf(x[it][2]); p[48] = (bf16)f2bf(x[it][3]); }
#pragma unroll
        for (int j = 0; j < 4; ++j) DF[(size_t)r * 256 + j * 64 + lane] = (bf16)f2bf(pd[j]);
    }
}
__device__ __forceinline__ void s5_carry_phase(Frame& F, int l) {
    const int cid = (int)blockIdx.x - (F.G - 64);
    if (F.wave != 0 || cid < 0) return;
    const int b = cid >> 5, d = (cid >> 4) & 1, g = cid & 15, p = F.lane;
    const int ix = ((l * 2 + d) * 16 + g) * 64 + p; const float are = AIN(14)[ix], aim = AIN(15)[ix], dt = expf(AIN(16)[(l * 2 + d) * 16 + g]);
    const float mg = expf(are * dt * (float)S5L); float sn, cs; sincosf(aim * dt * (float)S5L, &sn, &cs); const float Lr = mg * cs, Li = mg * sn;
    const float* E = WSP(float, WS_E) + (size_t)g * S5ROWS * 256 + d * 128 + p; bf16* A2 = WSP(bf16, WS_A2) + (size_t)g * S5ROWS * S5K + 512 + d * 128 + p;
    float sr = 0.f, si = 0.f;
#pragma unroll 1
    for (int k0 = 0; k0 < 520; k0 += 65) { float er[65], ei[65];
#pragma unroll
        for (int k = 0; k < 65; ++k) { const int kk = k0 + k; const int ch = d == 0 ? kk : (kk < 8 ? 7 - kk : 527 - kk); const size_t row = (size_t)b * 520 + ch; er[k] = E[row * 256]; ei[k] = E[row * 256 + 64]; }
#pragma unroll
        for (int k = 0; k < 65; ++k) { const int kk = k0 + k; const int ch = d == 0 ? kk : (kk < 8 ? 7 - kk : 527 - kk); const size_t row = (size_t)b * 520 + ch;
            A2[row * S5K] = (bf16)f2bf(sr); A2[row * S5K + 64] = (bf16)f2bf(si);
            const float nr = Lr * sr - Li * si + er[k], ni = Lr * si + Li * sr + ei[k]; sr = nr; si = ni; } }
}
__device__ __forceinline__ void attn_one(Frame& F, int l, int kind, int b, int h, int qb, char* lds) {
    using namespace attn_body;
    const attn_body::bf16* Q = (const attn_body::bf16*)WSP(::bf16, WS_Q); const attn_body::bf16* K = (const attn_body::bf16*)WSP(::bf16, WS_K); const attn_body::bf16* V = (const attn_body::bf16*)WSP(::bf16, WS_V);
    attn_body::bf16* O = (attn_body::bf16*)WSP(::bf16, WS_Y4) + (size_t)(kind == 0 ? 1 : 3) * MR * 256;
    const size_t row0 = (size_t)b * TOK + (size_t)qb * 256;
    const attn_body::bf16* Qu = Q + row0 * 512 + kind * 256 + h * 64; const attn_body::bf16* Kh = K + (size_t)b * TOK * 256 + kind * 128 + (h >> 1) * 64; const attn_body::bf16* Vh = V + (size_t)b * TOK * 256 + kind * 128 + (h >> 1) * 64;
    attn_body::bf16* Ou = O + row0 * 256 + h * 64;
    if (kind == 0) { int NT = 4, shift = 0;
        if (qb > 0) { const int lo = (4 * qb - 2) < 4 ? 4 : (4 * qb - 2), hi = (4 * qb + 5) > 259 ? 259 : (4 * qb + 5); NT = 4 + hi - lo + 1; shift = lo - 4; }
        attn_unit<8, true>(Qu, Kh, Vh, Ou, NT, shift, (qb - 1) * 256, AIN(10)[l * 4 + h] * LOG2E, lds, F.wave * 64 + F.lane);
    } else attn_unit<8, false>(Qu, Kh, Vh, Ou, qb > 0 ? 260 : 4, 0, 0, 0.f, lds, F.wave * 64 + F.lane);
}
__device__ __forceinline__ void attn_phase(Frame& F, int l, char* lds) {
    const int c = F.vcu;
#pragma unroll 1
    for (int u = c; u < 512; u += F.G) attn_one(F, l, 0, u >> 8, (u >> 6) & 3, 1 + (u & 63), lds);
#pragma unroll 1
    for (int u = c; u < 16; u += F.G) attn_one(F, l, u >> 3, (u >> 2) & 1, u & 3, 0, lds);
#pragma unroll 1
    for (int u = c; u < 512; u += F.G) attn_one(F, l, 1, u >> 8, (u >> 6) & 3, 1 + (u & 63), lds);
}

#define XB_TMO      128
#define XB_XCNT(j)  (256  + 64 * (j))
#define XB_XSUB(j)  (1280 + 64 * (j))
#define XB_XGEN(j)  (2304 + 64 * (j))
#define XB_TOP      3328
#define XB_TOPGEN   3392
#define XCD_BAR_WORDS 3456
#define XB_SPIN_CAP (1u << 18)

__device__ __forceinline__ unsigned xb_ld(unsigned* p)              { return __hip_atomic_load(p, __ATOMIC_RELAXED, __HIP_MEMORY_SCOPE_AGENT); }
__device__ __forceinline__ unsigned xb_add(unsigned* p, unsigned v) { return __hip_atomic_fetch_add(p, v, __ATOMIC_RELAXED, __HIP_MEMORY_SCOPE_AGENT); }
__device__ __forceinline__ unsigned xb_xcc_id() { return (unsigned)__builtin_amdgcn_s_getreg((3 << 11) | 20) & 0xFu; }
#define XB_SPIN(cond, bar) do { unsigned _sp = 0; while (cond) { __builtin_amdgcn_s_sleep(1); \
    if ((++_sp & 255u) == 0u) { if (xb_ld(&(bar)[XB_TMO])) break; if (_sp > XB_SPIN_CAP) { atomicAdd(&(bar)[XB_TMO], 1u); break; } } } } while (0)

struct XcdBarrier {
    unsigned* bar; unsigned x;
    volatile LAS unsigned* st;
};

__device__ __forceinline__ XcdBarrier xcd_barrier_post(unsigned* bar, volatile LAS unsigned* st) {
    XcdBarrier b; b.bar = bar; b.x = xb_xcc_id(); b.st = st;
    if (threadIdx.x == 0) (void)xb_add(&bar[XB_XCNT(b.x)], 1u);
    return b;
}
__device__ __forceinline__ void xcd_barrier_complete(unsigned* bar, unsigned x, unsigned& nloc, unsigned& nx) {
    const unsigned G = gridDim.x * gridDim.y * gridDim.z;
    unsigned sum, cnt, mine, sp = 0u;
    for (;;) {
        sum = 0u; cnt = 0u; mine = 0u;
#pragma unroll
        for (unsigned j = 0; j < 16; ++j) { const unsigned c = xb_ld(&bar[XB_XCNT(j)]); sum += c; cnt += (c > 0u) ? 1u : 0u; mine = (j == x) ? c : mine; }
        if (sum == G) break;
        __builtin_amdgcn_s_sleep(1);
        if ((++sp & 255u) == 0u) { if (xb_ld(&bar[XB_TMO])) break; if (sp > XB_SPIN_CAP) { atomicAdd(&bar[XB_TMO], 1u); break; } }
    }
    nloc = mine > 0u ? mine : 1u; nx = cnt > 0u ? cnt : 1u;
}

__device__ __forceinline__ void xcd_barrier(const XcdBarrier& b) {
    asm volatile("s_waitcnt vmcnt(0)" ::: "memory");
    __syncthreads();
    if (threadIdx.x == 0) {
        unsigned* bar = b.bar;
        __builtin_amdgcn_s_waitcnt(0);
        unsigned nloc = b.st[0], nx = b.st[1];
        if (nloc == 0u) { xcd_barrier_complete(bar, b.x, nloc, nx); b.st[0] = nloc; b.st[1] = nx; }
        const unsigned old = xb_add(&bar[XB_XSUB(b.x)], 1u);
        const unsigned gen = old / nloc;
        if (old + 1u == (gen + 1u) * nloc) {
            __builtin_amdgcn_fence(__ATOMIC_RELEASE, "agent");
            asm volatile("s_waitcnt vmcnt(0)" ::: "memory");
            const unsigned og = xb_add(&bar[XB_TOP], 1u);
            const unsigned tg = og / nx;
            if (og + 1u == (tg + 1u) * nx) xb_add(&bar[XB_TOPGEN], 1u);
            else XB_SPIN(xb_ld(&bar[XB_TOPGEN]) == tg, bar);
            __builtin_amdgcn_fence(__ATOMIC_ACQUIRE, "agent");
            xb_add(&bar[XB_XGEN(b.x)], 1u);
            asm volatile("s_waitcnt vmcnt(0)" ::: "memory");
        } else {
            XB_SPIN(xb_ld(&bar[XB_XGEN(b.x)]) == gen, bar);
            __builtin_amdgcn_fence(__ATOMIC_ACQUIRE, "agent");
            asm volatile("s_waitcnt vmcnt(0)" ::: "memory");
        }
    }
    __syncthreads();
}

constexpr size_t WS_BAR = 16384;
#ifndef MK_SPLIT
#define MK_SPLIT 0
#endif
constexpr int N_PHASES = 2 + DEPTH * 14 + 1;
__global__ void __launch_bounds__(NWAVES * 64, 2) mk_fwd(Args args) {
    extern __shared__ __attribute__((aligned(16))) unsigned char lds[];
    Frame F;
    F.lds = (LAS unsigned char*)lds; F.lane = 0; F.wave = __builtin_amdgcn_readfirstlane(threadIdx.x >> 6);
    F.G = gridDim.x; { const int bx = blockIdx.x; F.vcu = (F.G % 8 == 0) ? (bx % 8) * (F.G / 8) + bx / 8 : bx; }
    { volatile LAS unsigned* st_ = (volatile LAS unsigned*)(F.lds + RING_BYTES + 512); if (threadIdx.x < 2) st_[threadIdx.x] = 0u; __syncthreads();
      (void)xcd_barrier_post((unsigned*)(AWS + WS_BAR), st_); }
    const int lo = args.ph_lo, hi = args.ph_hi; int ph = 0;
#ifndef ONLY_MASK
#define ONLY_MASK 0xffffffffu
#endif
#define SEL(n) ((ONLY_MASK >> (n)) & 1u)
#define PH_BEGIN if (lo <= ph && ph < hi) { { int l_; asm volatile("v_mbcnt_lo_u32_b32 %0, -1, 0\n\tv_mbcnt_hi_u32_b32 %0, -1, %0" : "=v"(l_)); F.lane = l_; }
#define PH_END   if (ph + 1 < hi) { asm volatile("s_waitcnt vmcnt(0) lgkmcnt(0)" ::: "memory");   \
        if (hi < 0) cg::this_grid().sync();   \
        else { XcdBarrier xb_; xb_.bar = (unsigned*)(AWS + WS_BAR); xb_.x = xb_xcc_id(); xb_.st = (volatile LAS unsigned*)(F.lds + RING_BYTES + 512); xcd_barrier(xb_); } } } ++ph;
#define GEMM(EPI, SCHEDT, A_, B_, K_, S_, E_) pg8::gemm_phase<EPI, SCHEDT, true, true>(F.lds, pg8::Gemm{(const pg8::bf16_t*)(A_), (const pg8::bf16_t*)(B_), 0, 0, (K_), (K_)}, S_, E_, F.wave * 64 + F.lane)
#define GEMML(EPI, SCHEDT, A_, B_, K_, LD_, S_, E_) pg8::gemm_phase<EPI, SCHEDT, true, true>(F.lds, pg8::Gemm{(const pg8::bf16_t*)(A_), (const pg8::bf16_t*)(B_), 0, 0, (K_), (LD_)}, S_, E_, F.wave * 64 + F.lane)
    float* XC = WSP(float, WS_XC);
    PH_BEGIN if (SEL(1)) { prep_layer(F, 0); __syncthreads(); mod_phase(F); } PH_END
#pragma unroll 1
    for (int l = 0; l < DEPTH; ++l) {
        const bool last = (l == DEPTH - 1);
        const float* MODl = WSP(float, WS_MOD) + (size_t)l * 3 * NSUBMOD;
        const float* srcL = l == 0 ? AIN(0) : AOUT; const float* srcC = l == 0 ? AIN(2) : XC;
        PH_BEGIN if (SEL(2)) { if (l > 0) { prep_layer(F, l); } if (l > 0) norm_phase(F, l, 0, srcL, srcC, WSP(float, WS_Y4), 11, WSP(float, WS_MOD) + (size_t)(l - 1) * 3 * NSUBMOD + 2 * 3072 + 2048 + 2 * NSUBMOD, 0.5f, XC, XC); else norm_phase(F, l, 0, srcL, srcC); } PH_END
#pragma unroll 1
        for (int f = 0; f < 2; ++f) {
            if (f == 1) {
                PH_BEGIN if (SEL(3)) { { RowOrder S; S.init(1536, F.G, (int)blockIdx.x, false); EpiRoute E{WSP(bf16_t, WS_Q), WSP(bf16_t, WS_K), WSP(bf16_t, WS_V), WSP(bf16_t, WS_A2), WSP(bf16_t, WS_XA)};
                    GEMM(EpiRoute, RowOrder, WSP(bf16, WS_HN), WSP(bf16, WS_WINT), DM, S, E); } } PH_END
                PH_BEGIN if (SEL(4)) { { post_phase(F, l); S5Order S{1, F.G, (int)blockIdx.x}; EpiF32 E{WSP(float, WS_E)}; GEMM(EpiF32, S5Order, WSP(bf16, WS_A2), WSP(bf16, WS_BTE), S5K, S, E); } } PH_END
                PH_BEGIN if (SEL(5)) { { s5_carry_phase(F, l); RowOrder S; S.init(256, F.G, (int)blockIdx.x, last); EpiPlain E{WSP(bf16_t, WS_Y4), 256}; GEMM(EpiPlain, RowOrder, WSP(bf16, WS_DIFF), WSP(bf16, WS_WPT), 256, S, E); } } PH_END
                PH_BEGIN if (SEL(6)) { { S5Order S{2, F.G, (int)blockIdx.x}; EpiS5Y E{WSP(bf16_t, WS_G)}; GEMM(EpiS5Y, S5Order, WSP(bf16, WS_A2), WSP(bf16, WS_BTY), S5K, S, E); } } PH_END
                PH_BEGIN if (SEL(7)) { { RowOrder S; S.init(512, F.G, (int)blockIdx.x, last); EpiGlu E{WSP(bf16_t, WS_Y4) + (size_t)2 * MR * 256}; GEMM(EpiGlu, RowOrder, WSP(bf16, WS_G), WSP(bf16, WS_WGT), 256, S, E);
                    attn_phase(F, l, (char*)lds); } } PH_END
                PH_BEGIN if (SEL(8)) { { RowOrder S; S.init(DM, F.G, (int)blockIdx.x, last);
#pragma unroll 1
                    for (int k = 0; k < 4; ++k) { EpiGate Eg{WSP(bf16_t, WS_GS)}; GEMM(EpiGate, RowOrder, WSP(bf16, WS_HN), WSP(bf16, WS_WINT) + (size_t)(1536 + k * 1024) * DM, DM, S, Eg);
                        const bf16* Ak = WSP(bf16, WS_Y4) + (size_t)k * MR * 256; const bf16* Bk = WSP(bf16, WS_WBT) + (size_t)k * DM * 256;
                        if (k == 0) { EpiMerge<true> Em{WSP(bf16_t, WS_GS), WSP(bf16_t, WS_T)}; GEMM(EpiMerge<true>, RowOrder, Ak, Bk, 256, S, Em); }
                        else { EpiMerge<false> Em{WSP(bf16_t, WS_GS), WSP(bf16_t, WS_T)}; GEMM(EpiMerge<false>, RowOrder, Ak, Bk, 256, S, Em); } } } } PH_END
                PH_BEGIN if (SEL(9)) { { RowOrder S; S.init(DM, F.G, (int)blockIdx.x, true); EpiResid E{AOUT, XC, AOUT, XC, MODl + 1 * 3072 + 2048, 1.0f}; GEMM(EpiResid, RowOrder, WSP(bf16, WS_T), WSP(bf16, WS_WOT), DM, S, E); }
                    if (!last) { CtxSliceOrder S{4, F.G, (int)blockIdx.x}; EpiPart E{WSP(float, WS_Y4)}; GEMML(EpiPart, CtxSliceOrder, WSP(bf16, WS_T), WSP(bf16, WS_WOT), 256, DM, S, E); } } PH_END
                PH_BEGIN if (SEL(10)) { if (!last) norm_phase(F, l, 2, AOUT, XC, WSP(float, WS_Y4), 4, MODl + 1 * 3072 + 2048 + 2 * NSUBMOD, 1.0f, XC, XC); else norm_phase(F, l, 2, AOUT, XC); } PH_END
            }
            PH_BEGIN if (SEL(11)) { { RowOrder S; S.init(5632, F.G, (int)blockIdx.x, last && f == 1); EpiSwiglu E{WSP(bf16_t, WS_HID)}; GEMM(EpiSwiglu, RowOrder, WSP(bf16, WS_HN), WSP(bf16, WS_W1T) + (size_t)f * 5632 * DM, DM, S, E); } } PH_END
            PH_BEGIN if (SEL(12)) { { RowOrder S; S.init(DM, F.G, (int)blockIdx.x, true); const bool first = (l == 0 && f == 0);
                EpiResid E{first ? AIN(0) : AOUT, first ? AIN(2) : XC, AOUT, XC, MODl + (f == 0 ? 0 : 2) * 3072 + 2048, 0.5f};
                GEMM(EpiResid, RowOrder, WSP(bf16, WS_HID), WSP(bf16, WS_W2T) + (size_t)f * DM * DFF, DFF, S, E); }
                if (!(last && f == 1)) { CtxSliceOrder S{11, F.G, (int)blockIdx.x}; EpiPart E{WSP(float, WS_Y4)}; GEMML(EpiPart, CtxSliceOrder, WSP(bf16, WS_HID), WSP(bf16, WS_W2T) + (size_t)f * DM * DFF, 256, DFF, S, E); } } PH_END
            if (f == 0) { PH_BEGIN if (SEL(13)) { norm_phase(F, l, 1, AOUT, XC, WSP(float, WS_Y4), 11, MODl + 0 * 3072 + 2048 + 2 * NSUBMOD, 0.5f, l == 0 ? AIN(2) : XC, XC); } PH_END }
        }
    }
    PH_BEGIN if (SEL(14)) { final_norm_phase(F); } PH_END
}

extern "C" void kernel_launch(void* const* d_in, const int* in_sizes, int n_in, void* d_out, int out_size, void* d_ws, size_t ws_size, hipStream_t stream) {
    static int grid = 0;
    if (grid == 0) {
        int dev = 0, cus = 0, per_cu = 0;
        if (n_in != 26 || ws_size < WS_END) { fprintf(stderr, "kernel_launch: unexpected inputs (n_in %d, ws %zu < %zu)\n", n_in, ws_size, (size_t)WS_END); grid = -1; return; }
        hipGetDevice(&dev); hipDeviceGetAttribute(&cus, hipDeviceAttributeMultiprocessorCount, dev);
        hipFuncSetAttribute((const void*)mk_fwd, hipFuncAttributeMaxDynamicSharedMemorySize, LDS_BYTES);
        hipOccupancyMaxActiveBlocksPerMultiprocessor(&per_cu, (const void*)mk_fwd, NWAVES * 64, LDS_BYTES);
        if (per_cu < 1) { fprintf(stderr, "kernel_launch: occupancy query says %d blocks per CU\n", per_cu); per_cu = 1; }
        (void)hipGetLastError();
        grid = cus * per_cu;
    }
    if (grid < 0) return;
    Args a{};
    for (int i = 0; i < 26; ++i) a.in[i] = (const float*)d_in[i];
    a.out = (float*)d_out; a.ws = (unsigned char*)d_ws;
#if MK_SPLIT
    for (int p = 0; p < N_PHASES; ++p) { a.ph_lo = p; a.ph_hi = p + 1; hipLaunchKernelGGL(mk_fwd, dim3(grid), dim3(NWAVES * 64), LDS_BYTES, stream, a); }
#else
    if (hipMemsetAsync((char*)d_ws + WS_BAR, 0, 65536, stream) != hipSuccess) { fprintf(stderr, "kernel_launch: memset of the barrier words failed\n"); return; }
    a.ph_lo = 0; a.ph_hi = N_PHASES;
    void* kargs[] = {&a};
    hipError_t e = hipLaunchCooperativeKernel((const void*)mk_fwd, dim3(grid), dim3(NWAVES * 64), kargs, LDS_BYTES, stream);
    if (e != hipSuccess) fprintf(stderr, "cooperative launch failed: %s (grid %d)\n", hipGetErrorString(e), grid);
#endif
}
```

```cpp
#include <hip/hip_cooperative_groups.h>
#include <hip/hip_runtime.h>
#include <cstdio>
#include <cstdint>
namespace pg8 {
#define PG8_LAS __attribute__((address_space(3)))
typedef unsigned short bf16_t;
typedef short bf16x8 __attribute__((ext_vector_type(8)));
typedef float f32x4 __attribute__((ext_vector_type(4)));
typedef unsigned u32x4 __attribute__((ext_vector_type(4)));
constexpr int BM = 256, BK = 64, HALF = 128, HTB = HALF * BK * 2  , STAGE_BYTES = 8 * HTB, NXCD = 8, WGM = 8;

__host__ __device__ __forceinline__ int lds_byte(int r, int c) { const int st = (r >> 4) * 2 + (c >> 5), rr = r & 15, cc = c & 31, ob = rr * 64 + cc * 2; return st * 1024 + (ob ^ (((ob >> 9) & 1) << 5)); }
__host__ __device__ __forceinline__ void stage_rc(int b, int& R, int& C) { const int st = b / 1024, sb = b % 1024, swz = sb ^ (((sb >> 9) & 1) << 5); R = (st >> 1) * 16 + swz / 64; C = (st & 1) * 32 + (swz % 64) / 2; }
__host__ __device__ __forceinline__ int perm32(int rho) { const int n = rho >> 4, i = rho & 15; return 8 * (i >> 2) + 4 * n + (i & 3); }

struct Unit { int pm, pn, k0; };
struct Gemm { const bf16_t* A; const bf16_t* Bt; int M, N, K, ld; };

struct StaticOrder {
    int nM, nN, nwg, G, c;
    __host__ __device__ void init(int M, int N, int G_, int c_) { nM = M / BM; nN = N / BM; nwg = nM * nN; G = G_; c = c_; }
    __host__ __device__ bool next(int i, Unit& u) const {
        const long L = (long)i * G + c; if (L >= nwg) return false;
        int wgid = (int)L; { const int q = nwg / NXCD, r = nwg % NXCD, xcd = wgid % NXCD, off = wgid / NXCD; wgid = (xcd < r ? xcd * (q + 1) : r * (q + 1) + (xcd - r) * q) + off; }
        const int nig = WGM * nN, gid = wgid / nig, fm = gid * WGM, gsz = (nM - fm) < WGM ? (nM - fm) : WGM;
        u.pm = fm + ((wgid % nig) % gsz); u.pn = (wgid % nig) / gsz; u.k0 = 0; return true;
    }
    __device__ __forceinline__ void a_ready(const Unit&) const {}
    __device__ __forceinline__ void done(const Unit&) const {}
};

typedef float f32x2cv __attribute__((ext_vector_type(2))); typedef __bf16 bf16x2cv __attribute__((ext_vector_type(2)));
__device__ __forceinline__ unsigned cvt_pk_bf16(float lo, float hi) { f32x2cv v = {lo, hi}; bf16x2cv b = __builtin_convertvector(v, bf16x2cv); return __builtin_bit_cast(unsigned, b); }
typedef float f32x2 __attribute__((ext_vector_type(2)));
template <class Epi, class Sched, bool ALIGN_EPI = false, bool SP2 = false>
__device__ __forceinline__ void gemm_phase(PG8_LAS unsigned char* lds, const Gemm g, const Sched& S, const Epi& E, int tid) {
    float zf = 0.f; asm volatile("" : "+v"(zf));
    const int wid = __builtin_amdgcn_readfirstlane(tid >> 6), lane = tid & 63, wr = wid >> 2, wc = wid & 3, fr = lane & 15, fq = lane >> 4;
    const int K = g.K, nt = K / BK;
    unsigned voffA[2], voffB[2];
#pragma unroll
    for (int i = 0; i < 2; ++i) { int R, C; stage_rc(tid * 16 + i * 8192, R, C); const int Rb = Epi::PERM ? ((R & ~31) + perm32(R & 31)) : R;
        voffA[i] = (unsigned)(R * g.ld + C) * 2u; voffB[i] = (unsigned)(Rb * g.ld + C) * 2u; }
    const size_t kstep = (size_t)(BK * 2);
    const size_t hstep = (size_t)HALF * g.ld * 2;
    const size_t tstep = 2 * hstep;
    const unsigned ldsw = (unsigned)wid * 1024u;
    const int aoff = lds_byte(wr * 64 + fr, fq * 8), boff = lds_byte(wc * 32 + fr, fq * 8);
#define PG8_SA(b, h) (((b) * 2 + (h)) * HTB)
#define PG8_SB(b, h) ((4 + (b) * 2 + (h)) * HTB)
#define PG8_STAGE(bufoff, gbase, voff) do { _Pragma("unroll") for (int _i = 0; _i < 2; ++_i) \
        __builtin_amdgcn_global_load_lds((const unsigned*)((const char*)(gbase) + (voff)[_i]), (PG8_LAS unsigned*)(lds + (bufoff) + ldsw + _i * 8192), 16, 0, 0); } while (0)
#define PG8_LDA(dst, b, h) do { _Pragma("unroll") for (int m = 0; m < 4; ++m) _Pragma("unroll") for (int k = 0; k < 2; ++k) dst[m][k] = *(const PG8_LAS bf16x8*)(lds + PG8_SA(b, h) + aoff + m * 2048 + k * 1024); } while (0)
#define PG8_LDB(dst, b, h) do { _Pragma("unroll") for (int n = 0; n < 2; ++n) _Pragma("unroll") for (int k = 0; k < 2; ++k) dst[n][k] = *(const PG8_LAS bf16x8*)(lds + PG8_SB(b, h) + boff + n * 2048 + k * 1024); } while (0)
#define PG8_MMA(ai, bj, At, Bt) do { __builtin_amdgcn_s_setprio(1); _Pragma("unroll") for (int m = 0; m < 4; ++m) _Pragma("unroll") for (int n = 0; n < 2; ++n) _Pragma("unroll") for (int k = 0; k < 2; ++k) \
        acc[ai][bj][m][n] = __builtin_amdgcn_mfma_f32_16x16x32_bf16(Bt[n][k], At[m][k], acc[ai][bj][m][n], 0, 0, 0); __builtin_amdgcn_s_setprio(0); } while (0)
#define PG8_WAIT_V(n) asm volatile("s_waitcnt vmcnt(" #n ")" ::: "memory")
#define PG8_WAIT_L(n) asm volatile("s_waitcnt lgkmcnt(" #n ")" ::: "memory")
#define PG8_BAR __builtin_amdgcn_s_barrier()
#define PG8_SCHED __builtin_amdgcn_sched_barrier(0)
    Unit cur, nxt; int ui = 0;
    if (!S.next(0, cur)) return;
    f32x4 acc[2][2][4][2];
#pragma unroll
    for (int a = 0; a < 2; ++a)
#pragma unroll
        for (int b = 0; b < 2; ++b)
#pragma unroll
            for (int m = 0; m < 4; ++m)
#pragma unroll
                for (int n = 0; n < 2; ++n) acc[a][b][m][n] = (f32x4){zf, zf, zf, zf};
    bf16x8 At[4][2], B0[2][2], B1[2][2];
    const char* cA = (const char*)g.A + (size_t)cur.pm * tstep + (size_t)cur.k0 * 2; const char* cB = (const char*)g.Bt + (size_t)cur.pn * tstep + (size_t)cur.k0 * 2;
    S.a_ready(cur);
    if constexpr (SP2) {
        PG8_STAGE(PG8_SB(0, 0), cB, voffB); PG8_STAGE(PG8_SB(0, 1), cB + hstep, voffB); PG8_STAGE(PG8_SA(0, 0), cA, voffA); PG8_STAGE(PG8_SA(0, 1), cA + hstep, voffA);
        if (wr == 1) PG8_BAR;
        PG8_WAIT_V(2); PG8_BAR;
        PG8_STAGE(PG8_SB(1, 0), cB + kstep, voffB); PG8_STAGE(PG8_SA(1, 0), cA + kstep, voffA); PG8_STAGE(PG8_SB(1, 1), cB + hstep + kstep, voffB);
        PG8_WAIT_V(6); PG8_BAR;
    } else {
        PG8_STAGE(PG8_SB(0, 0), cB, voffB); PG8_STAGE(PG8_SA(0, 0), cA, voffA); PG8_STAGE(PG8_SB(0, 1), cB + hstep, voffB); PG8_STAGE(PG8_SA(0, 1), cA + hstep, voffA);
        if (wr == 1) PG8_BAR;
        PG8_WAIT_V(4); PG8_BAR;
        PG8_STAGE(PG8_SB(1, 0), cB + kstep, voffB); PG8_STAGE(PG8_SA(1, 0), cA + kstep, voffA); PG8_STAGE(PG8_SB(1, 1), cB + hstep + kstep, voffB);
        PG8_WAIT_V(6); PG8_BAR;
    }
    for (;;) {
        const bool has_next = S.next(ui + 1, nxt);
        const char* nA = has_next ? (const char*)g.A + (size_t)nxt.pm * tstep + (size_t)nxt.k0 * 2 : cA; const char* nB = has_next ? (const char*)g.Bt + (size_t)nxt.pn * tstep + (size_t)nxt.k0 * 2 : cB;
#pragma nounroll
        for (int t = 0; t < nt; t += 2) {
            const bool last = (t == nt - 2);
            const char* a1 = cA + (size_t)(t + 1) * kstep;
            const char* a2 = last ? nA : cA + (size_t)(t + 2) * kstep; const char* b2 = last ? nB : cB + (size_t)(t + 2) * kstep;
            const char* a3 = a2 + kstep; const char* b3 = b2 + kstep;
            if (last && has_next) S.a_ready(nxt);
            if constexpr (SP2) {
            PG8_LDB(B0, 0, 0); PG8_LDB(B1, 0, 1); PG8_SCHED; PG8_LDA(At, 0, 0); PG8_STAGE(PG8_SA(1, 1), a1 + hstep, voffA);
            PG8_WAIT_V(8); PG8_WAIT_L(0); PG8_BAR; PG8_MMA(0, 0, At, B0); PG8_MMA(0, 1, At, B1); PG8_BAR; PG8_SCHED;
            PG8_LDA(At, 0, 1); PG8_STAGE(PG8_SB(0, 0), b2, voffB); PG8_STAGE(PG8_SB(0, 1), b2 + hstep, voffB); PG8_STAGE(PG8_SA(0, 0), a2, voffA);
            PG8_WAIT_V(8); PG8_WAIT_L(0); PG8_BAR; PG8_MMA(1, 0, At, B0); PG8_MMA(1, 1, At, B1); PG8_BAR; PG8_SCHED;
            PG8_LDB(B0, 1, 0); PG8_LDB(B1, 1, 1); PG8_SCHED; PG8_LDA(At, 1, 0); PG8_STAGE(PG8_SA(0, 1), a2 + hstep, voffA);
            PG8_WAIT_V(8); PG8_WAIT_L(0); PG8_BAR; PG8_MMA(0, 0, At, B0); PG8_MMA(0, 1, At, B1); PG8_BAR; PG8_SCHED;
            PG8_LDA(At, 1, 1); PG8_STAGE(PG8_SB(1, 0), b3, voffB); PG8_STAGE(PG8_SB(1, 1), b3 + hstep, voffB); PG8_STAGE(PG8_SA(1, 0), a3, voffA);
            PG8_WAIT_V(8); PG8_WAIT_L(0); PG8_BAR; PG8_MMA(1, 0, At, B0); PG8_MMA(1, 1, At, B1); PG8_BAR; PG8_SCHED;
            } else {
            PG8_LDB(B0, 0, 0); PG8_SCHED; PG8_LDA(At, 0, 0); PG8_STAGE(PG8_SA(1, 1), a1 + hstep, voffA);
            PG8_WAIT_L(8); PG8_BAR; PG8_WAIT_L(0); PG8_MMA(0, 0, At, B0); PG8_BAR; PG8_SCHED;
            PG8_LDB(B1, 0, 1); PG8_STAGE(PG8_SB(0, 0), b2, voffB);
            PG8_BAR; PG8_WAIT_L(0); PG8_MMA(0, 1, At, B1); PG8_BAR;
            PG8_LDA(At, 0, 1); PG8_STAGE(PG8_SA(0, 0), a2, voffA);
            PG8_BAR; PG8_WAIT_L(0); PG8_MMA(1, 0, At, B0); PG8_BAR; PG8_SCHED;
            PG8_STAGE(PG8_SB(0, 1), b2 + hstep, voffB);
            PG8_WAIT_V(6); PG8_BAR; PG8_MMA(1, 1, At, B1); PG8_BAR;
            PG8_LDB(B0, 1, 0); PG8_SCHED; PG8_LDA(At, 1, 0); PG8_STAGE(PG8_SA(0, 1), a2 + hstep, voffA);
            PG8_WAIT_L(8); PG8_BAR; PG8_WAIT_L(0); PG8_MMA(0, 0, At, B0); PG8_BAR; PG8_SCHED;
            PG8_LDB(B1, 1, 1); PG8_STAGE(PG8_SB(1, 0), b3, voffB);
            PG8_BAR; PG8_WAIT_L(0); PG8_MMA(0, 1, At, B1); PG8_BAR;
            PG8_LDA(At, 1, 1); PG8_STAGE(PG8_SA(1, 0), a3, voffA);
            PG8_BAR; PG8_WAIT_L(0); PG8_MMA(1, 0, At, B0); PG8_BAR; PG8_SCHED;
            PG8_STAGE(PG8_SB(1, 1), b3 + hstep, voffB);
            PG8_WAIT_V(6); PG8_BAR; PG8_MMA(1, 1, At, B1); PG8_BAR;
            }
        }
        if constexpr (ALIGN_EPI) { if (wr == 0) PG8_BAR; }
        if constexpr (!Epi::AFTER_DRAIN) { E(acc, cur, wr, wc, fr, fq); S.done(cur); }
        if (!has_next) break;
#pragma unroll
        for (int a = 0; a < 2; ++a)
#pragma unroll
            for (int b = 0; b < 2; ++b)
#pragma unroll
                for (int m = 0; m < 4; ++m)
#pragma unroll
                    for (int n = 0; n < 2; ++n) acc[a][b][m][n] = (f32x4){zf, zf, zf, zf};
        cur = nxt; cA = nA; cB = nB; ++ui;
        if constexpr (ALIGN_EPI) { if (wr == 1) PG8_BAR; }
    }
    PG8_WAIT_V(0);
    if constexpr (!ALIGN_EPI) { if (wr == 0) PG8_BAR; }
    PG8_BAR;
    if constexpr (Epi::AFTER_DRAIN) { E.fused(acc, cur, wr, wc, fr, fq, lds, wid, lane); S.done(cur); }
#undef PG8_SA
#undef PG8_SB
#undef PG8_STAGE
#undef PG8_LDA
#undef PG8_LDB
#undef PG8_MMA
#undef PG8_WAIT_V
#undef PG8_WAIT_L
#undef PG8_BAR
#undef PG8_SCHED
}
}
namespace cg = cooperative_groups;
#include <hip/hip_bf16.h>
#include <cmath>
namespace attn_body {
using bf16=__hip_bfloat16;
using bf16x8=__attribute__((ext_vector_type(8)))short;
using s16x4=__attribute__((ext_vector_type(4)))short;
using f32x16=__attribute__((ext_vector_type(16)))float;
using u32x4=__attribute__((ext_vector_type(4)))unsigned;
constexpr int D=64,QP=512,KP=256,OP=256;
constexpr int NW=8,QBLK=32,QB=QBLK*NW,KVBLK=64;
__device__ __forceinline__ int crow(int r,int hi){return (r&3)+8*(r>>2)+4*hi;}
#define SBAR() __builtin_amdgcn_sched_barrier(0)
__device__ __forceinline__ void wmask(f32x16&p0,f32x16&p1,int dbase){
  const float NEG=-INFINITY;
  #pragma unroll
  for(int r=0;r<16;++r){int d=dbase+(r&3)+8*(r>>2); if((unsigned)(d+128)>256u)p0[r]=NEG; if((unsigned)(d+160)>256u)p1[r]=NEG;}
}

constexpr int NSLOT=3, SLOTB=8192;
constexpr int LDS_K=0, LDS_V=NSLOT*SLOTB, LDS_WS=2*NSLOT*SLOTB, LDS_OST=LDS_WS+NW*64*4, LDS_BYTES=LDS_OST+NW*4096;
constexpr float C2=0.125f*1.4426950408889634f;
__device__ __forceinline__ void glds16(const void*gsrc,unsigned lds_dst){unsigned keep;
  asm volatile("s_mov_b32 %0, m0\n\ts_mov_b32 m0, %2\n\ts_nop 0\n\tglobal_load_lds_dwordx4 %1, off\n\ts_mov_b32 m0, %0":"=&s"(keep):"v"(gsrc),"s"(lds_dst):"memory");}
__device__ __forceinline__ float max3f(float a,float b,float c){float r;asm("v_max3_f32 %0, %1, %2, %3":"=v"(r):"v"(a),"v"(b),"v"(c));return r;}
__device__ __forceinline__ float max2f(float a,float b){float r;asm("v_max_f32_e32 %0, %1, %2":"=v"(r):"v"(a),"v"(b));return r;}
__device__ __forceinline__ float fadd_s(float a,float b){float r;asm("v_add_f32_e32 %0, %1, %2":"=v"(r):"v"(a),"v"(b));return r;}
__device__ __forceinline__ float fsub_s(float a,float b){float r;asm("v_sub_f32_e32 %0, %1, %2":"=v"(r):"v"(a),"v"(b));return r;}
typedef float f32x2_t __attribute__((ext_vector_type(2))); typedef __bf16 bf16x2_t __attribute__((ext_vector_type(2)));
__device__ __forceinline__ unsigned cvtpk_s(float lo,float hi){f32x2_t v={lo,hi};bf16x2_t b=__builtin_convertvector(v,bf16x2_t);return __builtin_bit_cast(unsigned,b);}
#define WAIT_BAR(N) asm volatile("s_waitcnt vmcnt(" #N ") lgkmcnt(0)\n\ts_barrier":::"memory")

__device__ __forceinline__ void qkt(f32x16&p0,f32x16&p1,const char*Kslot,const bf16x8*qr,const f32x16&negm,int r32,int hi){
  const char*kb=Kslot+hi*1024+r32*16;
  #pragma unroll
  for(int d0=0;d0<4;++d0){
    const bf16x8 b0=*reinterpret_cast<const bf16x8*>(kb+d0*2048);
    const bf16x8 b1=*reinterpret_cast<const bf16x8*>(kb+d0*2048+512);
    if(d0==0){p0=__builtin_amdgcn_mfma_f32_32x32x16_bf16(b0,qr[0],negm,0,0,0);p1=__builtin_amdgcn_mfma_f32_32x32x16_bf16(b1,qr[0],negm,0,0,0);}
    else{p0=__builtin_amdgcn_mfma_f32_32x32x16_bf16(b0,qr[d0],p0,0,0,0);p1=__builtin_amdgcn_mfma_f32_32x32x16_bf16(b1,qr[d0],p1,0,0,0);}}
}
typedef __attribute__((address_space(3))) const char* lds_cptr;
typedef short v4i16_t __attribute__((ext_vector_type(4)));
__device__ __forceinline__ void kload8(bf16x8*kf,lds_cptr kp){
  kf[0]=*(const __attribute__((address_space(3))) bf16x8*)(kp);      kf[1]=*(const __attribute__((address_space(3))) bf16x8*)(kp+512);
  kf[2]=*(const __attribute__((address_space(3))) bf16x8*)(kp+2048); kf[3]=*(const __attribute__((address_space(3))) bf16x8*)(kp+2560);
  kf[4]=*(const __attribute__((address_space(3))) bf16x8*)(kp+4096); kf[5]=*(const __attribute__((address_space(3))) bf16x8*)(kp+4608);
  kf[6]=*(const __attribute__((address_space(3))) bf16x8*)(kp+6144); kf[7]=*(const __attribute__((address_space(3))) bf16x8*)(kp+6656);
}
__device__ __forceinline__ void kload2(bf16x8*kf,lds_cptr kp,int j){ kf[2*j]=*(const __attribute__((address_space(3))) bf16x8*)(kp+j*2048); kf[2*j+1]=*(const __attribute__((address_space(3))) bf16x8*)(kp+j*2048+512); }
__device__ __forceinline__ s16x4 vtr(lds_cptr p){ return __builtin_bit_cast(s16x4,__builtin_amdgcn_ds_read_tr16_b64_v4i16((__attribute__((address_space(3))) v4i16_t*)p)); }
__device__ __forceinline__ float rowmax(const f32x16&p0,const f32x16&p1){
  float a=max3f(p0[0],p0[1],p1[0]),b=max3f(p0[2],p0[3],p1[1]);a=max3f(a,p1[2],p1[3]);
  #pragma unroll
  for(int r=4;r<16;r+=4){a=max3f(a,p0[r],p0[r+1]);b=max3f(b,p0[r+2],p0[r+3]);a=max3f(a,p1[r],p1[r+1]);b=max3f(b,p1[r+2],p1[r+3]);}
  const float m=max2f(a,b);
  auto rr=__builtin_amdgcn_permlane32_swap(__float_as_uint(m),__float_as_uint(m),false,false);
  return max2f(__uint_as_float(rr[0]),__uint_as_float(rr[1]));
}
__device__ __forceinline__ void pv(f32x16*o,int vb,bf16x8 pa0,bf16x8 pa1,bf16x8 pa2,bf16x8 pa3){
  #pragma unroll
  for(int d0=0;d0<2;++d0){s16x4 lo[4],hi[4];
    #pragma unroll
    for(int ks=0;ks<4;++ks){
      asm volatile("ds_read_b64_tr_b16 %0,%1 offset:%c2":"=&v"(lo[ks]):"v"(vb),"i"(d0*4096+ks*1024):"memory");
      asm volatile("ds_read_b64_tr_b16 %0,%1 offset:%c2":"=&v"(hi[ks]):"v"(vb),"i"(d0*4096+ks*1024+512):"memory");}
    asm volatile("s_waitcnt lgkmcnt(0)":::"memory");SBAR();
    #define PK(k) (bf16x8){lo[k][0],lo[k][1],lo[k][2],lo[k][3],hi[k][0],hi[k][1],hi[k][2],hi[k][3]}
    o[d0]=__builtin_amdgcn_mfma_f32_32x32x16_bf16(pa0,PK(0),o[d0],0,0,0);
    o[d0]=__builtin_amdgcn_mfma_f32_32x32x16_bf16(pa1,PK(1),o[d0],0,0,0);
    o[d0]=__builtin_amdgcn_mfma_f32_32x32x16_bf16(pa2,PK(2),o[d0],0,0,0);
    o[d0]=__builtin_amdgcn_mfma_f32_32x32x16_bf16(pa3,PK(3),o[d0],0,0,0);
    #undef PK
  }
}

#ifndef ATTN_STORE16
#define ATTN_STORE16(p,v) (*(u32x4*)(p)=(v))
#endif
template<int THRL,bool WIN> __device__ __forceinline__ void attn_unit(const bf16*Qu,const bf16*__restrict__ Kh,const bf16*__restrict__ Vh,bf16*Ou,int NT,int shift,int qpos0,float sinkl2,char*shm,int tid){
  const int lane=tid&63,r32=lane&31,hi=lane>>5; const int wid=__builtin_amdgcn_readfirstlane(tid>>6);
  const bf16*Qw=Qu+(long)(wid*QBLK)*QP;
  const unsigned lds0=(unsigned)(uintptr_t)shm;
  float*wsf=(float*)(shm+LDS_WS)+wid*64;
  const bf16*ksrc=Kh+(long)lane*KP+wid*8;
  const bf16*vsrc=Vh+(long)(16*(wid&3)+(lane>>2))*KP+(wid>>2)*32+(lane&3)*8;
  const unsigned kdst=lds0+LDS_K+wid*1024, vdst=lds0+LDS_V+wid*1024;
  #define KROW(t) ((long)(((t)<4)?(t):((t)+shift))*(KVBLK*KP))
  #define DMA_K(t,slot) glds16(ksrc+KROW(t),(unsigned)__builtin_amdgcn_readfirstlane(kdst+(slot)))
  #define DMA_V(t,slot) glds16(vsrc+KROW(t),(unsigned)__builtin_amdgcn_readfirstlane(vdst+(slot)))
  const int vb0=(int)(lds0+LDS_V)+((lane>>4)&1)*32+(lane&3)*8+(4*hi+((lane&15)>>2))*64;
  const char*Kbase=shm+LDS_K; bf16x8 kf[8];
  const lds_cptr shm3=(lds_cptr)shm; const lds_cptr kp0=shm3+LDS_K+hi*1024+r32*16; const lds_cptr vp0=shm3+LDS_V+((lane>>4)&1)*32+(lane&3)*8+(4*hi+((lane&15)>>2))*64;
  DMA_K(0,0);DMA_V(0,0);DMA_K(1,SLOTB);
  bf16x8 qr[4];
  #pragma unroll
  for(int d0=0;d0<4;++d0)qr[d0]=*reinterpret_cast<const bf16x8*>(&Qw[(long)r32*QP+d0*16+hi*8]);
  float zf_=0.f;asm volatile("":"+v"(zf_)); float mhat=zf_,l_reg=zf_;f32x16 o[2];
  #pragma unroll
  for(int r=0;r<16;++r){o[0][r]=zf_;o[1][r]=zf_;}
  f32x16 negm;
  #pragma unroll
  for(int r=0;r<16;++r)negm[r]=zf_;
  asm volatile("":"+v"(negm));
  const int qrel=wid*QBLK+r32;
  const int mbase=4*hi-256-qpos0-qrel;
  #define CMASK(P0,P1,t) do{ if(WIN){ if((t)>=4) wmask(P0,P1,mbase+64*((t)+shift)); } }while(0)
  bool resc=false;
  #define START(P0,P1) do{ const float rm=rowmax(P0,P1); resc=false; \
    { const float dl=rm; mhat=fadd_s(mhat,dl); \
      _Pragma("unroll") for(int r=0;r<16;++r){P0[r]=fsub_s(P0[r],dl);P1[r]=fsub_s(P1[r],dl);} \
      _Pragma("unroll") for(int r=0;r<16;++r)negm[r]=-mhat; asm volatile("":"+v"(negm)); } \
    _Pragma("unroll") for(int r=0;r<16;++r)P0[r]=__builtin_amdgcn_exp2f(P0[r]); }while(0)
  #define RESC() do{ if(resc){ asm volatile("s_waitcnt lgkmcnt(0)":::"memory"); \
      _Pragma("unroll") for(int d_=0;d_<2;++d_) _Pragma("unroll") for(int r=0;r<16;++r)o[d_][r]*=wsf[crow(r,hi)]; } }while(0)
  f32x16 pA0,pA1,pB0,pB1;
  int sl_prev=0,sl_cur=0,sl_next=SLOTB;
  #define ROT() do{sl_prev=sl_cur;sl_cur=sl_next;sl_next=(sl_next==(NSLOT-1)*SLOTB)?0:sl_next+SLOTB;}while(0)
  DMA_K(2,2*SLOTB);
  WAIT_BAR(3);
  qkt(pA0,pA1,Kbase,qr,negm,r32,hi);asm volatile("s_nop 15\n\ts_nop 7":"+v"(pA0),"+v"(pA1));CMASK(pA0,pA1,0);
  START(pA0,pA1);
  _Pragma("unroll") for(int r=0;r<16;++r)pA1[r]=__builtin_amdgcn_exp2f(pA1[r]);
  WAIT_BAR(0);
  DMA_K(3,0);DMA_V(1,SLOTB);
  ROT();
  kload8(kf,kp0+sl_cur);
  WAIT_BAR(2);
  s16x4 vlo[8],vhi[8]; u32x4 pw0,pw1,pw2,pw3;
  #define PKW(P,B) cvtpk_s(P[B],P[B+1])
  #define PAF(k) __builtin_bit_cast(bf16x8,pw##k)
  #define VFR(i) (bf16x8){vlo[i][0],vlo[i][1],vlo[i][2],vlo[i][3],vhi[i][0],vhi[i][1],vhi[i][2],vhi[i][3]}
  #define PIN(x) asm volatile("":"+v"(x))
  #define MX3(a,b,c) __builtin_fmaxf(__builtin_fmaxf((a),(b)),(c))
  #define GAPA(MF,A0,A1,A2,A3,W0,W1,PW) do{ MF; sacc+=A0; sacc+=A1; sacc+=A2; sacc+=A3; PIN(sacc); W0; W1; PIN(PW); SBAR(); }while(0)
  #define EX(v) __builtin_amdgcn_exp2f(v)
  #define GAPB(MF,X,B) do{ MF; X[B]=EX(X[B]); X[B+1]=EX(X[B+1]); X[B+2]=EX(X[B+2]); X[B+3]=EX(X[B+3]); PIN(X); SBAR(); }while(0)
  #define VRD(i) do{ vlo[i]=vtr(vp_+(((i)>>2)*4096+((i)&3)*1024)); vhi[i]=vtr(vp_+(((i)>>2)*4096+((i)&3)*1024+512)); }while(0)
  #define KRD(G,j) do{ if(G){ kload2(kf,kp0+sl_next,j); SBAR(); } }while(0)
  #define STEP(C0,C1,P0,P1,t,GK,GV,GL) do{ SBAR(); \
    const lds_cptr vp_=vp0+sl_prev; \
    VRD(0); SBAR(); float sacc=(P0[0]+P0[1]); \
    GAPA(C0=__builtin_amdgcn_mfma_f32_32x32x16_bf16(kf[0],qr[0],negm,0,0,0), P0[2],P0[3],P0[4],P0[5],     pw0[0]=PKW(P0,0), pw0[1]=PKW(P0,2), pw0); \
    VRD(4); SBAR(); GAPA(C1=__builtin_amdgcn_mfma_f32_32x32x16_bf16(kf[1],qr[0],negm,0,0,0), P0[6],P0[7],P0[8],P0[9],     pw0[2]=PKW(P0,4), pw0[3]=PKW(P0,6), pw0); \
    VRD(1); SBAR(); GAPA(C0=__builtin_amdgcn_mfma_f32_32x32x16_bf16(kf[2],qr[1],C0,0,0,0),   P0[10],P0[11],P0[12],P0[13], pw1[0]=PKW(P0,8), pw1[1]=PKW(P0,10), pw1); \
    VRD(5); SBAR(); GAPA(C1=__builtin_amdgcn_mfma_f32_32x32x16_bf16(kf[3],qr[1],C1,0,0,0),   P0[14],P0[15],P1[0],P1[1],   pw1[2]=PKW(P0,12),pw1[3]=PKW(P0,14), pw1); \
    VRD(2); SBAR(); GAPA(C0=__builtin_amdgcn_mfma_f32_32x32x16_bf16(kf[4],qr[2],C0,0,0,0),   P1[2],P1[3],P1[4],P1[5],     pw2[0]=PKW(P1,0), pw2[1]=PKW(P1,2), pw2); \
    VRD(6); SBAR(); GAPA(C1=__builtin_amdgcn_mfma_f32_32x32x16_bf16(kf[5],qr[2],C1,0,0,0),   P1[6],P1[7],P1[8],P1[9],     pw2[2]=PKW(P1,4), pw2[3]=PKW(P1,6), pw2); \
    VRD(3); SBAR(); GAPA(C0=__builtin_amdgcn_mfma_f32_32x32x16_bf16(kf[6],qr[3],C0,0,0,0),   P1[10],P1[11],P1[12],P1[13], pw3[0]=PKW(P1,8), pw3[1]=PKW(P1,10), pw3); \
    VRD(7); SBAR(); GAPA(C1=__builtin_amdgcn_mfma_f32_32x32x16_bf16(kf[7],qr[3],C1,0,0,0),   P1[14],P1[15],0.f,0.f,       pw3[2]=PKW(P1,12),pw3[3]=PKW(P1,14), pw3); \
    l_reg+=sacc; \
    if(GK){DMA_K((t)+3,sl_cur);} if(GV){DMA_V((t)+1,sl_next);} \
    CMASK(C0,C1,t); \
    { float a=MX3(C0[0],C0[1],C1[0]),b=MX3(C0[2],C0[3],C1[1]); a=MX3(a,C1[2],C1[3]); \
      _Pragma("unroll") for(int r=4;r<16;r+=4){a=MX3(a,C0[r],C0[r+1]);b=MX3(b,C0[r+2],C0[r+3]);a=MX3(a,C1[r],C1[r+1]);b=MX3(b,C1[r+2],C1[r+3]);} \
      float rm=__builtin_fmaxf(a,b); { auto rr=__builtin_amdgcn_permlane32_swap(__float_as_uint(rm),__float_as_uint(rm),false,false); rm=__builtin_fmaxf(__uint_as_float(rr[0]),__uint_as_float(rr[1])); } \
      resc=false; \
      if(__builtin_expect(__any(rm>(float)THRL),0)){ const float dl=__builtin_fmaxf(rm,0.f); mhat+=dl; \
        _Pragma("unroll") for(int r=0;r<16;++r){C0[r]-=dl;C1[r]-=dl;} \
        _Pragma("unroll") for(int r=0;r<16;++r)negm[r]=-mhat; asm volatile("":"+v"(negm)); \
        const float f=__builtin_amdgcn_exp2f(-dl); l_reg*=f; if(hi==0)wsf[r32]=f; resc=true; } } \
    SBAR(); \
    GAPB(o[0]=__builtin_amdgcn_mfma_f32_32x32x16_bf16(PAF(0),VFR(0),o[0],0,0,0), C0,0); \
    GAPB(o[1]=__builtin_amdgcn_mfma_f32_32x32x16_bf16(PAF(0),VFR(4),o[1],0,0,0), C0,4); \
    KRD(GL,0); GAPB(o[0]=__builtin_amdgcn_mfma_f32_32x32x16_bf16(PAF(1),VFR(1),o[0],0,0,0), C0,8); \
    KRD(GL,1); GAPB(o[1]=__builtin_amdgcn_mfma_f32_32x32x16_bf16(PAF(1),VFR(5),o[1],0,0,0), C0,12); \
    KRD(GL,2); GAPB(o[0]=__builtin_amdgcn_mfma_f32_32x32x16_bf16(PAF(2),VFR(2),o[0],0,0,0), C1,0); \
    KRD(GL,3); GAPB(o[1]=__builtin_amdgcn_mfma_f32_32x32x16_bf16(PAF(2),VFR(6),o[1],0,0,0), C1,4); \
    GAPB(o[0]=__builtin_amdgcn_mfma_f32_32x32x16_bf16(PAF(3),VFR(3),o[0],0,0,0), C1,8); \
    GAPB(o[1]=__builtin_amdgcn_mfma_f32_32x32x16_bf16(PAF(3),VFR(7),o[1],0,0,0), C1,12); \
    }while(0)
  int t=1;
  for(;t+5<NT;t+=2){
    STEP(pB0,pB1,pA0,pA1,t,true,true,true);     WAIT_BAR(2); RESC(); ROT();
    STEP(pA0,pA1,pB0,pB1,t+1,true,true,true);   WAIT_BAR(2); RESC(); ROT();
  }
  #define ENDW(tt) do{ if((tt)+3<NT){WAIT_BAR(2);} else if((tt)+2<NT){WAIT_BAR(1);} else {WAIT_BAR(0);} }while(0)
  for(;t+1<NT;t+=2){
    STEP(pB0,pB1,pA0,pA1,t,(t+3<NT),(t+1<NT),(t+1<NT));       ENDW(t);   RESC(); ROT();
    STEP(pA0,pA1,pB0,pB1,t+1,(t+4<NT),(t+2<NT),(t+2<NT));     ENDW(t+1); RESC(); ROT();
  }
  STEP(pB0,pB1,pA0,pA1,NT-1,false,false,false); RESC();
  { float sacc=pB0[0]+pB0[1]; _Pragma("unroll") for(int r=2;r<16;++r)sacc+=pB0[r]; _Pragma("unroll") for(int r=0;r<16;++r)sacc+=pB1[r]; l_reg+=sacc;
    pw0=(u32x4){PKW(pB0,0),PKW(pB0,2),PKW(pB0,4),PKW(pB0,6)};pw1=(u32x4){PKW(pB0,8),PKW(pB0,10),PKW(pB0,12),PKW(pB0,14)};pw2=(u32x4){PKW(pB1,0),PKW(pB1,2),PKW(pB1,4),PKW(pB1,6)};pw3=(u32x4){PKW(pB1,8),PKW(pB1,10),PKW(pB1,12),PKW(pB1,14)};
    SBAR(); pv(o,vb0+sl_cur,PAF(0),PAF(1),PAF(2),PAF(3)); }
  #undef PKW
  #undef PAF
  #undef VFR
  #undef PIN
  #undef MX3
  #undef GAPA
  #undef GAPB
  #undef EX
  #undef VRD
  #undef KRD
  #undef STEP
  #undef ENDW
  {auto rr=__builtin_amdgcn_permlane32_swap(__float_as_uint(l_reg),__float_as_uint(l_reg),false,false);l_reg=__uint_as_float(rr[0])+__uint_as_float(rr[1]);}
  if(WIN)l_reg+=__builtin_amdgcn_exp2f(sinkl2-mhat);
  if(hi==0)wsf[32+r32]=l_reg;asm volatile("s_waitcnt lgkmcnt(0)":::"memory");
  float rli[16];
  #pragma unroll
  for(int r=0;r<16;++r)rli[r]=__builtin_amdgcn_rcpf(wsf[32+crow(r,hi)]);
  bf16*Ow=Ou+(long)(wid*QBLK)*OP;
  { bf16*stg=(bf16*)(shm+LDS_OST)+wid*2048;
    #pragma unroll
    for(int r=0;r<16;++r){const int orow=crow(r,hi);
      #pragma unroll
      for(int d0=0;d0<2;++d0)stg[orow*64+d0*32+r32]=__float2bfloat16(o[d0][r]*rli[r]);}
    asm volatile("s_waitcnt lgkmcnt(0)":::"memory");
    #pragma unroll
    for(int i=0;i<4;++i){const int row=i*8+(lane>>3),ch=lane&7; const u32x4 v=*(const u32x4*)(stg+row*64+ch*8); ATTN_STORE16(Ow+(long)row*OP+ch*8,v);} }
  asm volatile("s_waitcnt lgkmcnt(0)\n\ts_barrier":::"memory");
  #undef DMA_K
  #undef KROW
  #undef DMA_V
  #undef CMASK
  #undef START
  #undef RESC
  #undef ROT
}
constexpr int ATTN_LDS_BYTES=LDS_BYTES;
#undef SBAR
#undef WAIT_BAR
}
constexpr int NWAVES = 8;
constexpr int DM = 1024, NBATCH = 2, SEQ = 16384, CTXL = 256, TOK = SEQ + CTXL  , MR = NBATCH * TOK  ;
constexpr int DFF = 2816, NSUBMOD = 9216, DEPTH = 2;
constexpr float EPS = 1e-6f, LOG2E = 1.4426950408889634f;
constexpr int S5L = 32, S5ROWS = 1280  , S5CH = MR / S5L  , S5K = 768;

typedef unsigned short bf16;
typedef unsigned v4u __attribute__((ext_vector_type(4)));
typedef float f32x4 __attribute__((ext_vector_type(4)));
#define LAS __attribute__((address_space(3)))
#define LDS_WAIT() asm volatile("s_waitcnt lgkmcnt(0)" ::: "memory")
__device__ __forceinline__ unsigned f2bf(float f) { unsigned u = __builtin_bit_cast(unsigned, f); return (u + 0x7fffu + ((u >> 16) & 1u)) >> 16; }
__device__ __forceinline__ unsigned pk2(float lo, float hi) { return f2bf(lo) | (f2bf(hi) << 16); }
__device__ __forceinline__ float bf2f(unsigned short h) { return __builtin_bit_cast(float, (unsigned)h << 16); }
__device__ __forceinline__ float sigm(float x) { return __builtin_amdgcn_rcpf(1.0f + __builtin_amdgcn_exp2f(-x * LOG2E)); }

constexpr size_t MiB = 1u << 20;
constexpr size_t WS_MOD = 1 * MiB, WS_XC = 2 * MiB;
constexpr size_t WS_W1T = 4 * MiB, WS_W2T = 26 * MiB, WS_WINT = 37 * MiB, WS_WBT = 48 * MiB, WS_WOT = 50 * MiB, WS_WGT = 52 * MiB, WS_WPT = 52 * MiB + 256 * 1024;
constexpr size_t WS_BTY = 53 * MiB, WS_BTE = 65 * MiB, WS_E = 71 * MiB, WS_A2 = 91 * MiB, WS_HN = 121 * MiB, WS_T = 186 * MiB;
constexpr size_t WS_R = 251 * MiB;
constexpr size_t WS_HID = WS_R, WS_GS = WS_R, WS_Q = WS_R + 65 * MiB, WS_K = WS_Q + 65 * MiB / 2, WS_V = WS_K + 65 * MiB / 4, WS_XA = WS_V + 65 * MiB / 4, WS_G = WS_XA + 65 * MiB / 4,
                 WS_DIFF = WS_G + 65 * MiB / 4, WS_Y4 = WS_DIFF + 65 * MiB / 4, WS_END = WS_Y4 + 65 * MiB;
static_assert(WS_END <= 512 * MiB && WS_HID + (size_t)MR * DFF * 2 <= WS_Y4 + 65 * MiB, "ws map");
constexpr int RING_BYTES = 131072, LDS_BYTES = 147456;

struct Args { const float* in[26]; float* out; unsigned char* ws; int ph_lo, ph_hi; };
struct Frame { LAS unsigned char* lds; int lane, wave, vcu, G; };
typedef const volatile __attribute__((address_space(4))) unsigned long long karg_t;
__device__ __forceinline__ unsigned long long karg(int i) { return ((karg_t*)__builtin_amdgcn_kernarg_segment_ptr())[i]; }
#define AIN(i) ((const float*)karg(i))
#define AOUT ((float*)karg(26))
#define AWS ((unsigned char*)karg(27))
#define WSP(T, off) ((T*)(AWS + (off)))

__device__ __forceinline__ float* xrow_ptr(float* lat, float* ctxp, int r) { const int b = r / TOK, i = r - b * TOK; return i < CTXL ? ctxp + (size_t)(b * CTXL + i) * DM : lat + (size_t)(b * SEQ + i - CTXL) * DM; }

using pg8::f32x4; using pg8::Unit; using pg8::bf16_t; using pg8::cvt_pk_bf16; using pg8::u32x4;
#define EPI_ARGS const pg8::f32x4 (&acc)[2][2][4][2], const pg8::Unit& u, int wr, int wc, int fr_, int fq_
#define EPI_PIN int fr = fr_, fq = fq_; asm volatile("" : "+v"(fr), "+v"(fq));
struct EpiSwiglu { static constexpr bool PERM = true, AFTER_DRAIN = false; bf16_t* H;
    __device__ __forceinline__ void operator()(EPI_ARGS) const { EPI_PIN
        const int row0 = u.pm * 256 + wr * 64 + fr, hc = u.pn * 128 + wc * 32 + 8 * fq;
#pragma unroll
        for (int ai = 0; ai < 2; ++ai)
#pragma unroll
            for (int m = 0; m < 4; ++m) { bf16_t* rowp = H + (size_t)(row0 + ai * 128 + m * 16) * DFF + hc; float v[8];
#pragma unroll
                for (int n = 0; n < 2; ++n)
#pragma unroll
                    for (int j = 0; j < 4; ++j) { const float g = acc[ai][0][m][n][j], up = acc[ai][1][m][n][j]; v[n * 4 + j] = g * sigm(g) * up; }
                u32x4 w; w.x = cvt_pk_bf16(v[0], v[1]); w.y = cvt_pk_bf16(v[2], v[3]); w.z = cvt_pk_bf16(v[4], v[5]); w.w = cvt_pk_bf16(v[6], v[7]); *(u32x4*)rowp = w; }
    }
};
struct EpiResid { static constexpr bool PERM = true, AFTER_DRAIN = false; const float* src_lat; const float* src_ctx; float* dst_lat; float* dst_ctx; const float* gate; float sc;
    __device__ __forceinline__ void operator()(EPI_ARGS) const { EPI_PIN
        const int b = u.pm / 65, tq = u.pm - b * 65; const bool isc = tq == 0;
        const size_t off = isc ? (size_t)b * CTXL * DM : ((size_t)b * SEQ + (size_t)(tq - 1) * 256) * DM;
        const float* sp = (isc ? src_ctx : src_lat) + off; float* dp = (isc ? dst_ctx : dst_lat) + off;
        const float* gp = gate + (isc ? 2 : b) * NSUBMOD; const int col0 = u.pn * 256 + wc * 32 + 8 * fq;
        f32x4 gv[2][2];
#pragma unroll
        for (int bj = 0; bj < 2; ++bj)
#pragma unroll
            for (int n = 0; n < 2; ++n) gv[bj][n] = *(const f32x4*)(gp + col0 + bj * 128 + 4 * n) * sc;
#pragma unroll
        for (int ai = 0; ai < 2; ++ai)
#pragma unroll
            for (int m = 0; m < 4; ++m) { const size_t ro = (size_t)(ai * 128 + wr * 64 + m * 16 + fr) * DM + col0;
#pragma unroll
                for (int bj = 0; bj < 2; ++bj)
#pragma unroll
                    for (int n = 0; n < 2; ++n) { const f32x4 xv = *(const f32x4*)(sp + ro + bj * 128 + 4 * n); *(f32x4*)(dp + ro + bj * 128 + 4 * n) = xv + gv[bj][n] * acc[ai][bj][m][n]; } }
    }
};
__device__ __forceinline__ u32x4 pack8(const f32x4& a, const f32x4& b) { u32x4 w; w.x = cvt_pk_bf16(a[0], a[1]); w.y = cvt_pk_bf16(a[2], a[3]); w.z = cvt_pk_bf16(b[0], b[1]); w.w = cvt_pk_bf16(b[2], b[3]); return w; }
struct EpiRoute { static constexpr bool PERM = true, AFTER_DRAIN = false; bf16_t *Q, *K, *V, *A2, *XA;
    __device__ __forceinline__ void operator()(EPI_ARGS) const { EPI_PIN
        const int row0 = u.pm * 256 + wr * 64 + fr, cl = wc * 32 + 8 * fq;
        bf16_t* base; int ldc, coff = 0;
        if (u.pn == 0) { base = Q; ldc = 512; } else if (u.pn == 1) { base = Q; ldc = 512; coff = 256; } else if (u.pn == 2) { base = K; ldc = 256; } else if (u.pn == 3) { base = V; ldc = 256; } else { base = XA; ldc = 256; }
#pragma unroll
        for (int ai = 0; ai < 2; ++ai)
#pragma unroll
            for (int m = 0; m < 4; ++m) { const int row = row0 + ai * 128 + m * 16;
#pragma unroll
                for (int bj = 0; bj < 2; ++bj) { const u32x4 w = pack8(acc[ai][bj][m][0], acc[ai][bj][m][1]); const int c = bj * 128 + cl;
                    if (u.pn == 4) { const int g = c >> 4, h0 = c & 15; *(u32x4*)(A2 + ((size_t)g * S5ROWS + (row >> 5)) * S5K + (row & 31) * 16 + h0) = w; }
                    else *(u32x4*)(base + (size_t)row * ldc + coff + c) = w; } }
    }
};
struct EpiGate { static constexpr bool PERM = true, AFTER_DRAIN = false; bf16_t* GS;
    __device__ __forceinline__ void operator()(EPI_ARGS) const { EPI_PIN
        const int row0 = u.pm * 256 + wr * 64 + fr, col0 = u.pn * 256 + wc * 32 + 8 * fq;
#pragma unroll
        for (int ai = 0; ai < 2; ++ai)
#pragma unroll
            for (int m = 0; m < 4; ++m)
#pragma unroll
                for (int bj = 0; bj < 2; ++bj) { f32x4 a = acc[ai][bj][m][0], b = acc[ai][bj][m][1];
#pragma unroll
                    for (int j = 0; j < 4; ++j) { a[j] = sigm(a[j]); b[j] = sigm(b[j]); }
                    *(u32x4*)(GS + (size_t)(row0 + ai * 128 + m * 16) * DM + col0 + bj * 128) = pack8(a, b); }
    }
};
template <bool FIRST> struct EpiMerge { static constexpr bool PERM = true, AFTER_DRAIN = false; const bf16_t* GS; bf16_t* T;
    __device__ __forceinline__ void operator()(EPI_ARGS) const { EPI_PIN
        const int row0 = u.pm * 256 + wr * 64 + fr, col0 = u.pn * 256 + wc * 32 + 8 * fq;
#pragma unroll
        for (int ai = 0; ai < 2; ++ai)
#pragma unroll
            for (int m = 0; m < 4; ++m)
#pragma unroll
                for (int bj = 0; bj < 2; ++bj) { const size_t o = (size_t)(row0 + ai * 128 + m * 16) * DM + col0 + bj * 128;
                    const u32x4 g = *(const u32x4*)(GS + o); u32x4 t = {0u, 0u, 0u, 0u}; if (!FIRST) t = *(const u32x4*)(T + o);
                    f32x4 a = acc[ai][bj][m][0], b = acc[ai][bj][m][1];
#pragma unroll
                    for (int q = 0; q < 2; ++q) { const unsigned gw = g[q], tw = t[q], gw2 = g[q + 2], tw2 = t[q + 2];
                        a[2 * q] = __builtin_bit_cast(float, tw << 16) + (__builtin_bit_cast(float, gw << 16)) * a[2 * q]; a[2 * q + 1] = __builtin_bit_cast(float, tw & 0xffff0000u) + (__builtin_bit_cast(float, gw & 0xffff0000u)) * a[2 * q + 1];
                        b[2 * q] = __builtin_bit_cast(float, tw2 << 16) + (__builtin_bit_cast(float, gw2 << 16)) * b[2 * q]; b[2 * q + 1] = __builtin_bit_cast(float, tw2 & 0xffff0000u) + (__builtin_bit_cast(float, gw2 & 0xffff0000u)) * b[2 * q + 1]; }
                    *(u32x4*)(T + o) = pack8(a, b); }
    }
};
struct EpiPlain { static constexpr bool PERM = true, AFTER_DRAIN = false; bf16_t* O; int ldc;
    __device__ __forceinline__ void operator()(EPI_ARGS) const { EPI_PIN
        const int row0 = u.pm * 256 + wr * 64 + fr, col0 = u.pn * 256 + wc * 32 + 8 * fq;
#pragma unroll
        for (int ai = 0; ai < 2; ++ai)
#pragma unroll
            for (int m = 0; m < 4; ++m)
#pragma unroll
                for (int bj = 0; bj < 2; ++bj) *(u32x4*)(O + (size_t)(row0 + ai * 128 + m * 16) * ldc + col0 + bj * 128) = pack8(acc[ai][bj][m][0], acc[ai][bj][m][1]);
    }
};
struct EpiGlu { static constexpr bool PERM = true, AFTER_DRAIN = false; bf16_t* O;
    __device__ __forceinline__ void operator()(EPI_ARGS) const { EPI_PIN
        const int row0 = u.pm * 256 + wr * 64 + fr, col0 = u.pn * 128 + wc * 32 + 8 * fq;
#pragma unroll
        for (int ai = 0; ai < 2; ++ai)
#pragma unroll
            for (int m = 0; m < 4; ++m) { f32x4 a = acc[ai][0][m][0], b = acc[ai][0][m][1]; const f32x4 ga = acc[ai][1][m][0], gb = acc[ai][1][m][1];
#pragma unroll
                for (int j = 0; j < 4; ++j) { a[j] *= sigm(ga[j]); b[j] *= sigm(gb[j]); }
                *(u32x4*)(O + (size_t)(row0 + ai * 128 + m * 16) * 256 + col0) = pack8(a, b); }
    }
};
struct EpiF32 { static constexpr bool PERM = true, AFTER_DRAIN = false; float* O;
    __device__ __forceinline__ void operator()(EPI_ARGS) const { EPI_PIN
        const int row0 = u.pm * 256 + wr * 64 + fr, col0 = wc * 32 + 8 * fq;
#pragma unroll
        for (int ai = 0; ai < 2; ++ai)
#pragma unroll
            for (int m = 0; m < 4; ++m)
#pragma unroll
                for (int bj = 0; bj < 2; ++bj)
#pragma unroll
                    for (int n = 0; n < 2; ++n) *(f32x4*)(O + (size_t)(row0 + ai * 128 + m * 16) * 256 + col0 + bj * 128 + 4 * n) = acc[ai][bj][m][n];
    }
};
__device__ __forceinline__ float gelu_tanh(float x) { const float y = 0.7978845608028654f * (x + 0.044715f * x * x * x); return x * sigm(2.0f * y); }
struct EpiS5Y { static constexpr bool PERM = true, AFTER_DRAIN = false; bf16_t* Gb;
    __device__ __forceinline__ void operator()(EPI_ARGS) const { EPI_PIN
        const int g = u.pm / 5, i = u.pm - 5 * g, jn = u.pn & 1;
#pragma unroll
        for (int ai = 0; ai < 2; ++ai)
#pragma unroll
            for (int m = 0; m < 4; ++m) { const int cidx = i * 256 + ai * 128 + wr * 64 + m * 16 + fr;
                if (cidx < S5CH) {
#pragma unroll
                    for (int bj = 0; bj < 2; ++bj) { const int c = jn * 256 + bj * 128 + wc * 32 + 8 * fq, jo = c >> 4, h0 = c & 15; f32x4 a = acc[ai][bj][m][0], b = acc[ai][bj][m][1];
#pragma unroll
                        for (int j = 0; j < 4; ++j) { a[j] = gelu_tanh(a[j]); b[j] = gelu_tanh(b[j]); }
                        *(u32x4*)(Gb + (size_t)(cidx * S5L + jo) * 256 + g * 16 + h0) = pack8(a, b); } } }
    }
};
struct RowOrder { pg8::StaticOrder so; bool skip;
    __device__ void init(int N, int G, int c, bool skip_) { skip = skip_; so.init(skip_ ? NBATCH * SEQ : MR, N, G, c); }
    __device__ bool next(int i, Unit& u) const { if (!so.next(i, u)) return false; if (skip) u.pm = u.pm + 1 + (u.pm >> 6); return true; }
    __device__ __forceinline__ void a_ready(const Unit&) const {}
    __device__ __forceinline__ void done(const Unit&) const {}
};
struct CtxSliceOrder { int nsl, G, c;
    __device__ bool next(int i, Unit& u) const { const int L = i * G + c; if (L >= 8 * nsl) return false; const int t = L / nsl, sl = L - t * nsl; u.pm = (t >> 2) ? 65 : 0; u.pn = t & 3; u.k0 = sl * 256; return true; }
    __device__ __forceinline__ void a_ready(const Unit&) const {}
    __device__ __forceinline__ void done(const Unit&) const {}
};
struct EpiPart { static constexpr bool PERM = true, AFTER_DRAIN = false; float* P;
    __device__ __forceinline__ void operator()(EPI_ARGS) const { EPI_PIN
        const int sl = u.k0 >> 8, bb = u.pm ? 1 : 0; float* base = P + ((size_t)(sl * 2 + bb) * 256 + wr * 64 + fr) * DM + u.pn * 256 + wc * 32 + 8 * fq;
#pragma unroll
        for (int ai = 0; ai < 2; ++ai)
#pragma unroll
            for (int m = 0; m < 4; ++m)
#pragma unroll
                for (int bj = 0; bj < 2; ++bj)
#pragma unroll
                    for (int n = 0; n < 2; ++n) *(f32x4*)(base + (size_t)(ai * 128 + m * 16) * DM + bj * 128 + 4 * n) = acc[ai][bj][m][n];
    }
};
struct S5Order { int ncol, G, c;
    __device__ bool next(int i, Unit& u) const { const int L = i * G + c; if (L >= 80 * ncol) return false; const int g = L / (5 * ncol), rem = L - g * 5 * ncol; u.pm = g * 5 + rem / ncol; u.pn = g * ncol + rem % ncol; u.k0 = 0; return true; }
    __device__ __forceinline__ void a_ready(const Unit&) const {}
    __device__ __forceinline__ void done(const Unit&) const {}
};
__device__ __forceinline__ float shx(float v, int o, int lane) { return __builtin_bit_cast(float, __builtin_amdgcn_ds_bpermute((lane ^ o) << 2, __builtin_bit_cast(int, v))); }
__device__ __forceinline__ float wave_sum(float v, int lane) {
#pragma unroll
    for (int o = 1; o < 64; o <<= 1) v += shx(v, o, lane);
    return v;
}
__device__ __forceinline__ void tr_item(const float* W, int K, int ldw, int src_c0, bf16* WT, int dst_r0, int k0, LAS float* scr, int lane) {
    float tv[32];
#pragma unroll
    for (int i = 0; i < 32; ++i) { const int kk = 2 * i + (lane >> 5); tv[i] = W[(size_t)(k0 + kk) * ldw + src_c0 + (lane & 31)]; }
#pragma unroll
    for (int i = 0; i < 32; ++i) { const int kk = 2 * i + (lane >> 5); scr[kk * 33 + (lane & 31)] = tv[i]; }
    LDS_WAIT(); asm volatile("" ::: "memory");
    const int c = lane & 7;
#pragma unroll
    for (int j = 0; j < 4; ++j) { const int n = (lane >> 3) + 8 * j; const LAS float* s = scr + (8 * c) * 33 + n;
        v4u o; o.x = pk2(s[0 * 33], s[1 * 33]); o.y = pk2(s[2 * 33], s[3 * 33]); o.z = pk2(s[4 * 33], s[5 * 33]); o.w = pk2(s[6 * 33], s[7 * 33]);
        *(v4u*)(WT + (size_t)(dst_r0 + n) * K + k0 + 8 * c) = o; }
    LDS_WAIT(); asm volatile("" ::: "memory");
}
constexpr int CONV_ITEMS = 2 * 2816 + 2 * 1408 + 2816 + 4 * 128 + 512 + 64;
__device__ __forceinline__ void conv_item(Frame& F, int l, int it, LAS float* scr) {
    int r = it; const int lane = F.lane;
    if (r < 5632) { const int f = r / 2816; r -= f * 2816; const int kb = r / 176, n0 = (r % 176) * 32, pn = n0 >> 8, bj = (n0 >> 7) & 1, q = n0 & 127;
        tr_item(AIN(7) + (size_t)(l * 2 + f) * DM * 5632, DM, 5632, bj * DFF + 128 * pn + q, WSP(bf16, WS_W1T) + (size_t)f * 5632 * DM, n0, kb * 64, scr, lane); return; } r -= 5632;
    if (r < 2816) { const int f = r / 1408; r -= f * 1408; const int kb = r / 32, n0 = (r % 32) * 32;
        tr_item(AIN(8) + (size_t)(l * 2 + f) * DFF * DM, DFF, DM, n0, WSP(bf16, WS_W2T) + (size_t)f * DM * DFF, n0, kb * 64, scr, lane); return; } r -= 2816;
    if (r < 2816) { const int kb = r / 176, n0 = (r % 176) * 32; int src;
        if (n0 >= 1536) src = n0; else { const int t = n0 >> 8, off = n0 & 255;
            src = t == 0 ? 768 + off : t == 1 ? 1024 + off : t == 2 ? (off < 128 ? off : 512 + off - 128) : t == 3 ? (off < 128 ? 128 + off : 640 + off - 128) : t == 4 ? 256 + off : 1280 + off; }
        tr_item(AIN(9) + (size_t)l * DM * 5632, DM, 5632, src, WSP(bf16, WS_WINT), n0, kb * 64, scr, lane); return; } r -= 2816;
    if (r < 512) { const int k = r / 128; r -= k * 128; const int kb = r / 32, n0 = (r % 32) * 32;
        tr_item(AIN(23) + (size_t)(l * 4 + k) * 256 * DM, 256, DM, n0, WSP(bf16, WS_WBT) + (size_t)k * DM * 256, n0, kb * 64, scr, lane); return; } r -= 512;
    if (r < 512) { const int kb = r / 32, n0 = (r % 32) * 32;
        tr_item(AIN(24) + (size_t)l * DM * DM, DM, DM, n0, WSP(bf16, WS_WOT), n0, kb * 64, scr, lane); return; } r -= 512;
    { const int kb = r / 16, n0 = (r % 16) * 32, pn = n0 >> 8, bj = (n0 >> 7) & 1, q = n0 & 127;
        tr_item(AIN(22) + (size_t)l * 256 * 512, 256, 512, bj * 256 + 128 * pn + q, WSP(bf16, WS_WGT), n0, kb * 64, scr, lane); }
}
__device__ __forceinline__ void s5_table_item(Frame& F, int l, int item, LAS float* scr) {
    const int g = item >> 5, j = item & 31, lane = F.lane, p = lane;
    bf16* BtY = WSP(bf16, WS_BTY) + (size_t)g * 512 * S5K; bf16* BtE = WSP(bf16, WS_BTE) + (size_t)g * 256 * S5K;
    float lre[2], lim[2], cfr[2], cfi[2], are[2], aim[2], dtv[2];
#pragma unroll
    for (int d = 0; d < 2; ++d) { const int ix = ((l * 2 + d) * 16 + g) * 64 + p; are[d] = AIN(14)[ix]; aim[d] = AIN(15)[ix]; dtv[d] = expf(AIN(16)[(l * 2 + d) * 16 + g]);
        const float mg = expf(are[d] * dtv[d]); float sn, cs; sincosf(aim[d] * dtv[d], &sn, &cs); const float br = mg * cs - 1.0f, bi = mg * sn; const float den = 1.0f / (are[d] * are[d] + aim[d] * aim[d]);
        cfr[d] = (br * are[d] + bi * aim[d]) * den; cfi[d] = (bi * are[d] - br * aim[d]) * den; }
#define LAMPOW(d, e, outr, outi) do { const float mg_ = expf(are[d] * dtv[d] * (float)(e)); float sn_, cs_; sincosf(aim[d] * dtv[d] * (float)(e), &sn_, &cs_); outr = mg_ * cs_; outi = mg_ * sn_; } while (0)
#pragma unroll
    for (int d = 0; d < 2; ++d) { float pr, pi; LAMPOW(d, j, pr, pi); scr[(d * 64 + p) * 2] = pr * cfr[d] - pi * cfi[d]; scr[(d * 64 + p) * 2 + 1] = pr * cfi[d] + pi * cfr[d]; }
    LDS_WAIT(); asm volatile("" ::: "memory");
    const int hi_ = lane & 15;
#pragma unroll 1
    for (int i2 = 0; i2 < 4; ++i2) { const int ho = (lane >> 4) + 4 * i2; float kv[2];
#pragma unroll
        for (int d = 0; d < 2; ++d) { const float* cr = AIN(19) + (((size_t)(l * 2 + d) * 16 + g) * 16 + ho) * 64; const float* ci = AIN(20) + (((size_t)(l * 2 + d) * 16 + g) * 16 + ho) * 64;
            const float* br = AIN(17) + ((size_t)(l * 2 + d) * 16 + g) * 64 * 16 + hi_; const float* bi = AIN(18) + ((size_t)(l * 2 + d) * 16 + g) * 64 * 16 + hi_; float s = 0.f;
#pragma unroll 16
            for (int pp = 0; pp < 64; ++pp) { const float zr = scr[(d * 64 + pp) * 2], zi = scr[(d * 64 + pp) * 2 + 1], b_r = br[pp * 16], b_i = bi[pp * 16];
                const float wr_ = zr * b_r - zi * b_i, wi_ = zr * b_i + zi * b_r; s += cr[pp] * wr_ - ci[pp] * wi_; }
            kv[d] = s; }
        if (j == 0) { const float v = kv[0] + kv[1] + (ho == hi_ ? AIN(21)[l * 256 + g * 16 + ho] : 0.f);
            for (int q = 0; q < 32; ++q) BtY[(size_t)(q * 16 + ho) * S5K + q * 16 + hi_] = (bf16)f2bf(v); }
        else { const bf16 vf = (bf16)f2bf(kv[0]), vb = (bf16)f2bf(kv[1]);
            for (int q = 0; q + j < 32; ++q) { BtY[(size_t)((q + j) * 16 + ho) * S5K + q * 16 + hi_] = vf; BtY[(size_t)(q * 16 + ho) * S5K + (q + j) * 16 + hi_] = vb; } }
    }
#pragma unroll
    for (int d = 0; d < 2; ++d) { float pr, pi; LAMPOW(d, (d == 0 ? j + 1 : S5L - j), pr, pi);
#pragma unroll
        for (int ho = 0; ho < 16; ++ho) { const size_t ci_ = (((size_t)(l * 2 + d) * 16 + g) * 16 + ho) * 64 + p; const float c_r = AIN(19)[ci_], c_i = AIN(20)[ci_];
            bf16* row = BtY + (size_t)(j * 16 + ho) * S5K + 512 + d * 128; row[p] = (bf16)f2bf(c_r * pr - c_i * pi); row[64 + p] = (bf16)f2bf(-(c_r * pi + c_i * pr)); } }
#pragma unroll
    for (int d = 0; d < 2; ++d) { float pr, pi; LAMPOW(d, (d == 0 ? S5L - 1 - j : j), pr, pi); const float zr = pr * cfr[d] - pi * cfi[d], zi = pr * cfi[d] + pi * cfr[d];
        const size_t bi_ = (((size_t)(l * 2 + d) * 16 + g) * 64 + p) * 16; unsigned wre[8], wim[8];
#pragma unroll
        for (int h4 = 0; h4 < 4; ++h4) { const f32x4 b_r = *(const f32x4*)(AIN(17) + bi_ + 4 * h4), b_i = *(const f32x4*)(AIN(18) + bi_ + 4 * h4);
            wre[2 * h4] = pk2(zr * b_r.x - zi * b_i.x, zr * b_r.y - zi * b_i.y); wre[2 * h4 + 1] = pk2(zr * b_r.z - zi * b_i.z, zr * b_r.w - zi * b_i.w);
            wim[2 * h4] = pk2(zr * b_i.x + zi * b_r.x, zr * b_i.y + zi * b_r.y); wim[2 * h4 + 1] = pk2(zr * b_i.z + zi * b_r.z, zr * b_i.w + zi * b_r.w); }
        bf16* rre = BtE + (size_t)(d * 128 + p) * S5K + j * 16; bf16* rim = BtE + (size_t)(d * 128 + 64 + p) * S5K + j * 16;
        *(v4u*)rre = (v4u){wre[0], wre[1], wre[2], wre[3]}; *(v4u*)(rre + 8) = (v4u){wre[4], wre[5], wre[6], wre[7]};
        *(v4u*)rim = (v4u){wim[0], wim[1], wim[2], wim[3]}; *(v4u*)(rim + 8) = (v4u){wim[4], wim[5], wim[6], wim[7]}; }
    for (int q = lane; q < 8 * 256; q += 64) BtE[(size_t)(8 * j + (q >> 8)) * S5K + 512 + (q & 255)] = 0;
#undef LAMPOW
    LDS_WAIT(); asm volatile("" ::: "memory");
}
__device__ __forceinline__ void prep_layer(Frame& F, int l) {
    LAS float* scr = (LAS float*)(F.lds + F.wave * 16384);
    const int gw = F.vcu * NWAVES + F.wave, NGW = F.G * NWAVES;
    for (int it = gw; it < CONV_ITEMS; it += NGW) conv_item(F, l, it, scr);
    for (int it = NGW - 1 - gw; it < 512; it += NGW) s5_table_item(F, l, it, scr);
    const int gt = gw * 64 + F.lane, NGT = NGW * 64;
    { bf16* Wp = WSP(bf16, WS_WPT); const float* pw = AIN(12) + (size_t)l * 4 * 64 * 64; const float* ps = AIN(13) + l * 256;
      for (int e = gt; e < 65536; e += NGT) { const int n = e >> 8, k = e & 255; Wp[e] = (bf16)(((n >> 6) == (k >> 6)) ? f2bf(pw[((n >> 6) * 64 + (k & 63)) * 64 + (n & 63)] * ps[n]) : 0u); } }
    { bf16* A2 = WSP(bf16, WS_A2); unsigned z_ = 0u; asm volatile("" : "+v"(z_)); for (int e = gt; e < 16 * S5ROWS * 32; e += NGT) { const int row = e >> 5, c8 = e & 31; *(v4u*)(A2 + (size_t)row * S5K + 512 + c8 * 8) = (v4u){z_, z_, z_, z_}; } }
}
__device__ __forceinline__ void mod_phase(Frame& F) {
    LAS float* red = (LAS float*)F.lds;
    for (int it = F.vcu; it < DEPTH * (NSUBMOD / 64); it += F.G) { const int l = it / (NSUBMOD / 64), n = (it % (NSUBMOD / 64)) * 64 + F.lane;
        const float* w = AIN(4) + ((size_t)l * DM + F.wave * 128) * NSUBMOD + n; float a0 = 0.f, a1 = 0.f, a2 = 0.f;
#pragma unroll 16
        for (int k = 0; k < 128; ++k) { const int kk = F.wave * 128 + k; const float c0 = AIN(1)[kk], c1 = AIN(1)[DM + kk], c2 = AIN(3)[kk]; const float wv = w[(size_t)k * NSUBMOD];
            a0 += c0 * sigm(c0) * wv; a1 += c1 * sigm(c1) * wv; a2 += c2 * sigm(c2) * wv; }
        red[(F.wave * 3 + 0) * 64 + F.lane] = a0; red[(F.wave * 3 + 1) * 64 + F.lane] = a1; red[(F.wave * 3 + 2) * 64 + F.lane] = a2;
        __syncthreads();
        if (F.wave < 3) { float s = AIN(5)[l * NSUBMOD + n];
#pragma unroll
            for (int w8 = 0; w8 < 8; ++w8) s += red[(w8 * 3 + F.wave) * 64 + F.lane];
            WSP(float, WS_MOD)[((size_t)l * 3 + F.wave) * NSUBMOD + n] = s; }
        __syncthreads();
    }
}
__device__ __forceinline__ void norm_phase(Frame& F, int l, int sub, const float* lat, const float* ctxp, const float* part = nullptr, int nsl = 0, const float* pgate = nullptr, float psc = 0.f, const float* psrc = nullptr, float* pdst = nullptr) {
    const int gw = F.vcu * NWAVES + F.wave, NGW = F.G * NWAVES; const float* gptr = AIN(6) + (size_t)(l * 3 + sub) * DM; bf16* HN = WSP(bf16, WS_HN);
    for (int r0 = gw; r0 < MR; r0 += 2 * NGW) { f32x4 v[2][4]; float s[2]; const float* mod[2]; int rr[2];
#pragma unroll
        for (int q2 = 0; q2 < 2; ++q2) { int r = r0 + q2 * NGW; if (r >= MR) r = r0; rr[q2] = r; const int b = r / TOK, i = r - b * TOK;
            const float* xr = i < CTXL ? ctxp + (size_t)(b * CTXL + i) * DM : lat + (size_t)(b * SEQ + i - CTXL) * DM;
            mod[q2] = WSP(float, WS_MOD) + ((size_t)l * 3 + (i < CTXL ? 2 : b)) * NSUBMOD + sub * 3072; s[q2] = 0.f;
            if (part != nullptr && i < CTXL) { const size_t ro = (size_t)(b * CTXL + i) * DM;
#pragma unroll
                for (int j = 0; j < 4; ++j) { f32x4 a = {0.f, 0.f, 0.f, 0.f};
                    for (int sl = 0; sl < nsl; ++sl) a += *((const f32x4*)(part + (size_t)sl * 2 * CTXL * DM + ro) + F.lane + 64 * j);
                    const f32x4 o = *((const f32x4*)(psrc + ro) + F.lane + 64 * j) + (*((const f32x4*)pgate + F.lane + 64 * j) * psc) * a;
                    if (q2 == 0 || r != r0) *((f32x4*)(pdst + ro) + F.lane + 64 * j) = o; v[q2][j] = o; } }
            else {
#pragma unroll
                for (int j = 0; j < 4; ++j) v[q2][j] = *((const f32x4*)xr + F.lane + 64 * j); } }
#pragma unroll
        for (int q2 = 0; q2 < 2; ++q2) {
#pragma unroll
            for (int j = 0; j < 4; ++j) s[q2] += (v[q2][j].x * v[q2][j].x + v[q2][j].y * v[q2][j].y) + (v[q2][j].z * v[q2][j].z + v[q2][j].w * v[q2][j].w);
            const float rstd = 1.0f / sqrtf(wave_sum(s[q2], F.lane) * (1.0f / DM) + EPS);
            if (q2 == 0 || rr[1] != rr[0]) {
#pragma unroll
                for (int j = 0; j < 4; ++j) { const f32x4 gg = *((const f32x4*)gptr + F.lane + 64 * j), sh = *((const f32x4*)mod[q2] + F.lane + 64 * j), sc = *((const f32x4*)(mod[q2] + DM) + F.lane + 64 * j);
                    const f32x4 o = (v[q2][j] * rstd * gg) * (sc + 1.0f) + sh;
                    *((unsigned long long*)(HN + (size_t)rr[q2] * DM) + F.lane + 64 * j) = (unsigned long long)pk2(o.x, o.y) | ((unsigned long long)pk2(o.z, o.w) << 32); } } }
    }
}
__device__ __forceinline__ void final_norm_phase(Frame& F) {
    const int gw = F.vcu * NWAVES + F.wave, NGW = F.G * NWAVES; const float* gptr = AIN(25);
    for (int r = gw; r < NBATCH * SEQ; r += NGW) { float* xr = AOUT + (size_t)r * DM; f32x4 v[4]; float s = 0.f;
#pragma unroll
        for (int j = 0; j < 4; ++j) { v[j] = *((const f32x4*)xr + F.lane + 64 * j); s += (v[j].x * v[j].x + v[j].y * v[j].y) + (v[j].z * v[j].z + v[j].w * v[j].w); }
        const float rstd = 1.0f / sqrtf(wave_sum(s, F.lane) * (1.0f / DM) + EPS);
#pragma unroll
        for (int j = 0; j < 4; ++j) { const f32x4 gg = *((const f32x4*)gptr + F.lane + 64 * j); *((f32x4*)xr + F.lane + 64 * j) = v[j] * rstd * gg; }
    }
}
__device__ __forceinline__ void post_phase(Frame& F, int l) {
    const int gw = F.vcu * NWAVES + F.wave, NGW = F.G * NWAVES, lane = F.lane, hh = lane >> 4, d = lane & 15;
    bf16* Q = WSP(bf16, WS_Q); bf16* K = WSP(bf16, WS_K); const bf16* XA = WSP(bf16, WS_XA); bf16* DF = WSP(bf16, WS_DIFF);
    const float inv = exp2f(-(float)d * (13.287712379549449f / 16.0f));
    const float* qg = AIN(11) + (size_t)l * 128; const float* kg = qg + 64;
    for (int r = gw; r < MR; r += NGW) { const int b = r / TOK, i = r - b * TOK; const bool lat = i >= CTXL; const int t = i - CTXL;
        const int n = lat ? SEQ : CTXL, ts = lat ? t : i; const size_t seg0 = (size_t)(r - ts); float pd[4];
#pragma unroll
        for (int j = 0; j < 4; ++j) { const int w = 2 << j; int lo = ts - (w >> 1), hi2 = lo + w; lo = lo < 0 ? 0 : lo; hi2 = hi2 > n ? n : hi2; float s = 0.f;
            for (int q2 = lo; q2 < hi2; ++q2) s += bf2f(XA[(seg0 + q2) * 256 + j * 64 + lane]);
            pd[j] = s / (float)(hi2 - lo) - bf2f(XA[(size_t)r * 256 + j * 64 + lane]); }
        float x[3][4];
#pragma unroll
        for (int it = 0; it < 3; ++it) { const bf16* p = it < 2 ? Q + (size_t)r * 512 + (it * 4 + hh) * 64 + d : K + (size_t)r * 256 + hh * 64 + d;
            x[it][0] = bf2f(p[0]); x[it][1] = bf2f(p[16]); x[it][2] = bf2f(p[32]); x[it][3] = bf2f(p[48]); }
        float cr = 1.f, sr = 0.f, cc = 1.f, sc = 0.f;
        if (lat) { sincosf((float)(t >> 6) * inv, &sr, &cr); sincosf((float)(t & 63) * inv, &sc, &cc); }
#pragma unroll
        for (int it = 0; it < 3; ++it) { float x0 = x[it][0], x1 = x[it][1], x2 = x[it][2], x3 = x[it][3];
            const bool nrm = (it == 1) || (it == 2 && hh >= 2);
            float ss = (x0 * x0 + x1 * x1) + (x2 * x2 + x3 * x3);
            ss += shx(ss, 1, lane); ss += shx(ss, 2, lane); ss += shx(ss, 4, lane); ss += shx(ss, 8, lane);
            if (nrm) { const float rs = 1.0f / sqrtf(ss * (1.0f / 64.0f) + EPS); const float* gp = it == 1 ? qg : kg; x0 *= rs * gp[d]; x1 *= rs * gp[d + 16]; x2 *= rs * gp[d + 32]; x3 *= rs * gp[d + 48]; }
            float o0 = x0 * cr - x1 * sr, o1 = x1 * cr + x0 * sr, o2 = x2 * cc - x3 * sc, o3 = x3 * cc + x2 * sc;
            if (it < 2) { o0 *= attn_body::C2; o1 *= attn_body::C2; o2 *= attn_body::C2; o3 *= attn_body::C2; }
            x[it][0] = o0; x[it][1] = o1; x[it][2] = o2; x[it][3] = o3; }
#pragma unroll
        for (int it = 0; it < 3; ++it) { bf16* p = it < 2 ? Q + (size_t)r * 512 + (it * 4 + hh) * 64 + d : K + (size_t)r * 256 + hh * 64 + d;
            p[0] = (bf16)f2bf(x[it][0]); p[16] = (bf16)f2bf(x[it][1]); p[32] = (bf16)f2bf(x[it][2]); p[48] = (bf16)f2bf(x[it][3]); }
#pragma unroll
        for (int j = 0; j < 4; ++j) DF[(size_t)r * 256 + j * 64 + lane] = (bf16)f2bf(pd[j]);
    }
}
__device__ __forceinline__ void s5_carry_phase(Frame& F, int l) {
    const int cid = (int)blockIdx.x - (F.G - 64);
    if (F.wave != 0 || cid < 0) return;
    const int b = cid >> 5, d = (cid >> 4) & 1, g = cid & 15, p = F.lane;
    const int ix = ((l * 2 + d) * 16 + g) * 64 + p; const float are = AIN(14)[ix], aim = AIN(15)[ix], dt = expf(AIN(16)[(l * 2 + d) * 16 + g]);
    const float mg = expf(are * dt * (float)S5L); float sn, cs; sincosf(aim * dt * (float)S5L, &sn, &cs); const float Lr = mg * cs, Li = mg * sn;
    const float* E = WSP(float, WS_E) + (size_t)g * S5ROWS * 256 + d * 128 + p; bf16* A2 = WSP(bf16, WS_A2) + (size_t)g * S5ROWS * S5K + 512 + d * 128 + p;
    float sr = 0.f, si = 0.f;
#pragma unroll 1
    for (int k0 = 0; k0 < 520; k0 += 65) { float er[65], ei[65];
#pragma unroll
        for (int k = 0; k < 65; ++k) { const int kk = k0 + k; const int ch = d == 0 ? kk : (kk < 8 ? 7 - kk : 527 - kk); const size_t row = (size_t)b * 520 + ch; er[k] = E[row * 256]; ei[k] = E[row * 256 + 64]; }
#pragma unroll
        for (int k = 0; k < 65; ++k) { const int kk = k0 + k; const int ch = d == 0 ? kk : (kk < 8 ? 7 - kk : 527 - kk); const size_t row = (size_t)b * 520 + ch;
            A2[row * S5K] = (bf16)f2bf(sr); A2[row * S5K + 64] = (bf16)f2bf(si);
            const float nr = Lr * sr - Li * si + er[k], ni = Lr * si + Li * sr + ei[k]; sr = nr; si = ni; } }
}
__device__ __forceinline__ void attn_one(Frame& F, int l, int kind, int b, int h, int qb, char* lds) {
    using namespace attn_body;
    const attn_body::bf16* Q = (const attn_body::bf16*)WSP(::bf16, WS_Q); const attn_body::bf16* K = (const attn_body::bf16*)WSP(::bf16, WS_K); const attn_body::bf16* V = (const attn_body::bf16*)WSP(::bf16, WS_V);
    attn_body::bf16* O = (attn_body::bf16*)WSP(::bf16, WS_Y4) + (size_t)(kind == 0 ? 1 : 3) * MR * 256;
    const size_t row0 = (size_t)b * TOK + (size_t)qb * 256;
    const attn_body::bf16* Qu = Q + row0 * 512 + kind * 256 + h * 64; const attn_body::bf16* Kh = K + (size_t)b * TOK * 256 + kind * 128 + (h >> 1) * 64; const attn_body::bf16* Vh = V + (size_t)b * TOK * 256 + kind * 128 + (h >> 1) * 64;
    attn_body::bf16* Ou = O + row0 * 256 + h * 64;
    if (kind == 0) { int NT = 4, shift = 0;
        if (qb > 0) { const int lo = (4 * qb - 2) < 4 ? 4 : (4 * qb - 2), hi = (4 * qb + 5) > 259 ? 259 : (4 * qb + 5); NT = 4 + hi - lo + 1; shift = lo - 4; }
        attn_unit<8, true>(Qu, Kh, Vh, Ou, NT, shift, (qb - 1) * 256, AIN(10)[l * 4 + h] * LOG2E, lds, F.wave * 64 + F.lane);
    } else attn_unit<8, false>(Qu, Kh, Vh, Ou, qb > 0 ? 260 : 4, 0, 0, 0.f, lds, F.wave * 64 + F.lane);
}
__device__ __forceinline__ void attn_phase(Frame& F, int l, char* lds) {
    const int c = F.vcu;
#pragma unroll 1
    for (int u = c; u < 512; u += F.G) attn_one(F, l, 0, u >> 8, (u >> 6) & 3, 1 + (u & 63), lds);
#pragma unroll 1
    for (int u = c; u < 16; u += F.G) attn_one(F, l, u >> 3, (u >> 2) & 1, u & 3, 0, lds);
#pragma unroll 1
    for (int u = c; u < 512; u += F.G) attn_one(F, l, 1, u >> 8, (u >> 6) & 3, 1 + (u & 63), lds);
}

#define XB_TMO      128
#define XB_XCNT(j)  (256  + 64 * (j))
#define XB_XSUB(j)  (1280 + 64 * (j))
#define XB_XGEN(j)  (2304 + 64 * (j))
#define XB_TOP      3328
#define XB_TOPGEN   3392
#define XCD_BAR_WORDS 3456
#define XB_SPIN_CAP (1u << 18)

__device__ __forceinline__ unsigned xb_ld(unsigned* p)              { return __hip_atomic_load(p, __ATOMIC_RELAXED, __HIP_MEMORY_SCOPE_AGENT); }
__device__ __forceinline__ unsigned xb_add(unsigned* p, unsigned v) { return __hip_atomic_fetch_add(p, v, __ATOMIC_RELAXED, __HIP_MEMORY_SCOPE_AGENT); }
__device__ __forceinline__ unsigned xb_xcc_id() { return (unsigned)__builtin_amdgcn_s_getreg((3 << 11) | 20) & 0xFu; }
#define XB_SPIN(cond, bar) do { unsigned _sp = 0; while (cond) { __builtin_amdgcn_s_sleep(1); \
    if ((++_sp & 255u) == 0u) { if (xb_ld(&(bar)[XB_TMO])) break; if (_sp > XB_SPIN_CAP) { atomicAdd(&(bar)[XB_TMO], 1u); break; } } } } while (0)

struct XcdBarrier {
    unsigned* bar; unsigned x;
    volatile LAS unsigned* st;
};

__device__ __forceinline__ XcdBarrier xcd_barrier_post(unsigned* bar, volatile LAS unsigned* st) {
    XcdBarrier b; b.bar = bar; b.x = xb_xcc_id(); b.st = st;
    if (threadIdx.x == 0) (void)xb_add(&bar[XB_XCNT(b.x)], 1u);
    return b;
}
__device__ __forceinline__ void xcd_barrier_complete(unsigned* bar, unsigned x, unsigned& nloc, unsigned& nx) {
    const unsigned G = gridDim.x * gridDim.y * gridDim.z;
    unsigned sum, cnt, mine, sp = 0u;
    for (;;) {
        sum = 0u; cnt = 0u; mine = 0u;
#pragma unroll
        for (unsigned j = 0; j < 16; ++j) { const unsigned c = xb_ld(&bar[XB_XCNT(j)]); sum += c; cnt += (c > 0u) ? 1u : 0u; mine = (j == x) ? c : mine; }
        if (sum == G) break;
        __builtin_amdgcn_s_sleep(1);
        if ((++sp & 255u) == 0u) { if (xb_ld(&bar[XB_TMO])) break; if (sp > XB_SPIN_CAP) { atomicAdd(&bar[XB_TMO], 1u); break; } }
    }
    nloc = mine > 0u ? mine : 1u; nx = cnt > 0u ? cnt : 1u;
}

__device__ __forceinline__ void xcd_barrier(const XcdBarrier& b) {
    asm volatile("s_waitcnt vmcnt(0)" ::: "memory");
    __syncthreads();
    if (threadIdx.x == 0) {
        unsigned* bar = b.bar;
        __builtin_amdgcn_s_waitcnt(0);
        unsigned nloc = b.st[0], nx = b.st[1];
        if (nloc == 0u) { xcd_barrier_complete(bar, b.x, nloc, nx); b.st[0] = nloc; b.st[1] = nx; }
        const unsigned old = xb_add(&bar[XB_XSUB(b.x)], 1u);
        const unsigned gen = old / nloc;
        if (old + 1u == (gen + 1u) * nloc) {
            __builtin_amdgcn_fence(__ATOMIC_RELEASE, "agent");
            asm volatile("s_waitcnt vmcnt(0)" ::: "memory");
            const unsigned og = xb_add(&bar[XB_TOP], 1u);
            const unsigned tg = og / nx;
            if (og + 1u == (tg + 1u) * nx) xb_add(&bar[XB_TOPGEN], 1u);
            else XB_SPIN(xb_ld(&bar[XB_TOPGEN]) == tg, bar);
            __builtin_amdgcn_fence(__ATOMIC_ACQUIRE, "agent");
            xb_add(&bar[XB_XGEN(b.x)], 1u);
            asm volatile("s_waitcnt vmcnt(0)" ::: "memory");
        } else {
            XB_SPIN(xb_ld(&bar[XB_XGEN(b.x)]) == gen, bar);
            __builtin_amdgcn_fence(__ATOMIC_ACQUIRE, "agent");
            asm volatile("s_waitcnt vmcnt(0)" ::: "memory");
        }
    }
    __syncthreads();
}

constexpr size_t WS_BAR = 16384;
#ifndef MK_SPLIT
#define MK_SPLIT 0
#endif
constexpr int N_PHASES = 2 + DEPTH * 14 + 1;
__global__ void __launch_bounds__(NWAVES * 64, 2) mk_fwd(Args args) {
    extern __shared__ __attribute__((aligned(16))) unsigned char lds[];
    Frame F;
    F.lds = (LAS unsigned char*)lds; F.lane = 0; F.wave = __builtin_amdgcn_readfirstlane(threadIdx.x >> 6);
    F.G = gridDim.x; { const int bx = blockIdx.x; F.vcu = (F.G % 8 == 0) ? (bx % 8) * (F.G / 8) + bx / 8 : bx; }
    { volatile LAS unsigned* st_ = (volatile LAS unsigned*)(F.lds + RING_BYTES + 512); if (threadIdx.x < 2) st_[threadIdx.x] = 0u; __syncthreads();
      (void)xcd_barrier_post((unsigned*)(AWS + WS_BAR), st_); }
    const int lo = args.ph_lo, hi = args.ph_hi; int ph = 0;
#ifndef ONLY_MASK
#define ONLY_MASK 0xffffffffu
#endif
#define SEL(n) ((ONLY_MASK >> (n)) & 1u)
#define PH_BEGIN if (lo <= ph && ph < hi) { { int l_; asm volatile("v_mbcnt_lo_u32_b32 %0, -1, 0\n\tv_mbcnt_hi_u32_b32 %0, -1, %0" : "=v"(l_)); F.lane = l_; }
#define PH_END   if (ph + 1 < hi) { asm volatile("s_waitcnt vmcnt(0) lgkmcnt(0)" ::: "memory");   \
        if (hi < 0) cg::this_grid().sync();   \
        else { XcdBarrier xb_; xb_.bar = (unsigned*)(AWS + WS_BAR); xb_.x = xb_xcc_id(); xb_.st = (volatile LAS unsigned*)(F.lds + RING_BYTES + 512); xcd_barrier(xb_); } } } ++ph;
#define GEMM(EPI, SCHEDT, A_, B_, K_, S_, E_) pg8::gemm_phase<EPI, SCHEDT, true, true>(F.lds, pg8::Gemm{(const pg8::bf16_t*)(A_), (const pg8::bf16_t*)(B_), 0, 0, (K_), (K_)}, S_, E_, F.wave * 64 + F.lane)
#define GEMML(EPI, SCHEDT, A_, B_, K_, LD_, S_, E_) pg8::gemm_phase<EPI, SCHEDT, true, true>(F.lds, pg8::Gemm{(const pg8::bf16_t*)(A_), (const pg8::bf16_t*)(B_), 0, 0, (K_), (LD_)}, S_, E_, F.wave * 64 + F.lane)
    float* XC = WSP(float, WS_XC);
    PH_BEGIN if (SEL(1)) { prep_layer(F, 0); __syncthreads(); mod_phase(F); } PH_END
#pragma unroll 1
    for (int l = 0; l < DEPTH; ++l) {
        const bool last = (l == DEPTH - 1);
        const float* MODl = WSP(float, WS_MOD) + (size_t)l * 3 * NSUBMOD;
        const float* srcL = l == 0 ? AIN(0) : AOUT; const float* srcC = l == 0 ? AIN(2) : XC;
        PH_BEGIN if (SEL(2)) { if (l > 0) { prep_layer(F, l); } if (l > 0) norm_phase(F, l, 0, srcL, srcC, WSP(float, WS_Y4), 11, WSP(float, WS_MOD) + (size_t)(l - 1) * 3 * NSUBMOD + 2 * 3072 + 2048 + 2 * NSUBMOD, 0.5f, XC, XC); else norm_phase(F, l, 0, srcL, srcC); } PH_END
#pragma unroll 1
        for (int f = 0; f < 2; ++f) {
            if (f == 1) {
                PH_BEGIN if (SEL(3)) { { RowOrder S; S.init(1536, F.G, (int)blockIdx.x, false); EpiRoute E{WSP(bf16_t, WS_Q), WSP(bf16_t, WS_K), WSP(bf16_t, WS_V), WSP(bf16_t, WS_A2), WSP(bf16_t, WS_XA)};
                    GEMM(EpiRoute, RowOrder, WSP(bf16, WS_HN), WSP(bf16, WS_WINT), DM, S, E); } } PH_END
                PH_BEGIN if (SEL(4)) { { post_phase(F, l); S5Order S{1, F.G, (int)blockIdx.x}; EpiF32 E{WSP(float, WS_E)}; GEMM(EpiF32, S5Order, WSP(bf16, WS_A2), WSP(bf16, WS_BTE), S5K, S, E); } } PH_END
                PH_BEGIN if (SEL(5)) { { s5_carry_phase(F, l); RowOrder S; S.init(256, F.G, (int)blockIdx.x, last); EpiPlain E{WSP(bf16_t, WS_Y4), 256}; GEMM(EpiPlain, RowOrder, WSP(bf16, WS_DIFF), WSP(bf16, WS_WPT), 256, S, E); } } PH_END
                PH_BEGIN if (SEL(6)) { { S5Order S{2, F.G, (int)blockIdx.x}; EpiS5Y E{WSP(bf16_t, WS_G)}; GEMM(EpiS5Y, S5Order, WSP(bf16, WS_A2), WSP(bf16, WS_BTY), S5K, S, E); } } PH_END
                PH_BEGIN if (SEL(7)) { { RowOrder S; S.init(512, F.G, (int)blockIdx.x, last); EpiGlu E{WSP(bf16_t, WS_Y4) + (size_t)2 * MR * 256}; GEMM(EpiGlu, RowOrder, WSP(bf16, WS_G), WSP(bf16, WS_WGT), 256, S, E);
                    attn_phase(F, l, (char*)lds); } } PH_END
                PH_BEGIN if (SEL(8)) { { RowOrder S; S.init(DM, F.G, (int)blockIdx.x, last);
#pragma unroll 1
                    for (int k = 0; k < 4; ++k) { EpiGate Eg{WSP(bf16_t, WS_GS)}; GEMM(EpiGate, RowOrder, WSP(bf16, WS_HN), WSP(bf16, WS_WINT) + (size_t)(1536 + k * 1024) * DM, DM, S, Eg);
                        const bf16* Ak = WSP(bf16, WS_Y4) + (size_t)k * MR * 256; const bf16* Bk = WSP(bf16, WS_WBT) + (size_t)k * DM * 256;
                        if (k == 0) { EpiMerge<true> Em{WSP(bf16_t, WS_GS), WSP(bf16_t, WS_T)}; GEMM(EpiMerge<true>, RowOrder, Ak, Bk, 256, S, Em); }
                        else { EpiMerge<false> Em{WSP(bf16_t, WS_GS), WSP(bf16_t, WS_T)}; GEMM(EpiMerge<false>, RowOrder, Ak, Bk, 256, S, Em); } } } } PH_END
                PH_BEGIN if (SEL(9)) { { RowOrder S; S.init(DM, F.G, (int)blockIdx.x, true); EpiResid E{AOUT, XC, AOUT, XC, MODl + 1 * 3072 + 2048, 1.0f}; GEMM(EpiResid, RowOrder, WSP(bf16, WS_T), WSP(bf16, WS_WOT), DM, S, E); }
                    if (!last) { CtxSliceOrder S{4, F.G, (int)blockIdx.x}; EpiPart E{WSP(float, WS_Y4)}; GEMML(EpiPart, CtxSliceOrder, WSP(bf16, WS_T), WSP(bf16, WS_WOT), 256, DM, S, E); } } PH_END
                PH_BEGIN if (SEL(10)) { if (!last) norm_phase(F, l, 2, AOUT, XC, WSP(float, WS_Y4), 4, MODl + 1 * 3072 + 2048 + 2 * NSUBMOD, 1.0f, XC, XC); else norm_phase(F, l, 2, AOUT, XC); } PH_END
            }
            PH_BEGIN if (SEL(11)) { { RowOrder S; S.init(5632, F.G, (int)blockIdx.x, last && f == 1); EpiSwiglu E{WSP(bf16_t, WS_HID)}; GEMM(EpiSwiglu, RowOrder, WSP(bf16, WS_HN), WSP(bf16, WS_W1T) + (size_t)f * 5632 * DM, DM, S, E); } } PH_END
            PH_BEGIN if (SEL(12)) { { RowOrder S; S.init(DM, F.G, (int)blockIdx.x, true); const bool first = (l == 0 && f == 0);
                EpiResid E{first ? AIN(0) : AOUT, first ? AIN(2) : XC, AOUT, XC, MODl + (f == 0 ? 0 : 2) * 3072 + 2048, 0.5f};
                GEMM(EpiResid, RowOrder, WSP(bf16, WS_HID), WSP(bf16, WS_W2T) + (size_t)f * DM * DFF, DFF, S, E); }
                if (!(last && f == 1)) { CtxSliceOrder S{11, F.G, (int)blockIdx.x}; EpiPart E{WSP(float, WS_Y4)}; GEMML(EpiPart, CtxSliceOrder, WSP(bf16, WS_HID), WSP(bf16, WS_W2T) + (size_t)f * DM * DFF, 256, DFF, S, E); } } PH_END
            if (f == 0) { PH_BEGIN if (SEL(13)) { norm_phase(F, l, 1, AOUT, XC, WSP(float, WS_Y4), 11, MODl + 0 * 3072 + 2048 + 2 * NSUBMOD, 0.5f, l == 0 ? AIN(2) : XC, XC); } PH_END }
        }
    }
    PH_BEGIN if (SEL(14)) { final_norm_phase(F); } PH_END
}

extern "C" void kernel_launch(void* const* d_in, const int* in_sizes, int n_in, void* d_out, int out_size, void* d_ws, size_t ws_size, hipStream_t stream) {
    static int grid = 0;
    if (grid == 0) {
        int dev = 0, cus = 0, per_cu = 0;
        if (n_in != 26 || ws_size < WS_END) { fprintf(stderr, "kernel_launch: unexpected inputs (n_in %d, ws %zu < %zu)\n", n_in, ws_size, (size_t)WS_END); grid = -1; return; }
        hipGetDevice(&dev); hipDeviceGetAttribute(&cus, hipDeviceAttributeMultiprocessorCount, dev);
        hipFuncSetAttribute((const void*)mk_fwd, hipFuncAttributeMaxDynamicSharedMemorySize, LDS_BYTES);
        hipOccupancyMaxActiveBlocksPerMultiprocessor(&per_cu, (const void*)mk_fwd, NWAVES * 64, LDS_BYTES);
        if (per_cu < 1) { fprintf(stderr, "kernel_launch: occupancy query says %d blocks per CU\n", per_cu); per_cu = 1; }
        (void)hipGetLastError();
        grid = cus * per_cu;
    }
    if (grid < 0) return;
    Args a{};
    for (int i = 0; i < 26; ++i) a.in[i] = (const float*)d_in[i];
    a.out = (float*)d_out; a.ws = (unsigned char*)d_ws;
#if MK_SPLIT
    for (int p = 0; p < N_PHASES; ++p) { a.ph_lo = p; a.ph_hi = p + 1; hipLaunchKernelGGL(mk_fwd, dim3(grid), dim3(NWAVES * 64), LDS_BYTES, stream, a); }
#else
    if (hipMemsetAsync((char*)d_ws + WS_BAR, 0, 65536, stream) != hipSuccess) { fprintf(stderr, "kernel_launch: memset of the barrier words failed\n"); return; }
    a.ph_lo = 0; a.ph_hi = N_PHASES;
    void* kargs[] = {&a};
    hipError_t e = hipLaunchCooperativeKernel((const void*)mk_fwd, dim3(grid), dim3(NWAVES * 64), kargs, LDS_BYTES, stream);
    if (e != hipSuccess) fprintf(stderr, "cooperative launch failed: %s (grid %d)\n", hipGetErrorString(e), grid);
#endif
}
```

```cpp
#include <hip/hip_cooperative_groups.h>
#include <hip/hip_runtime.h>
#include <cstdio>
#include <cstdint>
namespace pg8 {
#define PG8_LAS __attribute__((address_space(3)))
typedef unsigned short bf16_t;
typedef short bf16x8 __attribute__((ext_vector_type(8)));
typedef float f32x4 __attribute__((ext_vector_type(4)));
typedef unsigned u32x4 __attribute__((ext_vector_type(4)));
constexpr int BM = 256, BK = 64, HALF = 128, HTB = HALF * BK * 2  , STAGE_BYTES = 8 * HTB, NXCD = 8, WGM = 8;

__host__ __device__ __forceinline__ int lds_byte(int r, int c) { const int st = (r >> 4) * 2 + (c >> 5), rr = r & 15, cc = c & 31, ob = rr * 64 + cc * 2; return st * 1024 + (ob ^ (((ob >> 9) & 1) << 5)); }
__host__ __device__ __forceinline__ void stage_rc(int b, int& R, int& C) { const int st = b / 1024, sb = b % 1024, swz = sb ^ (((sb >> 9) & 1) << 5); R = (st >> 1) * 16 + swz / 64; C = (st & 1) * 32 + (swz % 64) / 2; }
__host__ __device__ __forceinline__ int perm32(int rho) { const int n = rho >> 4, i = rho & 15; return 8 * (i >> 2) + 4 * n + (i & 3); }

struct Unit { int pm, pn, k0; };
struct Gemm { const bf16_t* A; const bf16_t* Bt; int M, N, K, ld; };

struct StaticOrder {
    int nM, nN, nwg, G, c;
    __host__ __device__ void init(int M, int N, int G_, int c_) { nM = M / BM; nN = N / BM; nwg = nM * nN; G = G_; c = c_; }
    __host__ __device__ bool next(int i, Unit& u) const {
        const long L = (long)i * G + c; if (L >= nwg) return false;
        int wgid = (int)L; { const int q = nwg / NXCD, r = nwg % NXCD, xcd = wgid % NXCD, off = wgid / NXCD; wgid = (xcd < r ? xcd * (q + 1) : r * (q + 1) + (xcd - r) * q) + off; }
        const int nig = WGM * nN, gid = wgid / nig, fm = gid * WGM, gsz = (nM - fm) < WGM ? (nM - fm) : WGM;
        u.pm = fm + ((wgid % nig) % gsz); u.pn = (wgid % nig) / gsz; u.k0 = 0; return true;
    }
    __device__ __forceinline__ void a_ready(const Unit&) const {}
    __device__ __forceinline__ void done(const Unit&) const {}
};

typedef float f32x2cv __attribute__((ext_vector_type(2))); typedef __bf16 bf16x2cv __attribute__((ext_vector_type(2)));
__device__ __forceinline__ unsigned cvt_pk_bf16(float lo, float hi) { f32x2cv v = {lo, hi}; bf16x2cv b = __builtin_convertvector(v, bf16x2cv); return __builtin_bit_cast(unsigned, b); }
typedef float f32x2 __attribute__((ext_vector_type(2)));
template <class Epi, class Sched, bool ALIGN_EPI = false, bool SP2 = false>
__device__ __forceinline__ void gemm_phase(PG8_LAS unsigned char* lds, const Gemm g, const Sched& S, const Epi& E, int tid) {
    float zf = 0.f; asm volatile("" : "+v"(zf));
    const int wid = __builtin_amdgcn_readfirstlane(tid >> 6), lane = tid & 63, wr = wid >> 2, wc = wid & 3, fr = lane & 15, fq = lane >> 4;
    const int K = g.K, nt = K / BK;
    unsigned voffA[2], voffB[2];
#pragma unroll
    for (int i = 0; i < 2; ++i) { int R, C; stage_rc(tid * 16 + i * 8192, R, C); const int Rb = Epi::PERM ? ((R & ~31) + perm32(R & 31)) : R;
        voffA[i] = (unsigned)(R * g.ld + C) * 2u; voffB[i] = (unsigned)(Rb * g.ld + C) * 2u; }
    const size_t kstep = (size_t)(BK * 2);
    const size_t hstep = (size_t)HALF * g.ld * 2;
    const size_t tstep = 2 * hstep;
    const unsigned ldsw = (unsigned)wid * 1024u;
    const int aoff = lds_byte(wr * 64 + fr, fq * 8), boff = lds_byte(wc * 32 + fr, fq * 8);
#define PG8_SA(b, h) (((b) * 2 + (h)) * HTB)
#define PG8_SB(b, h) ((4 + (b) * 2 + (h)) * HTB)
#define PG8_STAGE(bufoff, gbase, voff) do { _Pragma("unroll") for (int _i = 0; _i < 2; ++_i) \
        __builtin_amdgcn_global_load_lds((const unsigned*)((const char*)(gbase) + (voff)[_i]), (PG8_LAS unsigned*)(lds + (bufoff) + ldsw + _i * 8192), 16, 0, 0); } while (0)
#define PG8_LDA(dst, b, h) do { _Pragma("unroll") for (int m = 0; m < 4; ++m) _Pragma("unroll") for (int k = 0; k < 2; ++k) dst[m][k] = *(const PG8_LAS bf16x8*)(lds + PG8_SA(b, h) + aoff + m * 2048 + k * 1024); } while (0)
#define PG8_LDB(dst, b, h) do { _Pragma("unroll") for (int n = 0; n < 2; ++n) _Pragma("unroll") for (int k = 0; k < 2; ++k) dst[n][k] = *(const PG8_LAS bf16x8*)(lds + PG8_SB(b, h) + boff + n * 2048 + k * 1024); } while (0)
#define PG8_MMA(ai, bj, At, Bt) do { __builtin_amdgcn_s_setprio(1); _Pragma("unroll") for (int m = 0; m < 4; ++m) _Pragma("unroll") for (int n = 0; n < 2; ++n) _Pragma("unroll") for (int k = 0; k < 2; ++k) \
        acc[ai][bj][m][n] = __builtin_amdgcn_mfma_f32_16x16x32_bf16(Bt[n][k], At[m][k], acc[ai][bj][m][n], 0, 0, 0); __builtin_amdgcn_s_setprio(0); } while (0)
#define PG8_WAIT_V(n) asm volatile("s_waitcnt vmcnt(" #n ")" ::: "memory")
#define PG8_WAIT_L(n) asm volatile("s_waitcnt lgkmcnt(" #n ")" ::: "memory")
#define PG8_BAR __builtin_amdgcn_s_barrier()
#define PG8_SCHED __builtin_amdgcn_sched_barrier(0)
    Unit cur, nxt; int ui = 0;
    if (!S.next(0, cur)) return;
    f32x4 acc[2][2][4][2];
#pragma unroll
    for (int a = 0; a < 2; ++a)
#pragma unroll
        for (int b = 0; b < 2; ++b)
#pragma unroll
            for (int m = 0; m < 4; ++m)
#pragma unroll
                for (int n = 0; n < 2; ++n) acc[a][b][m][n] = (f32x4){zf, zf, zf, zf};
    bf16x8 At[4][2], B0[2][2], B1[2][2];
    const char* cA = (const char*)g.A + (size_t)cur.pm * tstep + (size_t)cur.k0 * 2; const char* cB = (const char*)g.Bt + (size_t)cur.pn * tstep + (size_t)cur.k0 * 2;
    S.a_ready(cur);
    if constexpr (SP2) {
        PG8_STAGE(PG8_SB(0, 0), cB, voffB); PG8_STAGE(PG8_SB(0, 1), cB + hstep, voffB); PG8_STAGE(PG8_SA(0, 0), cA, voffA); PG8_STAGE(PG8_SA(0, 1), cA + hstep, voffA);
        if (wr == 1) PG8_BAR;
        PG8_WAIT_V(2); PG8_BAR;
        PG8_STAGE(PG8_SB(1, 0), cB + kstep, voffB); PG8_STAGE(PG8_SA(1, 0), cA + kstep, voffA); PG8_STAGE(PG8_SB(1, 1), cB + hstep + kstep, voffB);
        PG8_WAIT_V(6); PG8_BAR;
    } else {
        PG8_STAGE(PG8_SB(0, 0), cB, voffB); PG8_STAGE(PG8_SA(0, 0), cA, voffA); PG8_STAGE(PG8_SB(0, 1), cB + hstep, voffB); PG8_STAGE(PG8_SA(0, 1), cA + hstep, voffA);
        if (wr == 1) PG8_BAR;
        PG8_WAIT_V(4); PG8_BAR;
        PG8_STAGE(PG8_SB(1, 0), cB + kstep, voffB); PG8_STAGE(PG8_SA(1, 0), cA + kstep, voffA); PG8_STAGE(PG8_SB(1, 1), cB + hstep + kstep, voffB);
        PG8_WAIT_V(6); PG8_BAR;
    }
    for (;;) {
        const bool has_next = S.next(ui + 1, nxt);
        const char* nA = has_next ? (const char*)g.A + (size_t)nxt.pm * tstep + (size_t)nxt.k0 * 2 : cA; const char* nB = has_next ? (const char*)g.Bt + (size_t)nxt.pn * tstep + (size_t)nxt.k0 * 2 : cB;
#pragma nounroll
        for (int t = 0; t < nt; t += 2) {
            const bool last = (t == nt - 2);
            const char* a1 = cA + (size_t)(t + 1) * kstep;
            const char* a2 = last ? nA : cA + (size_t)(t + 2) * kstep; const char* b2 = last ? nB : cB + (size_t)(t + 2) * kstep;
            const char* a3 = a2 + kstep; const char* b3 = b2 + kstep;
            if (last && has_next) S.a_ready(nxt);
            if constexpr (SP2) {
            PG8_LDB(B0, 0, 0); PG8_LDB(B1, 0, 1); PG8_SCHED; PG8_LDA(At, 0, 0); PG8_STAGE(PG8_SA(1, 1), a1 + hstep, voffA);
            PG8_WAIT_V(8); PG8_WAIT_L(0); PG8_BAR; PG8_MMA(0, 0, At, B0); PG8_MMA(0, 1, At, B1); PG8_BAR; PG8_SCHED;
            PG8_LDA(At, 0, 1); PG8_STAGE(PG8_SB(0, 0), b2, voffB); PG8_STAGE(PG8_SB(0, 1), b2 + hstep, voffB); PG8_STAGE(PG8_SA(0, 0), a2, voffA);
            PG8_WAIT_V(8); PG8_WAIT_L(0); PG8_BAR; PG8_MMA(1, 0, At, B0); PG8_MMA(1, 1, At, B1); PG8_BAR; PG8_SCHED;
            PG8_LDB(B0, 1, 0); PG8_LDB(B1, 1, 1); PG8_SCHED; PG8_LDA(At, 1, 0); PG8_STAGE(PG8_SA(0, 1), a2 + hstep, voffA);
            PG8_WAIT_V(8); PG8_WAIT_L(0); PG8_BAR; PG8_MMA(0, 0, At, B0); PG8_MMA(0, 1, At, B1); PG8_BAR; PG8_SCHED;
            PG8_LDA(At, 1, 1); PG8_STAGE(PG8_SB(1, 0), b3, voffB); PG8_STAGE(PG8_SB(1, 1), b3 + hstep, voffB); PG8_STAGE(PG8_SA(1, 0), a3, voffA);
            PG8_WAIT_V(8); PG8_WAIT_L(0); PG8_BAR; PG8_MMA(1, 0, At, B0); PG8_MMA(1, 1, At, B1); PG8_BAR; PG8_SCHED;
            } else {
            PG8_LDB(B0, 0, 0); PG8_SCHED; PG8_LDA(At, 0, 0); PG8_STAGE(PG8_SA(1, 1), a1 + hstep, voffA);
            PG8_WAIT_L(8); PG8_BAR; PG8_WAIT_L(0); PG8_MMA(0, 0, At, B0); PG8_BAR; PG8_SCHED;
            PG8_LDB(B1, 0, 1); PG8_STAGE(PG8_SB(0, 0), b2, voffB);
            PG8_BAR; PG8_WAIT_L(0); PG8_MMA(0, 1, At, B1); PG8_BAR;
            PG8_LDA(At, 0, 1); PG8_STAGE(PG8_SA(0, 0), a2, voffA);
            PG8_BAR; PG8_WAIT_L(0); PG8_MMA(1, 0, At, B0); PG8_BAR; PG8_SCHED;
            PG8_STAGE(PG8_SB(0, 1), b2 + hstep, voffB);
            PG8_WAIT_V(6); PG8_BAR; PG8_MMA(1, 1, At, B1); PG8_BAR;
            PG8_LDB(B0, 1, 0); PG8_SCHED; PG8_LDA(At, 1, 0); PG8_STAGE(PG8_SA(0, 1), a2 + hstep, voffA);
            PG8_WAIT_L(8); PG8_BAR; PG8_WAIT_L(0); PG8_MMA(0, 0, At, B0); PG8_BAR; PG8_SCHED;
            PG8_LDB(B1, 1, 1); PG8_STAGE(PG8_SB(1, 0), b3, voffB);
            PG8_BAR; PG8_WAIT_L(0); PG8_MMA(0, 1, At, B1); PG8_BAR;
            PG8_LDA(At, 1, 1); PG8_STAGE(PG8_SA(1, 0), a3, voffA);
            PG8_BAR; PG8_WAIT_L(0); PG8_MMA(1, 0, At, B0); PG8_BAR; PG8_SCHED;
            PG8_STAGE(PG8_SB(1, 1), b3 + hstep, voffB);
            PG8_WAIT_V(6); PG8_BAR; PG8_MMA(1, 1, At, B1); PG8_BAR;
            }
        }
        if constexpr (ALIGN_EPI) { if (wr == 0) PG8_BAR; }
        if constexpr (!Epi::AFTER_DRAIN) { E(acc, cur, wr, wc, fr, fq); S.done(cur); }
        if (!has_next) break;
#pragma unroll
        for (int a = 0; a < 2; ++a)
#pragma unroll
            for (int b = 0; b < 2; ++b)
#pragma unroll
                for (int m = 0; m < 4; ++m)
#pragma unroll
                    for (int n = 0; n < 2; ++n) acc[a][b][m][n] = (f32x4){zf, zf, zf, zf};
        cur = nxt; cA = nA; cB = nB; ++ui;
        if constexpr (ALIGN_EPI) { if (wr == 1) PG8_BAR; }
    }
    PG8_WAIT_V(0);
    if constexpr (!ALIGN_EPI) { if (wr == 0) PG8_BAR; }
    PG8_BAR;
    if constexpr (Epi::AFTER_DRAIN) { E.fused(acc, cur, wr, wc, fr, fq, lds, wid, lane); S.done(cur); }
#undef PG8_SA
#undef PG8_SB
#undef PG8_STAGE
#undef PG8_LDA
#undef PG8_LDB
#undef PG8_MMA
#undef PG8_WAIT_V
#undef PG8_WAIT_L
#undef PG8_BAR
#undef PG8_SCHED
}
}
namespace cg = cooperative_groups;
#include <hip/hip_bf16.h>
#include <cmath>
namespace attn_body {
using bf16=__hip_bfloat16;
using bf16x8=__attribute__((ext_vector_type(8)))short;
using s16x4=__attribute__((ext_vector_type(4)))short;
using f32x16=__attribute__((ext_vector_type(16)))float;
using u32x4=__attribute__((ext_vector_type(4)))unsigned;
constexpr int D=64,QP=512,KP=256,OP=256;
constexpr int NW=8,QBLK=32,QB=QBLK*NW,KVBLK=64;
__device__ __forceinline__ int crow(int r,int hi){return (r&3)+8*(r>>2)+4*hi;}
#define SBAR() __builtin_amdgcn_sched_barrier(0)
__device__ __forceinline__ void wmask(f32x16&p0,f32x16&p1,int dbase){
  const float NEG=-INFINITY;
  #pragma unroll
  for(int r=0;r<16;++r){int d=dbase+(r&3)+8*(r>>2); if((unsigned)(d+128)>256u)p0[r]=NEG; if((unsigned)(d+160)>256u)p1[r]=NEG;}
}

constexpr int NSLOT=3, SLOTB=8192;
constexpr int LDS_K=0, LDS_V=NSLOT*SLOTB, LDS_WS=2*NSLOT*SLOTB, LDS_OST=LDS_WS+NW*64*4, LDS_BYTES=LDS_OST+NW*4096;
constexpr float C2=0.125f*1.4426950408889634f;
__device__ __forceinline__ void glds16(const void*gsrc,unsigned lds_dst){unsigned keep;
  asm volatile("s_mov_b32 %0, m0\n\ts_mov_b32 m0, %2\n\ts_nop 0\n\tglobal_load_lds_dwordx4 %1, off\n\ts_mov_b32 m0, %0":"=&s"(keep):"v"(gsrc),"s"(lds_dst):"memory");}
__device__ __forceinline__ float max3f(float a,float b,float c){float r;asm("v_max3_f32 %0, %1, %2, %3":"=v"(r):"v"(a),"v"(b),"v"(c));return r;}
__device__ __forceinline__ float max2f(float a,float b){float r;asm("v_max_f32_e32 %0, %1, %2":"=v"(r):"v"(a),"v"(b));return r;}
__device__ __forceinline__ float fadd_s(float a,float b){float r;asm("v_add_f32_e32 %0, %1, %2":"=v"(r):"v"(a),"v"(b));return r;}
__device__ __forceinline__ float fsub_s(float a,float b){float r;asm("v_sub_f32_e32 %0, %1, %2":"=v"(r):"v"(a),"v"(b));return r;}
typedef float f32x2_t __attribute__((ext_vector_type(2))); typedef __bf16 bf16x2_t __attribute__((ext_vector_type(2)));
__device__ __forceinline__ unsigned cvtpk_s(float lo,float hi){f32x2_t v={lo,hi};bf16x2_t b=__builtin_convertvector(v,bf16x2_t);return __builtin_bit_cast(unsigned,b);}
#define WAIT_BAR(N) asm volatile("s_waitcnt vmcnt(" #N ") lgkmcnt(0)\n\ts_barrier":::"memory")

__device__ __forceinline__ void qkt(f32x16&p0,f32x16&p1,const char*Kslot,const bf16x8*qr,const f32x16&negm,int r32,int hi){
  const char*kb=Kslot+hi*1024+r32*16;
  #pragma unroll
  for(int d0=0;d0<4;++d0){
    const bf16x8 b0=*reinterpret_cast<const bf16x8*>(kb+d0*2048);
    const bf16x8 b1=*reinterpret_cast<const bf16x8*>(kb+d0*2048+512);
    if(d0==0){p0=__builtin_amdgcn_mfma_f32_32x32x16_bf16(b0,qr[0],negm,0,0,0);p1=__builtin_amdgcn_mfma_f32_32x32x16_bf16(b1,qr[0],negm,0,0,0);}
    else{p0=__builtin_amdgcn_mfma_f32_32x32x16_bf16(b0,qr[d0],p0,0,0,0);p1=__builtin_amdgcn_mfma_f32_32x32x16_bf16(b1,qr[d0],p1,0,0,0);}}
}
typedef __attribute__((address_space(3))) const char* lds_cptr;
typedef short v4i16_t __attribute__((ext_vector_type(4)));
__device__ __forceinline__ void kload8(bf16x8*kf,lds_cptr kp){
  kf[0]=*(const __attribute__((address_space(3))) bf16x8*)(kp);      kf[1]=*(const __attribute__((address_space(3))) bf16x8*)(kp+512);
  kf[2]=*(const __attribute__((address_space(3))) bf16x8*)(kp+2048); kf[3]=*(const __attribute__((address_space(3))) bf16x8*)(kp+2560);
  kf[4]=*(const __attribute__((address_space(3))) bf16x8*)(kp+4096); kf[5]=*(const __attribute__((address_space(3))) bf16x8*)(kp+4608);
  kf[6]=*(const __attribute__((address_space(3))) bf16x8*)(kp+6144); kf[7]=*(const __attribute__((address_space(3))) bf16x8*)(kp+6656);
}
__device__ __forceinline__ void kload2(bf16x8*kf,lds_cptr kp,int j){ kf[2*j]=*(const __attribute__((address_space(3))) bf16x8*)(kp+j*2048); kf[2*j+1]=*(const __attribute__((address_space(3))) bf16x8*)(kp+j*2048+512); }
__device__ __forceinline__ s16x4 vtr(lds_cptr p){ return __builtin_bit_cast(s16x4,__builtin_amdgcn_ds_read_tr16_b64_v4i16((__attribute__((address_space(3))) v4i16_t*)p)); }
__device__ __forceinline__ float rowmax(const f32x16&p0,const f32x16&p1){
  float a=max3f(p0[0],p0[1],p1[0]),b=max3f(p0[2],p0[3],p1[1]);a=max3f(a,p1[2],p1[3]);
  #pragma unroll
  for(int r=4;r<16;r+=4){a=max3f(a,p0[r],p0[r+1]);b=max3f(b,p0[r+2],p0[r+3]);a=max3f(a,p1[r],p1[r+1]);b=max3f(b,p1[r+2],p1[r+3]);}
  const float m=max2f(a,b);
  auto rr=__builtin_amdgcn_permlane32_swap(__float_as_uint(m),__float_as_uint(m),false,false);
  return max2f(__uint_as_float(rr[0]),__uint_as_float(rr[1]));
}
__device__ __forceinline__ void pv(f32x16*o,int vb,bf16x8 pa0,bf16x8 pa1,bf16x8 pa2,bf16x8 pa3){
  #pragma unroll
  for(int d0=0;d0<2;++d0){s16x4 lo[4],hi[4];
    #pragma unroll
    for(int ks=0;ks<4;++ks){
      asm volatile("ds_read_b64_tr_b16 %0,%1 offset:%c2":"=&v"(lo[ks]):"v"(vb),"i"(d0*4096+ks*1024):"memory");
      asm volatile("ds_read_b64_tr_b16 %0,%1 offset:%c2":"=&v"(hi[ks]):"v"(vb),"i"(d0*4096+ks*1024+512):"memory");}
    asm volatile("s_waitcnt lgkmcnt(0)":::"memory");SBAR();
    #define PK(k) (bf16x8){lo[k][0],lo[k][1],lo[k][2],lo[k][3],hi[k][0],hi[k][1],hi[k][2],hi[k][3]}
    o[d0]=__builtin_amdgcn_mfma_f32_32x32x16_bf16(pa0,PK(0),o[d0],0,0,0);
    o[d0]=__builtin_amdgcn_mfma_f32_32x32x16_bf16(pa1,PK(1),o[d0],0,0,0);
    o[d0]=__builtin_amdgcn_mfma_f32_32x32x16_bf16(pa2,PK(2),o[d0],0,0,0);
    o[d0]=__builtin_amdgcn_mfma_f32_32x32x16_bf16(pa3,PK(3),o[d0],0,0,0);
    #undef PK
  }
}

#ifndef ATTN_STORE16
#define ATTN_STORE16(p,v) (*(u32x4*)(p)=(v))
#endif
template<int THRL,bool WIN> __device__ __forceinline__ void attn_unit(const bf16*Qu,const bf16*__restrict__ Kh,const bf16*__restrict__ Vh,bf16*Ou,int NT,int shift,int qpos0,float sinkl2,char*shm,int tid){
  const int lane=tid&63,r32=lane&31,hi=lane>>5; const int wid=__builtin_amdgcn_readfirstlane(tid>>6);
  const bf16*Qw=Qu+(long)(wid*QBLK)*QP;
  const unsigned lds0=(unsigned)(uintptr_t)shm;
  float*wsf=(float*)(shm+LDS_WS)+wid*64;
  const bf16*ksrc=Kh+(long)lane*KP+wid*8;
  const bf16*vsrc=Vh+(long)(16*(wid&3)+(lane>>2))*KP+(wid>>2)*32+(lane&3)*8;
  const unsigned kdst=lds0+LDS_K+wid*1024, vdst=lds0+LDS_V+wid*1024;
  #define KROW(t) ((long)(((t)<4)?(t):((t)+shift))*(KVBLK*KP))
  #define DMA_K(t,slot) glds16(ksrc+KROW(t),(unsigned)__builtin_amdgcn_readfirstlane(kdst+(slot)))
  #define DMA_V(t,slot) glds16(vsrc+KROW(t),(unsigned)__builtin_amdgcn_readfirstlane(vdst+(slot)))
  const int vb0=(int)(lds0+LDS_V)+((lane>>4)&1)*32+(lane&3)*8+(4*hi+((lane&15)>>2))*64;
  const char*Kbase=shm+LDS_K; bf16x8 kf[8];
  const lds_cptr shm3=(lds_cptr)shm; const lds_cptr kp0=shm3+LDS_K+hi*1024+r32*16; const lds_cptr vp0=shm3+LDS_V+((lane>>4)&1)*32+(lane&3)*8+(4*hi+((lane&15)>>2))*64;
  DMA_K(0,0);DMA_V(0,0);DMA_K(1,SLOTB);
  bf16x8 qr[4];
  #pragma unroll
  for(int d0=0;d0<4;++d0)qr[d0]=*reinterpret_cast<const bf16x8*>(&Qw[(long)r32*QP+d0*16+hi*8]);
  float zf_=0.f;asm volatile("":"+v"(zf_)); float mhat=zf_,l_reg=zf_;f32x16 o[2];
  #pragma unroll
  for(int r=0;r<16;++r){o[0][r]=zf_;o[1][r]=zf_;}
  f32x16 negm;
  #pragma unroll
  for(int r=0;r<16;++r)negm[r]=zf_;
  asm volatile("":"+v"(negm));
  const int qrel=wid*QBLK+r32;
  const int mbase=4*hi-256-qpos0-qrel;
  #define CMASK(P0,P1,t) do{ if(WIN){ if((t)>=4) wmask(P0,P1,mbase+64*((t)+shift)); } }while(0)
  bool resc=false;
  #define START(P0,P1) do{ const float rm=rowmax(P0,P1); resc=false; \
    { const float dl=rm; mhat=fadd_s(mhat,dl); \
      _Pragma("unroll") for(int r=0;r<16;++r){P0[r]=fsub_s(P0[r],dl);P1[r]=fsub_s(P1[r],dl);} \
      _Pragma("unroll") for(int r=0;r<16;++r)negm[r]=-mhat; asm volatile("":"+v"(negm)); } \
    _Pragma("unroll") for(int r=0;r<16;++r)P0[r]=__builtin_amdgcn_exp2f(P0[r]); }while(0)
  #define RESC() do{ if(resc){ asm volatile("s_waitcnt lgkmcnt(0)":::"memory"); \
      _Pragma("unroll") for(int d_=0;d_<2;++d_) _Pragma("unroll") for(int r=0;r<16;++r)o[d_][r]*=wsf[crow(r,hi)]; } }while(0)
  f32x16 pA0,pA1,pB0,pB1;
  int sl_prev=0,sl_cur=0,sl_next=SLOTB;
  #define ROT() do{sl_prev=sl_cur;sl_cur=sl_next;sl_next=(sl_next==(NSLOT-1)*SLOTB)?0:sl_next+SLOTB;}while(0)
  DMA_K(2,2*SLOTB);
  WAIT_BAR(3);
  qkt(pA0,pA1,Kbase,qr,negm,r32,hi);asm volatile("s_nop 15\n\ts_nop 7":"+v"(pA0),"+v"(pA1));CMASK(pA0,pA1,0);
  START(pA0,pA1);
  _Pragma("unroll") for(int r=0;r<16;++r)pA1[r]=__builtin_amdgcn_exp2f(pA1[r]);
  WAIT_BAR(0);
  DMA_K(3,0);DMA_V(1,SLOTB);
  ROT();
  kload8(kf,kp0+sl_cur);
  WAIT_BAR(2);
  s16x4 vlo[8],vhi[8]; u32x4 pw0,pw1,pw2,pw3;
  #define PKW(P,B) cvtpk_s(P[B],P[B+1])
  #define PAF(k) __builtin_bit_cast(bf16x8,pw##k)
  #define VFR(i) (bf16x8){vlo[i][0],vlo[i][1],vlo[i][2],vlo[i][3],vhi[i][0],vhi[i][1],vhi[i][2],vhi[i][3]}
  #define PIN(x) asm volatile("":"+v"(x))
  #define MX3(a,b,c) __builtin_fmaxf(__builtin_fmaxf((a),(b)),(c))
  #define GAPA(MF,A0,A1,A2,A3,W0,W1,PW) do{ MF; sacc+=A0; sacc+=A1; sacc+=A2; sacc+=A3; PIN(sacc); W0; W1; PIN(PW); SBAR(); }while(0)
  #define EX(v) __builtin_amdgcn_exp2f(v)
  #define GAPB(MF,X,B) do{ MF; X[B]=EX(X[B]); X[B+1]=EX(X[B+1]); X[B+2]=EX(X[B+2]); X[B+3]=EX(X[B+3]); PIN(X); SBAR(); }while(0)
  #define VRD(i) do{ vlo[i]=vtr(vp_+(((i)>>2)*4096+((i)&3)*1024)); vhi[i]=vtr(vp_+(((i)>>2)*4096+((i)&3)*1024+512)); }while(0)
  #define KRD(G,j) do{ if(G){ kload2(kf,kp0+sl_next,j); SBAR(); } }while(0)
  #define STEP(C0,C1,P0,P1,t,GK,GV,GL) do{ SBAR(); \
    const lds_cptr vp_=vp0+sl_prev; \
    VRD(0); SBAR(); float sacc=(P0[0]+P0[1]); \
    GAPA(C0=__builtin_amdgcn_mfma_f32_32x32x16_bf16(kf[0],qr[0],negm,0,0,0), P0[2],P0[3],P0[4],P0[5],     pw0[0]=PKW(P0,0), pw0[1]=PKW(P0,2), pw0); \
    VRD(4); SBAR(); GAPA(C1=__builtin_amdgcn_mfma_f32_32x32x16_bf16(kf[1],qr[0],negm,0,0,0), P0[6],P0[7],P0[8],P0[9],     pw0[2]=PKW(P0,4), pw0[3]=PKW(P0,6), pw0); \
    VRD(1); SBAR(); GAPA(C0=__builtin_amdgcn_mfma_f32_32x32x16_bf16(kf[2],qr[1],C0,0,0,0),   P0[10],P0[11],P0[12],P0[13], pw1[0]=PKW(P0,8), pw1[1]=PKW(P0,10), pw1); \
    VRD(5); SBAR(); GAPA(C1=__builtin_amdgcn_mfma_f32_32x32x16_bf16(kf[3],qr[1],C1,0,0,0),   P0[14],P0[15],P1[0],P1[1],   pw1[2]=PKW(P0,12),pw1[3]=PKW(P0,14), pw1); \
    VRD(2); SBAR(); GAPA(C0=__builtin_amdgcn_mfma_f32_32x32x16_bf16(kf[4],qr[2],C0,0,0,0),   P1[2],P1[3],P1[4],P1[5],     pw2[0]=PKW(P1,0), pw2[1]=PKW(P1,2), pw2); \
    VRD(6); SBAR(); GAPA(C1=__builtin_amdgcn_mfma_f32_32x32x16_bf16(kf[5],qr[2],C1,0,0,0),   P1[6],P1[7],P1[8],P1[9],     pw2[2]=PKW(P1,4), pw2[3]=PKW(P1,6), pw2); \
    VRD(3); SBAR(); GAPA(C0=__builtin_amdgcn_mfma_f32_32x32x16_bf16(kf[6],qr[3],C0,0,0,0),   P1[10],P1[11],P1[12],P1[13], pw3[0]=PKW(P1,8), pw3[1]=PKW(P1,10), pw3); \
    VRD(7); SBAR(); GAPA(C1=__builtin_amdgcn_mfma_f32_32x32x16_bf16(kf[7],qr[3],C1,0,0,0),   P1[14],P1[15],0.f,0.f,       pw3[2]=PKW(P1,12),pw3[3]=PKW(P1,14), pw3); \
    l_reg+=sacc; \
    if(GK){DMA_K((t)+3,sl_cur);} if(GV){DMA_V((t)+1,sl_next);} \
    CMASK(C0,C1,t); \
    { float a=MX3(C0[0],C0[1],C1[0]),b=MX3(C0[2],C0[3],C1[1]); a=MX3(a,C1[2],C1[3]); \
      _Pragma("unroll") for(int r=4;r<16;r+=4){a=MX3(a,C0[r],C0[r+1]);b=MX3(b,C0[r+2],C0[r+3]);a=MX3(a,C1[r],C1[r+1]);b=MX3(b,C1[r+2],C1[r+3]);} \
      float rm=__builtin_fmaxf(a,b); { auto rr=__builtin_amdgcn_permlane32_swap(__float_as_uint(rm),__float_as_uint(rm),false,false); rm=__builtin_fmaxf(__uint_as_float(rr[0]),__uint_as_float(rr[1])); } \
      resc=false; \
      if(__builtin_expect(__any(rm>(float)THRL),0)){ const float dl=__builtin_fmaxf(rm,0.f); mhat+=dl; \
        _Pragma("unroll") for(int r=0;r<16;++r){C0[r]-=dl;C1[r]-=dl;} \
        _Pragma("unroll") for(int r=0;r<16;++r)negm[r]=-mhat; asm volatile("":"+v"(negm)); \
        const float f=__builtin_amdgcn_exp2f(-dl); l_reg*=f; if(hi==0)wsf[r32]=f; resc=true; } } \
    SBAR(); \
    GAPB(o[0]=__builtin_amdgcn_mfma_f32_32x32x16_bf16(PAF(0),VFR(0),o[0],0,0,0), C0,0); \
    GAPB(o[1]=__builtin_amdgcn_mfma_f32_32x32x16_bf16(PAF(0),VFR(4),o[1],0,0,0), C0,4); \
    KRD(GL,0); GAPB(o[0]=__builtin_amdgcn_mfma_f32_32x32x16_bf16(PAF(1),VFR(1),o[0],0,0,0), C0,8); \
    KRD(GL,1); GAPB(o[1]=__builtin_amdgcn_mfma_f32_32x32x16_bf16(PAF(1),VFR(5),o[1],0,0,0), C0,12); \
    KRD(GL,2); GAPB(o[0]=__builtin_amdgcn_mfma_f32_32x32x16_bf16(PAF(2),VFR(2),o[0],0,0,0), C1,0); \
    KRD(GL,3); GAPB(o[1]=__builtin_amdgcn_mfma_f32_32x32x16_bf16(PAF(2),VFR(6),o[1],0,0,0), C1,4); \
    GAPB(o[0]=__builtin_amdgcn_mfma_f32_32x32x16_bf16(PAF(3),VFR(3),o[0],0,0,0), C1,8); \
    GAPB(o[1]=__builtin_amdgcn_mfma_f32_32x32x16_bf16(PAF(3),VFR(7),o[1],0,0,0), C1,12); \
    }while(0)
  int t=1;
  for(;t+5<NT;t+=2){
    STEP(pB0,pB1,pA0,pA1,t,true,true,true);     WAIT_BAR(2); RESC(); ROT();
    STEP(pA0,pA1,pB0,pB1,t+1,true,true,true);   WAIT_BAR(2); RESC(); ROT();
  }
  #define ENDW(tt) do{ if((tt)+3<NT){WAIT_BAR(2);} else if((tt)+2<NT){WAIT_BAR(1);} else {WAIT_BAR(0);} }while(0)
  for(;t+1<NT;t+=2){
    STEP(pB0,pB1,pA0,pA1,t,(t+3<NT),(t+1<NT),(t+1<NT));       ENDW(t);   RESC(); ROT();
    STEP(pA0,pA1,pB0,pB1,t+1,(t+4<NT),(t+2<NT),(t+2<NT));     ENDW(t+1); RESC(); ROT();
  }
  STEP(pB0,pB1,pA0,pA1,NT-1,false,false,false); RESC();
  { float sacc=pB0[0]+pB0[1]; _Pragma("unroll") for(int r=2;r<16;++r)sacc+=pB0[r]; _Pragma("unroll") for(int r=0;r<16;++r)sacc+=pB1[r]; l_reg+=sacc;
    pw0=(u32x4){PKW(pB0,0),PKW(pB0,2),PKW(pB0,4),PKW(pB0,6)};pw1=(u32x4){PKW(pB0,8),PKW(pB0,10),PKW(pB0,12),PKW(pB0,14)};pw2=(u32x4){PKW(pB1,0),PKW(pB1,2),PKW(pB1,4),PKW(pB1,6)};pw3=(u32x4){PKW(pB1,8),PKW(pB1,10),PKW(pB1,12),PKW(pB1,14)};
    SBAR(); pv(o,vb0+sl_cur,PAF(0),PAF(1),PAF(2),PAF(3)); }
  #undef PKW
  #undef PAF
  #undef VFR
  #undef PIN
  #undef MX3
  #undef GAPA
  #undef GAPB
  #undef EX
  #undef VRD
  #undef KRD
  #undef STEP
  #undef ENDW
  {auto rr=__builtin_amdgcn_permlane32_swap(__float_as_uint(l_reg),__float_as_uint(l_reg),false,false);l_reg=__uint_as_float(rr[0])+__uint_as_float(rr[1]);}
  if(WIN)l_reg+=__builtin_amdgcn_exp2f(sinkl2-mhat);
  if(hi==0)wsf[32+r32]=l_reg;asm volatile("s_waitcnt lgkmcnt(0)":::"memory");
  float rli[16];
  #pragma unroll
  for(int r=0;r<16;++r)rli[r]=__builtin_amdgcn_rcpf(wsf[32+crow(r,hi)]);
  bf16*Ow=Ou+(long)(wid*QBLK)*OP;
  { bf16*stg=(bf16*)(shm+LDS_OST)+wid*2048;
    #pragma unroll
    for(int r=0;r<16;++r){const int orow=crow(r,hi);
      #pragma unroll
      for(int d0=0;d0<2;++d0)stg[orow*64+d0*32+r32]=__float2bfloat16(o[d0][r]*rli[r]);}
    asm volatile("s_waitcnt lgkmcnt(0)":::"memory");
    #pragma unroll
    for(int i=0;i<4;++i){const int row=i*8+(lane>>3),ch=lane&7; const u32x4 v=*(const u32x4*)(stg+row*64+ch*8); ATTN_STORE16(Ow+(long)row*OP+ch*8,v);} }
  asm volatile("s_waitcnt lgkmcnt(0)\n\ts_barrier":::"memory");
  #undef DMA_K
  #undef KROW
  #undef DMA_V
  #undef CMASK
  #undef START
  #undef RESC
  #undef ROT
}
constexpr int ATTN_LDS_BYTES=LDS_BYTES;
#undef SBAR
#undef WAIT_BAR
}
constexpr int NWAVES = 8;
constexpr int DM = 1024, NBATCH = 2, SEQ = 16384, CTXL = 256, TOK = SEQ + CTXL  , MR = NBATCH * TOK  ;
constexpr int DFF = 2816, NSUBMOD = 9216, DEPTH = 2;
constexpr float EPS = 1e-6f, LOG2E = 1.4426950408889634f;
constexpr int S5L = 32, S5ROWS = 1280  , S5CH = MR / S5L  , S5K = 768;

typedef unsigned short bf16;
typedef unsigned v4u __attribute__((ext_vector_type(4)));
typedef float f32x4 __attribute__((ext_vector_type(4)));
#define LAS __attribute__((address_space(3)))
#define LDS_WAIT() asm volatile("s_waitcnt lgkmcnt(0)" ::: "memory")
__device__ __forceinline__ unsigned f2bf(float f) { unsigned u = __builtin_bit_cast(unsigned, f); return (u + 0x7fffu + ((u >> 16) & 1u)) >> 16; }
__device__ __forceinline__ unsigned pk2(float lo, float hi) { return f2bf(lo) | (f2bf(hi) << 16); }
__device__ __forceinline__ float bf2f(unsigned short h) { return __builtin_bit_cast(float, (unsigned)h << 16); }
__device__ __forceinline__ float sigm(float x) { return __builtin_amdgcn_rcpf(1.0f + __builtin_amdgcn_exp2f(-x * LOG2E)); }

constexpr size_t MiB = 1u << 20;
constexpr size_t WS_MOD = 1 * MiB, WS_XC = 2 * MiB;
constexpr size_t WS_W1T = 4 * MiB, WS_W2T = 26 * MiB, WS_WINT = 37 * MiB, WS_WBT = 48 * MiB, WS_WOT = 50 * MiB, WS_WGT = 52 * MiB, WS_WPT = 52 * MiB + 256 * 1024;
constexpr size_t WS_BTY = 53 * MiB, WS_BTE = 65 * MiB, WS_E = 71 * MiB, WS_A2 = 91 * MiB, WS_HN = 121 * MiB, WS_T = 186 * MiB;
constexpr size_t WS_R = 251 * MiB;
constexpr size_t WS_HID = WS_R, WS_GS = WS_R, WS_Q = WS_R + 65 * MiB, WS_K = WS_Q + 65 * MiB / 2, WS_V = WS_K + 65 * MiB / 4, WS_XA = WS_V + 65 * MiB / 4, WS_G = WS_XA + 65 * MiB / 4,
                 WS_DIFF = WS_G + 65 * MiB / 4, WS_Y4 = WS_DIFF + 65 * MiB / 4, WS_END = WS_Y4 + 65 * MiB;
static_assert(WS_END <= 512 * MiB && WS_HID + (size_t)MR * DFF * 2 <= WS_Y4 + 65 * MiB, "ws map");
constexpr int RING_BYTES = 131072, LDS_BYTES = 147456;

struct Args { const float* in[26]; float* out; unsigned char* ws; int ph_lo, ph_hi; };
struct Frame { LAS unsigned char* lds; int lane, wave, vcu, G; };
typedef const volatile __attribute__((address_space(4))) unsigned long long karg_t;
__device__ __forceinline__ unsigned long long karg(int i) { return ((karg_t*)__builtin_amdgcn_kernarg_segment_ptr())[i]; }
#define AIN(i) ((const float*)karg(i))
#define AOUT ((float*)karg(26))
#define AWS ((unsigned char*)karg(27))
#define WSP(T, off) ((T*)(AWS + (off)))

__device__ __forceinline__ float* xrow_ptr(float* lat, float* ctxp, int r) { const int b = r / TOK, i = r - b * TOK; return i < CTXL ? ctxp + (size_t)(b * CTXL + i) * DM : lat + (size_t)(b * SEQ + i - CTXL) * DM; }

using pg8::f32x4; using pg8::Unit; using pg8::bf16_t; using pg8::cvt_pk_bf16; using pg8::u32x4;
#define EPI_ARGS const pg8::f32x4 (&acc)[2][2][4][2], const pg8::Unit& u, int wr, int wc, int fr_, int fq_
#define EPI_PIN int fr = fr_, fq = fq_; asm volatile("" : "+v"(fr), "+v"(fq));
struct EpiSwiglu { static constexpr bool PERM = true, AFTER_DRAIN = false; bf16_t* H;
    __device__ __forceinline__ void operator()(EPI_ARGS) const { EPI_PIN
        const int row0 = u.pm * 256 + wr * 64 + fr, hc = u.pn * 128 + wc * 32 + 8 * fq;
#pragma unroll
        for (int ai = 0; ai < 2; ++ai)
#pragma unroll
            for (int m = 0; m < 4; ++m) { bf16_t* rowp = H + (size_t)(row0 + ai * 128 + m * 16) * DFF + hc; float v[8];
#pragma unroll
                for (int n = 0; n < 2; ++n)
#pragma unroll
                    for (int j = 0; j < 4; ++j) { const float g = acc[ai][0][m][n][j], up = acc[ai][1][m][n][j]; v[n * 4 + j] = g * sigm(g) * up; }
                u32x4 w; w.x = cvt_pk_bf16(v[0], v[1]); w.y = cvt_pk_bf16(v[2], v[3]); w.z = cvt_pk_bf16(v[4], v[5]); w.w = cvt_pk_bf16(v[6], v[7]); *(u32x4*)rowp = w; }
    }
};
struct EpiResid { static constexpr bool PERM = true, AFTER_DRAIN = false; const float* src_lat; const float* src_ctx; float* dst_lat; float* dst_ctx; const float* gate; float sc;
    __device__ __forceinline__ void operator()(EPI_ARGS) const { EPI_PIN
        const int b = u.pm / 65, tq = u.pm - b * 65; const bool isc = tq == 0;
        const size_t off = isc ? (size_t)b * CTXL * DM : ((size_t)b * SEQ + (size_t)(tq - 1) * 256) * DM;
        const float* sp = (isc ? src_ctx : src_lat) + off; float* dp = (isc ? dst_ctx : dst_lat) + off;
        const float* gp = gate + (isc ? 2 : b) * NSUBMOD; const int col0 = u.pn * 256 + wc * 32 + 8 * fq;
        f32x4 gv[2][2];
#pragma unroll
        for (int bj = 0; bj < 2; ++bj)
#pragma unroll
            for (int n = 0; n < 2; ++n) gv[bj][n] = *(const f32x4*)(gp + col0 + bj * 128 + 4 * n) * sc;
#pragma unroll
        for (int ai = 0; ai < 2; ++ai)
#pragma unroll
            for (int m = 0; m < 4; ++m) { const size_t ro = (size_t)(ai * 128 + wr * 64 + m * 16 + fr) * DM + col0;
#pragma unroll
                for (int bj = 0; bj < 2; ++bj)
#pragma unroll
                    for (int n = 0; n < 2; ++n) { const f32x4 xv = *(const f32x4*)(sp + ro + bj * 128 + 4 * n); *(f32x4*)(dp + ro + bj * 128 + 4 * n) = xv + gv[bj][n] * acc[ai][bj][m][n]; } }
    }
};
__device__ __forceinline__ u32x4 pack8(const f32x4& a, const f32x4& b) { u32x4 w; w.x = cvt_pk_bf16(a[0], a[1]); w.y = cvt_pk_bf16(a[2], a[3]); w.z = cvt_pk_bf16(b[0], b[1]); w.w = cvt_pk_bf16(b[2], b[3]); return w; }
struct EpiRoute { static constexpr bool PERM = true, AFTER_DRAIN = false; bf16_t *Q, *K, *V, *A2, *XA;
    __device__ __forceinline__ void operator()(EPI_ARGS) const { EPI_PIN
        const int row0 = u.pm * 256 + wr * 64 + fr, cl = wc * 32 + 8 * fq;
        bf16_t* base; int ldc, coff = 0;
        if (u.pn == 0) { base = Q; ldc = 512; } else if (u.pn == 1) { base = Q; ldc = 512; coff = 256; } else if (u.pn == 2) { base = K; ldc = 256; } else if (u.pn == 3) { base = V; ldc = 256; } else { base = XA; ldc = 256; }
#pragma unroll
        for (int ai = 0; ai < 2; ++ai)
#pragma unroll
            for (int m = 0; m < 4; ++m) { const int row = row0 + ai * 128 + m * 16;
#pragma unroll
                for (int bj = 0; bj < 2; ++bj) { const u32x4 w = pack8(acc[ai][bj][m][0], acc[ai][bj][m][1]); const int c = bj * 128 + cl;
                    if (u.pn == 4) { const int g = c >> 4, h0 = c & 15; *(u32x4*)(A2 + ((size_t)g * S5ROWS + (row >> 5)) * S5K + (row & 31) * 16 + h0) = w; }
                    else *(u32x4*)(base + (size_t)row * ldc + coff + c) = w; } }
    }
};
struct EpiGate { static constexpr bool PERM = true, AFTER_DRAIN = false; bf16_t* GS;
    __device__ __forceinline__ void operator()(EPI_ARGS) const { EPI_PIN
        const int row0 = u.pm * 256 + wr * 64 + fr, col0 = u.pn * 256 + wc * 32 + 8 * fq;
#pragma unroll
        for (int ai = 0; ai < 2; ++ai)
#pragma unroll
            for (int m = 0; m < 4; ++m)
#pragma unroll
                for (int bj = 0; bj < 2; ++bj) { f32x4 a = acc[ai][bj][m][0], b = acc[ai][bj][m][1];
#pragma unroll
                    for (int j = 0; j < 4; ++j) { a[j] = sigm(a[j]); b[j] = sigm(b[j]); }
                    *(u32x4*)(GS + (size_t)(row0 + ai * 128 + m * 16) * DM + col0 + bj * 128) = pack8(a, b); }
    }
};
template <bool FIRST> struct EpiMerge { static constexpr bool PERM = true, AFTER_DRAIN = false; const bf16_t* GS; bf16_t* T;
    __device__ __forceinline__ void operator()(EPI_ARGS) const { EPI_PIN
        const int row0 = u.pm * 256 + wr * 64 + fr, col0 = u.pn * 256 + wc * 32 + 8 * fq;
#pragma unroll
        for (int ai = 0; ai < 2; ++ai)
#pragma unroll
            for (int m = 0; m < 4; ++m)
#pragma unroll
                for (int bj = 0; bj < 2; ++bj) { const size_t o = (size_t)(row0 + ai * 128 + m * 16) * DM + col0 + bj * 128;
                    const u32x4 g = *(const u32x4*)(GS + o); u32x4 t = {0u, 0u, 0u, 0u}; if (!FIRST) t = *(const u32x4*)(T + o);
                    f32x4 a = acc[ai][bj][m][0], b = acc[ai][bj][m][1];
#pragma unroll
                    for (int q = 0; q < 2; ++q) { const unsigned gw = g[q], tw = t[q], gw2 = g[q + 2], tw2 = t[q + 2];
                        a[2 * q] = __builtin_bit_cast(float, tw << 16) + (__builtin_bit_cast(float, gw << 16)) * a[2 * q]; a[2 * q + 1] = __builtin_bit_cast(float, tw & 0xffff0000u) + (__builtin_bit_cast(float, gw & 0xffff0000u)) * a[2 * q + 1];
                        b[2 * q] = __builtin_bit_cast(float, tw2 << 16) + (__builtin_bit_cast(float, gw2 << 16)) * b[2 * q]; b[2 * q + 1] = __builtin_bit_cast(float, tw2 & 0xffff0000u) + (__builtin_bit_cast(float, gw2 & 0xffff0000u)) * b[2 * q + 1]; }
                    *(u32x4*)(T + o) = pack8(a, b); }
    }
};
struct EpiPlain { static constexpr bool PERM = true, AFTER_DRAIN = false; bf16_t* O; int ldc;
    __device__ __forceinline__ void operator()(EPI_ARGS) const { EPI_PIN
        const int row0 = u.pm * 256 + wr * 64 + fr, col0 = u.pn * 256 + wc * 32 + 8 * fq;
#pragma unroll
        for (int ai = 0; ai < 2; ++ai)
#pragma unroll
            for (int m = 0; m < 4; ++m)
#pragma unroll
                for (int bj = 0; bj < 2; ++bj) *(u32x4*)(O + (size_t)(row0 + ai * 128 + m * 16) * ldc + col0 + bj * 128) = pack8(acc[ai][bj][m][0], acc[ai][bj][m][1]);
    }
};
struct EpiGlu { static constexpr bool PERM = true, AFTER_DRAIN = false; bf16_t* O;
    __device__ __forceinline__ void operator()(EPI_ARGS) const { EPI_PIN
        const int row0 = u.pm * 256 + wr * 64 + fr, col0 = u.pn * 128 + wc * 32 + 8 * fq;
#pragma unroll
        for (int ai = 0; ai < 2; ++ai)
#pragma unroll
            for (int m = 0; m < 4; ++m) { f32x4 a = acc[ai][0][m][0], b = acc[ai][0][m][1]; const f32x4 ga = acc[ai][1][m][0], gb = acc[ai][1][m][1];
#pragma unroll
                for (int j = 0; j < 4; ++j) { a[j] *= sigm(ga[j]); b[j] *= sigm(gb[j]); }
                *(u32x4*)(O + (size_t)(row0 + ai * 128 + m * 16) * 256 + col0) = pack8(a, b); }
    }
};
struct EpiF32 { static constexpr bool PERM = true, AFTER_DRAIN = false; float* O;
    __device__ __forceinline__ void operator()(EPI_ARGS) const { EPI_PIN
        const int row0 = u.pm * 256 + wr * 64 + fr, col0 = wc * 32 + 8 * fq;
#pragma unroll
        for (int ai = 0; ai < 2; ++ai)
#pragma unroll
            for (int m = 0; m < 4; ++m)
#pragma unroll
                for (int bj = 0; bj < 2; ++bj)
#pragma unroll
                    for (int n = 0; n < 2; ++n) *(f32x4*)(O + (size_t)(row0 + ai * 128 + m * 16) * 256 + col0 + bj * 128 + 4 * n) = acc[ai][bj][m][n];
    }
};
__device__ __forceinline__ float gelu_tanh(float x) { const float y = 0.7978845608028654f * (x + 0.044715f * x * x * x); return x * sigm(2.0f * y); }
struct EpiS5Y { static constexpr bool PERM = true, AFTER_DRAIN = false; bf16_t* Gb;
    __device__ __forceinline__ void operator()(EPI_ARGS) const { EPI_PIN
        const int g = u.pm / 5, i = u.pm - 5 * g, jn = u.pn & 1;
#pragma unroll
        for (int ai = 0; ai < 2; ++ai)
#pragma unroll
            for (int m = 0; m < 4; ++m) { const int cidx = i * 256 + ai * 128 + wr * 64 + m * 16 + fr;
                if (cidx < S5CH) {
#pragma unroll
                    for (int bj = 0; bj < 2; ++bj) { const int c = jn * 256 + bj * 128 + wc * 32 + 8 * fq, jo = c >> 4, h0 = c & 15; f32x4 a = acc[ai][bj][m][0], b = acc[ai][bj][m][1];
#pragma unroll
                        for (int j = 0; j < 4; ++j) { a[j] = gelu_tanh(a[j]); b[j] = gelu_tanh(b[j]); }
                        *(u32x4*)(Gb + (size_t)(cidx * S5L + jo) * 256 + g * 16 + h0) = pack8(a, b); } } }
    }
};
struct RowOrder { pg8::StaticOrder so; bool skip;
    __device__ void init(int N, int G, int c, bool skip_) { skip = skip_; so.init(skip_ ? NBATCH * SEQ : MR, N, G, c); }
    __device__ bool next(int i, Unit& u) const { if (!so.next(i, u)) return false; if (skip) u.pm = u.pm + 1 + (u.pm >> 6); return true; }
    __device__ __forceinline__ void a_ready(const Unit&) const {}
    __device__ __forceinline__ void done(const Unit&) const {}
};
struct CtxSliceOrder { int nsl, G, c;
    __device__ bool next(int i, Unit& u) const { const int L = i * G + c; if (L >= 8 * nsl) return false; const int t = L / nsl, sl = L - t * nsl; u.pm = (t >> 2) ? 65 : 0; u.pn = t & 3; u.k0 = sl * 256; return true; }
    __device__ __forceinline__ void a_ready(const Unit&) const {}
    __device__ __forceinline__ void done(const Unit&) const {}
};
struct EpiPart { static constexpr bool PERM = true, AFTER_DRAIN = false; float* P;
    __device__ __forceinline__ void operator()(EPI_ARGS) const { EPI_PIN
        const int sl = u.k0 >> 8, bb = u.pm ? 1 : 0; float* base = P + ((size_t)(sl * 2 + bb) * 256 + wr * 64 + fr) * DM + u.pn * 256 + wc * 32 + 8 * fq;
#pragma unroll
        for (int ai = 0; ai < 2; ++ai)
#pragma unroll
            for (int m = 0; m < 4; ++m)
#pragma unroll
                for (int bj = 0; bj < 2; ++bj)
#pragma unroll
                    for (int n = 0; n < 2; ++n) *(f32x4*)(base + (size_t)(ai * 128 + m * 16) * DM + bj * 128 + 4 * n) = acc[ai][bj][m][n];
    }
};
struct S5Order { int ncol, G, c;
    __device__ bool next(int i, Unit& u) const { const int L = i * G + c; if (L >= 80 * ncol) return false; const int g = L / (5 * ncol), rem = L - g * 5 * ncol; u.pm = g * 5 + rem / ncol; u.pn = g * ncol + rem % ncol; u.k0 = 0; return true; }
    __device__ __forceinline__ void a_ready(const Unit&) const {}
    __device__ __forceinline__ void done(const Unit&) const {}
};
__device__ __forceinline__ float shx(float v, int o, int lane) { return __builtin_bit_cast(float, __builtin_amdgcn_ds_bpermute((lane ^ o) << 2, __builtin_bit_cast(int, v))); }
__device__ __forceinline__ float wave_sum(float v, int lane) {
#pragma unroll
    for (int o = 1; o < 64; o <<= 1) v += shx(v, o, lane);
    return v;
}
__device__ __forceinline__ void tr_item(const float* W, int K, int ldw, int src_c0, bf16* WT, int dst_r0, int k0, LAS float* scr, int lane) {
    float tv[32];
#pragma unroll
    for (int i = 0; i < 32; ++i) { const int kk = 2 * i + (lane >> 5); tv[i] = W[(size_t)(k0 + kk) * ldw + src_c0 + (lane & 31)]; }
#pragma unroll
    for (int i = 0; i < 32; ++i) { const int kk = 2 * i + (lane >> 5); scr[kk * 33 + (lane & 31)] = tv[i]; }
    LDS_WAIT(); asm volatile("" ::: "memory");
    const int c = lane & 7;
#pragma unroll
    for (int j = 0; j < 4; ++j) { const int n = (lane >> 3) + 8 * j; const LAS float* s = scr + (8 * c) * 33 + n;
        v4u o; o.x = pk2(s[0 * 33], s[1 * 33]); o.y = pk2(s[2 * 33], s[3 * 33]); o.z = pk2(s[4 * 33], s[5 * 33]); o.w = pk2(s[6 * 33], s[7 * 33]);
        *(v4u*)(WT + (size_t)(dst_r0 + n) * K + k0 + 8 * c) = o; }
    LDS_WAIT(); asm volatile("" ::: "memory");
}
constexpr int CONV_ITEMS = 2 * 2816 + 2 * 1408 + 2816 + 4 * 128 + 512 + 64;
__device__ __forceinline__ void conv_item(Frame& F, int l, int it, LAS float* scr) {
    int r = it; const int lane = F.lane;
    if (r < 5632) { const int f = r / 2816; r -= f * 2816; const int kb = r / 176, n0 = (r % 176) * 32, pn = n0 >> 8, bj = (n0 >> 7) & 1, q = n0 & 127;
        tr_item(AIN(7) + (size_t)(l * 2 + f) * DM * 5632, DM, 5632, bj * DFF + 128 * pn + q, WSP(bf16, WS_W1T) + (size_t)f * 5632 * DM, n0, kb * 64, scr, lane); return; } r -= 5632;
    if (r < 2816) { const int f = r / 1408; r -= f * 1408; const int kb = r / 32, n0 = (r % 32) * 32;
        tr_item(AIN(8) + (size_t)(l * 2 + f) * DFF * DM, DFF, DM, n0, WSP(bf16, WS_W2T) + (size_t)f * DM * DFF, n0, kb * 64, scr, lane); return; } r -= 2816;
    if (r < 2816) { const int kb = r / 176, n0 = (r % 176) * 32; int src;
        if (n0 >= 1536) src = n0; else { const int t = n0 >> 8, off = n0 & 255;
            src = t == 0 ? 768 + off : t == 1 ? 1024 + off : t == 2 ? (off < 128 ? off : 512 + off - 128) : t == 3 ? (off < 128 ? 128 + off : 640 + off - 128) : t == 4 ? 256 + off : 1280 + off; }
        tr_item(AIN(9) + (size_t)l * DM * 5632, DM, 5632, src, WSP(bf16, WS_WINT), n0, kb * 64, scr, lane); return; } r -= 2816;
    if (r < 512) { const int k = r / 128; r -= k * 128; const int kb = r / 32, n0 = (r % 32) * 32;
        tr_item(AIN(23) + (size_t)(l * 4 + k) * 256 * DM, 256, DM, n0, WSP(bf16, WS_WBT) + (size_t)k * DM * 256, n0, kb * 64, scr, lane); return; } r -= 512;
    if (r < 512) { const int kb = r / 32, n0 = (r % 32) * 32;
        tr_item(AIN(24) + (size_t)l * DM * DM, DM, DM, n0, WSP(bf16, WS_WOT), n0, kb * 64, scr, lane); return; } r -= 512;
    { const int kb = r / 16, n0 = (r % 16) * 32, pn = n0 >> 8, bj = (n0 >> 7) & 1, q = n0 & 127;
        tr_item(AIN(22) + (size_t)l * 256 * 512, 256, 512, bj * 256 + 128 * pn + q, WSP(bf16, WS_WGT), n0, kb * 64, scr, lane); }
}
__device__ __forceinline__ void s5_table_item(Frame& F, int l, int item4, LAS float* scr) {
    const int item = item4 >> 2, qt = item4 & 3; const int g = item >> 5, j = item & 31, lane = F.lane, p = lane;
    bf16* BtY = WSP(bf16, WS_BTY) + (size_t)g * 512 * S5K; bf16* BtE = WSP(bf16, WS_BTE) + (size_t)g * 256 * S5K;
    float lre[2], lim[2], cfr[2], cfi[2], are[2], aim[2], dtv[2];
#pragma unroll
    for (int d = 0; d < 2; ++d) { const int ix = ((l * 2 + d) * 16 + g) * 64 + p; are[d] = AIN(14)[ix]; aim[d] = AIN(15)[ix]; dtv[d] = expf(AIN(16)[(l * 2 + d) * 16 + g]);
        const float mg = expf(are[d] * dtv[d]); float sn, cs; sincosf(aim[d] * dtv[d], &sn, &cs); const float br = mg * cs - 1.0f, bi = mg * sn; const float den = 1.0f / (are[d] * are[d] + aim[d] * aim[d]);
        cfr[d] = (br * are[d] + bi * aim[d]) * den; cfi[d] = (bi * are[d] - br * aim[d]) * den; }
#define LAMPOW(d, e, outr, outi) do { const float mg_ = expf(are[d] * dtv[d] * (float)(e)); float sn_, cs_; sincosf(aim[d] * dtv[d] * (float)(e), &sn_, &cs_); outr = mg_ * cs_; outi = mg_ * sn_; } while (0)
#pragma unroll
    for (int d = 0; d < 2; ++d) { float pr, pi; LAMPOW(d, j, pr, pi); scr[(d * 64 + p) * 2] = pr * cfr[d] - pi * cfi[d]; scr[(d * 64 + p) * 2 + 1] = pr * cfi[d] + pi * cfr[d]; }
    LDS_WAIT(); asm volatile("" ::: "memory");
    const int hi_ = lane & 15;
    { const int i2 = qt; const int ho = (lane >> 4) + 4 * i2; float kv[2];
#pragma unroll
        for (int d = 0; d < 2; ++d) { const float* cr = AIN(19) + (((size_t)(l * 2 + d) * 16 + g) * 16 + ho) * 64; const float* ci = AIN(20) + (((size_t)(l * 2 + d) * 16 + g) * 16 + ho) * 64;
            const float* br = AIN(17) + ((size_t)(l * 2 + d) * 16 + g) * 64 * 16 + hi_; const float* bi = AIN(18) + ((size_t)(l * 2 + d) * 16 + g) * 64 * 16 + hi_; float s = 0.f;
#pragma unroll 16
            for (int pp = 0; pp < 64; ++pp) { const float zr = scr[(d * 64 + pp) * 2], zi = scr[(d * 64 + pp) * 2 + 1], b_r = br[pp * 16], b_i = bi[pp * 16];
                const float wr_ = zr * b_r - zi * b_i, wi_ = zr * b_i + zi * b_r; s += cr[pp] * wr_ - ci[pp] * wi_; }
            kv[d] = s; }
        if (j == 0) { const float v = kv[0] + kv[1] + (ho == hi_ ? AIN(21)[l * 256 + g * 16 + ho] : 0.f);
            for (int q = 0; q < 32; ++q) BtY[(size_t)(q * 16 + ho) * S5K + q * 16 + hi_] = (bf16)f2bf(v); }
        else { const bf16 vf = (bf16)f2bf(kv[0]), vb = (bf16)f2bf(kv[1]);
            for (int q = 0; q + j < 32; ++q) { BtY[(size_t)((q + j) * 16 + ho) * S5K + q * 16 + hi_] = vf; BtY[(size_t)(q * 16 + ho) * S5K + (q + j) * 16 + hi_] = vb; } }
    }
    { const int d = qt >> 1; float pr, pi; LAMPOW(d, (d == 0 ? j + 1 : S5L - j), pr, pi);
#pragma unroll
        for (int ho = (qt & 1) * 8; ho < (qt & 1) * 8 + 8; ++ho) { const size_t ci_ = (((size_t)(l * 2 + d) * 16 + g) * 16 + ho) * 64 + p; const float c_r = AIN(19)[ci_], c_i = AIN(20)[ci_];
            bf16* row = BtY + (size_t)(j * 16 + ho) * S5K + 512 + d * 128; row[p] = (bf16)f2bf(c_r * pr - c_i * pi); row[64 + p] = (bf16)f2bf(-(c_r * pi + c_i * pr)); } }
    { const int d = qt >> 1, hh0 = (qt & 1) * 8; float pr, pi; LAMPOW(d, (d == 0 ? S5L - 1 - j : j), pr, pi); const float zr = pr * cfr[d] - pi * cfi[d], zi = pr * cfi[d] + pi * cfr[d];
        const size_t bi_ = (((size_t)(l * 2 + d) * 16 + g) * 64 + p) * 16 + hh0; unsigned wre[4], wim[4];
#pragma unroll
        for (int h4 = 0; h4 < 2; ++h4) { const f32x4 b_r = *(const f32x4*)(AIN(17) + bi_ + 4 * h4), b_i = *(const f32x4*)(AIN(18) + bi_ + 4 * h4);
            wre[2 * h4] = pk2(zr * b_r.x - zi * b_i.x, zr * b_r.y - zi * b_i.y); wre[2 * h4 + 1] = pk2(zr * b_r.z - zi * b_i.z, zr * b_r.w - zi * b_i.w);
            wim[2 * h4] = pk2(zr * b_i.x + zi * b_r.x, zr * b_i.y + zi * b_r.y); wim[2 * h4 + 1] = pk2(zr * b_i.z + zi * b_r.z, zr * b_i.w + zi * b_r.w); }
        *(v4u*)(BtE + (size_t)(d * 128 + p) * S5K + j * 16 + hh0) = (v4u){wre[0], wre[1], wre[2], wre[3]};
        *(v4u*)(BtE + (size_t)(d * 128 + 64 + p) * S5K + j * 16 + hh0) = (v4u){wim[0], wim[1], wim[2], wim[3]}; }
    for (int q = lane; q < 2 * 256; q += 64) BtE[(size_t)(8 * j + 2 * qt + (q >> 8)) * S5K + 512 + (q & 255)] = 0;
#undef LAMPOW
    LDS_WAIT(); asm volatile("" ::: "memory");
}
__device__ __forceinline__ void prep_layer(Frame& F, int l) {
    LAS float* scr = (LAS float*)(F.lds + F.wave * 16384);
    const int gw = F.vcu * NWAVES + F.wave, NGW = F.G * NWAVES;
    for (int it = gw; it < CONV_ITEMS; it += NGW) conv_item(F, l, it, scr);
    for (int it = NGW - 1 - gw; it < 2048; it += NGW) s5_table_item(F, l, it, scr);
    const int gt = gw * 64 + F.lane, NGT = NGW * 64;
    { bf16* Wp = WSP(bf16, WS_WPT); const float* pw = AIN(12) + (size_t)l * 4 * 64 * 64; const float* ps = AIN(13) + l * 256;
      for (int e = gt; e < 65536; e += NGT) { const int n = e >> 8, k = e & 255; Wp[e] = (bf16)(((n >> 6) == (k >> 6)) ? f2bf(pw[((n >> 6) * 64 + (k & 63)) * 64 + (n & 63)] * ps[n]) : 0u); } }
    { bf16* A2 = WSP(bf16, WS_A2); unsigned z_ = 0u; asm volatile("" : "+v"(z_)); for (int e = gt; e < 16 * S5ROWS * 32; e += NGT) { const int row = e >> 5, c8 = e & 31; *(v4u*)(A2 + (size_t)row * S5K + 512 + c8 * 8) = (v4u){z_, z_, z_, z_}; } }
}
__device__ __forceinline__ void mod_phase(Frame& F) {
    LAS float* red = (LAS float*)F.lds;
    for (int it = F.vcu; it < DEPTH * (NSUBMOD / 64); it += F.G) { const int l = it / (NSUBMOD / 64), n = (it % (NSUBMOD / 64)) * 64 + F.lane;
        const float* w = AIN(4) + ((size_t)l * DM + F.wave * 128) * NSUBMOD + n; float a0 = 0.f, a1 = 0.f, a2 = 0.f;
#pragma unroll 16
        for (int k = 0; k < 128; ++k) { const int kk = F.wave * 128 + k; const float c0 = AIN(1)[kk], c1 = AIN(1)[DM + kk], c2 = AIN(3)[kk]; const float wv = w[(size_t)k * NSUBMOD];
            a0 += c0 * sigm(c0) * wv; a1 += c1 * sigm(c1) * wv; a2 += c2 * sigm(c2) * wv; }
        red[(F.wave * 3 + 0) * 64 + F.lane] = a0; red[(F.wave * 3 + 1) * 64 + F.lane] = a1; red[(F.wave * 3 + 2) * 64 + F.lane] = a2;
        __syncthreads();
        if (F.wave < 3) { float s = AIN(5)[l * NSUBMOD + n];
#pragma unroll
            for (int w8 = 0; w8 < 8; ++w8) s += red[(w8 * 3 + F.wave) * 64 + F.lane];
            WSP(float, WS_MOD)[((size_t)l * 3 + F.wave) * NSUBMOD + n] = s; }
        __syncthreads();
    }
}
__device__ __forceinline__ void norm_phase(Frame& F, int l, int sub, const float* lat, const float* ctxp, const float* part = nullptr, int nsl = 0, const float* pgate = nullptr, float psc = 0.f, const float* psrc = nullptr, float* pdst = nullptr) {
    const int gw = F.vcu * NWAVES + F.wave, NGW = F.G * NWAVES; const float* gptr = AIN(6) + (size_t)(l * 3 + sub) * DM; bf16* HN = WSP(bf16, WS_HN);
    for (int r0 = gw; r0 < MR; r0 += 2 * NGW) { f32x4 v[2][4]; float s[2]; const float* mod[2]; int rr[2];
#pragma unroll
        for (int q2 = 0; q2 < 2; ++q2) { int r = r0 + q2 * NGW; if (r >= MR) r = r0; rr[q2] = r; const int b = r / TOK, i = r - b * TOK;
            const float* xr = i < CTXL ? ctxp + (size_t)(b * CTXL + i) * DM : lat + (size_t)(b * SEQ + i - CTXL) * DM;
            mod[q2] = WSP(float, WS_MOD) + ((size_t)l * 3 + (i < CTXL ? 2 : b)) * NSUBMOD + sub * 3072; s[q2] = 0.f;
            if (part != nullptr && i < CTXL) { const size_t ro = (size_t)(b * CTXL + i) * DM;
#pragma unroll
                for (int j = 0; j < 4; ++j) { f32x4 a = {0.f, 0.f, 0.f, 0.f};
                    for (int sl = 0; sl < nsl; ++sl) a += *((const f32x4*)(part + (size_t)sl * 2 * CTXL * DM + ro) + F.lane + 64 * j);
                    const f32x4 o = *((const f32x4*)(psrc + ro) + F.lane + 64 * j) + (*((const f32x4*)pgate + F.lane + 64 * j) * psc) * a;
                    if (q2 == 0 || r != r0) *((f32x4*)(pdst + ro) + F.lane + 64 * j) = o; v[q2][j] = o; } }
            else {
#pragma unroll
                for (int j = 0; j < 4; ++j) v[q2][j] = *((const f32x4*)xr + F.lane + 64 * j); } }
#pragma unroll
        for (int q2 = 0; q2 < 2; ++q2) {
#pragma unroll
            for (int j = 0; j < 4; ++j) s[q2] += (v[q2][j].x * v[q2][j].x + v[q2][j].y * v[q2][j].y) + (v[q2][j].z * v[q2][j].z + v[q2][j].w * v[q2][j].w);
            const float rstd = 1.0f / sqrtf(wave_sum(s[q2], F.lane) * (1.0f / DM) + EPS);
            if (q2 == 0 || rr[1] != rr[0]) {
#pragma unroll
                for (int j = 0; j < 4; ++j) { const f32x4 gg = *((const f32x4*)gptr + F.lane + 64 * j), sh = *((const f32x4*)mod[q2] + F.lane + 64 * j), sc = *((const f32x4*)(mod[q2] + DM) + F.lane + 64 * j);
                    const f32x4 o = (v[q2][j] * rstd * gg) * (sc + 1.0f) + sh;
                    *((unsigned long long*)(HN + (size_t)rr[q2] * DM) + F.lane + 64 * j) = (unsigned long long)pk2(o.x, o.y) | ((unsigned long long)pk2(o.z, o.w) << 32); } } }
    }
}
__device__ __forceinline__ void final_norm_phase(Frame& F) {
    const int gw = F.vcu * NWAVES + F.wave, NGW = F.G * NWAVES; const float* gptr = AIN(25);
    for (int r = gw; r < NBATCH * SEQ; r += NGW) { float* xr = AOUT + (size_t)r * DM; f32x4 v[4]; float s = 0.f;
#pragma unroll
        for (int j = 0; j < 4; ++j) { v[j] = *((const f32x4*)xr + F.lane + 64 * j); s += (v[j].x * v[j].x + v[j].y * v[j].y) + (v[j].z * v[j].z + v[j].w * v[j].w); }
        const float rstd = 1.0f / sqrtf(wave_sum(s, F.lane) * (1.0f / DM) + EPS);
#pragma unroll
        for (int j = 0; j < 4; ++j) { const f32x4 gg = *((const f32x4*)gptr + F.lane + 64 * j); *((f32x4*)xr + F.lane + 64 * j) = v[j] * rstd * gg; }
    }
}
__device__ __forceinline__ void post_phase(Frame& F, int l) {
    const int gw = F.vcu * NWAVES + F.wave, NGW = F.G * NWAVES, lane = F.lane, hh = lane >> 4, d = lane & 15;
    bf16* Q = WSP(bf16, WS_Q); bf16* K = WSP(bf16, WS_K); const bf16* XA = WSP(bf16, WS_XA); bf16* DF = WSP(bf16, WS_DIFF);
    const float inv = exp2f(-(float)d * (13.287712379549449f / 16.0f));
    const float* qg = AIN(11) + (size_t)l * 128; const float* kg = qg + 64;
    for (int r = gw; r < MR; r += NGW) { const int b = r / TOK, i = r - b * TOK; const bool lat = i >= CTXL; const int t = i - CTXL;
        const int n = lat ? SEQ : CTXL, ts = lat ? t : i; const size_t seg0 = (size_t)(r - ts); float pd[4];
#pragma unroll
        for (int j = 0; j < 4; ++j) { const int w = 2 << j; int lo = ts - (w >> 1), hi2 = lo + w; lo = lo < 0 ? 0 : lo; hi2 = hi2 > n ? n : hi2; float s = 0.f;
            for (int q2 = lo; q2 < hi2; ++q2) s += bf2f(XA[(seg0 + q2) * 256 + j * 64 + lane]);
            pd[j] = s / (float)(hi2 - lo) - bf2f(XA[(size_t)r * 256 + j * 64 + lane]); }
        float x[3][4];
#pragma unroll
        for (int it = 0; it < 3; ++it) { const bf16* p = it < 2 ? Q + (size_t)r * 512 + (it * 4 + hh) * 64 + d : K + (size_t)r * 256 + hh * 64 + d;
            x[it][0] = bf2f(p[0]); x[it][1] = bf2f(p[16]); x[it][2] = bf2f(p[32]); x[it][3] = bf2f(p[48]); }
        float cr = 1.f, sr = 0.f, cc = 1.f, sc = 0.f;
        if (lat) { sincosf((float)(t >> 6) * inv, &sr, &cr); sincosf((float)(t & 63) * inv, &sc, &cc); }
#pragma unroll
        for (int it = 0; it < 3; ++it) { float x0 = x[it][0], x1 = x[it][1], x2 = x[it][2], x3 = x[it][3];
            const bool nrm = (it == 1) || (it == 2 && hh >= 2);
            float ss = (x0 * x0 + x1 * x1) + (x2 * x2 + x3 * x3);
            ss += shx(ss, 1, lane); ss += shx(ss, 2, lane); ss += shx(ss, 4, lane); ss += shx(ss, 8, lane);
            if (nrm) { const float rs = 1.0f / sqrtf(ss * (1.0f / 64.0f) + EPS); const float* gp = it == 1 ? qg : kg; x0 *= rs * gp[d]; x1 *= rs * gp[d + 16]; x2 *= rs * gp[d + 32]; x3 *= rs * gp[d + 48]; }
            float o0 = x0 * cr - x1 * sr, o1 = x1 * cr + x0 * sr, o2 = x2 * cc - x3 * sc, o3 = x3 * cc + x2 * sc;
            if (it < 2) { o0 *= attn_body::C2; o1 *= attn_body::C2; o2 *= attn_body::C2; o3 *= attn_body::C2; }
            x[it][0] = o0; x[it][1] = o1; x[it][2] = o2; x[it][3] = o3; }
#pragma unroll
        for (int it = 0; it < 3; ++it) { bf16* p = it < 2 ? Q + (size_t)r * 512 + (it * 4 + hh) * 64 + d : K + (size_t)r * 256 + hh * 64 + d;
            p[0] = (bf16)f2bf(x[it][0]); p[16] = (bf16)f2bf(x[it][1]); p[32] = (bf16)f2bf(x[it][2]); p[48] = (bf16)f2bf(x[it][3]); }
#pragma unroll
        for (int j = 0; j < 4; ++j) DF[(size_t)r * 256 + j * 64 + lane] = (bf16)f2bf(pd[j]);
    }
}
__device__ __forceinline__ void s5_carry_phase(Frame& F, int l) {
    const int cid = (int)blockIdx.x - (F.G - 64);
    if (F.wave != 0 || cid < 0) return;
    const int b = cid >> 5, d = (cid >> 4) & 1, g = cid & 15, p = F.lane;
    const int ix = ((l * 2 + d) * 16 + g) * 64 + p; const float are = AIN(14)[ix], aim = AIN(15)[ix], dt = expf(AIN(16)[(l * 2 + d) * 16 + g]);
    const float mg = expf(are * dt * (float)S5L); float sn, cs; sincosf(aim * dt * (float)S5L, &sn, &cs); const float Lr = mg * cs, Li = mg * sn;
    const float* E = WSP(float, WS_E) + (size_t)g * S5ROWS * 256 + d * 128 + p; bf16* A2 = WSP(bf16, WS_A2) + (size_t)g * S5ROWS * S5K + 512 + d * 128 + p;
    float sr = 0.f, si = 0.f;
#pragma unroll 1
    for (int k0 = 0; k0 < 520; k0 += 65) { float er[65], ei[65];
#pragma unroll
        for (int k = 0; k < 65; ++k) { const int kk = k0 + k; const int ch = d == 0 ? kk : (kk < 8 ? 7 - kk : 527 - kk); const size_t row = (size_t)b * 520 + ch; er[k] = E[row * 256]; ei[k] = E[row * 256 + 64]; }
#pragma unroll
        for (int k = 0; k < 65; ++k) { const int kk = k0 + k; const int ch = d == 0 ? kk : (kk < 8 ? 7 - kk : 527 - kk); const size_t row = (size_t)b * 520 + ch;
            A2[row * S5K] = (bf16)f2bf(sr); A2[row * S5K + 64] = (bf16)f2bf(si);
            const float nr = Lr * sr - Li * si + er[k], ni = Lr * si + Li * sr + ei[k]; sr = nr; si = ni; } }
}
__device__ __forceinline__ void attn_one(Frame& F, int l, int kind, int b, int h, int qb, char* lds) {
    using namespace attn_body;
    const attn_body::bf16* Q = (const attn_body::bf16*)WSP(::bf16, WS_Q); const attn_body::bf16* K = (const attn_body::bf16*)WSP(::bf16, WS_K); const attn_body::bf16* V = (const attn_body::bf16*)WSP(::bf16, WS_V);
    attn_body::bf16* O = (attn_body::bf16*)WSP(::bf16, WS_Y4) + (size_t)(kind == 0 ? 1 : 3) * MR * 256;
    const size_t row0 = (size_t)b * TOK + (size_t)qb * 256;
    const attn_body::bf16* Qu = Q + row0 * 512 + kind * 256 + h * 64; const attn_body::bf16* Kh = K + (size_t)b * TOK * 256 + kind * 128 + (h >> 1) * 64; const attn_body::bf16* Vh = V + (size_t)b * TOK * 256 + kind * 128 + (h >> 1) * 64;
    attn_body::bf16* Ou = O + row0 * 256 + h * 64;
    if (kind == 0) { int NT = 4, shift = 0;
        if (qb > 0) { const int lo = (4 * qb - 2) < 4 ? 4 : (4 * qb - 2), hi = (4 * qb + 5) > 259 ? 259 : (4 * qb + 5); NT = 4 + hi - lo + 1; shift = lo - 4; }
        attn_unit<8, true>(Qu, Kh, Vh, Ou, NT, shift, (qb - 1) * 256, AIN(10)[l * 4 + h] * LOG2E, lds, F.wave * 64 + F.lane);
    } else attn_unit<8, false>(Qu, Kh, Vh, Ou, qb > 0 ? 260 : 4, 0, 0, 0.f, lds, F.wave * 64 + F.lane);
}
__device__ __forceinline__ void attn_phase(Frame& F, int l, char* lds) {
    const int c = F.vcu;
#pragma unroll 1
    for (int u = c; u < 512; u += F.G) attn_one(F, l, 0, u >> 8, (u >> 6) & 3, 1 + (u & 63), lds);
#pragma unroll 1
    for (int u = c; u < 16; u += F.G) attn_one(F, l, u >> 3, (u >> 2) & 1, u & 3, 0, lds);
#pragma unroll 1
    for (int u = c; u < 512; u += F.G) attn_one(F, l, 1, u >> 8, (u >> 6) & 3, 1 + (u & 63), lds);
}

#define XB_TMO      128
#define XB_XCNT(j)  (256  + 64 * (j))
#define XB_XSUB(j)  (1280 + 64 * (j))
#define XB_XGEN(j)  (2304 + 64 * (j))
#define XB_TOP      3328
#define XB_TOPGEN   3392
#define XCD_BAR_WORDS 3456
#define XB_SPIN_CAP (1u << 18)

__device__ __forceinline__ unsigned xb_ld(unsigned* p)              { return __hip_atomic_load(p, __ATOMIC_RELAXED, __HIP_MEMORY_SCOPE_AGENT); }
__device__ __forceinline__ unsigned xb_add(unsigned* p, unsigned v) { return __hip_atomic_fetch_add(p, v, __ATOMIC_RELAXED, __HIP_MEMORY_SCOPE_AGENT); }
__device__ __forceinline__ unsigned xb_xcc_id() { return (unsigned)__builtin_amdgcn_s_getreg((3 << 11) | 20) & 0xFu; }
#define XB_SPIN(cond, bar) do { unsigned _sp = 0; while (cond) { __builtin_amdgcn_s_sleep(1); \
    if ((++_sp & 255u) == 0u) { if (xb_ld(&(bar)[XB_TMO])) break; if (_sp > XB_SPIN_CAP) { atomicAdd(&(bar)[XB_TMO], 1u); break; } } } } while (0)

struct XcdBarrier {
    unsigned* bar; unsigned x;
    volatile LAS unsigned* st;
};

__device__ __forceinline__ XcdBarrier xcd_barrier_post(unsigned* bar, volatile LAS unsigned* st) {
    XcdBarrier b; b.bar = bar; b.x = xb_xcc_id(); b.st = st;
    if (threadIdx.x == 0) (void)xb_add(&bar[XB_XCNT(b.x)], 1u);
    return b;
}
__device__ __forceinline__ void xcd_barrier_complete(unsigned* bar, unsigned x, unsigned& nloc, unsigned& nx) {
    const unsigned G = gridDim.x * gridDim.y * gridDim.z;
    unsigned sum, cnt, mine, sp = 0u;
    for (;;) {
        sum = 0u; cnt = 0u; mine = 0u;
#pragma unroll
        for (unsigned j = 0; j < 16; ++j) { const unsigned c = xb_ld(&bar[XB_XCNT(j)]); sum += c; cnt += (c > 0u) ? 1u : 0u; mine = (j == x) ? c : mine; }
        if (sum == G) break;
        __builtin_amdgcn_s_sleep(1);
        if ((++sp & 255u) == 0u) { if (xb_ld(&bar[XB_TMO])) break; if (sp > XB_SPIN_CAP) { atomicAdd(&bar[XB_TMO], 1u); break; } }
    }
    nloc = mine > 0u ? mine : 1u; nx = cnt > 0u ? cnt : 1u;
}

__device__ __forceinline__ void xcd_barrier(const XcdBarrier& b) {
    asm volatile("s_waitcnt vmcnt(0)" ::: "memory");
    __syncthreads();
    if (threadIdx.x == 0) {
        unsigned* bar = b.bar;
        __builtin_amdgcn_s_waitcnt(0);
        unsigned nloc = b.st[0], nx = b.st[1];
        if (nloc == 0u) { xcd_barrier_complete(bar, b.x, nloc, nx); b.st[0] = nloc; b.st[1] = nx; }
        const unsigned old = xb_add(&bar[XB_XSUB(b.x)], 1u);
        const unsigned gen = old / nloc;
        if (old + 1u == (gen + 1u) * nloc) {
            __builtin_amdgcn_fence(__ATOMIC_RELEASE, "agent");
            asm volatile("s_waitcnt vmcnt(0)" ::: "memory");
            const unsigned og = xb_add(&bar[XB_TOP], 1u);
            const unsigned tg = og / nx;
            if (og + 1u == (tg + 1u) * nx) xb_add(&bar[XB_TOPGEN], 1u);
            else XB_SPIN(xb_ld(&bar[XB_TOPGEN]) == tg, bar);
            __builtin_amdgcn_fence(__ATOMIC_ACQUIRE, "agent");
            xb_add(&bar[XB_XGEN(b.x)], 1u);
            asm volatile("s_waitcnt vmcnt(0)" ::: "memory");
        } else {
            XB_SPIN(xb_ld(&bar[XB_XGEN(b.x)]) == gen, bar);
            __builtin_amdgcn_fence(__ATOMIC_ACQUIRE, "agent");
            asm volatile("s_waitcnt vmcnt(0)" ::: "memory");
        }
    }
    __syncthreads();
}

constexpr size_t WS_BAR = 16384;
#ifndef MK_SPLIT
#define MK_SPLIT 0
#endif
constexpr int N_PHASES = 2 + DEPTH * 14 + 1;
__global__ void __launch_bounds__(NWAVES * 64, 2) mk_fwd(Args args) {
    extern __shared__ __attribute__((aligned(16))) unsigned char lds[];
    Frame F;
    F.lds = (LAS unsigned char*)lds; F.lane = 0; F.wave = __builtin_amdgcn_readfirstlane(threadIdx.x >> 6);
    F.G = gridDim.x; { const int bx = blockIdx.x; F.vcu = (F.G % 8 == 0) ? (bx % 8) * (F.G / 8) + bx / 8 : bx; }
    { volatile LAS unsigned* st_ = (volatile LAS unsigned*)(F.lds + RING_BYTES + 512); if (threadIdx.x < 2) st_[threadIdx.x] = 0u; __syncthreads();
      (void)xcd_barrier_post((unsigned*)(AWS + WS_BAR), st_); }
    const int lo = args.ph_lo, hi = args.ph_hi; int ph = 0;
#ifndef ONLY_MASK
#define ONLY_MASK 0xffffffffu
#endif
#define SEL(n) ((ONLY_MASK >> (n)) & 1u)
#define PH_BEGIN if (lo <= ph && ph < hi) { { int l_; asm volatile("v_mbcnt_lo_u32_b32 %0, -1, 0\n\tv_mbcnt_hi_u32_b32 %0, -1, %0" : "=v"(l_)); F.lane = l_; }
#define PH_END   if (ph + 1 < hi) { asm volatile("s_waitcnt vmcnt(0) lgkmcnt(0)" ::: "memory");   \
        if (hi < 0) cg::this_grid().sync();   \
        else { XcdBarrier xb_; xb_.bar = (unsigned*)(AWS + WS_BAR); xb_.x = xb_xcc_id(); xb_.st = (volatile LAS unsigned*)(F.lds + RING_BYTES + 512); xcd_barrier(xb_); } } } ++ph;
#define GEMM(EPI, SCHEDT, A_, B_, K_, S_, E_) pg8::gemm_phase<EPI, SCHEDT, true, true>(F.lds, pg8::Gemm{(const pg8::bf16_t*)(A_), (const pg8::bf16_t*)(B_), 0, 0, (K_), (K_)}, S_, E_, F.wave * 64 + F.lane)
#define GEMML(EPI, SCHEDT, A_, B_, K_, LD_, S_, E_) pg8::gemm_phase<EPI, SCHEDT, true, true>(F.lds, pg8::Gemm{(const pg8::bf16_t*)(A_), (const pg8::bf16_t*)(B_), 0, 0, (K_), (LD_)}, S_, E_, F.wave * 64 + F.lane)
    float* XC = WSP(float, WS_XC);
    PH_BEGIN if (SEL(1)) { prep_layer(F, 0); __syncthreads(); mod_phase(F); } PH_END
#pragma unroll 1
    for (int l = 0; l < DEPTH; ++l) {
        const bool last = (l == DEPTH - 1);
        const float* MODl = WSP(float, WS_MOD) + (size_t)l * 3 * NSUBMOD;
        const float* srcL = l == 0 ? AIN(0) : AOUT; const float* srcC = l == 0 ? AIN(2) : XC;
        PH_BEGIN if (SEL(2)) { if (l > 0) { prep_layer(F, l); } if (l > 0) norm_phase(F, l, 0, srcL, srcC, WSP(float, WS_Y4), 11, WSP(float, WS_MOD) + (size_t)(l - 1) * 3 * NSUBMOD + 2 * 3072 + 2048 + 2 * NSUBMOD, 0.5f, XC, XC); else norm_phase(F, l, 0, srcL, srcC); } PH_END
#pragma unroll 1
        for (int f = 0; f < 2; ++f) {
            if (f == 1) {
                PH_BEGIN if (SEL(3)) { { RowOrder S; S.init(1536, F.G, (int)blockIdx.x, false); EpiRoute E{WSP(bf16_t, WS_Q), WSP(bf16_t, WS_K), WSP(bf16_t, WS_V), WSP(bf16_t, WS_A2), WSP(bf16_t, WS_XA)};
                    GEMM(EpiRoute, RowOrder, WSP(bf16, WS_HN), WSP(bf16, WS_WINT), DM, S, E); } } PH_END
                PH_BEGIN if (SEL(4)) { { post_phase(F, l); S5Order S{1, F.G, (int)blockIdx.x}; EpiF32 E{WSP(float, WS_E)}; GEMM(EpiF32, S5Order, WSP(bf16, WS_A2), WSP(bf16, WS_BTE), S5K, S, E); } } PH_END
                PH_BEGIN if (SEL(5)) { { s5_carry_phase(F, l); RowOrder S; S.init(256, F.G, (int)blockIdx.x, last); EpiPlain E{WSP(bf16_t, WS_Y4), 256}; GEMM(EpiPlain, RowOrder, WSP(bf16, WS_DIFF), WSP(bf16, WS_WPT), 256, S, E); } } PH_END
                PH_BEGIN if (SEL(6)) { { S5Order S{2, F.G, (int)blockIdx.x}; EpiS5Y E{WSP(bf16_t, WS_G)}; GEMM(EpiS5Y, S5Order, WSP(bf16, WS_A2), WSP(bf16, WS_BTY), S5K, S, E); } } PH_END
                PH_BEGIN if (SEL(7)) { { RowOrder S; S.init(512, F.G, (int)blockIdx.x, last); EpiGlu E{WSP(bf16_t, WS_Y4) + (size_t)2 * MR * 256}; GEMM(EpiGlu, RowOrder, WSP(bf16, WS_G), WSP(bf16, WS_WGT), 256, S, E);
                    attn_phase(F, l, (char*)lds); } } PH_END
                PH_BEGIN if (SEL(8)) { { RowOrder S; S.init(DM, F.G, (int)blockIdx.x, last);
#pragma unroll 1
                    for (int k = 0; k < 4; ++k) { EpiGate Eg{WSP(bf16_t, WS_GS)}; GEMM(EpiGate, RowOrder, WSP(bf16, WS_HN), WSP(bf16, WS_WINT) + (size_t)(1536 + k * 1024) * DM, DM, S, Eg);
                        const bf16* Ak = WSP(bf16, WS_Y4) + (size_t)k * MR * 256; const bf16* Bk = WSP(bf16, WS_WBT) + (size_t)k * DM * 256;
                        if (k == 0) { EpiMerge<true> Em{WSP(bf16_t, WS_GS), WSP(bf16_t, WS_T)}; GEMM(EpiMerge<true>, RowOrder, Ak, Bk, 256, S, Em); }
                        else { EpiMerge<false> Em{WSP(bf16_t, WS_GS), WSP(bf16_t, WS_T)}; GEMM(EpiMerge<false>, RowOrder, Ak, Bk, 256, S, Em); } } } } PH_END
                PH_BEGIN if (SEL(9)) { { RowOrder S; S.init(DM, F.G, (int)blockIdx.x, true); EpiResid E{AOUT, XC, AOUT, XC, MODl + 1 * 3072 + 2048, 1.0f}; GEMM(EpiResid, RowOrder, WSP(bf16, WS_T), WSP(bf16, WS_WOT), DM, S, E); }
                    if (!last) { CtxSliceOrder S{4, F.G, (int)blockIdx.x}; EpiPart E{WSP(float, WS_Y4)}; GEMML(EpiPart, CtxSliceOrder, WSP(bf16, WS_T), WSP(bf16, WS_WOT), 256, DM, S, E); } } PH_END
                PH_BEGIN if (SEL(10)) { if (!last) norm_phase(F, l, 2, AOUT, XC, WSP(float, WS_Y4), 4, MODl + 1 * 3072 + 2048 + 2 * NSUBMOD, 1.0f, XC, XC); else norm_phase(F, l, 2, AOUT, XC); } PH_END
            }
            PH_BEGIN if (SEL(11)) { { RowOrder S; S.init(5632, F.G, (int)blockIdx.x, last && f == 1); EpiSwiglu E{WSP(bf16_t, WS_HID)}; GEMM(EpiSwiglu, RowOrder, WSP(bf16, WS_HN), WSP(bf16, WS_W1T) + (size_t)f * 5632 * DM, DM, S, E); } } PH_END
            PH_BEGIN if (SEL(12)) { { RowOrder S; S.init(DM, F.G, (int)blockIdx.x, true); const bool first = (l == 0 && f == 0);
                EpiResid E{first ? AIN(0) : AOUT, first ? AIN(2) : XC, AOUT, XC, MODl + (f == 0 ? 0 : 2) * 3072 + 2048, 0.5f};
                GEMM(EpiResid, RowOrder, WSP(bf16, WS_HID), WSP(bf16, WS_W2T) + (size_t)f * DM * DFF, DFF, S, E); }
                if (!(last && f == 1)) { CtxSliceOrder S{11, F.G, (int)blockIdx.x}; EpiPart E{WSP(float, WS_Y4)}; GEMML(EpiPart, CtxSliceOrder, WSP(bf16, WS_HID), WSP(bf16, WS_W2T) + (size_t)f * DM * DFF, 256, DFF, S, E); } } PH_END
            if (f == 0) { PH_BEGIN if (SEL(13)) { norm_phase(F, l, 1, AOUT, XC, WSP(float, WS_Y4), 11, MODl + 0 * 3072 + 2048 + 2 * NSUBMOD, 0.5f, l == 0 ? AIN(2) : XC, XC); } PH_END }
        }
    }
    PH_BEGIN if (SEL(14)) { final_norm_phase(F); } PH_END
}

extern "C" void kernel_launch(void* const* d_in, const int* in_sizes, int n_in, void* d_out, int out_size, void* d_ws, size_t ws_size, hipStream_t stream) {
    static int grid = 0;
    if (grid == 0) {
        int dev = 0, cus = 0, per_cu = 0;
        if (n_in != 26 || ws_size < WS_END) { fprintf(stderr, "kernel_launch: unexpected inputs (n_in %d, ws %zu < %zu)\n", n_in, ws_size, (size_t)WS_END); grid = -1; return; }
        hipGetDevice(&dev); hipDeviceGetAttribute(&cus, hipDeviceAttributeMultiprocessorCount, dev);
        hipFuncSetAttribute((const void*)mk_fwd, hipFuncAttributeMaxDynamicSharedMemorySize, LDS_BYTES);
        hipOccupancyMaxActiveBlocksPerMultiprocessor(&per_cu, (const void*)mk_fwd, NWAVES * 64, LDS_BYTES);
        if (per_cu < 1) { fprintf(stderr, "kernel_launch: occupancy query says %d blocks per CU\n", per_cu); per_cu = 1; }
        (void)hipGetLastError();
        grid = cus * per_cu;
    }
    if (grid < 0) return;
    Args a{};
    for (int i = 0; i < 26; ++i) a.in[i] = (const float*)d_in[i];
    a.out = (float*)d_out; a.ws = (unsigned char*)d_ws;
#if MK_SPLIT
    for (int p = 0; p < N_PHASES; ++p) { a.ph_lo = p; a.ph_hi = p + 1; hipLaunchKernelGGL(mk_fwd, dim3(grid), dim3(NWAVES * 64), LDS_BYTES, stream, a); }
#else
    if (hipMemsetAsync((char*)d_ws + WS_BAR, 0, 65536, stream) != hipSuccess) { fprintf(stderr, "kernel_launch: memset of the barrier words failed\n"); return; }
    a.ph_lo = 0; a.ph_hi = N_PHASES;
    void* kargs[] = {&a};
    hipError_t e = hipLaunchCooperativeKernel((const void*)mk_fwd, dim3(grid), dim3(NWAVES * 64), kargs, LDS_BYTES, stream);
    if (e != hipSuccess) fprintf(stderr, "cooperative launch failed: %s (grid %d)\n", hipGetErrorString(e), grid);
#endif
}
```

```cpp
#include <hip/hip_cooperative_groups.h>
#include <hip/hip_runtime.h>
#include <cstdio>
#include <cstdint>
namespace pg8 {
#define PG8_LAS __attribute__((address_space(3)))
typedef unsigned short bf16_t;
typedef short bf16x8 __attribute__((ext_vector_type(8)));
typedef float f32x4 __attribute__((ext_vector_type(4)));
typedef unsigned u32x4 __attribute__((ext_vector_type(4)));
constexpr int BM = 256, BK = 64, HALF = 128, HTB = HALF * BK * 2  , STAGE_BYTES = 8 * HTB, NXCD = 8, WGM = 8;

__host__ __device__ __forceinline__ int lds_byte(int r, int c) { const int st = (r >> 4) * 2 + (c >> 5), rr = r & 15, cc = c & 31, ob = rr * 64 + cc * 2; return st * 1024 + (ob ^ (((ob >> 9) & 1) << 5)); }
__host__ __device__ __forceinline__ void stage_rc(int b, int& R, int& C) { const int st = b / 1024, sb = b % 1024, swz = sb ^ (((sb >> 9) & 1) << 5); R = (st >> 1) * 16 + swz / 64; C = (st & 1) * 32 + (swz % 64) / 2; }
__host__ __device__ __forceinline__ int perm32(int rho) { const int n = rho >> 4, i = rho & 15; return 8 * (i >> 2) + 4 * n + (i & 3); }

struct Unit { int pm, pn, k0; };
struct Gemm { const bf16_t* A; const bf16_t* Bt; int M, N, K, ld; };

struct StaticOrder {
    int nM, nN, nwg, G, c;
    __host__ __device__ void init(int M, int N, int G_, int c_) { nM = M / BM; nN = N / BM; nwg = nM * nN; G = G_; c = c_; }
    __host__ __device__ bool next(int i, Unit& u) const {
        const long L = (long)i * G + c; if (L >= nwg) return false;
        int wgid = (int)L; { const int q = nwg / NXCD, r = nwg % NXCD, xcd = wgid % NXCD, off = wgid / NXCD; wgid = (xcd < r ? xcd * (q + 1) : r * (q + 1) + (xcd - r) * q) + off; }
        const int nig = WGM * nN, gid = wgid / nig, fm = gid * WGM, gsz = (nM - fm) < WGM ? (nM - fm) : WGM;
        u.pm = fm + ((wgid % nig) % gsz); u.pn = (wgid % nig) / gsz; u.k0 = 0; return true;
    }
    __device__ __forceinline__ void a_ready(const Unit&) const {}
    __device__ __forceinline__ void done(const Unit&) const {}
};

typedef float f32x2cv __attribute__((ext_vector_type(2))); typedef __bf16 bf16x2cv __attribute__((ext_vector_type(2)));
__device__ __forceinline__ unsigned cvt_pk_bf16(float lo, float hi) { f32x2cv v = {lo, hi}; bf16x2cv b = __builtin_convertvector(v, bf16x2cv); return __builtin_bit_cast(unsigned, b); }
typedef float f32x2 __attribute__((ext_vector_type(2)));
template <class Epi, class Sched, bool ALIGN_EPI = false, bool SP2 = false>
__device__ __forceinline__ void gemm_phase(PG8_LAS unsigned char* lds, const Gemm g, const Sched& S, const Epi& E, int tid) {
    float zf = 0.f; asm volatile("" : "+v"(zf));
    const int wid = __builtin_amdgcn_readfirstlane(tid >> 6), lane = tid & 63, wr = wid >> 2, wc = wid & 3, fr = lane & 15, fq = lane >> 4;
    const int K = g.K, nt = K / BK;
    unsigned voffA[2], voffB[2];
#pragma unroll
    for (int i = 0; i < 2; ++i) { int R, C; stage_rc(tid * 16 + i * 8192, R, C); const int Rb = Epi::PERM ? ((R & ~31) + perm32(R & 31)) : R;
        voffA[i] = (unsigned)(R * g.ld + C) * 2u; voffB[i] = (unsigned)(Rb * g.ld + C) * 2u; }
    const size_t kstep = (size_t)(BK * 2);
    const size_t hstep = (size_t)HALF * g.ld * 2;
    const size_t tstep = 2 * hstep;
    const unsigned ldsw = (unsigned)wid * 1024u;
    const int aoff = lds_byte(wr * 64 + fr, fq * 8), boff = lds_byte(wc * 32 + fr, fq * 8);
#define PG8_SA(b, h) (((b) * 2 + (h)) * HTB)
#define PG8_SB(b, h) ((4 + (b) * 2 + (h)) * HTB)
#define PG8_STAGE(bufoff, gbase, voff) do { _Pragma("unroll") for (int _i = 0; _i < 2; ++_i) \
        __builtin_amdgcn_global_load_lds((const unsigned*)((const char*)(gbase) + (voff)[_i]), (PG8_LAS unsigned*)(lds + (bufoff) + ldsw + _i * 8192), 16, 0, 0); } while (0)
#define PG8_LDA(dst, b, h) do { _Pragma("unroll") for (int m = 0; m < 4; ++m) _Pragma("unroll") for (int k = 0; k < 2; ++k) dst[m][k] = *(const PG8_LAS bf16x8*)(lds + PG8_SA(b, h) + aoff + m * 2048 + k * 1024); } while (0)
#define PG8_LDB(dst, b, h) do { _Pragma("unroll") for (int n = 0; n < 2; ++n) _Pragma("unroll") for (int k = 0; k < 2; ++k) dst[n][k] = *(const PG8_LAS bf16x8*)(lds + PG8_SB(b, h) + boff + n * 2048 + k * 1024); } while (0)
#define PG8_MMA(ai, bj, At, Bt) do { __builtin_amdgcn_s_setprio(1); _Pragma("unroll") for (int m = 0; m < 4; ++m) _Pragma("unroll") for (int n = 0; n < 2; ++n) _Pragma("unroll") for (int k = 0; k < 2; ++k) \
        acc[ai][bj][m][n] = __builtin_amdgcn_mfma_f32_16x16x32_bf16(Bt[n][k], At[m][k], acc[ai][bj][m][n], 0, 0, 0); __builtin_amdgcn_s_setprio(0); } while (0)
#define PG8_WAIT_V(n) asm volatile("s_waitcnt vmcnt(" #n ")" ::: "memory")
#define PG8_WAIT_L(n) asm volatile("s_waitcnt lgkmcnt(" #n ")" ::: "memory")
#define PG8_BAR __builtin_amdgcn_s_barrier()
#define PG8_SCHED __builtin_amdgcn_sched_barrier(0)
    Unit cur, nxt; int ui = 0;
    if (!S.next(0, cur)) return;
    f32x4 acc[2][2][4][2];
#pragma unroll
    for (int a = 0; a < 2; ++a)
#pragma unroll
        for (int b = 0; b < 2; ++b)
#pragma unroll
            for (int m = 0; m < 4; ++m)
#pragma unroll
                for (int n = 0; n < 2; ++n) acc[a][b][m][n] = (f32x4){zf, zf, zf, zf};
    bf16x8 At[4][2], B0[2][2], B1[2][2];
    const char* cA = (const char*)g.A + (size_t)cur.pm * tstep + (size_t)cur.k0 * 2; const char* cB = (const char*)g.Bt + (size_t)cur.pn * tstep + (size_t)cur.k0 * 2;
    S.a_ready(cur);
    if constexpr (SP2) {
        PG8_STAGE(PG8_SB(0, 0), cB, voffB); PG8_STAGE(PG8_SB(0, 1), cB + hstep, voffB); PG8_STAGE(PG8_SA(0, 0), cA, voffA); PG8_STAGE(PG8_SA(0, 1), cA + hstep, voffA);
        if (wr == 1) PG8_BAR;
        PG8_WAIT_V(2); PG8_BAR;
        PG8_STAGE(PG8_SB(1, 0), cB + kstep, voffB); PG8_STAGE(PG8_SA(1, 0), cA + kstep, voffA); PG8_STAGE(PG8_SB(1, 1), cB + hstep + kstep, voffB);
        PG8_WAIT_V(6); PG8_BAR;
    } else {
        PG8_STAGE(PG8_SB(0, 0), cB, voffB); PG8_STAGE(PG8_SA(0, 0), cA, voffA); PG8_STAGE(PG8_SB(0, 1), cB + hstep, voffB); PG8_STAGE(PG8_SA(0, 1), cA + hstep, voffA);
        if (wr == 1) PG8_BAR;
        PG8_WAIT_V(4); PG8_BAR;
        PG8_STAGE(PG8_SB(1, 0), cB + kstep, voffB); PG8_STAGE(PG8_SA(1, 0), cA + kstep, voffA); PG8_STAGE(PG8_SB(1, 1), cB + hstep + kstep, voffB);
        PG8_WAIT_V(6); PG8_BAR;
    }
    for (;;) {
        const bool has_next = S.next(ui + 1, nxt);
        const char* nA = has_next ? (const char*)g.A + (size_t)nxt.pm * tstep + (size_t)nxt.k0 * 2 : cA; const char* nB = has_next ? (const char*)g.Bt + (size_t)nxt.pn * tstep + (size_t)nxt.k0 * 2 : cB;
#pragma nounroll
        for (int t = 0; t < nt; t += 2) {
            const bool last = (t == nt - 2);
            const char* a1 = cA + (size_t)(t + 1) * kstep;
            const char* a2 = last ? nA : cA + (size_t)(t + 2) * kstep; const char* b2 = last ? nB : cB + (size_t)(t + 2) * kstep;
            const char* a3 = a2 + kstep; const char* b3 = b2 + kstep;
            if (last && has_next) S.a_ready(nxt);
            if constexpr (SP2) {
            PG8_LDB(B0, 0, 0); PG8_LDB(B1, 0, 1); PG8_SCHED; PG8_LDA(At, 0, 0); PG8_STAGE(PG8_SA(1, 1), a1 + hstep, voffA);
            PG8_WAIT_V(8); PG8_WAIT_L(0); PG8_BAR; PG8_MMA(0, 0, At, B0); PG8_MMA(0, 1, At, B1); PG8_BAR; PG8_SCHED;
            PG8_LDA(At, 0, 1); PG8_STAGE(PG8_SB(0, 0), b2, voffB); PG8_STAGE(PG8_SB(0, 1), b2 + hstep, voffB); PG8_STAGE(PG8_SA(0, 0), a2, voffA);
            PG8_WAIT_V(8); PG8_WAIT_L(0); PG8_BAR; PG8_MMA(1, 0, At, B0); PG8_MMA(1, 1, At, B1); PG8_BAR; PG8_SCHED;
            PG8_LDB(B0, 1, 0); PG8_LDB(B1, 1, 1); PG8_SCHED; PG8_LDA(At, 1, 0); PG8_STAGE(PG8_SA(0, 1), a2 + hstep, voffA);
            PG8_WAIT_V(8); PG8_WAIT_L(0); PG8_BAR; PG8_MMA(0, 0, At, B0); PG8_MMA(0, 1, At, B1); PG8_BAR; PG8_SCHED;
            PG8_LDA(At, 1, 1); PG8_STAGE(PG8_SB(1, 0), b3, voffB); PG8_STAGE(PG8_SB(1, 1), b3 + hstep, voffB); PG8_STAGE(PG8_SA(1, 0), a3, voffA);
            PG8_WAIT_V(8); PG8_WAIT_L(0); PG8_BAR; PG8_MMA(1, 0, At, B0); PG8_MMA(1, 1, At, B1); PG8_BAR; PG8_SCHED;
            } else {
            PG8_LDB(B0, 0, 0); PG8_SCHED; PG8_LDA(At, 0, 0); PG8_STAGE(PG8_SA(1, 1), a1 + hstep, voffA);
            PG8_WAIT_L(8); PG8_BAR; PG8_WAIT_L(0); PG8_MMA(0, 0, At, B0); PG8_BAR; PG8_SCHED;
            PG8_LDB(B1, 0, 1); PG8_STAGE(PG8_SB(0, 0), b2, voffB);
            PG8_BAR; PG8_WAIT_L(0); PG8_MMA(0, 1, At, B1); PG8_BAR;
            PG8_LDA(At, 0, 1); PG8_STAGE(PG8_SA(0, 0), a2, voffA);
            PG8_BAR; PG8_WAIT_L(0); PG8_MMA(1, 0, At, B0); PG8_BAR; PG8_SCHED;
            PG8_STAGE(PG8_SB(0, 1), b2 + hstep, voffB);
            PG8_WAIT_V(6); PG8_BAR; PG8_MMA(1, 1, At, B1); PG8_BAR;
            PG8_LDB(B0, 1, 0); PG8_SCHED; PG8_LDA(At, 1, 0); PG8_STAGE(PG8_SA(0, 1), a2 + hstep, voffA);
            PG8_WAIT_L(8); PG8_BAR; PG8_WAIT_L(0); PG8_MMA(0, 0, At, B0); PG8_BAR; PG8_SCHED;
            PG8_LDB(B1, 1, 1); PG8_STAGE(PG8_SB(1, 0), b3, voffB);
            PG8_BAR; PG8_WAIT_L(0); PG8_MMA(0, 1, At, B1); PG8_BAR;
            PG8_LDA(At, 1, 1); PG8_STAGE(PG8_SA(1, 0), a3, voffA);
            PG8_BAR; PG8_WAIT_L(0); PG8_MMA(1, 0, At, B0); PG8_BAR; PG8_SCHED;
            PG8_STAGE(PG8_SB(1, 1), b3 + hstep, voffB);
            PG8_WAIT_V(6); PG8_BAR; PG8_MMA(1, 1, At, B1); PG8_BAR;
            }
        }
        if constexpr (ALIGN_EPI) { if (wr == 0) PG8_BAR; }
        if constexpr (!Epi::AFTER_DRAIN) { E(acc, cur, wr, wc, fr, fq); S.done(cur); }
        if (!has_next) break;
#pragma unroll
        for (int a = 0; a < 2; ++a)
#pragma unroll
            for (int b = 0; b < 2; ++b)
#pragma unroll
                for (int m = 0; m < 4; ++m)
#pragma unroll
                    for (int n = 0; n < 2; ++n) acc[a][b][m][n] = (f32x4){zf, zf, zf, zf};
        cur = nxt; cA = nA; cB = nB; ++ui;
        if constexpr (ALIGN_EPI) { if (wr == 1) PG8_BAR; }
    }
    PG8_WAIT_V(0);
    if constexpr (!ALIGN_EPI) { if (wr == 0) PG8_BAR; }
    PG8_BAR;
    if constexpr (Epi::AFTER_DRAIN) { E.fused(acc, cur, wr, wc, fr, fq, lds, wid, lane); S.done(cur); }
#undef PG8_SA
#undef PG8_SB
#undef PG8_STAGE
#undef PG8_LDA
#undef PG8_LDB
#undef PG8_MMA
#undef PG8_WAIT_V
#undef PG8_WAIT_L
#undef PG8_BAR
#undef PG8_SCHED
}
}
namespace cg = cooperative_groups;
#include <hip/hip_bf16.h>
#include <cmath>
namespace attn_body {
using bf16=__hip_bfloat16;
using bf16x8=__attribute__((ext_vector_type(8)))short;
using s16x4=__attribute__((ext_vector_type(4)))short;
using f32x16=__attribute__((ext_vector_type(16)))float;
using u32x4=__attribute__((ext_vector_type(4)))unsigned;
constexpr int D=64,QP=512,KP=256,OP=256;
constexpr int NW=8,QBLK=32,QB=QBLK*NW,KVBLK=64;
__device__ __forceinline__ int crow(int r,int hi){return (r&3)+8*(r>>2)+4*hi;}
#define SBAR() __builtin_amdgcn_sched_barrier(0)
__device__ __forceinline__ void wmask(f32x16&p0,f32x16&p1,int dbase){
  const float NEG=-INFINITY;
  #pragma unroll
  for(int r=0;r<16;++r){int d=dbase+(r&3)+8*(r>>2); if((unsigned)(d+128)>256u)p0[r]=NEG; if((unsigned)(d+160)>256u)p1[r]=NEG;}
}

constexpr int NSLOT=3, SLOTB=8192;
constexpr int LDS_K=0, LDS_V=NSLOT*SLOTB, LDS_WS=2*NSLOT*SLOTB, LDS_OST=LDS_WS+NW*64*4, LDS_BYTES=LDS_OST+NW*4096;
constexpr float C2=0.125f*1.4426950408889634f;
__device__ __forceinline__ void glds16(const void*gsrc,unsigned lds_dst){unsigned keep;
  asm volatile("s_mov_b32 %0, m0\n\ts_mov_b32 m0, %2\n\ts_nop 0\n\tglobal_load_lds_dwordx4 %1, off\n\ts_mov_b32 m0, %0":"=&s"(keep):"v"(gsrc),"s"(lds_dst):"memory");}
__device__ __forceinline__ float max3f(float a,float b,float c){float r;asm("v_max3_f32 %0, %1, %2, %3":"=v"(r):"v"(a),"v"(b),"v"(c));return r;}
__device__ __forceinline__ float max2f(float a,float b){float r;asm("v_max_f32_e32 %0, %1, %2":"=v"(r):"v"(a),"v"(b));return r;}
__device__ __forceinline__ float fadd_s(float a,float b){float r;asm("v_add_f32_e32 %0, %1, %2":"=v"(r):"v"(a),"v"(b));return r;}
__device__ __forceinline__ float fsub_s(float a,float b){float r;asm("v_sub_f32_e32 %0, %1, %2":"=v"(r):"v"(a),"v"(b));return r;}
typedef float f32x2_t __attribute__((ext_vector_type(2))); typedef __bf16 bf16x2_t __attribute__((ext_vector_type(2)));
__device__ __forceinline__ unsigned cvtpk_s(float lo,float hi){f32x2_t v={lo,hi};bf16x2_t b=__builtin_convertvector(v,bf16x2_t);return __builtin_bit_cast(unsigned,b);}
#define WAIT_BAR(N) asm volatile("s_waitcnt vmcnt(" #N ") lgkmcnt(0)\n\ts_barrier":::"memory")

__device__ __forceinline__ void qkt(f32x16&p0,f32x16&p1,const char*Kslot,const bf16x8*qr,const f32x16&negm,int r32,int hi){
  const char*kb=Kslot+hi*1024+r32*16;
  #pragma unroll
  for(int d0=0;d0<4;++d0){
    const bf16x8 b0=*reinterpret_cast<const bf16x8*>(kb+d0*2048);
    const bf16x8 b1=*reinterpret_cast<const bf16x8*>(kb+d0*2048+512);
    if(d0==0){p0=__builtin_amdgcn_mfma_f32_32x32x16_bf16(b0,qr[0],negm,0,0,0);p1=__builtin_amdgcn_mfma_f32_32x32x16_bf16(b1,qr[0],negm,0,0,0);}
    else{p0=__builtin_amdgcn_mfma_f32_32x32x16_bf16(b0,qr[d0],p0,0,0,0);p1=__builtin_amdgcn_mfma_f32_32x32x16_bf16(b1,qr[d0],p1,0,0,0);}}
}
typedef __attribute__((address_space(3))) const char* lds_cptr;
typedef short v4i16_t __attribute__((ext_vector_type(4)));
__device__ __forceinline__ void kload8(bf16x8*kf,lds_cptr kp){
  kf[0]=*(const __attribute__((address_space(3))) bf16x8*)(kp);      kf[1]=*(const __attribute__((address_space(3))) bf16x8*)(kp+512);
  kf[2]=*(const __attribute__((address_space(3))) bf16x8*)(kp+2048); kf[3]=*(const __attribute__((address_space(3))) bf16x8*)(kp+2560);
  kf[4]=*(const __attribute__((address_space(3))) bf16x8*)(kp+4096); kf[5]=*(const __attribute__((address_space(3))) bf16x8*)(kp+4608);
  kf[6]=*(const __attribute__((address_space(3))) bf16x8*)(kp+6144); kf[7]=*(const __attribute__((address_space(3))) bf16x8*)(kp+6656);
}
__device__ __forceinline__ void kload2(bf16x8*kf,lds_cptr kp,int j){ kf[2*j]=*(const __attribute__((address_space(3))) bf16x8*)(kp+j*2048); kf[2*j+1]=*(const __attribute__((address_space(3))) bf16x8*)(kp+j*2048+512); }
__device__ __forceinline__ s16x4 vtr(lds_cptr p){ return __builtin_bit_cast(s16x4,__builtin_amdgcn_ds_read_tr16_b64_v4i16((__attribute__((address_space(3))) v4i16_t*)p)); }
__device__ __forceinline__ float rowmax(const f32x16&p0,const f32x16&p1){
  float a=max3f(p0[0],p0[1],p1[0]),b=max3f(p0[2],p0[3],p1[1]);a=max3f(a,p1[2],p1[3]);
  #pragma unroll
  for(int r=4;r<16;r+=4){a=max3f(a,p0[r],p0[r+1]);b=max3f(b,p0[r+2],p0[r+3]);a=max3f(a,p1[r],p1[r+1]);b=max3f(b,p1[r+2],p1[r+3]);}
  const float m=max2f(a,b);
  auto rr=__builtin_amdgcn_permlane32_swap(__float_as_uint(m),__float_as_uint(m),false,false);
  return max2f(__uint_as_float(rr[0]),__uint_as_float(rr[1]));
}
__device__ __forceinline__ void pv(f32x16*o,int vb,bf16x8 pa0,bf16x8 pa1,bf16x8 pa2,bf16x8 pa3){
  #pragma unroll
  for(int d0=0;d0<2;++d0){s16x4 lo[4],hi[4];
    #pragma unroll
    for(int ks=0;ks<4;++ks){
      asm volatile("ds_read_b64_tr_b16 %0,%1 offset:%c2":"=&v"(lo[ks]):"v"(vb),"i"(d0*4096+ks*1024):"memory");
      asm volatile("ds_read_b64_tr_b16 %0,%1 offset:%c2":"=&v"(hi[ks]):"v"(vb),"i"(d0*4096+ks*1024+512):"memory");}
    asm volatile("s_waitcnt lgkmcnt(0)":::"memory");SBAR();
    #define PK(k) (bf16x8){lo[k][0],lo[k][1],lo[k][2],lo[k][3],hi[k][0],hi[k][1],hi[k][2],hi[k][3]}
    o[d0]=__builtin_amdgcn_mfma_f32_32x32x16_bf16(pa0,PK(0),o[d0],0,0,0);
    o[d0]=__builtin_amdgcn_mfma_f32_32x32x16_bf16(pa1,PK(1),o[d0],0,0,0);
    o[d0]=__builtin_amdgcn_mfma_f32_32x32x16_bf16(pa2,PK(2),o[d0],0,0,0);
    o[d0]=__builtin_amdgcn_mfma_f32_32x32x16_bf16(pa3,PK(3),o[d0],0,0,0);
    #undef PK
  }
}

#ifndef ATTN_STORE16
#define ATTN_STORE16(p,v) (*(u32x4*)(p)=(v))
#endif
template<int THRL,bool WIN> __device__ __forceinline__ void attn_unit(const bf16*Qu,const bf16*__restrict__ Kh,const bf16*__restrict__ Vh,bf16*Ou,int NT,int shift,int qpos0,float sinkl2,char*shm,int tid){
  const int lane=tid&63,r32=lane&31,hi=lane>>5; const int wid=__builtin_amdgcn_readfirstlane(tid>>6);
  const bf16*Qw=Qu+(long)(wid*QBLK)*QP;
  const unsigned lds0=(unsigned)(uintptr_t)shm;
  float*wsf=(float*)(shm+LDS_WS)+wid*64;
  const bf16*ksrc=Kh+(long)lane*KP+wid*8;
  const bf16*vsrc=Vh+(long)(16*(wid&3)+(lane>>2))*KP+(wid>>2)*32+(lane&3)*8;
  const unsigned kdst=lds0+LDS_K+wid*1024, vdst=lds0+LDS_V+wid*1024;
  #define KROW(t) ((long)(((t)<4)?(t):((t)+shift))*(KVBLK*KP))
  #define DMA_K(t,slot) glds16(ksrc+KROW(t),(unsigned)__builtin_amdgcn_readfirstlane(kdst+(slot)))
  #define DMA_V(t,slot) glds16(vsrc+KROW(t),(unsigned)__builtin_amdgcn_readfirstlane(vdst+(slot)))
  const int vb0=(int)(lds0+LDS_V)+((lane>>4)&1)*32+(lane&3)*8+(4*hi+((lane&15)>>2))*64;
  const char*Kbase=shm+LDS_K; bf16x8 kf[8];
  const lds_cptr shm3=(lds_cptr)shm; const lds_cptr kp0=shm3+LDS_K+hi*1024+r32*16; const lds_cptr vp0=shm3+LDS_V+((lane>>4)&1)*32+(lane&3)*8+(4*hi+((lane&15)>>2))*64;
  DMA_K(0,0);DMA_V(0,0);DMA_K(1,SLOTB);
  bf16x8 qr[4];
  #pragma unroll
  for(int d0=0;d0<4;++d0)qr[d0]=*reinterpret_cast<const bf16x8*>(&Qw[(long)r32*QP+d0*16+hi*8]);
  float zf_=0.f;asm volatile("":"+v"(zf_)); float mhat=zf_,l_reg=zf_;f32x16 o[2];
  #pragma unroll
  for(int r=0;r<16;++r){o[0][r]=zf_;o[1][r]=zf_;}
  f32x16 negm;
  #pragma unroll
  for(int r=0;r<16;++r)negm[r]=zf_;
  asm volatile("":"+v"(negm));
  const int qrel=wid*QBLK+r32;
  const int mbase=4*hi-256-qpos0-qrel;
  #define CMASK(P0,P1,t) do{ if(WIN){ if((t)>=4) wmask(P0,P1,mbase+64*((t)+shift)); } }while(0)
  bool resc=false;
  #define START(P0,P1) do{ const float rm=rowmax(P0,P1); resc=false; \
    { const float dl=rm; mhat=fadd_s(mhat,dl); \
      _Pragma("unroll") for(int r=0;r<16;++r){P0[r]=fsub_s(P0[r],dl);P1[r]=fsub_s(P1[r],dl);} \
      _Pragma("unroll") for(int r=0;r<16;++r)negm[r]=-mhat; asm volatile("":"+v"(negm)); } \
    _Pragma("unroll") for(int r=0;r<16;++r)P0[r]=__builtin_amdgcn_exp2f(P0[r]); }while(0)
  #define RESC() do{ if(resc){ asm volatile("s_waitcnt lgkmcnt(0)":::"memory"); \
      _Pragma("unroll") for(int d_=0;d_<2;++d_) _Pragma("unroll") for(int r=0;r<16;++r)o[d_][r]*=wsf[crow(r,hi)]; } }while(0)
  f32x16 pA0,pA1,pB0,pB1;
  int sl_prev=0,sl_cur=0,sl_next=SLOTB;
  #define ROT() do{sl_prev=sl_cur;sl_cur=sl_next;sl_next=(sl_next==(NSLOT-1)*SLOTB)?0:sl_next+SLOTB;}while(0)
  DMA_K(2,2*SLOTB);
  WAIT_BAR(3);
  qkt(pA0,pA1,Kbase,qr,negm,r32,hi);asm volatile("s_nop 15\n\ts_nop 7":"+v"(pA0),"+v"(pA1));CMASK(pA0,pA1,0);
  START(pA0,pA1);
  _Pragma("unroll") for(int r=0;r<16;++r)pA1[r]=__builtin_amdgcn_exp2f(pA1[r]);
  WAIT_BAR(0);
  DMA_K(3,0);DMA_V(1,SLOTB);
  ROT();
  kload8(kf,kp0+sl_cur);
  WAIT_BAR(2);
  s16x4 vlo[8],vhi[8]; u32x4 pw0,pw1,pw2,pw3;
  #define PKW(P,B) cvtpk_s(P[B],P[B+1])
  #define PAF(k) __builtin_bit_cast(bf16x8,pw##k)
  #define VFR(i) (bf16x8){vlo[i][0],vlo[i][1],vlo[i][2],vlo[i][3],vhi[i][0],vhi[i][1],vhi[i][2],vhi[i][3]}
  #define PIN(x) asm volatile("":"+v"(x))
  #define MX3(a,b,c) __builtin_fmaxf(__builtin_fmaxf((a),(b)),(c))
  #define GAPA(MF,A0,A1,A2,A3,W0,W1,PW) do{ MF; sacc+=A0; sacc+=A1; sacc+=A2; sacc+=A3; PIN(sacc); W0; W1; PIN(PW); SBAR(); }while(0)
  #define EX(v) __builtin_amdgcn_exp2f(v)
  #define GAPB(MF,X,B) do{ MF; X[B]=EX(X[B]); X[B+1]=EX(X[B+1]); X[B+2]=EX(X[B+2]); X[B+3]=EX(X[B+3]); PIN(X); SBAR(); }while(0)
  #define VRD(i) do{ vlo[i]=vtr(vp_+(((i)>>2)*4096+((i)&3)*1024)); vhi[i]=vtr(vp_+(((i)>>2)*4096+((i)&3)*1024+512)); }while(0)
  #define KRD(G,j) do{ if(G){ kload2(kf,kp0+sl_next,j); SBAR(); } }while(0)
  #define STEP(C0,C1,P0,P1,t,GK,GV,GL) do{ SBAR(); \
    const lds_cptr vp_=vp0+sl_prev; \
    VRD(0); SBAR(); float sacc=(P0[0]+P0[1]); \
    GAPA(C0=__builtin_amdgcn_mfma_f32_32x32x16_bf16(kf[0],qr[0],negm,0,0,0), P0[2],P0[3],P0[4],P0[5],     pw0[0]=PKW(P0,0), pw0[1]=PKW(P0,2), pw0); \
    VRD(4); SBAR(); GAPA(C1=__builtin_amdgcn_mfma_f32_32x32x16_bf16(kf[1],qr[0],negm,0,0,0), P0[6],P0[7],P0[8],P0[9],     pw0[2]=PKW(P0,4), pw0[3]=PKW(P0,6), pw0); \
    VRD(1); SBAR(); GAPA(C0=__builtin_amdgcn_mfma_f32_32x32x16_bf16(kf[2],qr[1],C0,0,0,0),   P0[10],P0[11],P0[12],P0[13], pw1[0]=PKW(P0,8), pw1[1]=PKW(P0,10), pw1); \
    VRD(5); SBAR(); GAPA(C1=__builtin_amdgcn_mfma_f32_32x32x16_bf16(kf[3],qr[1],C1,0,0,0),   P0[14],P0[15],P1[0],P1[1],   pw1[2]=PKW(P0,12),pw1[3]=PKW(P0,14), pw1); \
    VRD(2); SBAR(); GAPA(C0=__builtin_amdgcn_mfma_f32_32x32x16_bf16(kf[4],qr[2],C0,0,0,0),   P1[2],P1[3],P1[4],P1[5],     pw2[0]=PKW(P1,0), pw2[1]=PKW(P1,2), pw2); \
    VRD(6); SBAR(); GAPA(C1=__builtin_amdgcn_mfma_f32_32x32x16_bf16(kf[5],qr[2],C1,0,0,0),   P1[6],P1[7],P1[8],P1[9],     pw2[2]=PKW(P1,4), pw2[3]=PKW(P1,6), pw2); \
    VRD(3); SBAR(); GAPA(C0=__builtin_amdgcn_mfma_f32_32x32x16_bf16(kf[6],qr[3],C0,0,0,0),   P1[10],P1[11],P1[12],P1[13], pw3[0]=PKW(P1,8), pw3[1]=PKW(P1,10), pw3); \
    VRD(7); SBAR(); GAPA(C1=__builtin_amdgcn_mfma_f32_32x32x16_bf16(kf[7],qr[3],C1,0,0,0),   P1[14],P1[15],0.f,0.f,       pw3[2]=PKW(P1,12),pw3[3]=PKW(P1,14), pw3); \
    l_reg+=sacc; \
    if(GK){DMA_K((t)+3,sl_cur);} if(GV){DMA_V((t)+1,sl_next);} \
    CMASK(C0,C1,t); \
    { float a=MX3(C0[0],C0[1],C1[0]),b=MX3(C0[2],C0[3],C1[1]); a=MX3(a,C1[2],C1[3]); \
      _Pragma("unroll") for(int r=4;r<16;r+=4){a=MX3(a,C0[r],C0[r+1]);b=MX3(b,C0[r+2],C0[r+3]);a=MX3(a,C1[r],C1[r+1]);b=MX3(b,C1[r+2],C1[r+3]);} \
      float rm=__builtin_fmaxf(a,b); { auto rr=__builtin_amdgcn_permlane32_swap(__float_as_uint(rm),__float_as_uint(rm),false,false); rm=__builtin_fmaxf(__uint_as_float(rr[0]),__uint_as_float(rr[1])); } \
      resc=false; \
      if(__builtin_expect(__any(rm>(float)THRL),0)){ const float dl=__builtin_fmaxf(rm,0.f); mhat+=dl; \
        _Pragma("unroll") for(int r=0;r<16;++r){C0[r]-=dl;C1[r]-=dl;} \
        _Pragma("unroll") for(int r=0;r<16;++r)negm[r]=-mhat; asm volatile("":"+v"(negm)); \
        const float f=__builtin_amdgcn_exp2f(-dl); l_reg*=f; if(hi==0)wsf[r32]=f; resc=true; } } \
    SBAR(); \
    GAPB(o[0]=__builtin_amdgcn_mfma_f32_32x32x16_bf16(PAF(0),VFR(0),o[0],0,0,0), C0,0); \
    GAPB(o[1]=__builtin_amdgcn_mfma_f32_32x32x16_bf16(PAF(0),VFR(4),o[1],0,0,0), C0,4); \
    KRD(GL,0); GAPB(o[0]=__builtin_amdgcn_mfma_f32_32x32x16_bf16(PAF(1),VFR(1),o[0],0,0,0), C0,8); \
    KRD(GL,1); GAPB(o[1]=__builtin_amdgcn_mfma_f32_32x32x16_bf16(PAF(1),VFR(5),o[1],0,0,0), C0,12); \
    KRD(GL,2); GAPB(o[0]=__builtin_amdgcn_mfma_f32_32x32x16_bf16(PAF(2),VFR(2),o[0],0,0,0), C1,0); \
    KRD(GL,3); GAPB(o[1]=__builtin_amdgcn_mfma_f32_32x32x16_bf16(PAF(2),VFR(6),o[1],0,0,0), C1,4); \
    GAPB(o[0]=__builtin_amdgcn_mfma_f32_32x32x16_bf16(PAF(3),VFR(3),o[0],0,0,0), C1,8); \
    GAPB(o[1]=__builtin_amdgcn_mfma_f32_32x32x16_bf16(PAF(3),VFR(7),o[1],0,0,0), C1,12); \
    }while(0)
  int t=1;
  for(;t+5<NT;t+=2){
    STEP(pB0,pB1,pA0,pA1,t,true,true,true);     WAIT_BAR(2); RESC(); ROT();
    STEP(pA0,pA1,pB0,pB1,t+1,true,true,true);   WAIT_BAR(2); RESC(); ROT();
  }
  #define ENDW(tt) do{ if((tt)+3<NT){WAIT_BAR(2);} else if((tt)+2<NT){WAIT_BAR(1);} else {WAIT_BAR(0);} }while(0)
  for(;t+1<NT;t+=2){
    STEP(pB0,pB1,pA0,pA1,t,(t+3<NT),(t+1<NT),(t+1<NT));       ENDW(t);   RESC(); ROT();
    STEP(pA0,pA1,pB0,pB1,t+1,(t+4<NT),(t+2<NT),(t+2<NT));     ENDW(t+1); RESC(); ROT();
  }
  STEP(pB0,pB1,pA0,pA1,NT-1,false,false,false); RESC();
  { float sacc=pB0[0]+pB0[1]; _Pragma("unroll") for(int r=2;r<16;++r)sacc+=pB0[r]; _Pragma("unroll") for(int r=0;r<16;++r)sacc+=pB1[r]; l_reg+=sacc;
    pw0=(u32x4){PKW(pB0,0),PKW(pB0,2),PKW(pB0,4),PKW(pB0,6)};pw1=(u32x4){PKW(pB0,8),PKW(pB0,10),PKW(pB0,12),PKW(pB0,14)};pw2=(u32x4){PKW(pB1,0),PKW(pB1,2),PKW(pB1,4),PKW(pB1,6)};pw3=(u32x4){PKW(pB1,8),PKW(pB1,10),PKW(pB1,12),PKW(pB1,14)};
    SBAR(); pv(o,vb0+sl_cur,PAF(0),PAF(1),PAF(2),PAF(3)); }
  #undef PKW
  #undef PAF
  #undef VFR
  #undef PIN
  #undef MX3
  #undef GAPA
  #undef GAPB
  #undef EX
  #undef VRD
  #undef KRD
  #undef STEP
  #undef ENDW
  {auto rr=__builtin_amdgcn_permlane32_swap(__float_as_uint(l_reg),__float_as_uint(l_reg),false,false);l_reg=__uint_as_float(rr[0])+__uint_as_float(rr[1]);}
  if(WIN)l_reg+=__builtin_amdgcn_exp2f(sinkl2-mhat);
  if(hi==0)wsf[32+r32]=l_reg;asm volatile("s_waitcnt lgkmcnt(0)":::"memory");
  float rli[16];
  #pragma unroll
  for(int r=0;r<16;++r)rli[r]=__builtin_amdgcn_rcpf(wsf[32+crow(r,hi)]);
  bf16*Ow=Ou+(long)(wid*QBLK)*OP;
  { bf16*stg=(bf16*)(shm+LDS_OST)+wid*2048;
    #pragma unroll
    for(int r=0;r<16;++r){const int orow=crow(r,hi);
      #pragma unroll
      for(int d0=0;d0<2;++d0)stg[orow*64+d0*32+r32]=__float2bfloat16(o[d0][r]*rli[r]);}
    asm volatile("s_waitcnt lgkmcnt(0)":::"memory");
    #pragma unroll
    for(int i=0;i<4;++i){const int row=i*8+(lane>>3),ch=lane&7; const u32x4 v=*(const u32x4*)(stg+row*64+ch*8); ATTN_STORE16(Ow+(long)row*OP+ch*8,v);} }
  asm volatile("s_waitcnt lgkmcnt(0)\n\ts_barrier":::"memory");
  #undef DMA_K
  #undef KROW
  #undef DMA_V
  #undef CMASK
  #undef START
  #undef RESC
  #undef ROT
}
constexpr int ATTN_LDS_BYTES=LDS_BYTES;
#undef SBAR
#undef WAIT_BAR
}
constexpr int NWAVES = 8;
constexpr int DM = 1024, NBATCH = 2, SEQ = 16384, CTXL = 256, TOK = SEQ + CTXL  , MR = NBATCH * TOK  ;
constexpr int DFF = 2816, NSUBMOD = 9216, DEPTH = 2;
constexpr float EPS = 1e-6f, LOG2E = 1.4426950408889634f;
constexpr int S5L = 32, S5ROWS = 1280  , S5CH = MR / S5L  , S5K = 768;

typedef unsigned short bf16;
typedef unsigned v4u __attribute__((ext_vector_type(4)));
typedef float f32x4 __attribute__((ext_vector_type(4)));
#define LAS __attribute__((address_space(3)))
#define LDS_WAIT() asm volatile("s_waitcnt lgkmcnt(0)" ::: "memory")
__device__ __forceinline__ unsigned f2bf(float f) { unsigned u = __builtin_bit_cast(unsigned, f); return (u + 0x7fffu + ((u >> 16) & 1u)) >> 16; }
__device__ __forceinline__ unsigned pk2(float lo, float hi) { return f2bf(lo) | (f2bf(hi) << 16); }
__device__ __forceinline__ float bf2f(unsigned short h) { return __builtin_bit_cast(float, (unsigned)h << 16); }
__device__ __forceinline__ float sigm(float x) { return __builtin_amdgcn_rcpf(1.0f + __builtin_amdgcn_exp2f(-x * LOG2E)); }

constexpr size_t MiB = 1u << 20;
constexpr size_t WS_MOD = 1 * MiB, WS_XC = 2 * MiB;
constexpr size_t WS_W1T = 4 * MiB, WS_W2T = 26 * MiB, WS_WINT = 37 * MiB, WS_WBT = 48 * MiB, WS_WOT = 50 * MiB, WS_WGT = 52 * MiB, WS_WPT = 52 * MiB + 256 * 1024;
constexpr size_t WS_BTY = 53 * MiB, WS_BTE = 65 * MiB, WS_E = 71 * MiB, WS_A2 = 91 * MiB, WS_HN = 121 * MiB, WS_T = 186 * MiB;
constexpr size_t WS_R = 251 * MiB;
constexpr size_t WS_HID = WS_R, WS_GS = WS_R, WS_Q = WS_R + 65 * MiB, WS_K = WS_Q + 65 * MiB / 2, WS_V = WS_K + 65 * MiB / 4, WS_XA = WS_V + 65 * MiB / 4, WS_G = WS_XA + 65 * MiB / 4,
                 WS_DIFF = WS_G + 65 * MiB / 4, WS_Y4 = WS_DIFF + 65 * MiB / 4, WS_END = WS_Y4 + 65 * MiB;
static_assert(WS_END <= 512 * MiB && WS_HID + (size_t)MR * DFF * 2 <= WS_Y4 + 65 * MiB, "ws map");
constexpr int RING_BYTES = 131072, LDS_BYTES = 147456;

struct Args { const float* in[26]; float* out; unsigned char* ws; int ph_lo, ph_hi; };
struct Frame { LAS unsigned char* lds; int lane, wave, vcu, G; };
typedef const volatile __attribute__((address_space(4))) unsigned long long karg_t;
__device__ __forceinline__ unsigned long long karg(int i) { return ((karg_t*)__builtin_amdgcn_kernarg_segment_ptr())[i]; }
#define AIN(i) ((const float*)karg(i))
#define AOUT ((float*)karg(26))
#define AWS ((unsigned char*)karg(27))
#define WSP(T, off) ((T*)(AWS + (off)))

__device__ __forceinline__ float* xrow_ptr(float* lat, float* ctxp, int r) { const int b = r / TOK, i = r - b * TOK; return i < CTXL ? ctxp + (size_t)(b * CTXL + i) * DM : lat + (size_t)(b * SEQ + i - CTXL) * DM; }

using pg8::f32x4; using pg8::Unit; using pg8::bf16_t; using pg8::cvt_pk_bf16; using pg8::u32x4;
#define EPI_ARGS const pg8::f32x4 (&acc)[2][2][4][2], const pg8::Unit& u, int wr, int wc, int fr_, int fq_
#define EPI_PIN int fr = fr_, fq = fq_; asm volatile("" : "+v"(fr), "+v"(fq));
struct EpiSwiglu { static constexpr bool PERM = true, AFTER_DRAIN = false; bf16_t* H;
    __device__ __forceinline__ void operator()(EPI_ARGS) const { EPI_PIN
        const int row0 = u.pm * 256 + wr * 64 + fr, hc = u.pn * 128 + wc * 32 + 8 * fq;
#pragma unroll
        for (int ai = 0; ai < 2; ++ai)
#pragma unroll
            for (int m = 0; m < 4; ++m) { bf16_t* rowp = H + (size_t)(row0 + ai * 128 + m * 16) * DFF + hc; float v[8];
#pragma unroll
                for (int n = 0; n < 2; ++n)
#pragma unroll
                    for (int j = 0; j < 4; ++j) { const float g = acc[ai][0][m][n][j], up = acc[ai][1][m][n][j]; v[n * 4 + j] = g * sigm(g) * up; }
                u32x4 w; w.x = cvt_pk_bf16(v[0], v[1]); w.y = cvt_pk_bf16(v[2], v[3]); w.z = cvt_pk_bf16(v[4], v[5]); w.w = cvt_pk_bf16(v[6], v[7]); *(u32x4*)rowp = w; }
    }
};
struct EpiResid { static constexpr bool PERM = true, AFTER_DRAIN = false; const float* src_lat; const float* src_ctx; float* dst_lat; float* dst_ctx; const float* gate; float sc;
    __device__ __forceinline__ void operator()(EPI_ARGS) const { EPI_PIN
        const int b = u.pm / 65, tq = u.pm - b * 65; const bool isc = tq == 0;
        const size_t off = isc ? (size_t)b * CTXL * DM : ((size_t)b * SEQ + (size_t)(tq - 1) * 256) * DM;
        const float* sp = (isc ? src_ctx : src_lat) + off; float* dp = (isc ? dst_ctx : dst_lat) + off;
        const float* gp = gate + (isc ? 2 : b) * NSUBMOD; const int col0 = u.pn * 256 + wc * 32 + 8 * fq;
        f32x4 gv[2][2];
#pragma unroll
        for (int bj = 0; bj < 2; ++bj)
#pragma unroll
            for (int n = 0; n < 2; ++n) gv[bj][n] = *(const f32x4*)(gp + col0 + bj * 128 + 4 * n) * sc;
#pragma unroll
        for (int ai = 0; ai < 2; ++ai)
#pragma unroll
            for (int m = 0; m < 4; ++m) { const size_t ro = (size_t)(ai * 128 + wr * 64 + m * 16 + fr) * DM + col0;
#pragma unroll
                for (int bj = 0; bj < 2; ++bj)
#pragma unroll
                    for (int n = 0; n < 2; ++n) { const f32x4 xv = *(const f32x4*)(sp + ro + bj * 128 + 4 * n); *(f32x4*)(dp + ro + bj * 128 + 4 * n) = xv + gv[bj][n] * acc[ai][bj][m][n]; } }
    }
};
__device__ __forceinline__ u32x4 pack8(const f32x4& a, const f32x4& b) { u32x4 w; w.x = cvt_pk_bf16(a[0], a[1]); w.y = cvt_pk_bf16(a[2], a[3]); w.z = cvt_pk_bf16(b[0], b[1]); w.w = cvt_pk_bf16(b[2], b[3]); return w; }
struct EpiRoute { static constexpr bool PERM = true, AFTER_DRAIN = false; bf16_t *Q, *K, *V, *A2, *XA;
    __device__ __forceinline__ void operator()(EPI_ARGS) const { EPI_PIN
        const int row0 = u.pm * 256 + wr * 64 + fr, cl = wc * 32 + 8 * fq;
        bf16_t* base; int ldc, coff = 0;
        if (u.pn == 0) { base = Q; ldc = 512; } else if (u.pn == 1) { base = Q; ldc = 512; coff = 256; } else if (u.pn == 2) { base = K; ldc = 256; } else if (u.pn == 3) { base = V; ldc = 256; } else { base = XA; ldc = 256; }
#pragma unroll
        for (int ai = 0; ai < 2; ++ai)
#pragma unroll
            for (int m = 0; m < 4; ++m) { const int row = row0 + ai * 128 + m * 16;
#pragma unroll
                for (int bj = 0; bj < 2; ++bj) { const u32x4 w = pack8(acc[ai][bj][m][0], acc[ai][bj][m][1]); const int c = bj * 128 + cl;
                    if (u.pn == 4) { const int g = c >> 4, h0 = c & 15; *(u32x4*)(A2 + ((size_t)g * S5ROWS + (row >> 5)) * S5K + (row & 31) * 16 + h0) = w; }
                    else *(u32x4*)(base + (size_t)row * ldc + coff + c) = w; } }
    }
};
struct EpiGate { static constexpr bool PERM = true, AFTER_DRAIN = false; bf16_t* GS;
    __device__ __forceinline__ void operator()(EPI_ARGS) const { EPI_PIN
        const int row0 = u.pm * 256 + wr * 64 + fr, col0 = u.pn * 256 + wc * 32 + 8 * fq;
#pragma unroll
        for (int ai = 0; ai < 2; ++ai)
#pragma unroll
            for (int m = 0; m < 4; ++m)
#pragma unroll
                for (int bj = 0; bj < 2; ++bj) { f32x4 a = acc[ai][bj][m][0], b = acc[ai][bj][m][1];
#pragma unroll
                    for (int j = 0; j < 4; ++j) { a[j] = sigm(a[j]); b[j] = sigm(b[j]); }
                    *(u32x4*)(GS + (size_t)(row0 + ai * 128 + m * 16) * DM + col0 + bj * 128) = pack8(a, b); }
    }
};
template <bool FIRST> struct EpiMerge { static constexpr bool PERM = true, AFTER_DRAIN = false; const bf16_t* GS; bf16_t* T;
    __device__ __forceinline__ void operator()(EPI_ARGS) const { EPI_PIN
        const int row0 = u.pm * 256 + wr * 64 + fr, col0 = u.pn * 256 + wc * 32 + 8 * fq;
#pragma unroll
        for (int ai = 0; ai < 2; ++ai)
#pragma unroll
            for (int m = 0; m < 4; ++m)
#pragma unroll
                for (int bj = 0; bj < 2; ++bj) { const size_t o = (size_t)(row0 + ai * 128 + m * 16) * DM + col0 + bj * 128;
                    const u32x4 g = *(const u32x4*)(GS + o); u32x4 t = {0u, 0u, 0u, 0u}; if (!FIRST) t = *(const u32x4*)(T + o);
                    f32x4 a = acc[ai][bj][m][0], b = acc[ai][bj][m][1];
#pragma unroll
                    for (int q = 0; q < 2; ++q) { const unsigned gw = g[q], tw = t[q], gw2 = g[q + 2], tw2 = t[q + 2];
                        a[2 * q] = __builtin_bit_cast(float, tw << 16) + (__builtin_bit_cast(float, gw << 16)) * a[2 * q]; a[2 * q + 1] = __builtin_bit_cast(float, tw & 0xffff0000u) + (__builtin_bit_cast(float, gw & 0xffff0000u)) * a[2 * q + 1];
                        b[2 * q] = __builtin_bit_cast(float, tw2 << 16) + (__builtin_bit_cast(float, gw2 << 16)) * b[2 * q]; b[2 * q + 1] = __builtin_bit_cast(float, tw2 & 0xffff0000u) + (__builtin_bit_cast(float, gw2 & 0xffff0000u)) * b[2 * q + 1]; }
                    *(u32x4*)(T + o) = pack8(a, b); }
    }
};
struct EpiPlain { static constexpr bool PERM = true, AFTER_DRAIN = false; bf16_t* O; int ldc;
    __device__ __forceinline__ void operator()(EPI_ARGS) const { EPI_PIN
        const int row0 = u.pm * 256 + wr * 64 + fr, col0 = u.pn * 256 + wc * 32 + 8 * fq;
#pragma unroll
        for (int ai = 0; ai < 2; ++ai)
#pragma unroll
            for (int m = 0; m < 4; ++m)
#pragma unroll
                for (int bj = 0; bj < 2; ++bj) *(u32x4*)(O + (size_t)(row0 + ai * 128 + m * 16) * ldc + col0 + bj * 128) = pack8(acc[ai][bj][m][0], acc[ai][bj][m][1]);
    }
};
struct EpiGlu { static constexpr bool PERM = true, AFTER_DRAIN = false; bf16_t* O;
    __device__ __forceinline__ void operator()(EPI_ARGS) const { EPI_PIN
        const int row0 = u.pm * 256 + wr * 64 + fr, col0 = u.pn * 128 + wc * 32 + 8 * fq;
#pragma unroll
        for (int ai = 0; ai < 2; ++ai)
#pragma unroll
            for (int m = 0; m < 4; ++m) { f32x4 a = acc[ai][0][m][0], b = acc[ai][0][m][1]; const f32x4 ga = acc[ai][1][m][0], gb = acc[ai][1][m][1];
#pragma unroll
                for (int j = 0; j < 4; ++j) { a[j] *= sigm(ga[j]); b[j] *= sigm(gb[j]); }
                *(u32x4*)(O + (size_t)(row0 + ai * 128 + m * 16) * 256 + col0) = pack8(a, b); }
    }
};
struct EpiF32 { static constexpr bool PERM = true, AFTER_DRAIN = false; float* O;
    __device__ __forceinline__ void operator()(EPI_ARGS) const { EPI_PIN
        const int row0 = u.pm * 256 + wr * 64 + fr, col0 = wc * 32 + 8 * fq;
#pragma unroll
        for (int ai = 0; ai < 2; ++ai)
#pragma unroll
            for (int m = 0; m < 4; ++m)
#pragma unroll
                for (int bj = 0; bj < 2; ++bj)
#pragma unroll
                    for (int n = 0; n < 2; ++n) *(f32x4*)(O + (size_t)(row0 + ai * 128 + m * 16) * 256 + col0 + bj * 128 + 4 * n) = acc[ai][bj][m][n];
    }
};
__device__ __forceinline__ float gelu_tanh(float x) { const float y = 0.7978845608028654f * (x + 0.044715f * x * x * x); return x * sigm(2.0f * y); }
struct EpiS5Y { static constexpr bool PERM = true, AFTER_DRAIN = false; bf16_t* Gb;
    __device__ __forceinline__ void operator()(EPI_ARGS) const { EPI_PIN
        const int g = u.pm / 5, i = u.pm - 5 * g, jn = u.pn & 1;
#pragma unroll
        for (int ai = 0; ai < 2; ++ai)
#pragma unroll
            for (int m = 0; m < 4; ++m) { const int cidx = i * 256 + ai * 128 + wr * 64 + m * 16 + fr;
                if (cidx < S5CH) {
#pragma unroll
                    for (int bj = 0; bj < 2; ++bj) { const int c = jn * 256 + bj * 128 + wc * 32 + 8 * fq, jo = c >> 4, h0 = c & 15; f32x4 a = acc[ai][bj][m][0], b = acc[ai][bj][m][1];
#pragma unroll
                        for (int j = 0; j < 4; ++j) { a[j] = gelu_tanh(a[j]); b[j] = gelu_tanh(b[j]); }
                        *(u32x4*)(Gb + (size_t)(cidx * S5L + jo) * 256 + g * 16 + h0) = pack8(a, b); } } }
    }
};
struct RowOrder { pg8::StaticOrder so; bool skip;
    __device__ void init(int N, int G, int c, bool skip_) { skip = skip_; so.init(skip_ ? NBATCH * SEQ : MR, N, G, c); }
    __device__ bool next(int i, Unit& u) const { if (!so.next(i, u)) return false; if (skip) u.pm = u.pm + 1 + (u.pm >> 6); return true; }
    __device__ __forceinline__ void a_ready(const Unit&) const {}
    __device__ __forceinline__ void done(const Unit&) const {}
};
struct CtxSliceOrder { int nsl, G, c;
    __device__ bool next(int i, Unit& u) const { const int L = i * G + c; if (L >= 8 * nsl) return false; const int t = L / nsl, sl = L - t * nsl; u.pm = (t >> 2) ? 65 : 0; u.pn = t & 3; u.k0 = sl * 256; return true; }
    __device__ __forceinline__ void a_ready(const Unit&) const {}
    __device__ __forceinline__ void done(const Unit&) const {}
};
struct EpiPart { static constexpr bool PERM = true, AFTER_DRAIN = false; float* P;
    __device__ __forceinline__ void operator()(EPI_ARGS) const { EPI_PIN
        const int sl = u.k0 >> 8, bb = u.pm ? 1 : 0; float* base = P + ((size_t)(sl * 2 + bb) * 256 + wr * 64 + fr) * DM + u.pn * 256 + wc * 32 + 8 * fq;
#pragma unroll
        for (int ai = 0; ai < 2; ++ai)
#pragma unroll
            for (int m = 0; m < 4; ++m)
#pragma unroll
                for (int bj = 0; bj < 2; ++bj)
#pragma unroll
                    for (int n = 0; n < 2; ++n) *(f32x4*)(base + (size_t)(ai * 128 + m * 16) * DM + bj * 128 + 4 * n) = acc[ai][bj][m][n];
    }
};
struct S5Order { int ncol, G, c;
    __device__ bool next(int i, Unit& u) const { const int L = i * G + c; if (L >= 80 * ncol) return false; const int g = L / (5 * ncol), rem = L - g * 5 * ncol; u.pm = g * 5 + rem / ncol; u.pn = g * ncol + rem % ncol; u.k0 = 0; return true; }
    __device__ __forceinline__ void a_ready(const Unit&) const {}
    __device__ __forceinline__ void done(const Unit&) const {}
};
__device__ __forceinline__ float shx(float v, int o, int lane) { return __builtin_bit_cast(float, __builtin_amdgcn_ds_bpermute((lane ^ o) << 2, __builtin_bit_cast(int, v))); }
__device__ __forceinline__ float wave_sum(float v, int lane) {
#pragma unroll
    for (int o = 1; o < 64; o <<= 1) v += shx(v, o, lane);
    return v;
}
__device__ __forceinline__ void tr_item(const float* W, int K, int ldw, int src_c0, bf16* WT, int dst_r0, int k0, LAS float* scr, int lane) {
    float tv[32];
#pragma unroll
    for (int i = 0; i < 32; ++i) { const int kk = 2 * i + (lane >> 5); tv[i] = W[(size_t)(k0 + kk) * ldw + src_c0 + (lane & 31)]; }
#pragma unroll
    for (int i = 0; i < 32; ++i) { const int kk = 2 * i + (lane >> 5); scr[kk * 33 + (lane & 31)] = tv[i]; }
    LDS_WAIT(); asm volatile("" ::: "memory");
    const int c = lane & 7;
#pragma unroll
    for (int j = 0; j < 4; ++j) { const int n = (lane >> 3) + 8 * j; const LAS float* s = scr + (8 * c) * 33 + n;
        v4u o; o.x = pk2(s[0 * 33], s[1 * 33]); o.y = pk2(s[2 * 33], s[3 * 33]); o.z = pk2(s[4 * 33], s[5 * 33]); o.w = pk2(s[6 * 33], s[7 * 33]);
        *(v4u*)(WT + (size_t)(dst_r0 + n) * K + k0 + 8 * c) = o; }
    LDS_WAIT(); asm volatile("" ::: "memory");
}
constexpr int CONV_ITEMS = 2 * 2816 + 2 * 1408 + 2816 + 4 * 128 + 512 + 64;
__device__ __forceinline__ void conv_item(Frame& F, int l, int it, LAS float* scr) {
    int r = it; const int lane = F.lane;
    if (r < 5632) { const int f = r / 2816; r -= f * 2816; const int kb = r / 176, n0 = (r % 176) * 32, pn = n0 >> 8, bj = (n0 >> 7) & 1, q = n0 & 127;
        tr_item(AIN(7) + (size_t)(l * 2 + f) * DM * 5632, DM, 5632, bj * DFF + 128 * pn + q, WSP(bf16, WS_W1T) + (size_t)f * 5632 * DM, n0, kb * 64, scr, lane); return; } r -= 5632;
    if (r < 2816) { const int f = r / 1408; r -= f * 1408; const int kb = r / 32, n0 = (r % 32) * 32;
        tr_item(AIN(8) + (size_t)(l * 2 + f) * DFF * DM, DFF, DM, n0, WSP(bf16, WS_W2T) + (size_t)f * DM * DFF, n0, kb * 64, scr, lane); return; } r -= 2816;
    if (r < 2816) { const int kb = r / 176, n0 = (r % 176) * 32; int src;
        if (n0 >= 1536) src = n0; else { const int t = n0 >> 8, off = n0 & 255;
            src = t == 0 ? 768 + off : t == 1 ? 1024 + off : t == 2 ? (off < 128 ? off : 512 + off - 128) : t == 3 ? (off < 128 ? 128 + off : 640 + off - 128) : t == 4 ? 256 + off : 1280 + off; }
        tr_item(AIN(9) + (size_t)l * DM * 5632, DM, 5632, src, WSP(bf16, WS_WINT), n0, kb * 64, scr, lane); return; } r -= 2816;
    if (r < 512) { const int k = r / 128; r -= k * 128; const int kb = r / 32, n0 = (r % 32) * 32;
        tr_item(AIN(23) + (size_t)(l * 4 + k) * 256 * DM, 256, DM, n0, WSP(bf16, WS_WBT) + (size_t)k * DM * 256, n0, kb * 64, scr, lane); return; } r -= 512;
    if (r < 512) { const int kb = r / 32, n0 = (r % 32) * 32;
        tr_item(AIN(24) + (size_t)l * DM * DM, DM, DM, n0, WSP(bf16, WS_WOT), n0, kb * 64, scr, lane); return; } r -= 512;
    { const int kb = r / 16, n0 = (r % 16) * 32, pn = n0 >> 8, bj = (n0 >> 7) & 1, q = n0 & 127;
        tr_item(AIN(22) + (size_t)l * 256 * 512, 256, 512, bj * 256 + 128 * pn + q, WSP(bf16, WS_WGT), n0, kb * 64, scr, lane); }
}
__device__ __forceinline__ void s5_table_item(Frame& F, int l, int item4, LAS float* scr) {
    const int item = item4 >> 2, qt = item4 & 3; const int g = item >> 5, j = item & 31, lane = F.lane, p = lane;
    bf16* BtY = WSP(bf16, WS_BTY) + (size_t)g * 512 * S5K; bf16* BtE = WSP(bf16, WS_BTE) + (size_t)g * 256 * S5K;
    float lre[2], lim[2], cfr[2], cfi[2], are[2], aim[2], dtv[2];
#pragma unroll
    for (int d = 0; d < 2; ++d) { const int ix = ((l * 2 + d) * 16 + g) * 64 + p; are[d] = AIN(14)[ix]; aim[d] = AIN(15)[ix]; dtv[d] = expf(AIN(16)[(l * 2 + d) * 16 + g]);
        const float mg = expf(are[d] * dtv[d]); float sn, cs; sincosf(aim[d] * dtv[d], &sn, &cs); const float br = mg * cs - 1.0f, bi = mg * sn; const float den = 1.0f / (are[d] * are[d] + aim[d] * aim[d]);
        cfr[d] = (br * are[d] + bi * aim[d]) * den; cfi[d] = (bi * are[d] - br * aim[d]) * den; }
#define LAMPOW(d, e, outr, outi) do { const float mg_ = expf(are[d] * dtv[d] * (float)(e)); float sn_, cs_; sincosf(aim[d] * dtv[d] * (float)(e), &sn_, &cs_); outr = mg_ * cs_; outi = mg_ * sn_; } while (0)
#pragma unroll
    for (int d = 0; d < 2; ++d) { float pr, pi; LAMPOW(d, j, pr, pi); scr[(d * 64 + p) * 2] = pr * cfr[d] - pi * cfi[d]; scr[(d * 64 + p) * 2 + 1] = pr * cfi[d] + pi * cfr[d]; }
    LDS_WAIT(); asm volatile("" ::: "memory");
    const int hi_ = lane & 15;
    { const int i2 = qt; const int ho = (lane >> 4) + 4 * i2; float kv[2];
#pragma unroll
        for (int d = 0; d < 2; ++d) { const float* cr = AIN(19) + (((size_t)(l * 2 + d) * 16 + g) * 16 + ho) * 64; const float* ci = AIN(20) + (((size_t)(l * 2 + d) * 16 + g) * 16 + ho) * 64;
            const float* br = AIN(17) + ((size_t)(l * 2 + d) * 16 + g) * 64 * 16 + hi_; const float* bi = AIN(18) + ((size_t)(l * 2 + d) * 16 + g) * 64 * 16 + hi_; float s = 0.f;
#pragma unroll 16
            for (int pp = 0; pp < 64; ++pp) { const float zr = scr[(d * 64 + pp) * 2], zi = scr[(d * 64 + pp) * 2 + 1], b_r = br[pp * 16], b_i = bi[pp * 16];
                const float wr_ = zr * b_r - zi * b_i, wi_ = zr * b_i + zi * b_r; s += cr[pp] * wr_ - ci[pp] * wi_; }
            kv[d] = s; }
        if (j == 0) { const float v = kv[0] + kv[1] + (ho == hi_ ? AIN(21)[l * 256 + g * 16 + ho] : 0.f);
            for (int q = 0; q < 32; ++q) BtY[(size_t)(q * 16 + ho) * S5K + q * 16 + hi_] = (bf16)f2bf(v); }
        else { const bf16 vf = (bf16)f2bf(kv[0]), vb = (bf16)f2bf(kv[1]);
            for (int q = 0; q + j < 32; ++q) { BtY[(size_t)((q + j) * 16 + ho) * S5K + q * 16 + hi_] = vf; BtY[(size_t)(q * 16 + ho) * S5K + (q + j) * 16 + hi_] = vb; } }
    }
    { const int d = qt >> 1; float pr, pi; LAMPOW(d, (d == 0 ? j + 1 : S5L - j), pr, pi);
#pragma unroll
        for (int ho = (qt & 1) * 8; ho < (qt & 1) * 8 + 8; ++ho) { const size_t ci_ = (((size_t)(l * 2 + d) * 16 + g) * 16 + ho) * 64 + p; const float c_r = AIN(19)[ci_], c_i = AIN(20)[ci_];
            bf16* row = BtY + (size_t)(j * 16 + ho) * S5K + 512 + d * 128; row[p] = (bf16)f2bf(c_r * pr - c_i * pi); row[64 + p] = (bf16)f2bf(-(c_r * pi + c_i * pr)); } }
    { const int d = qt >> 1, hh0 = (qt & 1) * 8; float pr, pi; LAMPOW(d, (d == 0 ? S5L - 1 - j : j), pr, pi); const float zr = pr * cfr[d] - pi * cfi[d], zi = pr * cfi[d] + pi * cfr[d];
        const size_t bi_ = (((size_t)(l * 2 + d) * 16 + g) * 64 + p) * 16 + hh0; unsigned wre[4], wim[4];
#pragma unroll
        for (int h4 = 0; h4 < 2; ++h4) { const f32x4 b_r = *(const f32x4*)(AIN(17) + bi_ + 4 * h4), b_i = *(const f32x4*)(AIN(18) + bi_ + 4 * h4);
            wre[2 * h4] = pk2(zr * b_r.x - zi * b_i.x, zr * b_r.y - zi * b_i.y); wre[2 * h4 + 1] = pk2(zr * b_r.z - zi * b_i.z, zr * b_r.w - zi * b_i.w);
            wim[2 * h4] = pk2(zr * b_i.x + zi * b_r.x, zr * b_i.y + zi * b_r.y); wim[2 * h4 + 1] = pk2(zr * b_i.z + zi * b_r.z, zr * b_i.w + zi * b_r.w); }
        *(v4u*)(BtE + (size_t)(d * 128 + p) * S5K + j * 16 + hh0) = (v4u){wre[0], wre[1], wre[2], wre[3]};
        *(v4u*)(BtE + (size_t)(d * 128 + 64 + p) * S5K + j * 16 + hh0) = (v4u){wim[0], wim[1], wim[2], wim[3]}; }
    for (int q = lane; q < 2 * 256; q += 64) BtE[(size_t)(8 * j + 2 * qt + (q >> 8)) * S5K + 512 + (q & 255)] = 0;
#undef LAMPOW
    LDS_WAIT(); asm volatile("" ::: "memory");
}
__device__ __forceinline__ void prep_layer(Frame& F, int l) {
    LAS float* scr = (LAS float*)(F.lds + F.wave * 16384);
    const int gw = F.vcu * NWAVES + F.wave, NGW = F.G * NWAVES;
    for (int it = gw; it < CONV_ITEMS; it += NGW) conv_item(F, l, it, scr);
    for (int it = NGW - 1 - gw; it < 2048; it += NGW) s5_table_item(F, l, it, scr);
    const int gt = gw * 64 + F.lane, NGT = NGW * 64;
    { bf16* Wp = WSP(bf16, WS_WPT); const float* pw = AIN(12) + (size_t)l * 4 * 64 * 64; const float* ps = AIN(13) + l * 256;
      for (int e = gt; e < 65536; e += NGT) { const int n = e >> 8, k = e & 255; Wp[e] = (bf16)(((n >> 6) == (k >> 6)) ? f2bf(pw[((n >> 6) * 64 + (k & 63)) * 64 + (n & 63)] * ps[n]) : 0u); } }
    { bf16* A2 = WSP(bf16, WS_A2); unsigned z_ = 0u; asm volatile("" : "+v"(z_)); for (int e = gt; e < 16 * S5ROWS * 32; e += NGT) { const int row = e >> 5, c8 = e & 31; *(v4u*)(A2 + (size_t)row * S5K + 512 + c8 * 8) = (v4u){z_, z_, z_, z_}; } }
}
__device__ __forceinline__ void mod_phase(Frame& F) {
    LAS float* red = (LAS float*)F.lds;
    for (int it = F.vcu; it < DEPTH * (NSUBMOD / 64); it += F.G) { const int l = it / (NSUBMOD / 64), n = (it % (NSUBMOD / 64)) * 64 + F.lane;
        const float* w = AIN(4) + ((size_t)l * DM + F.wave * 128) * NSUBMOD + n; float a0 = 0.f, a1 = 0.f, a2 = 0.f;
#pragma unroll 16
        for (int k = 0; k < 128; ++k) { const int kk = F.wave * 128 + k; const float c0 = AIN(1)[kk], c1 = AIN(1)[DM + kk], c2 = AIN(3)[kk]; const float wv = w[(size_t)k * NSUBMOD];
            a0 += c0 * sigm(c0) * wv; a1 += c1 * sigm(c1) * wv; a2 += c2 * sigm(c2) * wv; }
        red[(F.wave * 3 + 0) * 64 + F.lane] = a0; red[(F.wave * 3 + 1) * 64 + F.lane] = a1; red[(F.wave * 3 + 2) * 64 + F.lane] = a2;
        __syncthreads();
        if (F.wave < 3) { float s = AIN(5)[l * NSUBMOD + n];
#pragma unroll
            for (int w8 = 0; w8 < 8; ++w8) s += red[(w8 * 3 + F.wave) * 64 + F.lane];
            WSP(float, WS_MOD)[((size_t)l * 3 + F.wave) * NSUBMOD + n] = s; }
        __syncthreads();
    }
}
__device__ __forceinline__ void norm_phase(Frame& F, int l, int sub, const float* lat, const float* ctxp, const float* part = nullptr, int nsl = 0, const float* pgate = nullptr, float psc = 0.f, const float* psrc = nullptr, float* pdst = nullptr) {
    const int gw = F.vcu * NWAVES + F.wave, NGW = F.G * NWAVES; const float* gptr = AIN(6) + (size_t)(l * 3 + sub) * DM; bf16* HN = WSP(bf16, WS_HN);
    for (int r0 = gw; r0 < MR; r0 += 2 * NGW) { f32x4 v[2][4]; float s[2]; const float* mod[2]; int rr[2];
#pragma unroll
        for (int q2 = 0; q2 < 2; ++q2) { int r = r0 + q2 * NGW; if (r >= MR) r = r0; rr[q2] = r; const int b = r / TOK, i = r - b * TOK;
            const float* xr = i < CTXL ? ctxp + (size_t)(b * CTXL + i) * DM : lat + (size_t)(b * SEQ + i - CTXL) * DM;
            mod[q2] = WSP(float, WS_MOD) + ((size_t)l * 3 + (i < CTXL ? 2 : b)) * NSUBMOD + sub * 3072; s[q2] = 0.f;
            if (part != nullptr && i < CTXL) { const size_t ro = (size_t)(b * CTXL + i) * DM;
#pragma unroll
                for (int j = 0; j < 4; ++j) { f32x4 a = {0.f, 0.f, 0.f, 0.f};
                    for (int sl = 0; sl < nsl; ++sl) a += *((const f32x4*)(part + (size_t)sl * 2 * CTXL * DM + ro) + F.lane + 64 * j);
                    const f32x4 o = *((const f32x4*)(psrc + ro) + F.lane + 64 * j) + (*((const f32x4*)pgate + F.lane + 64 * j) * psc) * a;
                    if (q2 == 0 || r != r0) *((f32x4*)(pdst + ro) + F.lane + 64 * j) = o; v[q2][j] = o; } }
            else {
#pragma unroll
                for (int j = 0; j < 4; ++j) v[q2][j] = *((const f32x4*)xr + F.lane + 64 * j); } }
#pragma unroll
        for (int q2 = 0; q2 < 2; ++q2) {
#pragma unroll
            for (int j = 0; j < 4; ++j) s[q2] += (v[q2][j].x * v[q2][j].x + v[q2][j].y * v[q2][j].y) + (v[q2][j].z * v[q2][j].z + v[q2][j].w * v[q2][j].w);
            const float rstd = 1.0f / sqrtf(wave_sum(s[q2], F.lane) * (1.0f / DM) + EPS);
            if (q2 == 0 || rr[1] != rr[0]) {
#pragma unroll
                for (int j = 0; j < 4; ++j) { const f32x4 gg = *((const f32x4*)gptr + F.lane + 64 * j), sh = *((const f32x4*)mod[q2] + F.lane + 64 * j), sc = *((const f32x4*)(mod[q2] + DM) + F.lane + 64 * j);
                    const f32x4 o = (v[q2][j] * rstd * gg) * (sc + 1.0f) + sh;
                    *((unsigned long long*)(HN + (size_t)rr[q2] * DM) + F.lane + 64 * j) = (unsigned long long)pk2(o.x, o.y) | ((unsigned long long)pk2(o.z, o.w) << 32); } } }
    }
}
__device__ __forceinline__ void final_norm_phase(Frame& F) {
    const int gw = F.vcu * NWAVES + F.wave, NGW = F.G * NWAVES; const float* gptr = AIN(25);
    for (int r = gw; r < NBATCH * SEQ; r += NGW) { float* xr = AOUT + (size_t)r * DM; f32x4 v[4]; float s = 0.f;
#pragma unroll
        for (int j = 0; j < 4; ++j) { v[j] = *((const f32x4*)xr + F.lane + 64 * j); s += (v[j].x * v[j].x + v[j].y * v[j].y) + (v[j].z * v[j].z + v[j].w * v[j].w); }
        const float rstd = 1.0f / sqrtf(wave_sum(s, F.lane) * (1.0f / DM) + EPS);
#pragma unroll
        for (int j = 0; j < 4; ++j) { const f32x4 gg = *((const f32x4*)gptr + F.lane + 64 * j); *((f32x4*)xr + F.lane + 64 * j) = v[j] * rstd * gg; }
    }
}
__device__ __forceinline__ void post_phase(Frame& F, int l) {
    const int gw = F.vcu * NWAVES + F.wave, NGW = F.G * NWAVES, lane = F.lane, hh = lane >> 4, d = lane & 15;
    bf16* Q = WSP(bf16, WS_Q); bf16* K = WSP(bf16, WS_K); const bf16* XA = WSP(bf16, WS_XA); bf16* DF = WSP(bf16, WS_DIFF);
    const float inv = exp2f(-(float)d * (13.287712379549449f / 16.0f));
    const float* qg = AIN(11) + (size_t)l * 128; const float* kg = qg + 64;
    for (int r = gw; r < MR; r += NGW) { const int b = r / TOK, i = r - b * TOK; const bool lat = i >= CTXL; const int t = i - CTXL;
        const int n = lat ? SEQ : CTXL, ts = lat ? t : i; const size_t seg0 = (size_t)(r - ts); float pd[4];
#pragma unroll
        for (int j = 0; j < 4; ++j) { const int w = 2 << j; int lo = ts - (w >> 1), hi2 = lo + w; lo = lo < 0 ? 0 : lo; hi2 = hi2 > n ? n : hi2; float s = 0.f;
            for (int q2 = lo; q2 < hi2; ++q2) s += bf2f(XA[(seg0 + q2) * 256 + j * 64 + lane]);
            pd[j] = s / (float)(hi2 - lo) - bf2f(XA[(size_t)r * 256 + j * 64 + lane]); }
        float x[3][4];
#pragma unroll
        for (int it = 0; it < 3; ++it) { const bf16* p = it < 2 ? Q + (size_t)r * 512 + (it * 4 + hh) * 64 + d : K + (size_t)r * 256 + hh * 64 + d;
            x[it][0] = bf2f(p[0]); x[it][1] = bf2f(p[16]); x[it][2] = bf2f(p[32]); x[it][3] = bf2f(p[48]); }
        float cr = 1.f, sr = 0.f, cc = 1.f, sc = 0.f;
        if (lat) { sincosf((float)(t >> 6) * inv, &sr, &cr); sincosf((float)(t & 63) * inv, &sc, &cc); }
#pragma unroll
        for (int it = 0; it < 3; ++it) { float x0 = x[it][0], x1 = x[it][1], x2 = x[it][2], x3 = x[it][3];
            const bool nrm = (it == 1) || (it == 2 && hh >= 2);
            float ss = (x0 * x0 + x1 * x1) + (x2 * x2 + x3 * x3);
            ss += shx(ss, 1, lane); ss += shx(ss, 2, lane); ss += shx(ss, 4, lane); ss += shx(ss, 8, lane);
            if (nrm) { const float rs = 1.0f / sqrtf(ss * (1.0f / 64.0f) + EPS); const float* gp = it == 1 ? qg : kg; x0 *= rs * gp[d]; x1 *= rs * gp[d + 16]; x2 *= rs * gp[d + 32]; x3 *= rs * gp[d + 48]; }
            float o0 = x0 * cr - x1 * sr, o1 = x1 * cr + x0 * sr, o2 = x2 * cc - x3 * sc, o3 = x3 * cc + x2 * sc;
            if (it < 2) { o0 *= attn_body::C2; o1 *= attn_body::C2; o2 *= attn_body::C2; o3 *= attn_body::C2; }
            x[it][0] = o0; x[it][1] = o1; x[it][2] = o2; x[it][3] = o3; }
#pragma unroll
        for (int it = 0; it < 3; ++it) { bf16* p = it < 2 ? Q + (size_t)r * 512 + (it * 4 + hh) * 64 + d : K + (size_t)r * 256 + hh * 64 + d;
            p[0] = (bf16)f2bf(x[it][0]); p[16] = (bf16)f2bf(x[it][1]); p[32] = (bf16)f2bf(x[it][2]); p[48] = (bf16)f2bf(x[it][3]); }
#pragma unroll
        for (int j = 0; j < 4; ++j) DF[(size_t)r * 256 + j * 64 + lane] = (bf16)f2bf(pd[j]);
    }
}
__device__ __forceinline__ void s5_carry_phase(Frame& F, int l) {
    const int cid = (int)blockIdx.x - (F.G - 64);
    if (F.wave != 0 || cid < 0) return;
    const int b = cid >> 5, d = (cid >> 4) & 1, g = cid & 15, p = F.lane;
    const int ix = ((l * 2 + d) * 16 + g) * 64 + p; const float are = AIN(14)[ix], aim = AIN(15)[ix], dt = expf(AIN(16)[(l * 2 + d) * 16 + g]);
    const float mg = expf(are * dt * (float)S5L); float sn, cs; sincosf(aim * dt * (float)S5L, &sn, &cs); const float Lr = mg * cs, Li = mg * sn;
    const float* E = WSP(float, WS_E) + (size_t)g * S5ROWS * 256 + d * 128 + p; bf16* A2 = WSP(bf16, WS_A2) + (size_t)g * S5ROWS * S5K + 512 + d * 128 + p;
    float sr = 0.f, si = 0.f;
#pragma unroll 1
    for (int k0 = 0; k0 < 520; k0 += 65) { float er[65], ei[65];
#pragma unroll
        for (int k = 0; k < 65; ++k) { const int kk = k0 + k; const int ch = d == 0 ? kk : (kk < 8 ? 7 - kk : 527 - kk); const size_t row = (size_t)b * 520 + ch; er[k] = E[row * 256]; ei[k] = E[row * 256 + 64]; }
#pragma unroll
        for (int k = 0; k < 65; ++k) { const int kk = k0 + k; const int ch = d == 0 ? kk : (kk < 8 ? 7 - kk : 527 - kk); const size_t row = (size_t)b * 520 + ch;
            A2[row * S5K] = (bf16)f2bf(sr); A2[row * S5K + 64] = (bf16)f2bf(si);
            const float nr = Lr * sr - Li * si + er[k], ni = Lr * si + Li * sr + ei[k]; sr = nr; si = ni; } }
}
__device__ __forceinline__ void attn_one(Frame& F, int l, int kind, int b, int h, int qb, char* lds) {
    using namespace attn_body;
    const attn_body::bf16* Q = (const attn_body::bf16*)WSP(::bf16, WS_Q); const attn_body::bf16* K = (const attn_body::bf16*)WSP(::bf16, WS_K); const attn_body::bf16* V = (const attn_body::bf16*)WSP(::bf16, WS_V);
    attn_body::bf16* O = (attn_body::bf16*)WSP(::bf16, WS_Y4) + (size_t)(kind == 0 ? 1 : 3) * MR * 256;
    const size_t row0 = (size_t)b * TOK + (size_t)qb * 256;
    const attn_body::bf16* Qu = Q + row0 * 512 + kind * 256 + h * 64; const attn_body::bf16* Kh = K + (size_t)b * TOK * 256 + kind * 128 + (h >> 1) * 64; const attn_body::bf16* Vh = V + (size_t)b * TOK * 256 + kind * 128 + (h >> 1) * 64;
    attn_body::bf16* Ou = O + row0 * 256 + h * 64;
    if (kind == 0) { int NT = 4, shift = 0;
        if (qb > 0) { const int lo = (4 * qb - 2) < 4 ? 4 : (4 * qb - 2), hi = (4 * qb + 5) > 259 ? 259 : (4 * qb + 5); NT = 4 + hi - lo + 1; shift = lo - 4; }
        attn_unit<8, true>(Qu, Kh, Vh, Ou, NT, shift, (qb - 1) * 256, AIN(10)[l * 4 + h] * LOG2E, lds, F.wave * 64 + F.lane);
    } else attn_unit<8, false>(Qu, Kh, Vh, Ou, qb > 0 ? 260 : 4, 0, 0, 0.f, lds, F.wave * 64 + F.lane);
}
__device__ __forceinline__ void attn_phase(Frame& F, int l, char* lds) {
    const int c = F.vcu;
#pragma unroll 1
    for (int u = c; u < 512; u += F.G) attn_one(F, l, 0, u >> 8, (u >> 6) & 3, 1 + (u & 63), lds);
#pragma unroll 1
    for (int u = c; u < 16; u += F.G) attn_one(F, l, u >> 3, (u >> 2) & 1, u & 3, 0, lds);
#pragma unroll 1
    for (int u = c; u < 512; u += F.G) attn_one(F, l, 1, u >> 8, (u >> 6) & 3, 1 + (u & 63), lds);
}

#define XB_TMO      128
#define XB_XCNT(j)  (256  + 64 * (j))
#define XB_XSUB(j)  (1280 + 64 * (j))
#define XB_XGEN(j)  (2304 + 64 * (j))
#define XB_TOP      3328
#define XB_TOPGEN   3392
#define XCD_BAR_WORDS 3456
#define XB_SPIN_CAP (1u << 18)

__device__ __forceinline__ unsigned xb_ld(unsigned* p)              { return __hip_atomic_load(p, __ATOMIC_RELAXED, __HIP_MEMORY_SCOPE_AGENT); }
__device__ __forceinline__ unsigned xb_add(unsigned* p, unsigned v) { return __hip_atomic_fetch_add(p, v, __ATOMIC_RELAXED, __HIP_MEMORY_SCOPE_AGENT); }
__device__ __forceinline__ unsigned xb_xcc_id() { return (unsigned)__builtin_amdgcn_s_getreg((3 << 11) | 20) & 0xFu; }
#define XB_SPIN(cond, bar) do { unsigned _sp = 0; while (cond) { __builtin_amdgcn_s_sleep(1); \
    if ((++_sp & 255u) == 0u) { if (xb_ld(&(bar)[XB_TMO])) break; if (_sp > XB_SPIN_CAP) { atomicAdd(&(bar)[XB_TMO], 1u); break; } } } } while (0)

struct XcdBarrier {
    unsigned* bar; unsigned x;
    volatile LAS unsigned* st;
};

__device__ __forceinline__ XcdBarrier xcd_barrier_post(unsigned* bar, volatile LAS unsigned* st) {
    XcdBarrier b; b.bar = bar; b.x = xb_xcc_id(); b.st = st;
    if (threadIdx.x == 0) (void)xb_add(&bar[XB_XCNT(b.x)], 1u);
    return b;
}
__device__ __forceinline__ void xcd_barrier_complete(unsigned* bar, unsigned x, unsigned& nloc, unsigned& nx) {
    const unsigned G = gridDim.x * gridDim.y * gridDim.z;
    unsigned sum, cnt, mine, sp = 0u;
    for (;;) {
        sum = 0u; cnt = 0u; mine = 0u;
#pragma unroll
        for (unsigned j = 0; j < 16; ++j) { const unsigned c = xb_ld(&bar[XB_XCNT(j)]); sum += c; cnt += (c > 0u) ? 1u : 0u; mine = (j == x) ? c : mine; }
        if (sum == G) break;
        __builtin_amdgcn_s_sleep(1);
        if ((++sp & 255u) == 0u) { if (xb_ld(&bar[XB_TMO])) break; if (sp > XB_SPIN_CAP) { atomicAdd(&bar[XB_TMO], 1u); break; } }
    }
    nloc = mine > 0u ? mine : 1u; nx = cnt > 0u ? cnt : 1u;
}

__device__ __forceinline__ void xcd_barrier(const XcdBarrier& b) {
    asm volatile("s_waitcnt vmcnt(0)" ::: "memory");
    __syncthreads();
    if (threadIdx.x == 0) {
        unsigned* bar = b.bar;
        __builtin_amdgcn_s_waitcnt(0);
        unsigned nloc = b.st[0], nx = b.st[1];
        if (nloc == 0u) { xcd_barrier_complete(bar, b.x, nloc, nx); b.st[0] = nloc; b.st[1] = nx; }
        const unsigned old = xb_add(&bar[XB_XSUB(b.x)], 1u);
        const unsigned gen = old / nloc;
        if (old + 1u == (gen + 1u) * nloc) {
            __builtin_amdgcn_fence(__ATOMIC_RELEASE, "agent");
            asm volatile("s_waitcnt vmcnt(0)" ::: "memory");
            const unsigned og = xb_add(&bar[XB_TOP], 1u);
            const unsigned tg = og / nx;
            if (og + 1u == (tg + 1u) * nx) xb_add(&bar[XB_TOPGEN], 1u);
            else XB_SPIN(xb_ld(&bar[XB_TOPGEN]) == tg, bar);
            __builtin_amdgcn_fence(__ATOMIC_ACQUIRE, "agent");
            xb_add(&bar[XB_XGEN(b.x)], 1u);
            asm volatile("s_waitcnt vmcnt(0)" ::: "memory");
        } else {
            XB_SPIN(xb_ld(&bar[XB_XGEN(b.x)]) == gen, bar);
            __builtin_amdgcn_fence(__ATOMIC_ACQUIRE, "agent");
            asm volatile("s_waitcnt vmcnt(0)" ::: "memory");
        }
    }
    __syncthreads();
}

constexpr size_t WS_BAR = 16384;
#ifndef MK_SPLIT
#define MK_SPLIT 0
#endif
constexpr int N_PHASES = 2 + DEPTH * 14 + 1;
__global__ void __launch_bounds__(NWAVES * 64, 2) mk_fwd(Args args) {
    extern __shared__ __attribute__((aligned(16))) unsigned char lds[];
    Frame F;
    F.lds = (LAS unsigned char*)lds; F.lane = 0; F.wave = __builtin_amdgcn_readfirstlane(threadIdx.x >> 6);
    F.G = gridDim.x; { const int bx = blockIdx.x; F.vcu = (F.G % 8 == 0) ? (bx % 8) * (F.G / 8) + bx / 8 : bx; }
    { volatile LAS unsigned* st_ = (volatile LAS unsigned*)(F.lds + RING_BYTES + 512); if (threadIdx.x < 2) st_[threadIdx.x] = 0u; __syncthreads();
      (void)xcd_barrier_post((unsigned*)(AWS + WS_BAR), st_); }
    const int lo = args.ph_lo, hi = args.ph_hi; int ph = 0;
#ifndef ONLY_MASK
#define ONLY_MASK 0xffffffffu
#endif
#define SEL(n) ((ONLY_MASK >> (n)) & 1u)
#define PH_BEGIN if (lo <= ph && ph < hi) { { int l_; asm volatile("v_mbcnt_lo_u32_b32 %0, -1, 0\n\tv_mbcnt_hi_u32_b32 %0, -1, %0" : "=v"(l_)); F.lane = l_; }
#define PH_END   if (ph + 1 < hi) { asm volatile("s_waitcnt vmcnt(0) lgkmcnt(0)" ::: "memory");   \
        if (hi < 0) cg::this_grid().sync();   \
        else { XcdBarrier xb_; xb_.bar = (unsigned*)(AWS + WS_BAR); xb_.x = xb_xcc_id(); xb_.st = (volatile LAS unsigned*)(F.lds + RING_BYTES + 512); xcd_barrier(xb_); } } } ++ph;
#define GEMM(EPI, SCHEDT, A_, B_, K_, S_, E_) pg8::gemm_phase<EPI, SCHEDT, true, true>(F.lds, pg8::Gemm{(const pg8::bf16_t*)(A_), (const pg8::bf16_t*)(B_), 0, 0, (K_), (K_)}, S_, E_, F.wave * 64 + F.lane)
#define GEMM_P4(EPI, SCHEDT, A_, B_, K_, S_, E_) pg8::gemm_phase<EPI, SCHEDT, true, false>(F.lds, pg8::Gemm{(const pg8::bf16_t*)(A_), (const pg8::bf16_t*)(B_), 0, 0, (K_), (K_)}, S_, E_, F.wave * 64 + F.lane)
#define GEMML(EPI, SCHEDT, A_, B_, K_, LD_, S_, E_) pg8::gemm_phase<EPI, SCHEDT, true, true>(F.lds, pg8::Gemm{(const pg8::bf16_t*)(A_), (const pg8::bf16_t*)(B_), 0, 0, (K_), (LD_)}, S_, E_, F.wave * 64 + F.lane)
    float* XC = WSP(float, WS_XC);
    PH_BEGIN if (SEL(1)) { prep_layer(F, 0); __syncthreads(); mod_phase(F); } PH_END
#pragma unroll 1
    for (int l = 0; l < DEPTH; ++l) {
        const bool last = (l == DEPTH - 1);
        const float* MODl = WSP(float, WS_MOD) + (size_t)l * 3 * NSUBMOD;
        const float* srcL = l == 0 ? AIN(0) : AOUT; const float* srcC = l == 0 ? AIN(2) : XC;
        PH_BEGIN if (SEL(2)) { if (l > 0) { prep_layer(F, l); } if (l > 0) norm_phase(F, l, 0, srcL, srcC, WSP(float, WS_Y4), 11, WSP(float, WS_MOD) + (size_t)(l - 1) * 3 * NSUBMOD + 2 * 3072 + 2048 + 2 * NSUBMOD, 0.5f, XC, XC); else norm_phase(F, l, 0, srcL, srcC); } PH_END
#pragma unroll 1
        for (int f = 0; f < 2; ++f) {
            if (f == 1) {
                PH_BEGIN if (SEL(3)) { { RowOrder S; S.init(1536, F.G, (int)blockIdx.x, false); EpiRoute E{WSP(bf16_t, WS_Q), WSP(bf16_t, WS_K), WSP(bf16_t, WS_V), WSP(bf16_t, WS_A2), WSP(bf16_t, WS_XA)};
                    GEMM(EpiRoute, RowOrder, WSP(bf16, WS_HN), WSP(bf16, WS_WINT), DM, S, E); } } PH_END
                PH_BEGIN if (SEL(4)) { { post_phase(F, l); S5Order S{1, F.G, (int)blockIdx.x}; EpiF32 E{WSP(float, WS_E)}; GEMM(EpiF32, S5Order, WSP(bf16, WS_A2), WSP(bf16, WS_BTE), S5K, S, E); } } PH_END
                PH_BEGIN if (SEL(5)) { { s5_carry_phase(F, l); RowOrder S; S.init(256, F.G, (int)blockIdx.x, last); EpiPlain E{WSP(bf16_t, WS_Y4), 256}; GEMM(EpiPlain, RowOrder, WSP(bf16, WS_DIFF), WSP(bf16, WS_WPT), 256, S, E); } } PH_END
                PH_BEGIN if (SEL(6)) { { S5Order S{2, F.G, (int)blockIdx.x}; EpiS5Y E{WSP(bf16_t, WS_G)}; GEMM(EpiS5Y, S5Order, WSP(bf16, WS_A2), WSP(bf16, WS_BTY), S5K, S, E); } } PH_END
                PH_BEGIN if (SEL(7)) { { RowOrder S; S.init(512, F.G, (int)blockIdx.x, last); EpiGlu E{WSP(bf16_t, WS_Y4) + (size_t)2 * MR * 256}; GEMM(EpiGlu, RowOrder, WSP(bf16, WS_G), WSP(bf16, WS_WGT), 256, S, E);
                    attn_phase(F, l, (char*)lds); } } PH_END
                PH_BEGIN if (SEL(8)) { { RowOrder S; S.init(DM, F.G, (int)blockIdx.x, last);
#pragma unroll 1
                    for (int k = 0; k < 4; ++k) { EpiGate Eg{WSP(bf16_t, WS_GS)}; GEMM(EpiGate, RowOrder, WSP(bf16, WS_HN), WSP(bf16, WS_WINT) + (size_t)(1536 + k * 1024) * DM, DM, S, Eg);
                        const bf16* Ak = WSP(bf16, WS_Y4) + (size_t)k * MR * 256; const bf16* Bk = WSP(bf16, WS_WBT) + (size_t)k * DM * 256;
                        if (k == 0) { EpiMerge<true> Em{WSP(bf16_t, WS_GS), WSP(bf16_t, WS_T)}; GEMM_P4(EpiMerge<true>, RowOrder, Ak, Bk, 256, S, Em); }
                        else { EpiMerge<false> Em{WSP(bf16_t, WS_GS), WSP(bf16_t, WS_T)}; GEMM_P4(EpiMerge<false>, RowOrder, Ak, Bk, 256, S, Em); } } } } PH_END
                PH_BEGIN if (SEL(9)) { { RowOrder S; S.init(DM, F.G, (int)blockIdx.x, true); EpiResid E{AOUT, XC, AOUT, XC, MODl + 1 * 3072 + 2048, 1.0f}; GEMM(EpiResid, RowOrder, WSP(bf16, WS_T), WSP(bf16, WS_WOT), DM, S, E); }
                    if (!last) { CtxSliceOrder S{4, F.G, (int)blockIdx.x}; EpiPart E{WSP(float, WS_Y4)}; GEMML(EpiPart, CtxSliceOrder, WSP(bf16, WS_T), WSP(bf16, WS_WOT), 256, DM, S, E); } } PH_END
                PH_BEGIN if (SEL(10)) { if (!last) norm_phase(F, l, 2, AOUT, XC, WSP(float, WS_Y4), 4, MODl + 1 * 3072 + 2048 + 2 * NSUBMOD, 1.0f, XC, XC); else norm_phase(F, l, 2, AOUT, XC); } PH_END
            }
            PH_BEGIN if (SEL(11)) { { RowOrder S; S.init(5632, F.G, (int)blockIdx.x, last && f == 1); EpiSwiglu E{WSP(bf16_t, WS_HID)}; GEMM(EpiSwiglu, RowOrder, WSP(bf16, WS_HN), WSP(bf16, WS_W1T) + (size_t)f * 5632 * DM, DM, S, E); } } PH_END
            PH_BEGIN if (SEL(12)) { { RowOrder S; S.init(DM, F.G, (int)blockIdx.x, true); const bool first = (l == 0 && f == 0);
                EpiResid E{first ? AIN(0) : AOUT, first ? AIN(2) : XC, AOUT, XC, MODl + (f == 0 ? 0 : 2) * 3072 + 2048, 0.5f};
                GEMM(EpiResid, RowOrder, WSP(bf16, WS_HID), WSP(bf16, WS_W2T) + (size_t)f * DM * DFF, DFF, S, E); }
                if (!(last && f == 1)) { CtxSliceOrder S{11, F.G, (int)blockIdx.x}; EpiPart E{WSP(float, WS_Y4)}; GEMML(EpiPart, CtxSliceOrder, WSP(bf16, WS_HID), WSP(bf16, WS_W2T) + (size_t)f * DM * DFF, 256, DFF, S, E); } } PH_END
            if (f == 0) { PH_BEGIN if (SEL(13)) { norm_phase(F, l, 1, AOUT, XC, WSP(float, WS_Y4), 11, MODl + 0 * 3072 + 2048 + 2 * NSUBMOD, 0.5f, l == 0 ? AIN(2) : XC, XC); } PH_END }
        }
    }
    PH_BEGIN if (SEL(14)) { final_norm_phase(F); } PH_END
}

extern "C" void kernel_launch(void* const* d_in, const int* in_sizes, int n_in, void* d_out, int out_size, void* d_ws, size_t ws_size, hipStream_t stream) {
    static int grid = 0;
    if (grid == 0) {
        int dev = 0, cus = 0, per_cu = 0;
        if (n_in != 26 || ws_size < WS_END) { fprintf(stderr, "kernel_launch: unexpected inputs (n_in %d, ws %zu < %zu)\n", n_in, ws_size, (size_t)WS_END); grid = -1; return; }
        hipGetDevice(&dev); hipDeviceGetAttribute(&cus, hipDeviceAttributeMultiprocessorCount, dev);
        hipFuncSetAttribute((const void*)mk_fwd, hipFuncAttributeMaxDynamicSharedMemorySize, LDS_BYTES);
        hipOccupancyMaxActiveBlocksPerMultiprocessor(&per_cu, (const void*)mk_fwd, NWAVES * 64, LDS_BYTES);
        if (per_cu < 1) { fprintf(stderr, "kernel_launch: occupancy query says %d blocks per CU\n", per_cu); per_cu = 1; }
        (void)hipGetLastError();
        grid = cus * per_cu;
    }
    if (grid < 0) return;
    Args a{};
    for (int i = 0; i < 26; ++i) a.in[i] = (const float*)d_in[i];
    a.out = (float*)d_out; a.ws = (unsigned char*)d_ws;
#if MK_SPLIT
    for (int p = 0; p < N_PHASES; ++p) { a.ph_lo = p; a.ph_hi = p + 1; hipLaunchKernelGGL(mk_fwd, dim3(grid), dim3(NWAVES * 64), LDS_BYTES, stream, a); }
#else
    if (hipMemsetAsync((char*)d_ws + WS_BAR, 0, 65536, stream) != hipSuccess) { fprintf(stderr, "kernel_launch: memset of the barrier words failed\n"); return; }
    a.ph_lo = 0; a.ph_hi = N_PHASES;
    void* kargs[] = {&a};
    hipError_t e = hipLaunchCooperativeKernel((const void*)mk_fwd, dim3(grid), dim3(NWAVES * 64), kargs, LDS_BYTES, stream);
    if (e != hipSuccess) fprintf(stderr, "cooperative launch failed: %s (grid %d)\n", hipGetErrorString(e), grid);
#endif
}
```

```cpp
#include <hip/hip_cooperative_groups.h>
#include <hip/hip_runtime.h>
#include <cstdio>
#include <cstdint>
namespace pg8 {
#define PG8_LAS __attribute__((address_space(3)))
typedef unsigned short bf16_t;
typedef short bf16x8 __attribute__((ext_vector_type(8)));
typedef float f32x4 __attribute__((ext_vector_type(4)));
typedef unsigned u32x4 __attribute__((ext_vector_type(4)));
constexpr int BM = 256, BK = 64, HALF = 128, HTB = HALF * BK * 2  , STAGE_BYTES = 8 * HTB, NXCD = 8, WGM = 8;

__host__ __device__ __forceinline__ int lds_byte(int r, int c) { const int st = (r >> 4) * 2 + (c >> 5), rr = r & 15, cc = c & 31, ob = rr * 64 + cc * 2; return st * 1024 + (ob ^ (((ob >> 9) & 1) << 5)); }
__host__ __device__ __forceinline__ void stage_rc(int b, int& R, int& C) { const int st = b / 1024, sb = b % 1024, swz = sb ^ (((sb >> 9) & 1) << 5); R = (st >> 1) * 16 + swz / 64; C = (st & 1) * 32 + (swz % 64) / 2; }
__host__ __device__ __forceinline__ int perm32(int rho) { const int n = rho >> 4, i = rho & 15; return 8 * (i >> 2) + 4 * n + (i & 3); }

struct Unit { int pm, pn, k0; };
struct Gemm { const bf16_t* A; const bf16_t* Bt; int M, N, K, ld; };

struct StaticOrder {
    int nM, nN, nwg, G, c;
    __host__ __device__ void init(int M, int N, int G_, int c_) { nM = M / BM; nN = N / BM; nwg = nM * nN; G = G_; c = c_; }
    __host__ __device__ bool next(int i, Unit& u) const {
        const long L = (long)i * G + c; if (L >= nwg) return false;
        int wgid = (int)L; { const int q = nwg / NXCD, r = nwg % NXCD, xcd = wgid % NXCD, off = wgid / NXCD; wgid = (xcd < r ? xcd * (q + 1) : r * (q + 1) + (xcd - r) * q) + off; }
        const int nig = WGM * nN, gid = wgid / nig, fm = gid * WGM, gsz = (nM - fm) < WGM ? (nM - fm) : WGM;
        u.pm = fm + ((wgid % nig) % gsz); u.pn = (wgid % nig) / gsz; u.k0 = 0; return true;
    }
    __device__ __forceinline__ void a_ready(const Unit&) const {}
    __device__ __forceinline__ void done(const Unit&) const {}
};

typedef float f32x2cv __attribute__((ext_vector_type(2))); typedef __bf16 bf16x2cv __attribute__((ext_vector_type(2)));
__device__ __forceinline__ unsigned cvt_pk_bf16(float lo, float hi) { f32x2cv v = {lo, hi}; bf16x2cv b = __builtin_convertvector(v, bf16x2cv); return __builtin_bit_cast(unsigned, b); }
typedef float f32x2 __attribute__((ext_vector_type(2)));
template <class Epi, class Sched, bool ALIGN_EPI = false, bool SP2 = false>
__device__ __forceinline__ void gemm_phase(PG8_LAS unsigned char* lds, const Gemm g, const Sched& S, const Epi& E, int tid) {
    float zf = 0.f; asm volatile("" : "+v"(zf));
    const int wid = __builtin_amdgcn_readfirstlane(tid >> 6), lane = tid & 63, wr = wid >> 2, wc = wid & 3, fr = lane & 15, fq = lane >> 4;
    const int K = g.K, nt = K / BK;
    unsigned voffA[2], voffB[2];
#pragma unroll
    for (int i = 0; i < 2; ++i) { int R, C; stage_rc(tid * 16 + i * 8192, R, C); const int Rb = Epi::PERM ? ((R & ~31) + perm32(R & 31)) : R;
        voffA[i] = (unsigned)(R * g.ld + C) * 2u; voffB[i] = (unsigned)(Rb * g.ld + C) * 2u; }
    const size_t kstep = (size_t)(BK * 2);
    const size_t hstep = (size_t)HALF * g.ld * 2;
    const size_t tstep = 2 * hstep;
    const unsigned ldsw = (unsigned)wid * 1024u;
    const int aoff = lds_byte(wr * 64 + fr, fq * 8), boff = lds_byte(wc * 32 + fr, fq * 8);
#define PG8_SA(b, h) (((b) * 2 + (h)) * HTB)
#define PG8_SB(b, h) ((4 + (b) * 2 + (h)) * HTB)
#define PG8_STAGE(bufoff, gbase, voff) do { _Pragma("unroll") for (int _i = 0; _i < 2; ++_i) \
        __builtin_amdgcn_global_load_lds((const unsigned*)((const char*)(gbase) + (voff)[_i]), (PG8_LAS unsigned*)(lds + (bufoff) + ldsw + _i * 8192), 16, 0, 0); } while (0)
#define PG8_LDA(dst, b, h) do { _Pragma("unroll") for (int m = 0; m < 4; ++m) _Pragma("unroll") for (int k = 0; k < 2; ++k) dst[m][k] = *(const PG8_LAS bf16x8*)(lds + PG8_SA(b, h) + aoff + m * 2048 + k * 1024); } while (0)
#define PG8_LDB(dst, b, h) do { _Pragma("unroll") for (int n = 0; n < 2; ++n) _Pragma("unroll") for (int k = 0; k < 2; ++k) dst[n][k] = *(const PG8_LAS bf16x8*)(lds + PG8_SB(b, h) + boff + n * 2048 + k * 1024); } while (0)
#define PG8_MMA(ai, bj, At, Bt) do { __builtin_amdgcn_s_setprio(1); _Pragma("unroll") for (int m = 0; m < 4; ++m) _Pragma("unroll") for (int n = 0; n < 2; ++n) _Pragma("unroll") for (int k = 0; k < 2; ++k) \
        acc[ai][bj][m][n] = __builtin_amdgcn_mfma_f32_16x16x32_bf16(Bt[n][k], At[m][k], acc[ai][bj][m][n], 0, 0, 0); __builtin_amdgcn_s_setprio(0); } while (0)
#define PG8_WAIT_V(n) asm volatile("s_waitcnt vmcnt(" #n ")" ::: "memory")
#define PG8_WAIT_L(n) asm volatile("s_waitcnt lgkmcnt(" #n ")" ::: "memory")
#define PG8_BAR __builtin_amdgcn_s_barrier()
#define PG8_SCHED __builtin_amdgcn_sched_barrier(0)
    Unit cur, nxt; int ui = 0;
    if (!S.next(0, cur)) return;
    f32x4 acc[2][2][4][2];
#pragma unroll
    for (int a = 0; a < 2; ++a)
#pragma unroll
        for (int b = 0; b < 2; ++b)
#pragma unroll
            for (int m = 0; m < 4; ++m)
#pragma unroll
                for (int n = 0; n < 2; ++n) acc[a][b][m][n] = (f32x4){zf, zf, zf, zf};
    bf16x8 At[4][2], B0[2][2], B1[2][2];
    const char* cA = (const char*)g.A + (size_t)cur.pm * tstep + (size_t)cur.k0 * 2; const char* cB = (const char*)g.Bt + (size_t)cur.pn * tstep + (size_t)cur.k0 * 2;
    S.a_ready(cur);
    if constexpr (SP2) {
        PG8_STAGE(PG8_SB(0, 0), cB, voffB); PG8_STAGE(PG8_SB(0, 1), cB + hstep, voffB); PG8_STAGE(PG8_SA(0, 0), cA, voffA); PG8_STAGE(PG8_SA(0, 1), cA + hstep, voffA);
        if (wr == 1) PG8_BAR;
        PG8_WAIT_V(2); PG8_BAR;
        PG8_STAGE(PG8_SB(1, 0), cB + kstep, voffB); PG8_STAGE(PG8_SA(1, 0), cA + kstep, voffA); PG8_STAGE(PG8_SB(1, 1), cB + hstep + kstep, voffB);
        PG8_WAIT_V(6); PG8_BAR;
    } else {
        PG8_STAGE(PG8_SB(0, 0), cB, voffB); PG8_STAGE(PG8_SA(0, 0), cA, voffA); PG8_STAGE(PG8_SB(0, 1), cB + hstep, voffB); PG8_STAGE(PG8_SA(0, 1), cA + hstep, voffA);
        if (wr == 1) PG8_BAR;
        PG8_WAIT_V(4); PG8_BAR;
        PG8_STAGE(PG8_SB(1, 0), cB + kstep, voffB); PG8_STAGE(PG8_SA(1, 0), cA + kstep, voffA); PG8_STAGE(PG8_SB(1, 1), cB + hstep + kstep, voffB);
        PG8_WAIT_V(6); PG8_BAR;
    }
    for (;;) {
        const bool has_next = S.next(ui + 1, nxt);
        const char* nA = has_next ? (const char*)g.A + (size_t)nxt.pm * tstep + (size_t)nxt.k0 * 2 : cA; const char* nB = has_next ? (const char*)g.Bt + (size_t)nxt.pn * tstep + (size_t)nxt.k0 * 2 : cB;
#pragma nounroll
        for (int t = 0; t < nt; t += 2) {
            const bool last = (t == nt - 2);
            const char* a1 = cA + (size_t)(t + 1) * kstep;
            const char* a2 = last ? nA : cA + (size_t)(t + 2) * kstep; const char* b2 = last ? nB : cB + (size_t)(t + 2) * kstep;
            const char* a3 = a2 + kstep; const char* b3 = b2 + kstep;
            if (last && has_next) S.a_ready(nxt);
            if constexpr (SP2) {
            PG8_LDB(B0, 0, 0); PG8_LDB(B1, 0, 1); PG8_SCHED; PG8_LDA(At, 0, 0); PG8_STAGE(PG8_SA(1, 1), a1 + hstep, voffA);
            PG8_WAIT_V(8); PG8_WAIT_L(0); PG8_BAR; PG8_MMA(0, 0, At, B0); PG8_MMA(0, 1, At, B1); PG8_BAR; PG8_SCHED;
            PG8_LDA(At, 0, 1); PG8_STAGE(PG8_SB(0, 0), b2, voffB); PG8_STAGE(PG8_SB(0, 1), b2 + hstep, voffB); PG8_STAGE(PG8_SA(0, 0), a2, voffA);
            PG8_WAIT_V(8); PG8_WAIT_L(0); PG8_BAR; PG8_MMA(1, 0, At, B0); PG8_MMA(1, 1, At, B1); PG8_BAR; PG8_SCHED;
            PG8_LDB(B0, 1, 0); PG8_LDB(B1, 1, 1); PG8_SCHED; PG8_LDA(At, 1, 0); PG8_STAGE(PG8_SA(0, 1), a2 + hstep, voffA);
            PG8_WAIT_V(8); PG8_WAIT_L(0); PG8_BAR; PG8_MMA(0, 0, At, B0); PG8_MMA(0, 1, At, B1); PG8_BAR; PG8_SCHED;
            PG8_LDA(At, 1, 1); PG8_STAGE(PG8_SB(1, 0), b3, voffB); PG8_STAGE(PG8_SB(1, 1), b3 + hstep, voffB); PG8_STAGE(PG8_SA(1, 0), a3, voffA);
            PG8_WAIT_V(8); PG8_WAIT_L(0); PG8_BAR; PG8_MMA(1, 0, At, B0); PG8_MMA(1, 1, At, B1); PG8_BAR; PG8_SCHED;
            } else {
            PG8_LDB(B0, 0, 0); PG8_SCHED; PG8_LDA(At, 0, 0); PG8_STAGE(PG8_SA(1, 1), a1 + hstep, voffA);
            PG8_WAIT_L(8); PG8_BAR; PG8_WAIT_L(0); PG8_MMA(0, 0, At, B0); PG8_BAR; PG8_SCHED;
            PG8_LDB(B1, 0, 1); PG8_STAGE(PG8_SB(0, 0), b2, voffB);
            PG8_BAR; PG8_WAIT_L(0); PG8_MMA(0, 1, At, B1); PG8_BAR;
            PG8_LDA(At, 0, 1); PG8_STAGE(PG8_SA(0, 0), a2, voffA);
            PG8_BAR; PG8_WAIT_L(0); PG8_MMA(1, 0, At, B0); PG8_BAR; PG8_SCHED;
            PG8_STAGE(PG8_SB(0, 1), b2 + hstep, voffB);
            PG8_WAIT_V(6); PG8_BAR; PG8_MMA(1, 1, At, B1); PG8_BAR;
            PG8_LDB(B0, 1, 0); PG8_SCHED; PG8_LDA(At, 1, 0); PG8_STAGE(PG8_SA(0, 1), a2 + hstep, voffA);
            PG8_WAIT_L(8); PG8_BAR; PG8_WAIT_L(0); PG8_MMA(0, 0, At, B0); PG8_BAR; PG8_SCHED;
            PG8_LDB(B1, 1, 1); PG8_STAGE(PG8_SB(1, 0), b3, voffB);
            PG8_BAR; PG8_WAIT_L(0); PG8_MMA(0, 1, At, B1); PG8_BAR;
            PG8_LDA(At, 1, 1); PG8_STAGE(PG8_SA(1, 0), a3, voffA);
            PG8_BAR; PG8_WAIT_L(0); PG8_MMA(1, 0, At, B0); PG8_BAR; PG8_SCHED;
            PG8_STAGE(PG8_SB(1, 1), b3 + hstep, voffB);
            PG8_WAIT_V(6); PG8_BAR; PG8_MMA(1, 1, At, B1); PG8_BAR;
            }
        }
        if constexpr (ALIGN_EPI) { if (wr == 0) PG8_BAR; }
        if constexpr (!Epi::AFTER_DRAIN) { E(acc, cur, wr, wc, fr, fq); S.done(cur); }
        if (!has_next) break;
#pragma unroll
        for (int a = 0; a < 2; ++a)
#pragma unroll
            for (int b = 0; b < 2; ++b)
#pragma unroll
                for (int m = 0; m < 4; ++m)
#pragma unroll
                    for (int n = 0; n < 2; ++n) acc[a][b][m][n] = (f32x4){zf, zf, zf, zf};
        cur = nxt; cA = nA; cB = nB; ++ui;
        if constexpr (ALIGN_EPI) { if (wr == 1) PG8_BAR; }
    }
    PG8_WAIT_V(0);
    if constexpr (!ALIGN_EPI) { if (wr == 0) PG8_BAR; }
    PG8_BAR;
    if constexpr (Epi::AFTER_DRAIN) { E.fused(acc, cur, wr, wc, fr, fq, lds, wid, lane); S.done(cur); }
#undef PG8_SA
#undef PG8_SB
#undef PG8_STAGE
#undef PG8_LDA
#undef PG8_LDB
#undef PG8_MMA
#undef PG8_WAIT_V
#undef PG8_WAIT_L
#undef PG8_BAR
#undef PG8_SCHED
}
}
namespace cg = cooperative_groups;
#include <hip/hip_bf16.h>
#include <cmath>
namespace attn_body {
using bf16=__hip_bfloat16;
using bf16x8=__attribute__((ext_vector_type(8)))short;
using s16x4=__attribute__((ext_vector_type(4)))short;
using f32x16=__attribute__((ext_vector_type(16)))float;
using u32x4=__attribute__((ext_vector_type(4)))unsigned;
constexpr int D=64,QP=512,KP=256,OP=256;
constexpr int NW=8,QBLK=32,QB=QBLK*NW,KVBLK=64;
__device__ __forceinline__ int crow(int r,int hi){return (r&3)+8*(r>>2)+4*hi;}
#define SBAR() __builtin_amdgcn_sched_barrier(0)
__device__ __forceinline__ void wmask(f32x16&p0,f32x16&p1,int dbase){
  const float NEG=-INFINITY;
  #pragma unroll
  for(int r=0;r<16;++r){int d=dbase+(r&3)+8*(r>>2); if((unsigned)(d+128)>256u)p0[r]=NEG; if((unsigned)(d+160)>256u)p1[r]=NEG;}
}

constexpr int NSLOT=3, SLOTB=8192;
constexpr int LDS_K=0, LDS_V=NSLOT*SLOTB, LDS_WS=2*NSLOT*SLOTB, LDS_OST=LDS_WS+NW*64*4, LDS_BYTES=LDS_OST+NW*4096;
constexpr float C2=0.125f*1.4426950408889634f;
__device__ __forceinline__ void glds16(const void*gsrc,unsigned lds_dst){unsigned keep;
  asm volatile("s_mov_b32 %0, m0\n\ts_mov_b32 m0, %2\n\ts_nop 0\n\tglobal_load_lds_dwordx4 %1, off\n\ts_mov_b32 m0, %0":"=&s"(keep):"v"(gsrc),"s"(lds_dst):"memory");}
__device__ __forceinline__ float max3f(float a,float b,float c){float r;asm("v_max3_f32 %0, %1, %2, %3":"=v"(r):"v"(a),"v"(b),"v"(c));return r;}
__device__ __forceinline__ float max2f(float a,float b){float r;asm("v_max_f32_e32 %0, %1, %2":"=v"(r):"v"(a),"v"(b));return r;}
__device__ __forceinline__ float fadd_s(float a,float b){float r;asm("v_add_f32_e32 %0, %1, %2":"=v"(r):"v"(a),"v"(b));return r;}
__device__ __forceinline__ float fsub_s(float a,float b){float r;asm("v_sub_f32_e32 %0, %1, %2":"=v"(r):"v"(a),"v"(b));return r;}
typedef float f32x2_t __attribute__((ext_vector_type(2))); typedef __bf16 bf16x2_t __attribute__((ext_vector_type(2)));
__device__ __forceinline__ unsigned cvtpk_s(float lo,float hi){f32x2_t v={lo,hi};bf16x2_t b=__builtin_convertvector(v,bf16x2_t);return __builtin_bit_cast(unsigned,b);}
#define WAIT_BAR(N) asm volatile("s_waitcnt vmcnt(" #N ") lgkmcnt(0)\n\ts_barrier":::"memory")

__device__ __forceinline__ void qkt(f32x16&p0,f32x16&p1,const char*Kslot,const bf16x8*qr,const f32x16&negm,int r32,int hi){
  const char*kb=Kslot+hi*1024+r32*16;
  #pragma unroll
  for(int d0=0;d0<4;++d0){
    const bf16x8 b0=*reinterpret_cast<const bf16x8*>(kb+d0*2048);
    const bf16x8 b1=*reinterpret_cast<const bf16x8*>(kb+d0*2048+512);
    if(d0==0){p0=__builtin_amdgcn_mfma_f32_32x32x16_bf16(b0,qr[0],negm,0,0,0);p1=__builtin_amdgcn_mfma_f32_32x32x16_bf16(b1,qr[0],negm,0,0,0);}
    else{p0=__builtin_amdgcn_mfma_f32_32x32x16_bf16(b0,qr[d0],p0,0,0,0);p1=__builtin_amdgcn_mfma_f32_32x32x16_bf16(b1,qr[d0],p1,0,0,0);}}
}
typedef __attribute__((address_space(3))) const char* lds_cptr;
typedef short v4i16_t __attribute__((ext_vector_type(4)));
__device__ __forceinline__ void kload8(bf16x8*kf,lds_cptr kp){
  kf[0]=*(const __attribute__((address_space(3))) bf16x8*)(kp);      kf[1]=*(const __attribute__((address_space(3))) bf16x8*)(kp+512);
  kf[2]=*(const __attribute__((address_space(3))) bf16x8*)(kp+2048); kf[3]=*(const __attribute__((address_space(3))) bf16x8*)(kp+2560);
  kf[4]=*(const __attribute__((address_space(3))) bf16x8*)(kp+4096); kf[5]=*(const __attribute__((address_space(3))) bf16x8*)(kp+4608);
  kf[6]=*(const __attribute__((address_space(3))) bf16x8*)(kp+6144); kf[7]=*(const __attribute__((address_space(3))) bf16x8*)(kp+6656);
}
__device__ __forceinline__ void kload2(bf16x8*kf,lds_cptr kp,int j){ kf[2*j]=*(const __attribute__((address_space(3))) bf16x8*)(kp+j*2048); kf[2*j+1]=*(const __attribute__((address_space(3))) bf16x8*)(kp+j*2048+512); }
__device__ __forceinline__ s16x4 vtr(lds_cptr p){ return __builtin_bit_cast(s16x4,__builtin_amdgcn_ds_read_tr16_b64_v4i16((__attribute__((address_space(3))) v4i16_t*)p)); }
__device__ __forceinline__ float rowmax(const f32x16&p0,const f32x16&p1){
  float a=max3f(p0[0],p0[1],p1[0]),b=max3f(p0[2],p0[3],p1[1]);a=max3f(a,p1[2],p1[3]);
  #pragma unroll
  for(int r=4;r<16;r+=4){a=max3f(a,p0[r],p0[r+1]);b=max3f(b,p0[r+2],p0[r+3]);a=max3f(a,p1[r],p1[r+1]);b=max3f(b,p1[r+2],p1[r+3]);}
  const float m=max2f(a,b);
  auto rr=__builtin_amdgcn_permlane32_swap(__float_as_uint(m),__float_as_uint(m),false,false);
  return max2f(__uint_as_float(rr[0]),__uint_as_float(rr[1]));
}
__device__ __forceinline__ void pv(f32x16*o,int vb,bf16x8 pa0,bf16x8 pa1,bf16x8 pa2,bf16x8 pa3){
  #pragma unroll
  for(int d0=0;d0<2;++d0){s16x4 lo[4],hi[4];
    #pragma unroll
    for(int ks=0;ks<4;++ks){
      asm volatile("ds_read_b64_tr_b16 %0,%1 offset:%c2":"=&v"(lo[ks]):"v"(vb),"i"(d0*4096+ks*1024):"memory");
      asm volatile("ds_read_b64_tr_b16 %0,%1 offset:%c2":"=&v"(hi[ks]):"v"(vb),"i"(d0*4096+ks*1024+512):"memory");}
    asm volatile("s_waitcnt lgkmcnt(0)":::"memory");SBAR();
    #define PK(k) (bf16x8){lo[k][0],lo[k][1],lo[k][2],lo[k][3],hi[k][0],hi[k][1],hi[k][2],hi[k][3]}
    o[d0]=__builtin_amdgcn_mfma_f32_32x32x16_bf16(pa0,PK(0),o[d0],0,0,0);
    o[d0]=__builtin_amdgcn_mfma_f32_32x32x16_bf16(pa1,PK(1),o[d0],0,0,0);
    o[d0]=__builtin_amdgcn_mfma_f32_32x32x16_bf16(pa2,PK(2),o[d0],0,0,0);
    o[d0]=__builtin_amdgcn_mfma_f32_32x32x16_bf16(pa3,PK(3),o[d0],0,0,0);
    #undef PK
  }
}

#ifndef ATTN_STORE16
#define ATTN_STORE16(p,v) (*(u32x4*)(p)=(v))
#endif
template<int THRL,bool WIN> __device__ __forceinline__ void attn_unit(const bf16*Qu,const bf16*__restrict__ Kh,const bf16*__restrict__ Vh,bf16*Ou,int NT,int shift,int qpos0,float sinkl2,char*shm,int tid){
  const int lane=tid&63,r32=lane&31,hi=lane>>5; const int wid=__builtin_amdgcn_readfirstlane(tid>>6);
  const bf16*Qw=Qu+(long)(wid*QBLK)*QP;
  const unsigned lds0=(unsigned)(uintptr_t)shm;
  float*wsf=(float*)(shm+LDS_WS)+wid*64;
  const bf16*ksrc=Kh+(long)lane*KP+wid*8;
  const bf16*vsrc=Vh+(long)(16*(wid&3)+(lane>>2))*KP+(wid>>2)*32+(lane&3)*8;
  const unsigned kdst=lds0+LDS_K+wid*1024, vdst=lds0+LDS_V+wid*1024;
  #define KROW(t) ((long)(((t)<4)?(t):((t)+shift))*(KVBLK*KP))
  #define DMA_K(t,slot) glds16(ksrc+KROW(t),(unsigned)__builtin_amdgcn_readfirstlane(kdst+(slot)))
  #define DMA_V(t,slot) glds16(vsrc+KROW(t),(unsigned)__builtin_amdgcn_readfirstlane(vdst+(slot)))
  const int vb0=(int)(lds0+LDS_V)+((lane>>4)&1)*32+(lane&3)*8+(4*hi+((lane&15)>>2))*64;
  const char*Kbase=shm+LDS_K; bf16x8 kf[8];
  const lds_cptr shm3=(lds_cptr)shm; const lds_cptr kp0=shm3+LDS_K+hi*1024+r32*16; const lds_cptr vp0=shm3+LDS_V+((lane>>4)&1)*32+(lane&3)*8+(4*hi+((lane&15)>>2))*64;
  DMA_K(0,0);DMA_V(0,0);DMA_K(1,SLOTB);
  bf16x8 qr[4];
  #pragma unroll
  for(int d0=0;d0<4;++d0)qr[d0]=*reinterpret_cast<const bf16x8*>(&Qw[(long)r32*QP+d0*16+hi*8]);
  float zf_=0.f;asm volatile("":"+v"(zf_)); float mhat=zf_,l_reg=zf_;f32x16 o[2];
  #pragma unroll
  for(int r=0;r<16;++r){o[0][r]=zf_;o[1][r]=zf_;}
  f32x16 negm;
  #pragma unroll
  for(int r=0;r<16;++r)negm[r]=zf_;
  asm volatile("":"+v"(negm));
  const int qrel=wid*QBLK+r32;
  const int mbase=4*hi-256-qpos0-qrel;
  #define CMASK(P0,P1,t) do{ if(WIN){ if((t)>=4) wmask(P0,P1,mbase+64*((t)+shift)); } }while(0)
  bool resc=false;
  #define START(P0,P1) do{ const float rm=rowmax(P0,P1); resc=false; \
    { const float dl=rm; mhat=fadd_s(mhat,dl); \
      _Pragma("unroll") for(int r=0;r<16;++r){P0[r]=fsub_s(P0[r],dl);P1[r]=fsub_s(P1[r],dl);} \
      _Pragma("unroll") for(int r=0;r<16;++r)negm[r]=-mhat; asm volatile("":"+v"(negm)); } \
    _Pragma("unroll") for(int r=0;r<16;++r)P0[r]=__builtin_amdgcn_exp2f(P0[r]); }while(0)
  #define RESC() do{ if(resc){ asm volatile("s_waitcnt lgkmcnt(0)":::"memory"); \
      _Pragma("unroll") for(int d_=0;d_<2;++d_) _Pragma("unroll") for(int r=0;r<16;++r)o[d_][r]*=wsf[crow(r,hi)]; } }while(0)
  f32x16 pA0,pA1,pB0,pB1;
  int sl_prev=0,sl_cur=0,sl_next=SLOTB;
  #define ROT() do{sl_prev=sl_cur;sl_cur=sl_next;sl_next=(sl_next==(NSLOT-1)*SLOTB)?0:sl_next+SLOTB;}while(0)
  DMA_K(2,2*SLOTB);
  WAIT_BAR(3);
  qkt(pA0,pA1,Kbase,qr,negm,r32,hi);asm volatile("s_nop 15\n\ts_nop 7":"+v"(pA0),"+v"(pA1));CMASK(pA0,pA1,0);
  START(pA0,pA1);
  _Pragma("unroll") for(int r=0;r<16;++r)pA1[r]=__builtin_amdgcn_exp2f(pA1[r]);
  WAIT_BAR(0);
  DMA_K(3,0);DMA_V(1,SLOTB);
  ROT();
  kload8(kf,kp0+sl_cur);
  WAIT_BAR(2);
  s16x4 vlo[8],vhi[8]; u32x4 pw0,pw1,pw2,pw3;
  #define PKW(P,B) cvtpk_s(P[B],P[B+1])
  #define PAF(k) __builtin_bit_cast(bf16x8,pw##k)
  #define VFR(i) (bf16x8){vlo[i][0],vlo[i][1],vlo[i][2],vlo[i][3],vhi[i][0],vhi[i][1],vhi[i][2],vhi[i][3]}
  #define PIN(x) asm volatile("":"+v"(x))
  #define MX3(a,b,c) __builtin_fmaxf(__builtin_fmaxf((a),(b)),(c))
  #define GAPA(MF,A0,A1,A2,A3,W0,W1,PW) do{ MF; sacc+=A0; sacc+=A1; sacc+=A2; sacc+=A3; PIN(sacc); W0; W1; PIN(PW); SBAR(); }while(0)
  #define EX(v) __builtin_amdgcn_exp2f(v)
  #define GAPB(MF,X,B) do{ MF; X[B]=EX(X[B]); X[B+1]=EX(X[B+1]); X[B+2]=EX(X[B+2]); X[B+3]=EX(X[B+3]); PIN(X); SBAR(); }while(0)
  #define VRD(i) do{ vlo[i]=vtr(vp_+(((i)>>2)*4096+((i)&3)*1024)); vhi[i]=vtr(vp_+(((i)>>2)*4096+((i)&3)*1024+512)); }while(0)
  #define KRD(G,j) do{ if(G){ kload2(kf,kp0+sl_next,j); SBAR(); } }while(0)
  #define STEP(C0,C1,P0,P1,t,GK,GV,GL) do{ SBAR(); \
    const lds_cptr vp_=vp0+sl_prev; \
    VRD(0); SBAR(); float sacc=(P0[0]+P0[1]); \
    GAPA(C0=__builtin_amdgcn_mfma_f32_32x32x16_bf16(kf[0],qr[0],negm,0,0,0), P0[2],P0[3],P0[4],P0[5],     pw0[0]=PKW(P0,0), pw0[1]=PKW(P0,2), pw0); \
    VRD(4); SBAR(); GAPA(C1=__builtin_amdgcn_mfma_f32_32x32x16_bf16(kf[1],qr[0],negm,0,0,0), P0[6],P0[7],P0[8],P0[9],     pw0[2]=PKW(P0,4), pw0[3]=PKW(P0,6), pw0); \
    VRD(1); SBAR(); GAPA(C0=__builtin_amdgcn_mfma_f32_32x32x16_bf16(kf[2],qr[1],C0,0,0,0),   P0[10],P0[11],P0[12],P0[13], pw1[0]=PKW(P0,8), pw1[1]=PKW(P0,10), pw1); \
    VRD(5); SBAR(); GAPA(C1=__builtin_amdgcn_mfma_f32_32x32x16_bf16(kf[3],qr[1],C1,0,0,0),   P0[14],P0[15],P1[0],P1[1],   pw1[2]=PKW(P0,12),pw1[3]=PKW(P0,14), pw1); \
    VRD(2); SBAR(); GAPA(C0=__builtin_amdgcn_mfma_f32_32x32x16_bf16(kf[4],qr[2],C0,0,0,0),   P1[2],P1[3],P1[4],P1[5],     pw2[0]=PKW(P1,0), pw2[1]=PKW(P1,2), pw2); \
    VRD(6); SBAR(); GAPA(C1=__builtin_amdgcn_mfma_f32_32x32x16_bf16(kf[5],qr[2],C1,0,0,0),   P1[6],P1[7],P1[8],P1[9],     pw2[2]=PKW(P1,4), pw2[3]=PKW(P1,6), pw2); \
    VRD(3); SBAR(); GAPA(C0=__builtin_amdgcn_mfma_f32_32x32x16_bf16(kf[6],qr[3],C0,0,0,0),   P1[10],P1[11],P1[12],P1[13], pw3[0]=PKW(P1,8), pw3[1]=PKW(P1,10), pw3); \
    VRD(7); SBAR(); GAPA(C1=__builtin_amdgcn_mfma_f32_32x32x16_bf16(kf[7],qr[3],C1,0,0,0),   P1[14],P1[15],0.f,0.f,       pw3[2]=PKW(P1,12),pw3[3]=PKW(P1,14), pw3); \
    l_reg+=sacc; \
    if(GK){DMA_K((t)+3,sl_cur);} if(GV){DMA_V((t)+1,sl_next);} \
    CMASK(C0,C1,t); \
    { float a=MX3(C0[0],C0[1],C1[0]),b=MX3(C0[2],C0[3],C1[1]); a=MX3(a,C1[2],C1[3]); \
      _Pragma("unroll") for(int r=4;r<16;r+=4){a=MX3(a,C0[r],C0[r+1]);b=MX3(b,C0[r+2],C0[r+3]);a=MX3(a,C1[r],C1[r+1]);b=MX3(b,C1[r+2],C1[r+3]);} \
      float rm=__builtin_fmaxf(a,b); { auto rr=__builtin_amdgcn_permlane32_swap(__float_as_uint(rm),__float_as_uint(rm),false,false); rm=__builtin_fmaxf(__uint_as_float(rr[0]),__uint_as_float(rr[1])); } \
      resc=false; \
      if(__builtin_expect(__any(rm>(float)THRL),0)){ const float dl=__builtin_fmaxf(rm,0.f); mhat+=dl; \
        _Pragma("unroll") for(int r=0;r<16;++r){C0[r]-=dl;C1[r]-=dl;} \
        _Pragma("unroll") for(int r=0;r<16;++r)negm[r]=-mhat; asm volatile("":"+v"(negm)); \
        const float f=__builtin_amdgcn_exp2f(-dl); l_reg*=f; if(hi==0)wsf[r32]=f; resc=true; } } \
    SBAR(); \
    GAPB(o[0]=__builtin_amdgcn_mfma_f32_32x32x16_bf16(PAF(0),VFR(0),o[0],0,0,0), C0,0); \
    GAPB(o[1]=__builtin_amdgcn_mfma_f32_32x32x16_bf16(PAF(0),VFR(4),o[1],0,0,0), C0,4); \
    KRD(GL,0); GAPB(o[0]=__builtin_amdgcn_mfma_f32_32x32x16_bf16(PAF(1),VFR(1),o[0],0,0,0), C0,8); \
    KRD(GL,1); GAPB(o[1]=__builtin_amdgcn_mfma_f32_32x32x16_bf16(PAF(1),VFR(5),o[1],0,0,0), C0,12); \
    KRD(GL,2); GAPB(o[0]=__builtin_amdgcn_mfma_f32_32x32x16_bf16(PAF(2),VFR(2),o[0],0,0,0), C1,0); \
    KRD(GL,3); GAPB(o[1]=__builtin_amdgcn_mfma_f32_32x32x16_bf16(PAF(2),VFR(6),o[1],0,0,0), C1,4); \
    GAPB(o[0]=__builtin_amdgcn_mfma_f32_32x32x16_bf16(PAF(3),VFR(3),o[0],0,0,0), C1,8); \
    GAPB(o[1]=__builtin_amdgcn_mfma_f32_32x32x16_bf16(PAF(3),VFR(7),o[1],0,0,0), C1,12); \
    }while(0)
  int t=1;
  for(;t+5<NT;t+=2){
    STEP(pB0,pB1,pA0,pA1,t,true,true,true);     WAIT_BAR(2); RESC(); ROT();
    STEP(pA0,pA1,pB0,pB1,t+1,true,true,true);   WAIT_BAR(2); RESC(); ROT();
  }
  #define ENDW(tt) do{ if((tt)+3<NT){WAIT_BAR(2);} else if((tt)+2<NT){WAIT_BAR(1);} else {WAIT_BAR(0);} }while(0)
  for(;t+1<NT;t+=2){
    STEP(pB0,pB1,pA0,pA1,t,(t+3<NT),(t+1<NT),(t+1<NT));       ENDW(t);   RESC(); ROT();
    STEP(pA0,pA1,pB0,pB1,t+1,(t+4<NT),(t+2<NT),(t+2<NT));     ENDW(t+1); RESC(); ROT();
  }
  STEP(pB0,pB1,pA0,pA1,NT-1,false,false,false); RESC();
  { float sacc=pB0[0]+pB0[1]; _Pragma("unroll") for(int r=2;r<16;++r)sacc+=pB0[r]; _Pragma("unroll") for(int r=0;r<16;++r)sacc+=pB1[r]; l_reg+=sacc;
    pw0=(u32x4){PKW(pB0,0),PKW(pB0,2),PKW(pB0,4),PKW(pB0,6)};pw1=(u32x4){PKW(pB0,8),PKW(pB0,10),PKW(pB0,12),PKW(pB0,14)};pw2=(u32x4){PKW(pB1,0),PKW(pB1,2),PKW(pB1,4),PKW(pB1,6)};pw3=(u32x4){PKW(pB1,8),PKW(pB1,10),PKW(pB1,12),PKW(pB1,14)};
    SBAR(); pv(o,vb0+sl_cur,PAF(0),PAF(1),PAF(2),PAF(3)); }
  #undef PKW
  #undef PAF
  #undef VFR
  #undef PIN
  #undef MX3
  #undef GAPA
  #undef GAPB
  #undef EX
  #undef VRD
  #undef KRD
  #undef STEP
  #undef ENDW
  {auto rr=__builtin_amdgcn_permlane32_swap(__float_as_uint(l_reg),__float_as_uint(l_reg),false,false);l_reg=__uint_as_float(rr[0])+__uint_as_float(rr[1]);}
  if(WIN)l_reg+=__builtin_amdgcn_exp2f(sinkl2-mhat);
  if(hi==0)wsf[32+r32]=l_reg;asm volatile("s_waitcnt lgkmcnt(0)":::"memory");
  float rli[16];
  #pragma unroll
  for(int r=0;r<16;++r)rli[r]=__builtin_amdgcn_rcpf(wsf[32+crow(r,hi)]);
  bf16*Ow=Ou+(long)(wid*QBLK)*OP;
  { bf16*stg=(bf16*)(shm+LDS_OST)+wid*2048;
    #pragma unroll
    for(int r=0;r<16;++r){const int orow=crow(r,hi);
      #pragma unroll
      for(int d0=0;d0<2;++d0)stg[orow*64+d0*32+r32]=__float2bfloat16(o[d0][r]*rli[r]);}
    asm volatile("s_waitcnt lgkmcnt(0)":::"memory");
    #pragma unroll
    for(int i=0;i<4;++i){const int row=i*8+(lane>>3),ch=lane&7; const u32x4 v=*(const u32x4*)(stg+row*64+ch*8); ATTN_STORE16(Ow+(long)row*OP+ch*8,v);} }
  asm volatile("s_waitcnt lgkmcnt(0)\n\ts_barrier":::"memory");
  #undef DMA_K
  #undef KROW
  #undef DMA_V
  #undef CMASK
  #undef START
  #undef RESC
  #undef ROT
}
constexpr int ATTN_LDS_BYTES=LDS_BYTES;
#undef SBAR
#undef WAIT_BAR
}
constexpr int NWAVES = 8;
constexpr int DM = 1024, NBATCH = 2, SEQ = 16384, CTXL = 256, TOK = SEQ + CTXL  , MR = NBATCH * TOK  ;
constexpr int DFF = 2816, NSUBMOD = 9216, DEPTH = 2;
constexpr float EPS = 1e-6f, LOG2E = 1.4426950408889634f;
constexpr int S5L = 32, S5ROWS = 1280  , S5CH = MR / S5L  , S5K = 768;

typedef unsigned short bf16;
typedef unsigned v4u __attribute__((ext_vector_type(4)));
typedef float f32x4 __attribute__((ext_vector_type(4)));
#define LAS __attribute__((address_space(3)))
#define LDS_WAIT() asm volatile("s_waitcnt lgkmcnt(0)" ::: "memory")
__device__ __forceinline__ unsigned f2bf(float f) { unsigned u = __builtin_bit_cast(unsigned, f); return (u + 0x7fffu + ((u >> 16) & 1u)) >> 16; }
__device__ __forceinline__ unsigned pk2(float lo, float hi) { return f2bf(lo) | (f2bf(hi) << 16); }
__device__ __forceinline__ float bf2f(unsigned short h) { return __builtin_bit_cast(float, (unsigned)h << 16); }
__device__ __forceinline__ float sigm(float x) { return __builtin_amdgcn_rcpf(1.0f + __builtin_amdgcn_exp2f(-x * LOG2E)); }

constexpr size_t MiB = 1u << 20;
constexpr size_t WS_MOD = 1 * MiB, WS_XC = 2 * MiB;
constexpr size_t WS_W1T = 4 * MiB, WS_W2T = 26 * MiB, WS_WINT = 37 * MiB, WS_WBT = 48 * MiB, WS_WOT = 50 * MiB, WS_WGT = 52 * MiB, WS_WPT = 52 * MiB + 256 * 1024;
constexpr size_t WS_BTY = 53 * MiB, WS_BTE = 65 * MiB, WS_E = 71 * MiB, WS_A2 = 91 * MiB, WS_HN = 121 * MiB, WS_T = 186 * MiB;
constexpr size_t WS_R = 251 * MiB;
constexpr size_t WS_HID = WS_R, WS_GS = WS_R, WS_Q = WS_R + 65 * MiB, WS_K = WS_Q + 65 * MiB / 2, WS_V = WS_K + 65 * MiB / 4, WS_XA = WS_V + 65 * MiB / 4, WS_G = WS_XA + 65 * MiB / 4,
                 WS_DIFF = WS_G + 65 * MiB / 4, WS_Y4 = WS_DIFF + 65 * MiB / 4, WS_GSC = 495 * MiB  , WS_END = 499 * MiB;
static_assert(WS_END <= 512 * MiB && WS_HID + (size_t)MR * DFF * 2 <= WS_Y4 + 65 * MiB, "ws map");
constexpr int RING_BYTES = 131072, LDS_BYTES = 147456;

struct Args { const float* in[26]; float* out; unsigned char* ws; int ph_lo, ph_hi; };
struct Frame { LAS unsigned char* lds; int lane, wave, vcu, G; };
typedef const volatile __attribute__((address_space(4))) unsigned long long karg_t;
__device__ __forceinline__ unsigned long long karg(int i) { return ((karg_t*)__builtin_amdgcn_kernarg_segment_ptr())[i]; }
#define AIN(i) ((const float*)karg(i))
#define AOUT ((float*)karg(26))
#define AWS ((unsigned char*)karg(27))
#define WSP(T, off) ((T*)(AWS + (off)))

__device__ __forceinline__ float* xrow_ptr(float* lat, float* ctxp, int r) { const int b = r / TOK, i = r - b * TOK; return i < CTXL ? ctxp + (size_t)(b * CTXL + i) * DM : lat + (size_t)(b * SEQ + i - CTXL) * DM; }

using pg8::f32x4; using pg8::Unit; using pg8::bf16_t; using pg8::cvt_pk_bf16; using pg8::u32x4;
#define EPI_ARGS const pg8::f32x4 (&acc)[2][2][4][2], const pg8::Unit& u, int wr, int wc, int fr_, int fq_
#define EPI_PIN int fr = fr_, fq = fq_; asm volatile("" : "+v"(fr), "+v"(fq));
struct EpiSwiglu { static constexpr bool PERM = true, AFTER_DRAIN = false; bf16_t* H;
    __device__ __forceinline__ void operator()(EPI_ARGS) const { EPI_PIN
        const int row0 = u.pm * 256 + wr * 64 + fr, hc = u.pn * 128 + wc * 32 + 8 * fq;
#pragma unroll
        for (int ai = 0; ai < 2; ++ai)
#pragma unroll
            for (int m = 0; m < 4; ++m) { bf16_t* rowp = H + (size_t)(row0 + ai * 128 + m * 16) * DFF + hc; float v[8];
#pragma unroll
                for (int n = 0; n < 2; ++n)
#pragma unroll
                    for (int j = 0; j < 4; ++j) { const float g = acc[ai][0][m][n][j], up = acc[ai][1][m][n][j]; v[n * 4 + j] = g * sigm(g) * up; }
                u32x4 w; w.x = cvt_pk_bf16(v[0], v[1]); w.y = cvt_pk_bf16(v[2], v[3]); w.z = cvt_pk_bf16(v[4], v[5]); w.w = cvt_pk_bf16(v[6], v[7]); *(u32x4*)rowp = w; }
    }
};
struct EpiResid { static constexpr bool PERM = true, AFTER_DRAIN = false; const float* src_lat; const float* src_ctx; float* dst_lat; float* dst_ctx; const float* gate; float sc;
    __device__ __forceinline__ void operator()(EPI_ARGS) const { EPI_PIN
        const int b = u.pm / 65, tq = u.pm - b * 65; const bool isc = tq == 0;
        const size_t off = isc ? (size_t)b * CTXL * DM : ((size_t)b * SEQ + (size_t)(tq - 1) * 256) * DM;
        const float* sp = (isc ? src_ctx : src_lat) + off; float* dp = (isc ? dst_ctx : dst_lat) + off;
        const float* gp = gate + (isc ? 2 : b) * NSUBMOD; const int col0 = u.pn * 256 + wc * 32 + 8 * fq;
        f32x4 gv[2][2];
#pragma unroll
        for (int bj = 0; bj < 2; ++bj)
#pragma unroll
            for (int n = 0; n < 2; ++n) gv[bj][n] = *(const f32x4*)(gp + col0 + bj * 128 + 4 * n) * sc;
#pragma unroll
        for (int ai = 0; ai < 2; ++ai)
#pragma unroll
            for (int m = 0; m < 4; ++m) { const size_t ro = (size_t)(ai * 128 + wr * 64 + m * 16 + fr) * DM + col0;
#pragma unroll
                for (int bj = 0; bj < 2; ++bj)
#pragma unroll
                    for (int n = 0; n < 2; ++n) { const f32x4 xv = *(const f32x4*)(sp + ro + bj * 128 + 4 * n); *(f32x4*)(dp + ro + bj * 128 + 4 * n) = xv + gv[bj][n] * acc[ai][bj][m][n]; } }
    }
};
__device__ __forceinline__ u32x4 pack8(const f32x4& a, const f32x4& b) { u32x4 w; w.x = cvt_pk_bf16(a[0], a[1]); w.y = cvt_pk_bf16(a[2], a[3]); w.z = cvt_pk_bf16(b[0], b[1]); w.w = cvt_pk_bf16(b[2], b[3]); return w; }
struct EpiRoute { static constexpr bool PERM = true, AFTER_DRAIN = false; bf16_t *Q, *K, *V, *A2, *XA, *GSC;
    __device__ __forceinline__ void operator()(EPI_ARGS) const { EPI_PIN
        const int row0 = u.pm * 256 + wr * 64 + fr, cl = wc * 32 + 8 * fq;
        if (u.pn >= 6) {
            const int k = (u.pn - 6) >> 2, ct = (u.pn - 6) & 3; bf16_t* g0 = GSC + ((size_t)(k * 512 + (u.pm ? 256 : 0) + wr * 64 + fr)) * DM + ct * 256 + cl;
#pragma unroll
            for (int ai = 0; ai < 2; ++ai)
#pragma unroll
                for (int m = 0; m < 4; ++m)
#pragma unroll
                    for (int bj = 0; bj < 2; ++bj) { f32x4 a = acc[ai][bj][m][0], b = acc[ai][bj][m][1];
#pragma unroll
                        for (int j = 0; j < 4; ++j) { a[j] = sigm(a[j]); b[j] = sigm(b[j]); }
                        *(u32x4*)(g0 + (size_t)(ai * 128 + m * 16) * DM + bj * 128) = pack8(a, b); }
            return; }
        bf16_t* base; int ldc, coff = 0;
        if (u.pn == 0) { base = Q; ldc = 512; } else if (u.pn == 1) { base = Q; ldc = 512; coff = 256; } else if (u.pn == 2) { base = K; ldc = 256; } else if (u.pn == 3) { base = V; ldc = 256; } else { base = XA; ldc = 256; }
#pragma unroll
        for (int ai = 0; ai < 2; ++ai)
#pragma unroll
            for (int m = 0; m < 4; ++m) { const int row = row0 + ai * 128 + m * 16;
#pragma unroll
                for (int bj = 0; bj < 2; ++bj) { const u32x4 w = pack8(acc[ai][bj][m][0], acc[ai][bj][m][1]); const int c = bj * 128 + cl;
                    if (u.pn == 4) { const int g = c >> 4, h0 = c & 15; *(u32x4*)(A2 + ((size_t)g * S5ROWS + (row >> 5)) * S5K + (row & 31) * 16 + h0) = w; }
                    else *(u32x4*)(base + (size_t)row * ldc + coff + c) = w; } }
    }
};
struct EpiGate { static constexpr bool PERM = true, AFTER_DRAIN = false; bf16_t* GS;
    __device__ __forceinline__ void operator()(EPI_ARGS) const { EPI_PIN
        const int row0 = u.pm * 256 + wr * 64 + fr, col0 = u.pn * 256 + wc * 32 + 8 * fq;
#pragma unroll
        for (int ai = 0; ai < 2; ++ai)
#pragma unroll
            for (int m = 0; m < 4; ++m)
#pragma unroll
                for (int bj = 0; bj < 2; ++bj) { f32x4 a = acc[ai][bj][m][0], b = acc[ai][bj][m][1];
#pragma unroll
                    for (int j = 0; j < 4; ++j) { a[j] = sigm(a[j]); b[j] = sigm(b[j]); }
                    *(u32x4*)(GS + (size_t)(row0 + ai * 128 + m * 16) * DM + col0 + bj * 128) = pack8(a, b); }
    }
};
template <bool FIRST, bool CTX = false> struct EpiMerge { static constexpr bool PERM = true, AFTER_DRAIN = false; const bf16_t* GS; bf16_t* T;
    __device__ __forceinline__ void operator()(EPI_ARGS) const { EPI_PIN
        const int row0 = u.pm * 256 + wr * 64 + fr, col0 = u.pn * 256 + wc * 32 + 8 * fq, grow0 = CTX ? (u.pm ? 256 : 0) + wr * 64 + fr : row0;
#pragma unroll
        for (int ai = 0; ai < 2; ++ai)
#pragma unroll
            for (int m = 0; m < 4; ++m)
#pragma unroll
                for (int bj = 0; bj < 2; ++bj) { const size_t o = (size_t)(row0 + ai * 128 + m * 16) * DM + col0 + bj * 128;
                    const u32x4 g = *(const u32x4*)(GS + (size_t)(grow0 + ai * 128 + m * 16) * DM + col0 + bj * 128); u32x4 t = {0u, 0u, 0u, 0u}; if (!FIRST) t = *(const u32x4*)(T + o);
                    f32x4 a = acc[ai][bj][m][0], b = acc[ai][bj][m][1];
#pragma unroll
                    for (int q = 0; q < 2; ++q) { const unsigned gw = g[q], tw = t[q], gw2 = g[q + 2], tw2 = t[q + 2];
                        a[2 * q] = __builtin_bit_cast(float, tw << 16) + (__builtin_bit_cast(float, gw << 16)) * a[2 * q]; a[2 * q + 1] = __builtin_bit_cast(float, tw & 0xffff0000u) + (__builtin_bit_cast(float, gw & 0xffff0000u)) * a[2 * q + 1];
                        b[2 * q] = __builtin_bit_cast(float, tw2 << 16) + (__builtin_bit_cast(float, gw2 << 16)) * b[2 * q]; b[2 * q + 1] = __builtin_bit_cast(float, tw2 & 0xffff0000u) + (__builtin_bit_cast(float, gw2 & 0xffff0000u)) * b[2 * q + 1]; }
                    *(u32x4*)(T + o) = pack8(a, b); }
    }
};
struct EpiPlain { static constexpr bool PERM = true, AFTER_DRAIN = false; bf16_t* O; int ldc;
    __device__ __forceinline__ void operator()(EPI_ARGS) const { EPI_PIN
        const int row0 = u.pm * 256 + wr * 64 + fr, col0 = u.pn * 256 + wc * 32 + 8 * fq;
#pragma unroll
        for (int ai = 0; ai < 2; ++ai)
#pragma unroll
            for (int m = 0; m < 4; ++m)
#pragma unroll
                for (int bj = 0; bj < 2; ++bj) *(u32x4*)(O + (size_t)(row0 + ai * 128 + m * 16) * ldc + col0 + bj * 128) = pack8(acc[ai][bj][m][0], acc[ai][bj][m][1]);
    }
};
struct EpiGlu { static constexpr bool PERM = true, AFTER_DRAIN = false; bf16_t* O;
    __device__ __forceinline__ void operator()(EPI_ARGS) const { EPI_PIN
        const int row0 = u.pm * 256 + wr * 64 + fr, col0 = u.pn * 128 + wc * 32 + 8 * fq;
#pragma unroll
        for (int ai = 0; ai < 2; ++ai)
#pragma unroll
            for (int m = 0; m < 4; ++m) { f32x4 a = acc[ai][0][m][0], b = acc[ai][0][m][1]; const f32x4 ga = acc[ai][1][m][0], gb = acc[ai][1][m][1];
#pragma unroll
                for (int j = 0; j < 4; ++j) { a[j] *= sigm(ga[j]); b[j] *= sigm(gb[j]); }
                *(u32x4*)(O + (size_t)(row0 + ai * 128 + m * 16) * 256 + col0) = pack8(a, b); }
    }
};
struct EpiF32 { static constexpr bool PERM = true, AFTER_DRAIN = false; float* O;
    __device__ __forceinline__ void operator()(EPI_ARGS) const { EPI_PIN
        const int row0 = u.pm * 256 + wr * 64 + fr, col0 = wc * 32 + 8 * fq;
#pragma unroll
        for (int ai = 0; ai < 2; ++ai)
#pragma unroll
            for (int m = 0; m < 4; ++m)
#pragma unroll
                for (int bj = 0; bj < 2; ++bj)
#pragma unroll
                    for (int n = 0; n < 2; ++n) *(f32x4*)(O + (size_t)(row0 + ai * 128 + m * 16) * 256 + col0 + bj * 128 + 4 * n) = acc[ai][bj][m][n];
    }
};
__device__ __forceinline__ float gelu_tanh(float x) { const float y = 0.7978845608028654f * (x + 0.044715f * x * x * x); return x * sigm(2.0f * y); }
struct EpiS5Y { static constexpr bool PERM = true, AFTER_DRAIN = false; bf16_t* Gb;
    __device__ __forceinline__ void operator()(EPI_ARGS) const { EPI_PIN
        const int g = u.pm / 5, i = u.pm - 5 * g, jn = u.pn & 1;
#pragma unroll
        for (int ai = 0; ai < 2; ++ai)
#pragma unroll
            for (int m = 0; m < 4; ++m) { const int cidx = i * 256 + ai * 128 + wr * 64 + m * 16 + fr;
                if (cidx < S5CH) {
#pragma unroll
                    for (int bj = 0; bj < 2; ++bj) { const int c = jn * 256 + bj * 128 + wc * 32 + 8 * fq, jo = c >> 4, h0 = c & 15; f32x4 a = acc[ai][bj][m][0], b = acc[ai][bj][m][1];
#pragma unroll
                        for (int j = 0; j < 4; ++j) { a[j] = gelu_tanh(a[j]); b[j] = gelu_tanh(b[j]); }
                        *(u32x4*)(Gb + (size_t)(cidx * S5L + jo) * 256 + g * 16 + h0) = pack8(a, b); } } }
    }
};
struct RowOrder { pg8::StaticOrder so; bool skip;
    __device__ void init(int N, int G, int c, bool skip_) { skip = skip_; so.init(skip_ ? NBATCH * SEQ : MR, N, G, c); }
    __device__ bool next(int i, Unit& u) const { if (!so.next(i, u)) return false; if (skip) u.pm = u.pm + 1 + (u.pm >> 6); return true; }
    __device__ __forceinline__ void a_ready(const Unit&) const {}
    __device__ __forceinline__ void done(const Unit&) const {}
};
struct CtxSliceOrder { int nsl, G, c;
    __device__ bool next(int i, Unit& u) const { const int L = i * G + c; if (L >= 8 * nsl) return false; const int t = L / nsl, sl = L - t * nsl; u.pm = (t >> 2) ? 65 : 0; u.pn = t & 3; u.k0 = sl * 256; return true; }
    __device__ __forceinline__ void a_ready(const Unit&) const {}
    __device__ __forceinline__ void done(const Unit&) const {}
};
struct EpiPart { static constexpr bool PERM = true, AFTER_DRAIN = false; float* P;
    __device__ __forceinline__ void operator()(EPI_ARGS) const { EPI_PIN
        const int sl = u.k0 >> 8, bb = u.pm ? 1 : 0; float* base = P + ((size_t)(sl * 2 + bb) * 256 + wr * 64 + fr) * DM + u.pn * 256 + wc * 32 + 8 * fq;
#pragma unroll
        for (int ai = 0; ai < 2; ++ai)
#pragma unroll
            for (int m = 0; m < 4; ++m)
#pragma unroll
                for (int bj = 0; bj < 2; ++bj)
#pragma unroll
                    for (int n = 0; n < 2; ++n) *(f32x4*)(base + (size_t)(ai * 128 + m * 16) * DM + bj * 128 + 4 * n) = acc[ai][bj][m][n];
    }
};
struct InprojOrder { RowOrder ro; int nct, G, c;
    __device__ void init(int G_, int c_, int nct_) { ro.init(1536, G_, c_, true); nct = nct_; G = G_; c = c_; }
    __device__ bool next(int i, Unit& u) const { if (ro.next(i, u)) return true; const int idx = i * G + c - 768; if (idx < 0 || idx >= 2 * nct) return false; const int t = idx >= nct ? 1 : 0; u.pm = t ? 65 : 0; u.pn = idx - t * nct; u.k0 = 0; return true; }
    __device__ __forceinline__ void a_ready(const Unit&) const {}
    __device__ __forceinline__ void done(const Unit&) const {}
};
struct CtxTileOrder { int G, c;
    __device__ bool next(int i, Unit& u) const { const int L = i * G + c; if (L >= 8) return false; u.pm = (L >> 2) ? 65 : 0; u.pn = L & 3; u.k0 = 0; return true; }
    __device__ __forceinline__ void a_ready(const Unit&) const {}
    __device__ __forceinline__ void done(const Unit&) const {}
};
struct S5Order { int ncol, G, c;
    __device__ bool next(int i, Unit& u) const { const int L = i * G + c; if (L >= 80 * ncol) return false; const int g = L / (5 * ncol), rem = L - g * 5 * ncol; u.pm = g * 5 + rem / ncol; u.pn = g * ncol + rem % ncol; u.k0 = 0; return true; }
    __device__ __forceinline__ void a_ready(const Unit&) const {}
    __device__ __forceinline__ void done(const Unit&) const {}
};
__device__ __forceinline__ float shx(float v, int o, int lane) { return __builtin_bit_cast(float, __builtin_amdgcn_ds_bpermute((lane ^ o) << 2, __builtin_bit_cast(int, v))); }
__device__ __forceinline__ float wave_sum(float v, int lane) {
#pragma unroll
    for (int o = 1; o < 64; o <<= 1) v += shx(v, o, lane);
    return v;
}
__device__ __forceinline__ void tr_item(const float* W, int K, int ldw, int src_c0, bf16* WT, int dst_r0, int k0, LAS float* scr, int lane) {
    float tv[32];
#pragma unroll
    for (int i = 0; i < 32; ++i) { const int kk = 2 * i + (lane >> 5); tv[i] = W[(size_t)(k0 + kk) * ldw + src_c0 + (lane & 31)]; }
#pragma unroll
    for (int i = 0; i < 32; ++i) { const int kk = 2 * i + (lane >> 5); scr[kk * 33 + (lane & 31)] = tv[i]; }
    LDS_WAIT(); asm volatile("" ::: "memory");
    const int c = lane & 7;
#pragma unroll
    for (int j = 0; j < 4; ++j) { const int n = (lane >> 3) + 8 * j; const LAS float* s = scr + (8 * c) * 33 + n;
        v4u o; o.x = pk2(s[0 * 33], s[1 * 33]); o.y = pk2(s[2 * 33], s[3 * 33]); o.z = pk2(s[4 * 33], s[5 * 33]); o.w = pk2(s[6 * 33], s[7 * 33]);
        *(v4u*)(WT + (size_t)(dst_r0 + n) * K + k0 + 8 * c) = o; }
    LDS_WAIT(); asm volatile("" ::: "memory");
}
constexpr int CONV_ITEMS = 2 * 2816 + 2 * 1408 + 2816 + 4 * 128 + 512 + 64;
__device__ __forceinline__ void conv_item(Frame& F, int l, int it, LAS float* scr) {
    int r = it; const int lane = F.lane;
    if (r < 5632) { const int f = r / 2816; r -= f * 2816; const int kb = r / 176, n0 = (r % 176) * 32, pn = n0 >> 8, bj = (n0 >> 7) & 1, q = n0 & 127;
        tr_item(AIN(7) + (size_t)(l * 2 + f) * DM * 5632, DM, 5632, bj * DFF + 128 * pn + q, WSP(bf16, WS_W1T) + (size_t)f * 5632 * DM, n0, kb * 64, scr, lane); return; } r -= 5632;
    if (r < 2816) { const int f = r / 1408; r -= f * 1408; const int kb = r / 32, n0 = (r % 32) * 32;
        tr_item(AIN(8) + (size_t)(l * 2 + f) * DFF * DM, DFF, DM, n0, WSP(bf16, WS_W2T) + (size_t)f * DM * DFF, n0, kb * 64, scr, lane); return; } r -= 2816;
    if (r < 2816) { const int kb = r / 176, n0 = (r % 176) * 32; int src;
        if (n0 >= 1536) src = n0; else { const int t = n0 >> 8, off = n0 & 255;
            src = t == 0 ? 768 + off : t == 1 ? 1024 + off : t == 2 ? (off < 128 ? off : 512 + off - 128) : t == 3 ? (off < 128 ? 128 + off : 640 + off - 128) : t == 4 ? 256 + off : 1280 + off; }
        tr_item(AIN(9) + (size_t)l * DM * 5632, DM, 5632, src, WSP(bf16, WS_WINT), n0, kb * 64, scr, lane); return; } r -= 2816;
    if (r < 512) { const int k = r / 128; r -= k * 128; const int kb = r / 32, n0 = (r % 32) * 32;
        tr_item(AIN(23) + (size_t)(l * 4 + k) * 256 * DM, 256, DM, n0, WSP(bf16, WS_WBT) + (size_t)k * DM * 256, n0, kb * 64, scr, lane); return; } r -= 512;
    if (r < 512) { const int kb = r / 32, n0 = (r % 32) * 32;
        tr_item(AIN(24) + (size_t)l * DM * DM, DM, DM, n0, WSP(bf16, WS_WOT), n0, kb * 64, scr, lane); return; } r -= 512;
    { const int kb = r / 16, n0 = (r % 16) * 32, pn = n0 >> 8, bj = (n0 >> 7) & 1, q = n0 & 127;
        tr_item(AIN(22) + (size_t)l * 256 * 512, 256, 512, bj * 256 + 128 * pn + q, WSP(bf16, WS_WGT), n0, kb * 64, scr, lane); }
}
__device__ __forceinline__ void s5_table_item(Frame& F, int l, int item4, LAS float* scr) {
    asm volatile("" : "+s"(item4));
    const int item = item4 >> 2, qt = item4 & 3; const int g = item >> 5, j = item & 31, lane = F.lane, p = lane;
    bf16* BtY = WSP(bf16, WS_BTY) + (size_t)g * 512 * S5K; bf16* BtE = WSP(bf16, WS_BTE) + (size_t)g * 256 * S5K;
    float lre[2], lim[2], cfr[2], cfi[2], are[2], aim[2], dtv[2];
#pragma unroll
    for (int d = 0; d < 2; ++d) { const int ix = ((l * 2 + d) * 16 + g) * 64 + p; are[d] = AIN(14)[ix]; aim[d] = AIN(15)[ix]; dtv[d] = expf(AIN(16)[(l * 2 + d) * 16 + g]);
        const float mg = expf(are[d] * dtv[d]); float sn, cs; sincosf(aim[d] * dtv[d], &sn, &cs); const float br = mg * cs - 1.0f, bi = mg * sn; const float den = 1.0f / (are[d] * are[d] + aim[d] * aim[d]);
        cfr[d] = (br * are[d] + bi * aim[d]) * den; cfi[d] = (bi * are[d] - br * aim[d]) * den; }
#define LAMPOW(d, e, outr, outi) do { const float mg_ = expf(are[d] * dtv[d] * (float)(e)); float sn_, cs_; sincosf(aim[d] * dtv[d] * (float)(e), &sn_, &cs_); outr = mg_ * cs_; outi = mg_ * sn_; } while (0)
#pragma unroll
    for (int d = 0; d < 2; ++d) { float pr, pi; LAMPOW(d, j, pr, pi); scr[(d * 64 + p) * 2] = pr * cfr[d] - pi * cfi[d]; scr[(d * 64 + p) * 2 + 1] = pr * cfi[d] + pi * cfr[d]; }
    LDS_WAIT(); asm volatile("" ::: "memory");
    const int hi_ = lane & 15;
    { const int i2 = qt; const int ho = (lane >> 4) + 4 * i2; float kv[2];
#pragma unroll
        for (int d = 0; d < 2; ++d) { const float* cr = AIN(19) + (((size_t)(l * 2 + d) * 16 + g) * 16 + ho) * 64; const float* ci = AIN(20) + (((size_t)(l * 2 + d) * 16 + g) * 16 + ho) * 64;
            const float* br = AIN(17) + ((size_t)(l * 2 + d) * 16 + g) * 64 * 16 + hi_; const float* bi = AIN(18) + ((size_t)(l * 2 + d) * 16 + g) * 64 * 16 + hi_; float s = 0.f;
#pragma unroll 16
            for (int pp = 0; pp < 64; ++pp) { const float zr = scr[(d * 64 + pp) * 2], zi = scr[(d * 64 + pp) * 2 + 1], b_r = br[pp * 16], b_i = bi[pp * 16];
                const float wr_ = zr * b_r - zi * b_i, wi_ = zr * b_i + zi * b_r; s += cr[pp] * wr_ - ci[pp] * wi_; }
            kv[d] = s; }
        if (j == 0) { const float v = kv[0] + kv[1] + (ho == hi_ ? AIN(21)[l * 256 + g * 16 + ho] : 0.f);
            for (int q = 0; q < 32; ++q) BtY[(size_t)(q * 16 + ho) * S5K + q * 16 + hi_] = (bf16)f2bf(v); }
        else { const bf16 vf = (bf16)f2bf(kv[0]), vb = (bf16)f2bf(kv[1]);
            for (int q = 0; q + j < 32; ++q) { BtY[(size_t)((q + j) * 16 + ho) * S5K + q * 16 + hi_] = vf; BtY[(size_t)(q * 16 + ho) * S5K + (q + j) * 16 + hi_] = vb; } }
    }
    { const int d = qt >> 1; float pr, pi; LAMPOW(d, (d == 0 ? j + 1 : S5L - j), pr, pi);
#pragma unroll
        for (int ho = (qt & 1) * 8; ho < (qt & 1) * 8 + 8; ++ho) { const size_t ci_ = (((size_t)(l * 2 + d) * 16 + g) * 16 + ho) * 64 + p; const float c_r = AIN(19)[ci_], c_i = AIN(20)[ci_];
            bf16* row = BtY + (size_t)(j * 16 + ho) * S5K + 512 + d * 128; row[p] = (bf16)f2bf(c_r * pr - c_i * pi); row[64 + p] = (bf16)f2bf(-(c_r * pi + c_i * pr)); } }
    { const int d = qt >> 1, hh0 = (qt & 1) * 8; float pr, pi; LAMPOW(d, (d == 0 ? S5L - 1 - j : j), pr, pi); const float zr = pr * cfr[d] - pi * cfi[d], zi = pr * cfi[d] + pi * cfr[d];
        const size_t bi_ = (((size_t)(l * 2 + d) * 16 + g) * 64 + p) * 16 + hh0; unsigned wre[4], wim[4];
#pragma unroll
        for (int h4 = 0; h4 < 2; ++h4) { const f32x4 b_r = *(const f32x4*)(AIN(17) + bi_ + 4 * h4), b_i = *(const f32x4*)(AIN(18) + bi_ + 4 * h4);
            wre[2 * h4] = pk2(zr * b_r.x - zi * b_i.x, zr * b_r.y - zi * b_i.y); wre[2 * h4 + 1] = pk2(zr * b_r.z - zi * b_i.z, zr * b_r.w - zi * b_i.w);
            wim[2 * h4] = pk2(zr * b_i.x + zi * b_r.x, zr * b_i.y + zi * b_r.y); wim[2 * h4 + 1] = pk2(zr * b_i.z + zi * b_r.z, zr * b_i.w + zi * b_r.w); }
        *(v4u*)(BtE + (size_t)(d * 128 + p) * S5K + j * 16 + hh0) = (v4u){wre[0], wre[1], wre[2], wre[3]};
        *(v4u*)(BtE + (size_t)(d * 128 + 64 + p) * S5K + j * 16 + hh0) = (v4u){wim[0], wim[1], wim[2], wim[3]}; }
    for (int q = lane; q < 2 * 256; q += 64) BtE[(size_t)(8 * j + 2 * qt + (q >> 8)) * S5K + 512 + (q & 255)] = 0;
#undef LAMPOW
    LDS_WAIT(); asm volatile("" ::: "memory");
}
__device__ __forceinline__ void prep_layer(Frame& F, int l) {
    LAS float* scr = (LAS float*)(F.lds + F.wave * 16384);
    const int gw = F.vcu * NWAVES + F.wave, NGW = F.G * NWAVES;
    for (int it = gw; it < CONV_ITEMS; it += NGW) conv_item(F, l, it, scr);
    for (int it = NGW - 1 - gw; it < 2048; it += NGW) s5_table_item(F, l, it, scr);
    const int gt = gw * 64 + F.lane, NGT = NGW * 64;
    { bf16* Wp = WSP(bf16, WS_WPT); const float* pw = AIN(12) + (size_t)l * 4 * 64 * 64; const float* ps = AIN(13) + l * 256;
      for (int e = gt; e < 65536; e += NGT) { const int n = e >> 8, k = e & 255; Wp[e] = (bf16)(((n >> 6) == (k >> 6)) ? f2bf(pw[((n >> 6) * 64 + (k & 63)) * 64 + (n & 63)] * ps[n]) : 0u); } }
    { bf16* A2 = WSP(bf16, WS_A2); unsigned z_ = 0u; asm volatile("" : "+v"(z_)); for (int e = gt; e < 16 * S5ROWS * 32; e += NGT) { const int row = e >> 5, c8 = e & 31; *(v4u*)(A2 + (size_t)row * S5K + 512 + c8 * 8) = (v4u){z_, z_, z_, z_}; } }
}
__device__ __forceinline__ void mod_phase(Frame& F) {
    LAS float* red = (LAS float*)F.lds;
    for (int it = F.vcu; it < DEPTH * (NSUBMOD / 64); it += F.G) { const int l = it / (NSUBMOD / 64), n = (it % (NSUBMOD / 64)) * 64 + F.lane;
        const float* w = AIN(4) + ((size_t)l * DM + F.wave * 128) * NSUBMOD + n; float a0 = 0.f, a1 = 0.f, a2 = 0.f;
#pragma unroll 16
        for (int k = 0; k < 128; ++k) { const int kk = F.wave * 128 + k; const float c0 = AIN(1)[kk], c1 = AIN(1)[DM + kk], c2 = AIN(3)[kk]; const float wv = w[(size_t)k * NSUBMOD];
            a0 += c0 * sigm(c0) * wv; a1 += c1 * sigm(c1) * wv; a2 += c2 * sigm(c2) * wv; }
        red[(F.wave * 3 + 0) * 64 + F.lane] = a0; red[(F.wave * 3 + 1) * 64 + F.lane] = a1; red[(F.wave * 3 + 2) * 64 + F.lane] = a2;
        __syncthreads();
        if (F.wave < 3) { float s = AIN(5)[l * NSUBMOD + n];
#pragma unroll
            for (int w8 = 0; w8 < 8; ++w8) s += red[(w8 * 3 + F.wave) * 64 + F.lane];
            WSP(float, WS_MOD)[((size_t)l * 3 + F.wave) * NSUBMOD + n] = s; }
        __syncthreads();
    }
}
__device__ __forceinline__ void norm_phase(Frame& F, int l, int sub, const float* lat, const float* ctxp, const float* part = nullptr, int nsl = 0, const float* pgate = nullptr, float psc = 0.f, const float* psrc = nullptr, float* pdst = nullptr) {
    const int gw = F.vcu * NWAVES + F.wave, NGW = F.G * NWAVES; const float* gptr = AIN(6) + (size_t)(l * 3 + sub) * DM; bf16* HN = WSP(bf16, WS_HN);
    for (int r0 = gw; r0 < MR; r0 += 2 * NGW) { f32x4 v[2][4]; float s[2]; const float* mod[2]; int rr[2];
#pragma unroll
        for (int q2 = 0; q2 < 2; ++q2) { int r = r0 + q2 * NGW; if (r >= MR) r = r0; rr[q2] = r; const int b = r / TOK, i = r - b * TOK;
            const float* xr = i < CTXL ? ctxp + (size_t)(b * CTXL + i) * DM : lat + (size_t)(b * SEQ + i - CTXL) * DM;
            mod[q2] = WSP(float, WS_MOD) + ((size_t)l * 3 + (i < CTXL ? 2 : b)) * NSUBMOD + sub * 3072; s[q2] = 0.f;
            if (part != nullptr && i < CTXL) { const size_t ro = (size_t)(b * CTXL + i) * DM;
#pragma unroll
                for (int j = 0; j < 4; ++j) { f32x4 a = {0.f, 0.f, 0.f, 0.f};
                    for (int sl = 0; sl < nsl; ++sl) a += *((const f32x4*)(part + (size_t)sl * 2 * CTXL * DM + ro) + F.lane + 64 * j);
                    const f32x4 o = *((const f32x4*)(psrc + ro) + F.lane + 64 * j) + (*((const f32x4*)pgate + F.lane + 64 * j) * psc) * a;
                    if (q2 == 0 || r != r0) *((f32x4*)(pdst + ro) + F.lane + 64 * j) = o; v[q2][j] = o; } }
            else {
#pragma unroll
                for (int j = 0; j < 4; ++j) v[q2][j] = *((const f32x4*)xr + F.lane + 64 * j); } }
#pragma unroll
        for (int q2 = 0; q2 < 2; ++q2) {
#pragma unroll
            for (int j = 0; j < 4; ++j) s[q2] += (v[q2][j].x * v[q2][j].x + v[q2][j].y * v[q2][j].y) + (v[q2][j].z * v[q2][j].z + v[q2][j].w * v[q2][j].w);
            const float rstd = 1.0f / sqrtf(wave_sum(s[q2], F.lane) * (1.0f / DM) + EPS);
            if (q2 == 0 || rr[1] != rr[0]) {
#pragma unroll
                for (int j = 0; j < 4; ++j) { const f32x4 gg = *((const f32x4*)gptr + F.lane + 64 * j), sh = *((const f32x4*)mod[q2] + F.lane + 64 * j), sc = *((const f32x4*)(mod[q2] + DM) + F.lane + 64 * j);
                    const f32x4 o = (v[q2][j] * rstd * gg) * (sc + 1.0f) + sh;
                    *((unsigned long long*)(HN + (size_t)rr[q2] * DM) + F.lane + 64 * j) = (unsigned long long)pk2(o.x, o.y) | ((unsigned long long)pk2(o.z, o.w) << 32); } } }
    }
}
__device__ __forceinline__ void final_norm_phase(Frame& F) {
    const int gw = F.vcu * NWAVES + F.wave, NGW = F.G * NWAVES; const float* gptr = AIN(25);
    for (int r = gw; r < NBATCH * SEQ; r += NGW) { float* xr = AOUT + (size_t)r * DM; f32x4 v[4]; float s = 0.f;
#pragma unroll
        for (int j = 0; j < 4; ++j) { v[j] = *((const f32x4*)xr + F.lane + 64 * j); s += (v[j].x * v[j].x + v[j].y * v[j].y) + (v[j].z * v[j].z + v[j].w * v[j].w); }
        const float rstd = 1.0f / sqrtf(wave_sum(s, F.lane) * (1.0f / DM) + EPS);
#pragma unroll
        for (int j = 0; j < 4; ++j) { const f32x4 gg = *((const f32x4*)gptr + F.lane + 64 * j); *((f32x4*)xr + F.lane + 64 * j) = v[j] * rstd * gg; }
    }
}
__device__ __forceinline__ void post_phase(Frame& F, int l) {
    const int gw = F.vcu * NWAVES + F.wave, NGW = F.G * NWAVES, lane = F.lane, hh = lane >> 4, d = lane & 15;
    bf16* Q = WSP(bf16, WS_Q); bf16* K = WSP(bf16, WS_K); const bf16* XA = WSP(bf16, WS_XA); bf16* DF = WSP(bf16, WS_DIFF);
    const float inv = exp2f(-(float)d * (13.287712379549449f / 16.0f));
    const float* qg = AIN(11) + (size_t)l * 128; const float* kg = qg + 64;
    for (int r = gw; r < MR; r += NGW) { const int b = r / TOK, i = r - b * TOK; const bool lat = i >= CTXL; const int t = i - CTXL;
        const int n = lat ? SEQ : CTXL, ts = lat ? t : i; const size_t seg0 = (size_t)(r - ts); float pd[4];
#pragma unroll
        for (int j = 0; j < 4; ++j) { const int w = 2 << j; int lo = ts - (w >> 1), hi2 = lo + w; lo = lo < 0 ? 0 : lo; hi2 = hi2 > n ? n : hi2; float s = 0.f;
            for (int q2 = lo; q2 < hi2; ++q2) s += bf2f(XA[(seg0 + q2) * 256 + j * 64 + lane]);
            pd[j] = s / (float)(hi2 - lo) - bf2f(XA[(size_t)r * 256 + j * 64 + lane]); }
        float x[3][4];
#pragma unroll
        for (int it = 0; it < 3; ++it) { const bf16* p = it < 2 ? Q + (size_t)r * 512 + (it * 4 + hh) * 64 + d : K + (size_t)r * 256 + hh * 64 + d;
            x[it][0] = bf2f(p[0]); x[it][1] = bf2f(p[16]); x[it][2] = bf2f(p[32]); x[it][3] = bf2f(p[48]); }
        float cr = 1.f, sr = 0.f, cc = 1.f, sc = 0.f;
        if (lat) { sincosf((float)(t >> 6) * inv, &sr, &cr); sincosf((float)(t & 63) * inv, &sc, &cc); }
#pragma unroll
        for (int it = 0; it < 3; ++it) { float x0 = x[it][0], x1 = x[it][1], x2 = x[it][2], x3 = x[it][3];
            const bool nrm = (it == 1) || (it == 2 && hh >= 2);
            float ss = (x0 * x0 + x1 * x1) + (x2 * x2 + x3 * x3);
            ss += shx(ss, 1, lane); ss += shx(ss, 2, lane); ss += shx(ss, 4, lane); ss += shx(ss, 8, lane);
            if (nrm) { const float rs = 1.0f / sqrtf(ss * (1.0f / 64.0f) + EPS); const float* gp = it == 1 ? qg : kg; x0 *= rs * gp[d]; x1 *= rs * gp[d + 16]; x2 *= rs * gp[d + 32]; x3 *= rs * gp[d + 48]; }
            float o0 = x0 * cr - x1 * sr, o1 = x1 * cr + x0 * sr, o2 = x2 * cc - x3 * sc, o3 = x3 * cc + x2 * sc;
            if (it < 2) { o0 *= attn_body::C2; o1 *= attn_body::C2; o2 *= attn_body::C2; o3 *= attn_body::C2; }
            x[it][0] = o0; x[it][1] = o1; x[it][2] = o2; x[it][3] = o3; }
#pragma unroll
        for (int it = 0; it < 3; ++it) { bf16* p = it < 2 ? Q + (size_t)r * 512 + (it * 4 + hh) * 64 + d : K + (size_t)r * 256 + hh * 64 + d;
            p[0] = (bf16)f2bf(x[it][0]); p[16] = (bf16)f2bf(x[it][1]); p[32] = (bf16)f2bf(x[it][2]); p[48] = (bf16)f2bf(x[it][3]); }
#pragma unroll
        for (int j = 0; j < 4; ++j) DF[(size_t)r * 256 + j * 64 + lane] = (bf16)f2bf(pd[j]);
    }
}
__device__ __forceinline__ void s5_carry_phase(Frame& F, int l) {
    const int cid = (int)blockIdx.x - (F.G - 64);
    if (F.wave != 0 || cid < 0) return;
    const int b = cid >> 5, d = (cid >> 4) & 1, g = cid & 15, p = F.lane;
    const int ix = ((l * 2 + d) * 16 + g) * 64 + p; const float are = AIN(14)[ix], aim = AIN(15)[ix], dt = expf(AIN(16)[(l * 2 + d) * 16 + g]);
    const float mg = expf(are * dt * (float)S5L); float sn, cs; sincosf(aim * dt * (float)S5L, &sn, &cs); const float Lr = mg * cs, Li = mg * sn;
    const float* E = WSP(float, WS_E) + (size_t)g * S5ROWS * 256 + d * 128 + p; bf16* A2 = WSP(bf16, WS_A2) + (size_t)g * S5ROWS * S5K + 512 + d * 128 + p;
    float sr = 0.f, si = 0.f;
#pragma unroll 1
    for (int k0 = 0; k0 < 520; k0 += 65) { float er[65], ei[65];
#pragma unroll
        for (int k = 0; k < 65; ++k) { const int kk = k0 + k; const int ch = d == 0 ? kk : (kk < 8 ? 7 - kk : 527 - kk); const size_t row = (size_t)b * 520 + ch; er[k] = E[row * 256]; ei[k] = E[row * 256 + 64]; }
#pragma unroll
        for (int k = 0; k < 65; ++k) { const int kk = k0 + k; const int ch = d == 0 ? kk : (kk < 8 ? 7 - kk : 527 - kk); const size_t row = (size_t)b * 520 + ch;
            A2[row * S5K] = (bf16)f2bf(sr); A2[row * S5K + 64] = (bf16)f2bf(si);
            const float nr = Lr * sr - Li * si + er[k], ni = Lr * si + Li * sr + ei[k]; sr = nr; si = ni; } }
}
__device__ __forceinline__ void attn_one(Frame& F, int l, int kind, int b, int h, int qb, char* lds) {
    using namespace attn_body;
    const attn_body::bf16* Q = (const attn_body::bf16*)WSP(::bf16, WS_Q); const attn_body::bf16* K = (const attn_body::bf16*)WSP(::bf16, WS_K); const attn_body::bf16* V = (const attn_body::bf16*)WSP(::bf16, WS_V);
    attn_body::bf16* O = (attn_body::bf16*)WSP(::bf16, WS_Y4) + (size_t)(kind == 0 ? 1 : 3) * MR * 256;
    const size_t row0 = (size_t)b * TOK + (size_t)qb * 256;
    const attn_body::bf16* Qu = Q + row0 * 512 + kind * 256 + h * 64; const attn_body::bf16* Kh = K + (size_t)b * TOK * 256 + kind * 128 + (h >> 1) * 64; const attn_body::bf16* Vh = V + (size_t)b * TOK * 256 + kind * 128 + (h >> 1) * 64;
    attn_body::bf16* Ou = O + row0 * 256 + h * 64;
    if (kind == 0) { int NT = 4, shift = 0;
        if (qb > 0) { const int lo = (4 * qb - 2) < 4 ? 4 : (4 * qb - 2), hi = (4 * qb + 5) > 259 ? 259 : (4 * qb + 5); NT = 4 + hi - lo + 1; shift = lo - 4; }
        attn_unit<8, true>(Qu, Kh, Vh, Ou, NT, shift, (qb - 1) * 256, AIN(10)[l * 4 + h] * LOG2E, lds, F.wave * 64 + F.lane);
    } else attn_unit<8, false>(Qu, Kh, Vh, Ou, qb > 0 ? 260 : 4, 0, 0, 0.f, lds, F.wave * 64 + F.lane);
}
__device__ __forceinline__ void attn_phase(Frame& F, int l, char* lds) {
    const int c = F.vcu;
#pragma unroll 1
    for (int u = c; u < 512; u += F.G) attn_one(F, l, 0, u >> 8, (u >> 6) & 3, 1 + (u & 63), lds);
#pragma unroll 1
    for (int u = c; u < 16; u += F.G) attn_one(F, l, u >> 3, (u >> 2) & 1, u & 3, 0, lds);
#pragma unroll 1
    for (int u = c; u < 512; u += F.G) attn_one(F, l, 1, u >> 8, (u >> 6) & 3, 1 + (u & 63), lds);
}

#define XB_TMO      128
#define XB_XCNT(j)  (256  + 64 * (j))
#define XB_XSUB(j)  (1280 + 64 * (j))
#define XB_XGEN(j)  (2304 + 64 * (j))
#define XB_TOP      3328
#define XB_TOPGEN   3392
#define XCD_BAR_WORDS 3456
#define XB_SPIN_CAP (1u << 18)

__device__ __forceinline__ unsigned xb_ld(unsigned* p)              { return __hip_atomic_load(p, __ATOMIC_RELAXED, __HIP_MEMORY_SCOPE_AGENT); }
__device__ __forceinline__ unsigned xb_add(unsigned* p, unsigned v) { return __hip_atomic_fetch_add(p, v, __ATOMIC_RELAXED, __HIP_MEMORY_SCOPE_AGENT); }
__device__ __forceinline__ unsigned xb_xcc_id() { return (unsigned)__builtin_amdgcn_s_getreg((3 << 11) | 20) & 0xFu; }
#define XB_SPIN(cond, bar) do { unsigned _sp = 0; while (cond) { __builtin_amdgcn_s_sleep(1); \
    if ((++_sp & 255u) == 0u) { if (xb_ld(&(bar)[XB_TMO])) break; if (_sp > XB_SPIN_CAP) { atomicAdd(&(bar)[XB_TMO], 1u); break; } } } } while (0)

struct XcdBarrier {
    unsigned* bar; unsigned x;
    volatile LAS unsigned* st;
};

__device__ __forceinline__ XcdBarrier xcd_barrier_post(unsigned* bar, volatile LAS unsigned* st) {
    XcdBarrier b; b.bar = bar; b.x = xb_xcc_id(); b.st = st;
    if (threadIdx.x == 0) (void)xb_add(&bar[XB_XCNT(b.x)], 1u);
    return b;
}
__device__ __forceinline__ void xcd_barrier_complete(unsigned* bar, unsigned x, unsigned& nloc, unsigned& nx) {
    const unsigned G = gridDim.x * gridDim.y * gridDim.z;
    unsigned sum, cnt, mine, sp = 0u;
    for (;;) {
        sum = 0u; cnt = 0u; mine = 0u;
#pragma unroll
        for (unsigned j = 0; j < 16; ++j) { const unsigned c = xb_ld(&bar[XB_XCNT(j)]); sum += c; cnt += (c > 0u) ? 1u : 0u; mine = (j == x) ? c : mine; }
        if (sum == G) break;
        __builtin_amdgcn_s_sleep(1);
        if ((++sp & 255u) == 0u) { if (xb_ld(&bar[XB_TMO])) break; if (sp > XB_SPIN_CAP) { atomicAdd(&bar[XB_TMO], 1u); break; } }
    }
    nloc = mine > 0u ? mine : 1u; nx = cnt > 0u ? cnt : 1u;
}

__device__ __forceinline__ void xcd_barrier(const XcdBarrier& b) {
    asm volatile("s_waitcnt vmcnt(0)" ::: "memory");
    __syncthreads();
    if (threadIdx.x == 0) {
        unsigned* bar = b.bar;
        __builtin_amdgcn_s_waitcnt(0);
        unsigned nloc = b.st[0], nx = b.st[1];
        if (nloc == 0u) { xcd_barrier_complete(bar, b.x, nloc, nx); b.st[0] = nloc; b.st[1] = nx; }
        const unsigned old = xb_add(&bar[XB_XSUB(b.x)], 1u);
        const unsigned gen = old / nloc;
        if (old + 1u == (gen + 1u) * nloc) {
            __builtin_amdgcn_fence(__ATOMIC_RELEASE, "agent");
            asm volatile("s_waitcnt vmcnt(0)" ::: "memory");
            const unsigned og = xb_add(&bar[XB_TOP], 1u);
            const unsigned tg = og / nx;
            if (og + 1u == (tg + 1u) * nx) xb_add(&bar[XB_TOPGEN], 1u);
            else XB_SPIN(xb_ld(&bar[XB_TOPGEN]) == tg, bar);
            __builtin_amdgcn_fence(__ATOMIC_ACQUIRE, "agent");
            xb_add(&bar[XB_XGEN(b.x)], 1u);
            asm volatile("s_waitcnt vmcnt(0)" ::: "memory");
        } else {
            XB_SPIN(xb_ld(&bar[XB_XGEN(b.x)]) == gen, bar);
            __builtin_amdgcn_fence(__ATOMIC_ACQUIRE, "agent");
            asm volatile("s_waitcnt vmcnt(0)" ::: "memory");
        }
    }
    __syncthreads();
}

constexpr size_t WS_BAR = 16384;
using EpiMergeCT = EpiMerge<true, true>; using EpiMergeCF = EpiMerge<false, true>;
#ifndef MK_SPLIT
#define MK_SPLIT 0
#endif
constexpr int N_PHASES = 2 + DEPTH * 14 + 1;
__global__ void __launch_bounds__(NWAVES * 64, 2) mk_fwd(Args args) {
    extern __shared__ __attribute__((aligned(16))) unsigned char lds[];
    Frame F;
    F.lds = (LAS unsigned char*)lds; F.lane = 0; F.wave = __builtin_amdgcn_readfirstlane(threadIdx.x >> 6);
    F.G = gridDim.x; { const int bx = blockIdx.x; F.vcu = (F.G % 8 == 0) ? (bx % 8) * (F.G / 8) + bx / 8 : bx; }
    { volatile LAS unsigned* st_ = (volatile LAS unsigned*)(F.lds + RING_BYTES + 512); if (threadIdx.x < 2) st_[threadIdx.x] = 0u; __syncthreads();
      (void)xcd_barrier_post((unsigned*)(AWS + WS_BAR), st_); }
    const int lo = args.ph_lo, hi = args.ph_hi; int ph = 0;
    if (hi < 0) cg::this_grid().sync();
#ifndef ONLY_MASK
#define ONLY_MASK 0xffffffffu
#endif
#define SEL(n) ((ONLY_MASK >> (n)) & 1u)
#define PH_BEGIN if (lo <= ph && ph < hi) { { int l_; asm volatile("v_mbcnt_lo_u32_b32 %0, -1, 0\n\tv_mbcnt_hi_u32_b32 %0, -1, %0" : "=v"(l_)); F.lane = l_; }
#define PH_END   if (ph + 1 < hi) { asm volatile("s_waitcnt vmcnt(0) lgkmcnt(0)" ::: "memory");   \
        { XcdBarrier xb_; xb_.bar = (unsigned*)(AWS + WS_BAR); xb_.x = xb_xcc_id(); xb_.st = (volatile LAS unsigned*)(F.lds + RING_BYTES + 512); xcd_barrier(xb_); } } } ++ph;
#define GEMM(EPI, SCHEDT, A_, B_, K_, S_, E_) pg8::gemm_phase<EPI, SCHEDT, true, true>(F.lds, pg8::Gemm{(const pg8::bf16_t*)(A_), (const pg8::bf16_t*)(B_), 0, 0, (K_), (K_)}, S_, E_, F.wave * 64 + F.lane)
#define GEMM_P4(EPI, SCHEDT, A_, B_, K_, S_, E_) pg8::gemm_phase<EPI, SCHEDT, true, false>(F.lds, pg8::Gemm{(const pg8::bf16_t*)(A_), (const pg8::bf16_t*)(B_), 0, 0, (K_), (K_)}, S_, E_, F.wave * 64 + F.lane)
#define GEMML(EPI, SCHEDT, A_, B_, K_, LD_, S_, E_) pg8::gemm_phase<EPI, SCHEDT, true, true>(F.lds, pg8::Gemm{(const pg8::bf16_t*)(A_), (const pg8::bf16_t*)(B_), 0, 0, (K_), (LD_)}, S_, E_, F.wave * 64 + F.lane)
    float* XC = WSP(float, WS_XC);
    PH_BEGIN if (SEL(1)) { prep_layer(F, 0); __syncthreads(); mod_phase(F); } PH_END
#pragma unroll 1
    for (int l = 0; l < DEPTH; ++l) {
        const bool last = (l == DEPTH - 1);
        const float* MODl = WSP(float, WS_MOD) + (size_t)l * 3 * NSUBMOD;
        const float* srcL = l == 0 ? AIN(0) : AOUT; const float* srcC = l == 0 ? AIN(2) : XC;
        PH_BEGIN if (SEL(2)) { if (l > 0) { prep_layer(F, l); } if (l > 0) norm_phase(F, l, 0, srcL, srcC, WSP(float, WS_Y4), 11, WSP(float, WS_MOD) + (size_t)(l - 1) * 3 * NSUBMOD + 2 * 3072 + 2048 + 2 * NSUBMOD, 0.5f, XC, XC); else norm_phase(F, l, 0, srcL, srcC); } PH_END
#pragma unroll 1
        for (int f = 0; f < 2; ++f) {
            if (f == 1) {
                PH_BEGIN if (SEL(3)) { { InprojOrder S; S.init(F.G, (int)blockIdx.x, last ? 6 : 22); EpiRoute E{WSP(bf16_t, WS_Q), WSP(bf16_t, WS_K), WSP(bf16_t, WS_V), WSP(bf16_t, WS_A2), WSP(bf16_t, WS_XA), WSP(bf16_t, WS_GSC)};
                    GEMM(EpiRoute, InprojOrder, WSP(bf16, WS_HN), WSP(bf16, WS_WINT), DM, S, E); } } PH_END
                PH_BEGIN if (SEL(4)) { { post_phase(F, l); S5Order S{1, F.G, (int)blockIdx.x}; EpiF32 E{WSP(float, WS_E)}; GEMM(EpiF32, S5Order, WSP(bf16, WS_A2), WSP(bf16, WS_BTE), S5K, S, E); } } PH_END
                PH_BEGIN if (SEL(5)) { { s5_carry_phase(F, l); RowOrder S; S.init(256, F.G, (int)blockIdx.x, last); EpiPlain E{WSP(bf16_t, WS_Y4), 256}; GEMM(EpiPlain, RowOrder, WSP(bf16, WS_DIFF), WSP(bf16, WS_WPT), 256, S, E); } } PH_END
                PH_BEGIN if (SEL(6)) { { S5Order S{2, F.G, (int)blockIdx.x}; EpiS5Y E{WSP(bf16_t, WS_G)}; GEMM(EpiS5Y, S5Order, WSP(bf16, WS_A2), WSP(bf16, WS_BTY), S5K, S, E); } } PH_END
                PH_BEGIN if (SEL(7)) { { RowOrder S; S.init(512, F.G, (int)blockIdx.x, last); EpiGlu E{WSP(bf16_t, WS_Y4) + (size_t)2 * MR * 256}; GEMM(EpiGlu, RowOrder, WSP(bf16, WS_G), WSP(bf16, WS_WGT), 256, S, E);
                    attn_phase(F, l, (char*)lds); } } PH_END
                PH_BEGIN if (SEL(8)) { { RowOrder S; S.init(DM, F.G, (int)blockIdx.x, true); CtxTileOrder SC{F.G, (int)blockIdx.x};
#pragma unroll 1
                    for (int k = 0; k < 4; ++k) { EpiGate Eg{WSP(bf16_t, WS_GS)}; GEMM(EpiGate, RowOrder, WSP(bf16, WS_HN), WSP(bf16, WS_WINT) + (size_t)(1536 + k * 1024) * DM, DM, S, Eg);
                        const bf16* Ak = WSP(bf16, WS_Y4) + (size_t)k * MR * 256; const bf16* Bk = WSP(bf16, WS_WBT) + (size_t)k * DM * 256; const bf16_t* Gc = WSP(bf16_t, WS_GSC) + (size_t)k * 512 * DM;
                        if (k == 0) { EpiMerge<true> Em{WSP(bf16_t, WS_GS), WSP(bf16_t, WS_T)}; GEMM_P4(EpiMerge<true>, RowOrder, Ak, Bk, 256, S, Em);
                            if (!last) { EpiMerge<true, true> Ec{Gc, WSP(bf16_t, WS_T)}; GEMM_P4(EpiMergeCT, CtxTileOrder, Ak, Bk, 256, SC, Ec); } }
                        else { EpiMerge<false> Em{WSP(bf16_t, WS_GS), WSP(bf16_t, WS_T)}; GEMM_P4(EpiMerge<false>, RowOrder, Ak, Bk, 256, S, Em);
                            if (!last) { EpiMerge<false, true> Ec{Gc, WSP(bf16_t, WS_T)}; GEMM_P4(EpiMergeCF, CtxTileOrder, Ak, Bk, 256, SC, Ec); } } } } } PH_END
                PH_BEGIN if (SEL(9)) { { RowOrder S; S.init(DM, F.G, (int)blockIdx.x, true); EpiResid E{AOUT, XC, AOUT, XC, MODl + 1 * 3072 + 2048, 1.0f}; GEMM(EpiResid, RowOrder, WSP(bf16, WS_T), WSP(bf16, WS_WOT), DM, S, E); }
                    if (!last) { CtxSliceOrder S{4, F.G, (int)blockIdx.x}; EpiPart E{WSP(float, WS_Y4)}; GEMML(EpiPart, CtxSliceOrder, WSP(bf16, WS_T), WSP(bf16, WS_WOT), 256, DM, S, E); } } PH_END
                PH_BEGIN if (SEL(10)) { if (!last) norm_phase(F, l, 2, AOUT, XC, WSP(float, WS_Y4), 4, MODl + 1 * 3072 + 2048 + 2 * NSUBMOD, 1.0f, XC, XC); else norm_phase(F, l, 2, AOUT, XC); } PH_END
            }
            PH_BEGIN if (SEL(11)) { { RowOrder S; S.init(5632, F.G, (int)blockIdx.x, last && f == 1); EpiSwiglu E{WSP(bf16_t, WS_HID)}; GEMM(EpiSwiglu, RowOrder, WSP(bf16, WS_HN), WSP(bf16, WS_W1T) + (size_t)f * 5632 * DM, DM, S, E); } } PH_END
            PH_BEGIN if (SEL(12)) { { RowOrder S; S.init(DM, F.G, (int)blockIdx.x, true); const bool first = (l == 0 && f == 0);
                EpiResid E{first ? AIN(0) : AOUT, first ? AIN(2) : XC, AOUT, XC, MODl + (f == 0 ? 0 : 2) * 3072 + 2048, 0.5f};
                GEMM(EpiResid, RowOrder, WSP(bf16, WS_HID), WSP(bf16, WS_W2T) + (size_t)f * DM * DFF, DFF, S, E); }
                if (!(last && f == 1)) { CtxSliceOrder S{11, F.G, (int)blockIdx.x}; EpiPart E{WSP(float, WS_Y4)}; GEMML(EpiPart, CtxSliceOrder, WSP(bf16, WS_HID), WSP(bf16, WS_W2T) + (size_t)f * DM * DFF, 256, DFF, S, E); } } PH_END
            if (f == 0) { PH_BEGIN if (SEL(13)) { norm_phase(F, l, 1, AOUT, XC, WSP(float, WS_Y4), 11, MODl + 0 * 3072 + 2048 + 2 * NSUBMOD, 0.5f, l == 0 ? AIN(2) : XC, XC); } PH_END }
        }
    }
    PH_BEGIN if (SEL(14)) { final_norm_phase(F); } PH_END
}

extern "C" void kernel_launch(void* const* d_in, const int* in_sizes, int n_in, void* d_out, int out_size, void* d_ws, size_t ws_size, hipStream_t stream) {
    static int grid = 0;
    if (grid == 0) {
        int dev = 0, cus = 0, per_cu = 0;
        if (n_in != 26 || ws_size < WS_END) { fprintf(stderr, "kernel_launch: unexpected inputs (n_in %d, ws %zu < %zu)\n", n_in, ws_size, (size_t)WS_END); grid = -1; return; }
        hipGetDevice(&dev); hipDeviceGetAttribute(&cus, hipDeviceAttributeMultiprocessorCount, dev);
        hipFuncSetAttribute((const void*)mk_fwd, hipFuncAttributeMaxDynamicSharedMemorySize, LDS_BYTES);
        hipOccupancyMaxActiveBlocksPerMultiprocessor(&per_cu, (const void*)mk_fwd, NWAVES * 64, LDS_BYTES);
        if (per_cu < 1) { fprintf(stderr, "kernel_launch: occupancy query says %d blocks per CU\n", per_cu); per_cu = 1; }
        (void)hipGetLastError();
        grid = cus * per_cu;
    }
    if (grid < 0) return;
    Args a{};
    for (int i = 0; i < 26; ++i) a.in[i] = (const float*)d_in[i];
    a.out = (float*)d_out; a.ws = (unsigned char*)d_ws;
#if MK_SPLIT
    for (int p = 0; p < N_PHASES; ++p) { a.ph_lo = p; a.ph_hi = p + 1; hipLaunchKernelGGL(mk_fwd, dim3(grid), dim3(NWAVES * 64), LDS_BYTES, stream, a); }
#else
    if (hipMemsetAsync((char*)d_ws + WS_BAR, 0, 65536, stream) != hipSuccess) { fprintf(stderr, "kernel_launch: memset of the barrier words failed\n"); return; }
    a.ph_lo = 0; a.ph_hi = N_PHASES;
    void* kargs[] = {&a};
    hipError_t e = hipLaunchCooperativeKernel((const void*)mk_fwd, dim3(grid), dim3(NWAVES * 64), kargs, LDS_BYTES, stream);
    if (e != hipSuccess) fprintf(stderr, "cooperative launch failed: %s (grid %d)\n", hipGetErrorString(e), grid);
#endif
}
```

```cpp
#include <hip/hip_cooperative_groups.h>
#include <hip/hip_runtime.h>
#include <cstdio>
#include <cstdint>
namespace pg8 {
#define PG8_LAS __attribute__((address_space(3)))
typedef unsigned short bf16_t;
typedef short bf16x8 __attribute__((ext_vector_type(8)));
typedef float f32x4 __attribute__((ext_vector_type(4)));
typedef unsigned u32x4 __attribute__((ext_vector_type(4)));
constexpr int BM = 256, BK = 64, HALF = 128, HTB = HALF * BK * 2  , STAGE_BYTES = 8 * HTB, NXCD = 8, WGM = 8;

__host__ __device__ __forceinline__ int lds_byte(int r, int c) { const int st = (r >> 4) * 2 + (c >> 5), rr = r & 15, cc = c & 31, ob = rr * 64 + cc * 2; return st * 1024 + (ob ^ (((ob >> 9) & 1) << 5)); }
__host__ __device__ __forceinline__ void stage_rc(int b, int& R, int& C) { const int st = b / 1024, sb = b % 1024, swz = sb ^ (((sb >> 9) & 1) << 5); R = (st >> 1) * 16 + swz / 64; C = (st & 1) * 32 + (swz % 64) / 2; }
__host__ __device__ __forceinline__ int perm32(int rho) { const int n = rho >> 4, i = rho & 15; return 8 * (i >> 2) + 4 * n + (i & 3); }

struct Unit { int pm, pn, k0; };
struct Gemm { const bf16_t* A; const bf16_t* Bt; int M, N, K, ld; };

struct StaticOrder {
    int nM, nN, nwg, G, c;
    __host__ __device__ void init(int M, int N, int G_, int c_) { nM = M / BM; nN = N / BM; nwg = nM * nN; G = G_; c = c_; }
    __host__ __device__ bool next(int i, Unit& u) const {
        const long L = (long)i * G + c; if (L >= nwg) return false;
        int wgid = (int)L; { const int q = nwg / NXCD, r = nwg % NXCD, xcd = wgid % NXCD, off = wgid / NXCD; wgid = (xcd < r ? xcd * (q + 1) : r * (q + 1) + (xcd - r) * q) + off; }
        const int nig = WGM * nN, gid = wgid / nig, fm = gid * WGM, gsz = (nM - fm) < WGM ? (nM - fm) : WGM;
        u.pm = fm + ((wgid % nig) % gsz); u.pn = (wgid % nig) / gsz; u.k0 = 0; return true;
    }
    __device__ __forceinline__ void a_ready(const Unit&) const {}
    __device__ __forceinline__ void done(const Unit&) const {}
};

typedef float f32x2cv __attribute__((ext_vector_type(2))); typedef __bf16 bf16x2cv __attribute__((ext_vector_type(2)));
__device__ __forceinline__ unsigned cvt_pk_bf16(float lo, float hi) { f32x2cv v = {lo, hi}; bf16x2cv b = __builtin_convertvector(v, bf16x2cv); return __builtin_bit_cast(unsigned, b); }
typedef float f32x2 __attribute__((ext_vector_type(2)));
template <class Epi, class Sched, bool ALIGN_EPI = false, bool SP2 = false>
__device__ __forceinline__ void gemm_phase(PG8_LAS unsigned char* lds, const Gemm g, const Sched& S, const Epi& E, int tid) {
    float zf = 0.f; asm volatile("" : "+v"(zf));
    const int wid = __builtin_amdgcn_readfirstlane(tid >> 6), lane = tid & 63, wr = wid >> 2, wc = wid & 3, fr = lane & 15, fq = lane >> 4;
    const int K = g.K, nt = K / BK;
    unsigned voffA[2], voffB[2];
#pragma unroll
    for (int i = 0; i < 2; ++i) { int R, C; stage_rc(tid * 16 + i * 8192, R, C); const int Rb = Epi::PERM ? ((R & ~31) + perm32(R & 31)) : R;
        voffA[i] = (unsigned)(R * g.ld + C) * 2u; voffB[i] = (unsigned)(Rb * g.ld + C) * 2u; }
    const size_t kstep = (size_t)(BK * 2);
    const size_t hstep = (size_t)HALF * g.ld * 2;
    const size_t tstep = 2 * hstep;
    const unsigned ldsw = (unsigned)wid * 1024u;
    const int aoff = lds_byte(wr * 64 + fr, fq * 8), boff = lds_byte(wc * 32 + fr, fq * 8);
#define PG8_SA(b, h) (((b) * 2 + (h)) * HTB)
#define PG8_SB(b, h) ((4 + (b) * 2 + (h)) * HTB)
#define PG8_STAGE(bufoff, gbase, voff) do { _Pragma("unroll") for (int _i = 0; _i < 2; ++_i) \
        __builtin_amdgcn_global_load_lds((const unsigned*)((const char*)(gbase) + (voff)[_i]), (PG8_LAS unsigned*)(lds + (bufoff) + ldsw + _i * 8192), 16, 0, 0); } while (0)
#define PG8_LDA(dst, b, h) do { _Pragma("unroll") for (int m = 0; m < 4; ++m) _Pragma("unroll") for (int k = 0; k < 2; ++k) dst[m][k] = *(const PG8_LAS bf16x8*)(lds + PG8_SA(b, h) + aoff + m * 2048 + k * 1024); } while (0)
#define PG8_LDB(dst, b, h) do { _Pragma("unroll") for (int n = 0; n < 2; ++n) _Pragma("unroll") for (int k = 0; k < 2; ++k) dst[n][k] = *(const PG8_LAS bf16x8*)(lds + PG8_SB(b, h) + boff + n * 2048 + k * 1024); } while (0)
#define PG8_MMA(ai, bj, At, Bt) do { __builtin_amdgcn_s_setprio(1); _Pragma("unroll") for (int m = 0; m < 4; ++m) _Pragma("unroll") for (int n = 0; n < 2; ++n) _Pragma("unroll") for (int k = 0; k < 2; ++k) \
        acc[ai][bj][m][n] = __builtin_amdgcn_mfma_f32_16x16x32_bf16(Bt[n][k], At[m][k], acc[ai][bj][m][n], 0, 0, 0); __builtin_amdgcn_s_setprio(0); } while (0)
#define PG8_WAIT_V(n) asm volatile("s_waitcnt vmcnt(" #n ")" ::: "memory")
#define PG8_WAIT_L(n) asm volatile("s_waitcnt lgkmcnt(" #n ")" ::: "memory")
#define PG8_BAR __builtin_amdgcn_s_barrier()
#define PG8_SCHED __builtin_amdgcn_sched_barrier(0)
    Unit cur, nxt; int ui = 0;
    if (!S.next(0, cur)) return;
    f32x4 acc[2][2][4][2];
#pragma unroll
    for (int a = 0; a < 2; ++a)
#pragma unroll
        for (int b = 0; b < 2; ++b)
#pragma unroll
            for (int m = 0; m < 4; ++m)
#pragma unroll
                for (int n = 0; n < 2; ++n) acc[a][b][m][n] = (f32x4){zf, zf, zf, zf};
    bf16x8 At[4][2], B0[2][2], B1[2][2];
    const char* cA = (const char*)g.A + (size_t)cur.pm * tstep + (size_t)cur.k0 * 2; const char* cB = (const char*)g.Bt + (size_t)cur.pn * tstep + (size_t)cur.k0 * 2;
    S.a_ready(cur);
    if constexpr (SP2) {
        PG8_STAGE(PG8_SB(0, 0), cB, voffB); PG8_STAGE(PG8_SB(0, 1), cB + hstep, voffB); PG8_STAGE(PG8_SA(0, 0), cA, voffA); PG8_STAGE(PG8_SA(0, 1), cA + hstep, voffA);
        if (wr == 1) PG8_BAR;
        PG8_WAIT_V(2); PG8_BAR;
        PG8_STAGE(PG8_SB(1, 0), cB + kstep, voffB); PG8_STAGE(PG8_SA(1, 0), cA + kstep, voffA); PG8_STAGE(PG8_SB(1, 1), cB + hstep + kstep, voffB);
        PG8_WAIT_V(6); PG8_BAR;
    } else {
        PG8_STAGE(PG8_SB(0, 0), cB, voffB); PG8_STAGE(PG8_SA(0, 0), cA, voffA); PG8_STAGE(PG8_SB(0, 1), cB + hstep, voffB); PG8_STAGE(PG8_SA(0, 1), cA + hstep, voffA);
        if (wr == 1) PG8_BAR;
        PG8_WAIT_V(4); PG8_BAR;
        PG8_STAGE(PG8_SB(1, 0), cB + kstep, voffB); PG8_STAGE(PG8_SA(1, 0), cA + kstep, voffA); PG8_STAGE(PG8_SB(1, 1), cB + hstep + kstep, voffB);
        PG8_WAIT_V(6); PG8_BAR;
    }
    for (;;) {
        const bool has_next = S.next(ui + 1, nxt);
        const char* nA = has_next ? (const char*)g.A + (size_t)nxt.pm * tstep + (size_t)nxt.k0 * 2 : cA; const char* nB = has_next ? (const char*)g.Bt + (size_t)nxt.pn * tstep + (size_t)nxt.k0 * 2 : cB;
#pragma nounroll
        for (int t = 0; t < nt; t += 2) {
            const bool last = (t == nt - 2);
            const char* a1 = cA + (size_t)(t + 1) * kstep;
            const char* a2 = last ? nA : cA + (size_t)(t + 2) * kstep; const char* b2 = last ? nB : cB + (size_t)(t + 2) * kstep;
            const char* a3 = a2 + kstep; const char* b3 = b2 + kstep;
            if (last && has_next) S.a_ready(nxt);
            if constexpr (SP2) {
            PG8_LDB(B0, 0, 0); PG8_LDB(B1, 0, 1); PG8_SCHED; PG8_LDA(At, 0, 0); PG8_STAGE(PG8_SA(1, 1), a1 + hstep, voffA);
            PG8_WAIT_V(8); PG8_WAIT_L(0); PG8_BAR; PG8_MMA(0, 0, At, B0); PG8_MMA(0, 1, At, B1); PG8_BAR; PG8_SCHED;
            PG8_LDA(At, 0, 1); PG8_STAGE(PG8_SB(0, 0), b2, voffB); PG8_STAGE(PG8_SB(0, 1), b2 + hstep, voffB); PG8_STAGE(PG8_SA(0, 0), a2, voffA);
            PG8_WAIT_V(8); PG8_WAIT_L(0); PG8_BAR; PG8_MMA(1, 0, At, B0); PG8_MMA(1, 1, At, B1); PG8_BAR; PG8_SCHED;
            PG8_LDB(B0, 1, 0); PG8_LDB(B1, 1, 1); PG8_SCHED; PG8_LDA(At, 1, 0); PG8_STAGE(PG8_SA(0, 1), a2 + hstep, voffA);
            PG8_WAIT_V(8); PG8_WAIT_L(0); PG8_BAR; PG8_MMA(0, 0, At, B0); PG8_MMA(0, 1, At, B1); PG8_BAR; PG8_SCHED;
            PG8_LDA(At, 1, 1); PG8_STAGE(PG8_SB(1, 0), b3, voffB); PG8_STAGE(PG8_SB(1, 1), b3 + hstep, voffB); PG8_STAGE(PG8_SA(1, 0), a3, voffA);
            PG8_WAIT_V(8); PG8_WAIT_L(0); PG8_BAR; PG8_MMA(1, 0, At, B0); PG8_MMA(1, 1, At, B1); PG8_BAR; PG8_SCHED;
            } else {
            PG8_LDB(B0, 0, 0); PG8_SCHED; PG8_LDA(At, 0, 0); PG8_STAGE(PG8_SA(1, 1), a1 + hstep, voffA);
            PG8_WAIT_L(8); PG8_BAR; PG8_WAIT_L(0); PG8_MMA(0, 0, At, B0); PG8_BAR; PG8_SCHED;
            PG8_LDB(B1, 0, 1); PG8_STAGE(PG8_SB(0, 0), b2, voffB);
            PG8_BAR; PG8_WAIT_L(0); PG8_MMA(0, 1, At, B1); PG8_BAR;
            PG8_LDA(At, 0, 1); PG8_STAGE(PG8_SA(0, 0), a2, voffA);
            PG8_BAR; PG8_WAIT_L(0); PG8_MMA(1, 0, At, B0); PG8_BAR; PG8_SCHED;
            PG8_STAGE(PG8_SB(0, 1), b2 + hstep, voffB);
            PG8_WAIT_V(6); PG8_BAR; PG8_MMA(1, 1, At, B1); PG8_BAR;
            PG8_LDB(B0, 1, 0); PG8_SCHED; PG8_LDA(At, 1, 0); PG8_STAGE(PG8_SA(0, 1), a2 + hstep, voffA);
            PG8_WAIT_L(8); PG8_BAR; PG8_WAIT_L(0); PG8_MMA(0, 0, At, B0); PG8_BAR; PG8_SCHED;
            PG8_LDB(B1, 1, 1); PG8_STAGE(PG8_SB(1, 0), b3, voffB);
            PG8_BAR; PG8_WAIT_L(0); PG8_MMA(0, 1, At, B1); PG8_BAR;
            PG8_LDA(At, 1, 1); PG8_STAGE(PG8_SA(1, 0), a3, voffA);
            PG8_BAR; PG8_WAIT_L(0); PG8_MMA(1, 0, At, B0); PG8_BAR; PG8_SCHED;
            PG8_STAGE(PG8_SB(1, 1), b3 + hstep, voffB);
            PG8_WAIT_V(6); PG8_BAR; PG8_MMA(1, 1, At, B1); PG8_BAR;
            }
        }
        if constexpr (ALIGN_EPI) { if (wr == 0) PG8_BAR; }
        if constexpr (!Epi::AFTER_DRAIN) { E(acc, cur, wr, wc, fr, fq); S.done(cur); }
        if (!has_next) break;
#pragma unroll
        for (int a = 0; a < 2; ++a)
#pragma unroll
            for (int b = 0; b < 2; ++b)
#pragma unroll
                for (int m = 0; m < 4; ++m)
#pragma unroll
                    for (int n = 0; n < 2; ++n) acc[a][b][m][n] = (f32x4){zf, zf, zf, zf};
        cur = nxt; cA = nA; cB = nB; ++ui;
        if constexpr (ALIGN_EPI) { if (wr == 1) PG8_BAR; }
    }
    PG8_WAIT_V(0);
    if constexpr (!ALIGN_EPI) { if (wr == 0) PG8_BAR; }
    PG8_BAR;
    if constexpr (Epi::AFTER_DRAIN) { E.fused(acc, cur, wr, wc, fr, fq, lds, wid, lane); S.done(cur); }
#undef PG8_SA
#undef PG8_SB
#undef PG8_STAGE
#undef PG8_LDA
#undef PG8_LDB
#undef PG8_MMA
#undef PG8_WAIT_V
#undef PG8_WAIT_L
#undef PG8_BAR
#undef PG8_SCHED
}
}
namespace cg = cooperative_groups;
#include <hip/hip_bf16.h>
#include <cmath>
namespace attn_body {
using bf16=__hip_bfloat16;
using bf16x8=__attribute__((ext_vector_type(8)))short;
using s16x4=__attribute__((ext_vector_type(4)))short;
using f32x16=__attribute__((ext_vector_type(16)))float;
using u32x4=__attribute__((ext_vector_type(4)))unsigned;
constexpr int D=64,QP=512,KP=256,OP=256;
constexpr int NW=8,QBLK=32,QB=QBLK*NW,KVBLK=64;
__device__ __forceinline__ int crow(int r,int hi){return (r&3)+8*(r>>2)+4*hi;}
#define SBAR() __builtin_amdgcn_sched_barrier(0)
__device__ __forceinline__ void wmask(f32x16&p0,f32x16&p1,int dbase){
  const float NEG=-INFINITY;
  #pragma unroll
  for(int r=0;r<16;++r){int d=dbase+(r&3)+8*(r>>2); if((unsigned)(d+128)>256u)p0[r]=NEG; if((unsigned)(d+160)>256u)p1[r]=NEG;}
}

constexpr int NSLOT=3, SLOTB=8192;
constexpr int LDS_K=0, LDS_V=NSLOT*SLOTB, LDS_WS=2*NSLOT*SLOTB, LDS_OST=LDS_WS+NW*64*4, LDS_BYTES=LDS_OST+NW*4096;
constexpr float C2=0.125f*1.4426950408889634f;
__device__ __forceinline__ void glds16(const void*gsrc,unsigned lds_dst){unsigned keep;
  asm volatile("s_mov_b32 %0, m0\n\ts_mov_b32 m0, %2\n\ts_nop 0\n\tglobal_load_lds_dwordx4 %1, off\n\ts_mov_b32 m0, %0":"=&s"(keep):"v"(gsrc),"s"(lds_dst):"memory");}
__device__ __forceinline__ float max3f(float a,float b,float c){float r;asm("v_max3_f32 %0, %1, %2, %3":"=v"(r):"v"(a),"v"(b),"v"(c));return r;}
__device__ __forceinline__ float max2f(float a,float b){float r;asm("v_max_f32_e32 %0, %1, %2":"=v"(r):"v"(a),"v"(b));return r;}
__device__ __forceinline__ float fadd_s(float a,float b){float r;asm("v_add_f32_e32 %0, %1, %2":"=v"(r):"v"(a),"v"(b));return r;}
__device__ __forceinline__ float fsub_s(float a,float b){float r;asm("v_sub_f32_e32 %0, %1, %2":"=v"(r):"v"(a),"v"(b));return r;}
typedef float f32x2_t __attribute__((ext_vector_type(2))); typedef __bf16 bf16x2_t __attribute__((ext_vector_type(2)));
__device__ __forceinline__ unsigned cvtpk_s(float lo,float hi){f32x2_t v={lo,hi};bf16x2_t b=__builtin_convertvector(v,bf16x2_t);return __builtin_bit_cast(unsigned,b);}
#define WAIT_BAR(N) asm volatile("s_waitcnt vmcnt(" #N ") lgkmcnt(0)\n\ts_barrier":::"memory")

__device__ __forceinline__ void qkt(f32x16&p0,f32x16&p1,const char*Kslot,const bf16x8*qr,const f32x16&negm,int r32,int hi){
  const char*kb=Kslot+hi*1024+r32*16;
  #pragma unroll
  for(int d0=0;d0<4;++d0){
    const bf16x8 b0=*reinterpret_cast<const bf16x8*>(kb+d0*2048);
    const bf16x8 b1=*reinterpret_cast<const bf16x8*>(kb+d0*2048+512);
    if(d0==0){p0=__builtin_amdgcn_mfma_f32_32x32x16_bf16(b0,qr[0],negm,0,0,0);p1=__builtin_amdgcn_mfma_f32_32x32x16_bf16(b1,qr[0],negm,0,0,0);}
    else{p0=__builtin_amdgcn_mfma_f32_32x32x16_bf16(b0,qr[d0],p0,0,0,0);p1=__builtin_amdgcn_mfma_f32_32x32x16_bf16(b1,qr[d0],p1,0,0,0);}}
}
typedef __attribute__((address_space(3))) const char* lds_cptr;
typedef short v4i16_t __attribute__((ext_vector_type(4)));
__device__ __forceinline__ void kload8(bf16x8*kf,lds_cptr kp){
  kf[0]=*(const __attribute__((address_space(3))) bf16x8*)(kp);      kf[1]=*(const __attribute__((address_space(3))) bf16x8*)(kp+512);
  kf[2]=*(const __attribute__((address_space(3))) bf16x8*)(kp+2048); kf[3]=*(const __attribute__((address_space(3))) bf16x8*)(kp+2560);
  kf[4]=*(const __attribute__((address_space(3))) bf16x8*)(kp+4096); kf[5]=*(const __attribute__((address_space(3))) bf16x8*)(kp+4608);
  kf[6]=*(const __attribute__((address_space(3))) bf16x8*)(kp+6144); kf[7]=*(const __attribute__((address_space(3))) bf16x8*)(kp+6656);
}
__device__ __forceinline__ void kload2(bf16x8*kf,lds_cptr kp,int j){ kf[2*j]=*(const __attribute__((address_space(3))) bf16x8*)(kp+j*2048); kf[2*j+1]=*(const __attribute__((address_space(3))) bf16x8*)(kp+j*2048+512); }
__device__ __forceinline__ s16x4 vtr(lds_cptr p){ return __builtin_bit_cast(s16x4,__builtin_amdgcn_ds_read_tr16_b64_v4i16((__attribute__((address_space(3))) v4i16_t*)p)); }
__device__ __forceinline__ float rowmax(const f32x16&p0,const f32x16&p1){
  float a=max3f(p0[0],p0[1],p1[0]),b=max3f(p0[2],p0[3],p1[1]);a=max3f(a,p1[2],p1[3]);
  #pragma unroll
  for(int r=4;r<16;r+=4){a=max3f(a,p0[r],p0[r+1]);b=max3f(b,p0[r+2],p0[r+3]);a=max3f(a,p1[r],p1[r+1]);b=max3f(b,p1[r+2],p1[r+3]);}
  const float m=max2f(a,b);
  auto rr=__builtin_amdgcn_permlane32_swap(__float_as_uint(m),__float_as_uint(m),false,false);
  return max2f(__uint_as_float(rr[0]),__uint_as_float(rr[1]));
}
__device__ __forceinline__ void pv(f32x16*o,int vb,bf16x8 pa0,bf16x8 pa1,bf16x8 pa2,bf16x8 pa3){
  #pragma unroll
  for(int d0=0;d0<2;++d0){s16x4 lo[4],hi[4];
    #pragma unroll
    for(int ks=0;ks<4;++ks){
      asm volatile("ds_read_b64_tr_b16 %0,%1 offset:%c2":"=&v"(lo[ks]):"v"(vb),"i"(d0*4096+ks*1024):"memory");
      asm volatile("ds_read_b64_tr_b16 %0,%1 offset:%c2":"=&v"(hi[ks]):"v"(vb),"i"(d0*4096+ks*1024+512):"memory");}
    asm volatile("s_waitcnt lgkmcnt(0)":::"memory");SBAR();
    #define PK(k) (bf16x8){lo[k][0],lo[k][1],lo[k][2],lo[k][3],hi[k][0],hi[k][1],hi[k][2],hi[k][3]}
    o[d0]=__builtin_amdgcn_mfma_f32_32x32x16_bf16(pa0,PK(0),o[d0],0,0,0);
    o[d0]=__builtin_amdgcn_mfma_f32_32x32x16_bf16(pa1,PK(1),o[d0],0,0,0);
    o[d0]=__builtin_amdgcn_mfma_f32_32x32x16_bf16(pa2,PK(2),o[d0],0,0,0);
    o[d0]=__builtin_amdgcn_mfma_f32_32x32x16_bf16(pa3,PK(3),o[d0],0,0,0);
    #undef PK
  }
}

#ifndef ATTN_STORE16
#define ATTN_STORE16(p,v) (*(u32x4*)(p)=(v))
#endif
template<int THRL,bool WIN> __device__ __forceinline__ void attn_unit(const bf16*Qu,const bf16*__restrict__ Kh,const bf16*__restrict__ Vh,bf16*Ou,int NT,int shift,int qpos0,float sinkl2,char*shm,int tid){
  const int lane=tid&63,r32=lane&31,hi=lane>>5; const int wid=__builtin_amdgcn_readfirstlane(tid>>6);
  const bf16*Qw=Qu+(long)(wid*QBLK)*QP;
  const unsigned lds0=(unsigned)(uintptr_t)shm;
  float*wsf=(float*)(shm+LDS_WS)+wid*64;
  const bf16*ksrc=Kh+(long)lane*KP+wid*8;
  const bf16*vsrc=Vh+(long)(16*(wid&3)+(lane>>2))*KP+(wid>>2)*32+(lane&3)*8;
  const unsigned kdst=lds0+LDS_K+wid*1024, vdst=lds0+LDS_V+wid*1024;
  #define KROW(t) ((long)(((t)<4)?(t):((t)+shift))*(KVBLK*KP))
  #define DMA_K(t,slot) glds16(ksrc+KROW(t),(unsigned)__builtin_amdgcn_readfirstlane(kdst+(slot)))
  #define DMA_V(t,slot) glds16(vsrc+KROW(t),(unsigned)__builtin_amdgcn_readfirstlane(vdst+(slot)))
  const int vb0=(int)(lds0+LDS_V)+((lane>>4)&1)*32+(lane&3)*8+(4*hi+((lane&15)>>2))*64;
  const char*Kbase=shm+LDS_K; bf16x8 kf[8];
  const lds_cptr shm3=(lds_cptr)shm; const lds_cptr kp0=shm3+LDS_K+hi*1024+r32*16; const lds_cptr vp0=shm3+LDS_V+((lane>>4)&1)*32+(lane&3)*8+(4*hi+((lane&15)>>2))*64;
  DMA_K(0,0);DMA_V(0,0);DMA_K(1,SLOTB);
  bf16x8 qr[4];
  #pragma unroll
  for(int d0=0;d0<4;++d0)qr[d0]=*reinterpret_cast<const bf16x8*>(&Qw[(long)r32*QP+d0*16+hi*8]);
  float zf_=0.f;asm volatile("":"+v"(zf_)); float mhat=zf_,l_reg=zf_;f32x16 o[2];
  #pragma unroll
  for(int r=0;r<16;++r){o[0][r]=zf_;o[1][r]=zf_;}
  f32x16 negm;
  #pragma unroll
  for(int r=0;r<16;++r)negm[r]=zf_;
  asm volatile("":"+v"(negm));
  const int qrel=wid*QBLK+r32;
  const int mbase=4*hi-256-qpos0-qrel;
  #define CMASK(P0,P1,t) do{ if(WIN){ if((t)>=4) wmask(P0,P1,mbase+64*((t)+shift)); } }while(0)
  bool resc=false;
  #define START(P0,P1) do{ const float rm=rowmax(P0,P1); resc=false; \
    { const float dl=rm; mhat=fadd_s(mhat,dl); \
      _Pragma("unroll") for(int r=0;r<16;++r){P0[r]=fsub_s(P0[r],dl);P1[r]=fsub_s(P1[r],dl);} \
      _Pragma("unroll") for(int r=0;r<16;++r)negm[r]=-mhat; asm volatile("":"+v"(negm)); } \
    _Pragma("unroll") for(int r=0;r<16;++r)P0[r]=__builtin_amdgcn_exp2f(P0[r]); }while(0)
  #define RESC() do{ if(resc){ asm volatile("s_waitcnt lgkmcnt(0)":::"memory"); \
      _Pragma("unroll") for(int d_=0;d_<2;++d_) _Pragma("unroll") for(int r=0;r<16;++r)o[d_][r]*=wsf[crow(r,hi)]; } }while(0)
  f32x16 pA0,pA1,pB0,pB1;
  int sl_prev=0,sl_cur=0,sl_next=SLOTB;
  #define ROT() do{sl_prev=sl_cur;sl_cur=sl_next;sl_next=(sl_next==(NSLOT-1)*SLOTB)?0:sl_next+SLOTB;}while(0)
  DMA_K(2,2*SLOTB);
  WAIT_BAR(3);
  qkt(pA0,pA1,Kbase,qr,negm,r32,hi);asm volatile("s_nop 15\n\ts_nop 7":"+v"(pA0),"+v"(pA1));CMASK(pA0,pA1,0);
  START(pA0,pA1);
  _Pragma("unroll") for(int r=0;r<16;++r)pA1[r]=__builtin_amdgcn_exp2f(pA1[r]);
  WAIT_BAR(0);
  DMA_K(3,0);DMA_V(1,SLOTB);
  ROT();
  kload8(kf,kp0+sl_cur);
  WAIT_BAR(2);
  s16x4 vlo[8],vhi[8]; u32x4 pw0,pw1,pw2,pw3;
  #define PKW(P,B) cvtpk_s(P[B],P[B+1])
  #define PAF(k) __builtin_bit_cast(bf16x8,pw##k)
  #define VFR(i) (bf16x8){vlo[i][0],vlo[i][1],vlo[i][2],vlo[i][3],vhi[i][0],vhi[i][1],vhi[i][2],vhi[i][3]}
  #define PIN(x) asm volatile("":"+v"(x))
  #define MX3(a,b,c) __builtin_fmaxf(__builtin_fmaxf((a),(b)),(c))
  #define GAPA(MF,A0,A1,A2,A3,W0,W1,PW) do{ MF; sacc+=A0; sacc+=A1; sacc+=A2; sacc+=A3; PIN(sacc); W0; W1; PIN(PW); SBAR(); }while(0)
  #define EX(v) __builtin_amdgcn_exp2f(v)
  #define GAPB(MF,X,B) do{ MF; X[B]=EX(X[B]); X[B+1]=EX(X[B+1]); X[B+2]=EX(X[B+2]); X[B+3]=EX(X[B+3]); PIN(X); SBAR(); }while(0)
  #define VRD(i) do{ vlo[i]=vtr(vp_+(((i)>>2)*4096+((i)&3)*1024)); vhi[i]=vtr(vp_+(((i)>>2)*4096+((i)&3)*1024+512)); }while(0)
  #define KRD(G,j) do{ if(G){ kload2(kf,kp0+sl_next,j); SBAR(); } }while(0)
  #define STEP(C0,C1,P0,P1,t,GK,GV,GL) do{ SBAR(); \
    const lds_cptr vp_=vp0+sl_prev; \
    VRD(0); SBAR(); float sacc=(P0[0]+P0[1]); \
    GAPA(C0=__builtin_amdgcn_mfma_f32_32x32x16_bf16(kf[0],qr[0],negm,0,0,0), P0[2],P0[3],P0[4],P0[5],     pw0[0]=PKW(P0,0), pw0[1]=PKW(P0,2), pw0); \
    VRD(4); SBAR(); GAPA(C1=__builtin_amdgcn_mfma_f32_32x32x16_bf16(kf[1],qr[0],negm,0,0,0), P0[6],P0[7],P0[8],P0[9],     pw0[2]=PKW(P0,4), pw0[3]=PKW(P0,6), pw0); \
    VRD(1); SBAR(); GAPA(C0=__builtin_amdgcn_mfma_f32_32x32x16_bf16(kf[2],qr[1],C0,0,0,0),   P0[10],P0[11],P0[12],P0[13], pw1[0]=PKW(P0,8), pw1[1]=PKW(P0,10), pw1); \
    VRD(5); SBAR(); GAPA(C1=__builtin_amdgcn_mfma_f32_32x32x16_bf16(kf[3],qr[1],C1,0,0,0),   P0[14],P0[15],P1[0],P1[1],   pw1[2]=PKW(P0,12),pw1[3]=PKW(P0,14), pw1); \
    VRD(2); SBAR(); GAPA(C0=__builtin_amdgcn_mfma_f32_32x32x16_bf16(kf[4],qr[2],C0,0,0,0),   P1[2],P1[3],P1[4],P1[5],     pw2[0]=PKW(P1,0), pw2[1]=PKW(P1,2), pw2); \
    VRD(6); SBAR(); GAPA(C1=__builtin_amdgcn_mfma_f32_32x32x16_bf16(kf[5],qr[2],C1,0,0,0),   P1[6],P1[7],P1[8],P1[9],     pw2[2]=PKW(P1,4), pw2[3]=PKW(P1,6), pw2); \
    VRD(3); SBAR(); GAPA(C0=__builtin_amdgcn_mfma_f32_32x32x16_bf16(kf[6],qr[3],C0,0,0,0),   P1[10],P1[11],P1[12],P1[13], pw3[0]=PKW(P1,8), pw3[1]=PKW(P1,10), pw3); \
    VRD(7); SBAR(); GAPA(C1=__builtin_amdgcn_mfma_f32_32x32x16_bf16(kf[7],qr[3],C1,0,0,0),   P1[14],P1[15],0.f,0.f,       pw3[2]=PKW(P1,12),pw3[3]=PKW(P1,14), pw3); \
    l_reg+=sacc; \
    if(GK){DMA_K((t)+3,sl_cur);} if(GV){DMA_V((t)+1,sl_next);} \
    CMASK(C0,C1,t); \
    { float a=MX3(C0[0],C0[1],C1[0]),b=MX3(C0[2],C0[3],C1[1]); a=MX3(a,C1[2],C1[3]); \
      _Pragma("unroll") for(int r=4;r<16;r+=4){a=MX3(a,C0[r],C0[r+1]);b=MX3(b,C0[r+2],C0[r+3]);a=MX3(a,C1[r],C1[r+1]);b=MX3(b,C1[r+2],C1[r+3]);} \
      float rm=__builtin_fmaxf(a,b); { auto rr=__builtin_amdgcn_permlane32_swap(__float_as_uint(rm),__float_as_uint(rm),false,false); rm=__builtin_fmaxf(__uint_as_float(rr[0]),__uint_as_float(rr[1])); } \
      resc=false; \
      if(__builtin_expect(__any(rm>(float)THRL),0)){ const float dl=__builtin_fmaxf(rm,0.f); mhat+=dl; \
        _Pragma("unroll") for(int r=0;r<16;++r){C0[r]-=dl;C1[r]-=dl;} \
        _Pragma("unroll") for(int r=0;r<16;++r)negm[r]=-mhat; asm volatile("":"+v"(negm)); \
        const float f=__builtin_amdgcn_exp2f(-dl); l_reg*=f; if(hi==0)wsf[r32]=f; resc=true; } } \
    SBAR(); \
    GAPB(o[0]=__builtin_amdgcn_mfma_f32_32x32x16_bf16(PAF(0),VFR(0),o[0],0,0,0), C0,0); \
    GAPB(o[1]=__builtin_amdgcn_mfma_f32_32x32x16_bf16(PAF(0),VFR(4),o[1],0,0,0), C0,4); \
    KRD(GL,0); GAPB(o[0]=__builtin_amdgcn_mfma_f32_32x32x16_bf16(PAF(1),VFR(1),o[0],0,0,0), C0,8); \
    KRD(GL,1); GAPB(o[1]=__builtin_amdgcn_mfma_f32_32x32x16_bf16(PAF(1),VFR(5),o[1],0,0,0), C0,12); \
    KRD(GL,2); GAPB(o[0]=__builtin_amdgcn_mfma_f32_32x32x16_bf16(PAF(2),VFR(2),o[0],0,0,0), C1,0); \
    KRD(GL,3); GAPB(o[1]=__builtin_amdgcn_mfma_f32_32x32x16_bf16(PAF(2),VFR(6),o[1],0,0,0), C1,4); \
    GAPB(o[0]=__builtin_amdgcn_mfma_f32_32x32x16_bf16(PAF(3),VFR(3),o[0],0,0,0), C1,8); \
    GAPB(o[1]=__builtin_amdgcn_mfma_f32_32x32x16_bf16(PAF(3),VFR(7),o[1],0,0,0), C1,12); \
    }while(0)
  int t=1;
  for(;t+5<NT;t+=2){
    STEP(pB0,pB1,pA0,pA1,t,true,true,true);     WAIT_BAR(2); RESC(); ROT();
    STEP(pA0,pA1,pB0,pB1,t+1,true,true,true);   WAIT_BAR(2); RESC(); ROT();
  }
  #define ENDW(tt) do{ if((tt)+3<NT){WAIT_BAR(2);} else if((tt)+2<NT){WAIT_BAR(1);} else {WAIT_BAR(0);} }while(0)
  for(;t+1<NT;t+=2){
    STEP(pB0,pB1,pA0,pA1,t,(t+3<NT),(t+1<NT),(t+1<NT));       ENDW(t);   RESC(); ROT();
    STEP(pA0,pA1,pB0,pB1,t+1,(t+4<NT),(t+2<NT),(t+2<NT));     ENDW(t+1); RESC(); ROT();
  }
  STEP(pB0,pB1,pA0,pA1,NT-1,false,false,false); RESC();
  { float sacc=pB0[0]+pB0[1]; _Pragma("unroll") for(int r=2;r<16;++r)sacc+=pB0[r]; _Pragma("unroll") for(int r=0;r<16;++r)sacc+=pB1[r]; l_reg+=sacc;
    pw0=(u32x4){PKW(pB0,0),PKW(pB0,2),PKW(pB0,4),PKW(pB0,6)};pw1=(u32x4){PKW(pB0,8),PKW(pB0,10),PKW(pB0,12),PKW(pB0,14)};pw2=(u32x4){PKW(pB1,0),PKW(pB1,2),PKW(pB1,4),PKW(pB1,6)};pw3=(u32x4){PKW(pB1,8),PKW(pB1,10),PKW(pB1,12),PKW(pB1,14)};
    SBAR(); pv(o,vb0+sl_cur,PAF(0),PAF(1),PAF(2),PAF(3)); }
  #undef PKW
  #undef PAF
  #undef VFR
  #undef PIN
  #undef MX3
  #undef GAPA
  #undef GAPB
  #undef EX
  #undef VRD
  #undef KRD
  #undef STEP
  #undef ENDW
  {auto rr=__builtin_amdgcn_permlane32_swap(__float_as_uint(l_reg),__float_as_uint(l_reg),false,false);l_reg=__uint_as_float(rr[0])+__uint_as_float(rr[1]);}
  if(WIN)l_reg+=__builtin_amdgcn_exp2f(sinkl2-mhat);
  if(hi==0)wsf[32+r32]=l_reg;asm volatile("s_waitcnt lgkmcnt(0)":::"memory");
  float rli[16];
  #pragma unroll
  for(int r=0;r<16;++r)rli[r]=__builtin_amdgcn_rcpf(wsf[32+crow(r,hi)]);
  bf16*Ow=Ou+(long)(wid*QBLK)*OP;
  { bf16*stg=(bf16*)(shm+LDS_OST)+wid*2048;
    #pragma unroll
    for(int r=0;r<16;++r){const int orow=crow(r,hi);
      #pragma unroll
      for(int d0=0;d0<2;++d0)stg[orow*64+d0*32+r32]=__float2bfloat16(o[d0][r]*rli[r]);}
    asm volatile("s_waitcnt lgkmcnt(0)":::"memory");
    #pragma unroll
    for(int i=0;i<4;++i){const int row=i*8+(lane>>3),ch=lane&7; const u32x4 v=*(const u32x4*)(stg+row*64+ch*8); ATTN_STORE16(Ow+(long)row*OP+ch*8,v);} }
  asm volatile("s_waitcnt lgkmcnt(0)\n\ts_barrier":::"memory");
  #undef DMA_K
  #undef KROW
  #undef DMA_V
  #undef CMASK
  #undef START
  #undef RESC
  #undef ROT
}
constexpr int ATTN_LDS_BYTES=LDS_BYTES;
#undef SBAR
#undef WAIT_BAR
}
constexpr int NWAVES = 8;
constexpr int DM = 1024, NBATCH = 2, SEQ = 16384, CTXL = 256, TOK = SEQ + CTXL  , MR = NBATCH * TOK  ;
constexpr int DFF = 2816, NSUBMOD = 9216, DEPTH = 2;
constexpr float EPS = 1e-6f, LOG2E = 1.4426950408889634f;
constexpr int S5L = 32, S5ROWS = 1280  , S5CH = MR / S5L  , S5K = 768;

typedef unsigned short bf16;
typedef unsigned v4u __attribute__((ext_vector_type(4)));
typedef float f32x4 __attribute__((ext_vector_type(4)));
#define LAS __attribute__((address_space(3)))
#define LDS_WAIT() asm volatile("s_waitcnt lgkmcnt(0)" ::: "memory")
__device__ __forceinline__ unsigned f2bf(float f) { unsigned u = __builtin_bit_cast(unsigned, f); return (u + 0x7fffu + ((u >> 16) & 1u)) >> 16; }
__device__ __forceinline__ unsigned pk2(float lo, float hi) { return f2bf(lo) | (f2bf(hi) << 16); }
__device__ __forceinline__ float bf2f(unsigned short h) { return __builtin_bit_cast(float, (unsigned)h << 16); }
__device__ __forceinline__ float sigm(float x) { return __builtin_amdgcn_rcpf(1.0f + __builtin_amdgcn_exp2f(-x * LOG2E)); }

constexpr size_t MiB = 1u << 20;
constexpr size_t WS_MOD = 1 * MiB, WS_XC = 2 * MiB;
constexpr size_t WS_W1T = 4 * MiB, WS_W2T = 26 * MiB, WS_WINT = 37 * MiB, WS_WBT = 48 * MiB, WS_WOT = 50 * MiB, WS_WGT = 52 * MiB, WS_WPT = 52 * MiB + 256 * 1024;
constexpr size_t WS_BTY = 53 * MiB, WS_BTE = 65 * MiB, WS_E = 71 * MiB, WS_A2 = 91 * MiB, WS_HN = 121 * MiB, WS_T = 186 * MiB;
constexpr size_t WS_R = 251 * MiB;
constexpr size_t WS_HID = WS_R, WS_GS = WS_R, WS_Q = WS_R + 65 * MiB, WS_K = WS_Q + 65 * MiB / 2, WS_V = WS_K + 65 * MiB / 4, WS_XA = WS_V + 65 * MiB / 4, WS_G = WS_XA + 65 * MiB / 4,
                 WS_DIFF = WS_G + 65 * MiB / 4, WS_Y4 = WS_DIFF + 65 * MiB / 4, WS_GSC = 495 * MiB  , WS_END = 499 * MiB;
static_assert(WS_END <= 512 * MiB && WS_HID + (size_t)MR * DFF * 2 <= WS_Y4 + 65 * MiB, "ws map");
constexpr int RING_BYTES = 131072, LDS_BYTES = 147456;

struct Args { const float* in[26]; float* out; unsigned char* ws; int ph_lo, ph_hi; };
struct Frame { LAS unsigned char* lds; int lane, wave, vcu, G; };
typedef const volatile __attribute__((address_space(4))) unsigned long long karg_t;
__device__ __forceinline__ unsigned long long karg(int i) { return ((karg_t*)__builtin_amdgcn_kernarg_segment_ptr())[i]; }
#define AIN(i) ((const float*)karg(i))
#define AOUT ((float*)karg(26))
#define AWS ((unsigned char*)karg(27))
#define WSP(T, off) ((T*)(AWS + (off)))

__device__ __forceinline__ float* xrow_ptr(float* lat, float* ctxp, int r) { const int b = r / TOK, i = r - b * TOK; return i < CTXL ? ctxp + (size_t)(b * CTXL + i) * DM : lat + (size_t)(b * SEQ + i - CTXL) * DM; }

using pg8::f32x4; using pg8::Unit; using pg8::bf16_t; using pg8::cvt_pk_bf16; using pg8::u32x4;
#define EPI_ARGS const pg8::f32x4 (&acc)[2][2][4][2], const pg8::Unit& u, int wr, int wc, int fr_, int fq_
#define EPI_PIN int fr = fr_, fq = fq_; asm volatile("" : "+v"(fr), "+v"(fq));
struct EpiSwiglu { static constexpr bool PERM = true, AFTER_DRAIN = false; bf16_t* H;
    __device__ __forceinline__ void operator()(EPI_ARGS) const { EPI_PIN
        const int row0 = u.pm * 256 + wr * 64 + fr, hc = u.pn * 128 + wc * 32 + 8 * fq;
#pragma unroll
        for (int ai = 0; ai < 2; ++ai)
#pragma unroll
            for (int m = 0; m < 4; ++m) { bf16_t* rowp = H + (size_t)(row0 + ai * 128 + m * 16) * DFF + hc; float v[8];
#pragma unroll
                for (int n = 0; n < 2; ++n)
#pragma unroll
                    for (int j = 0; j < 4; ++j) { const float g = acc[ai][0][m][n][j], up = acc[ai][1][m][n][j]; v[n * 4 + j] = g * sigm(g) * up; }
                u32x4 w; w.x = cvt_pk_bf16(v[0], v[1]); w.y = cvt_pk_bf16(v[2], v[3]); w.z = cvt_pk_bf16(v[4], v[5]); w.w = cvt_pk_bf16(v[6], v[7]); *(u32x4*)rowp = w; }
    }
};
struct EpiResid { static constexpr bool PERM = true, AFTER_DRAIN = false; const float* src_lat; const float* src_ctx; float* dst_lat; float* dst_ctx; const float* gate; float sc;
    __device__ __forceinline__ void operator()(EPI_ARGS) const { EPI_PIN
        const int b = u.pm / 65, tq = u.pm - b * 65; const bool isc = tq == 0;
        const size_t off = isc ? (size_t)b * CTXL * DM : ((size_t)b * SEQ + (size_t)(tq - 1) * 256) * DM;
        const float* sp = (isc ? src_ctx : src_lat) + off; float* dp = (isc ? dst_ctx : dst_lat) + off;
        const float* gp = gate + (isc ? 2 : b) * NSUBMOD; const int col0 = u.pn * 256 + wc * 32 + 8 * fq;
        f32x4 gv[2][2];
#pragma unroll
        for (int bj = 0; bj < 2; ++bj)
#pragma unroll
            for (int n = 0; n < 2; ++n) gv[bj][n] = *(const f32x4*)(gp + col0 + bj * 128 + 4 * n) * sc;
#pragma unroll
        for (int ai = 0; ai < 2; ++ai)
#pragma unroll
            for (int m = 0; m < 4; ++m) { const size_t ro = (size_t)(ai * 128 + wr * 64 + m * 16 + fr) * DM + col0;
#pragma unroll
                for (int bj = 0; bj < 2; ++bj)
#pragma unroll
                    for (int n = 0; n < 2; ++n) { const f32x4 xv = *(const f32x4*)(sp + ro + bj * 128 + 4 * n); *(f32x4*)(dp + ro + bj * 128 + 4 * n) = xv + gv[bj][n] * acc[ai][bj][m][n]; } }
    }
};
__device__ __forceinline__ u32x4 pack8(const f32x4& a, const f32x4& b) { u32x4 w; w.x = cvt_pk_bf16(a[0], a[1]); w.y = cvt_pk_bf16(a[2], a[3]); w.z = cvt_pk_bf16(b[0], b[1]); w.w = cvt_pk_bf16(b[2], b[3]); return w; }
struct EpiRoute { static constexpr bool PERM = true, AFTER_DRAIN = false; bf16_t *Q, *K, *V, *A2, *XA, *GSC;
    __device__ __forceinline__ void operator()(EPI_ARGS) const { EPI_PIN
        const int row0 = u.pm * 256 + wr * 64 + fr, cl = wc * 32 + 8 * fq;
        if (u.pn >= 6) {
            const int k = (u.pn - 6) >> 2, ct = (u.pn - 6) & 3; bf16_t* g0 = GSC + ((size_t)(k * 512 + (u.pm ? 256 : 0) + wr * 64 + fr)) * DM + ct * 256 + cl;
#pragma unroll
            for (int ai = 0; ai < 2; ++ai)
#pragma unroll
                for (int m = 0; m < 4; ++m)
#pragma unroll
                    for (int bj = 0; bj < 2; ++bj) { f32x4 a = acc[ai][bj][m][0], b = acc[ai][bj][m][1];
#pragma unroll
                        for (int j = 0; j < 4; ++j) { a[j] = sigm(a[j]); b[j] = sigm(b[j]); }
                        *(u32x4*)(g0 + (size_t)(ai * 128 + m * 16) * DM + bj * 128) = pack8(a, b); }
            return; }
        bf16_t* base; int ldc, coff = 0;
        if (u.pn == 0) { base = Q; ldc = 512; } else if (u.pn == 1) { base = Q; ldc = 512; coff = 256; } else if (u.pn == 2) { base = K; ldc = 256; } else if (u.pn == 3) { base = V; ldc = 256; } else { base = XA; ldc = 256; }
#pragma unroll
        for (int ai = 0; ai < 2; ++ai)
#pragma unroll
            for (int m = 0; m < 4; ++m) { const int row = row0 + ai * 128 + m * 16;
#pragma unroll
                for (int bj = 0; bj < 2; ++bj) { const u32x4 w = pack8(acc[ai][bj][m][0], acc[ai][bj][m][1]); const int c = bj * 128 + cl;
                    if (u.pn == 4) { const int g = c >> 4, h0 = c & 15; *(u32x4*)(A2 + ((size_t)g * S5ROWS + (row >> 5)) * S5K + (row & 31) * 16 + h0) = w; }
                    else *(u32x4*)(base + (size_t)row * ldc + coff + c) = w; } }
    }
};
struct EpiGate { static constexpr bool PERM = true, AFTER_DRAIN = false; bf16_t* GS;
    __device__ __forceinline__ void operator()(EPI_ARGS) const { EPI_PIN
        const int row0 = u.pm * 256 + wr * 64 + fr, col0 = u.pn * 256 + wc * 32 + 8 * fq;
#pragma unroll
        for (int ai = 0; ai < 2; ++ai)
#pragma unroll
            for (int m = 0; m < 4; ++m)
#pragma unroll
                for (int bj = 0; bj < 2; ++bj) { f32x4 a = acc[ai][bj][m][0], b = acc[ai][bj][m][1];
#pragma unroll
                    for (int j = 0; j < 4; ++j) { a[j] = sigm(a[j]); b[j] = sigm(b[j]); }
                    *(u32x4*)(GS + (size_t)(row0 + ai * 128 + m * 16) * DM + col0 + bj * 128) = pack8(a, b); }
    }
};
template <bool FIRST, bool CTX = false> struct EpiMerge { static constexpr bool PERM = true, AFTER_DRAIN = false; const bf16_t* GS; bf16_t* T;
    __device__ __forceinline__ void operator()(EPI_ARGS) const { EPI_PIN
        const int row0 = u.pm * 256 + wr * 64 + fr, col0 = u.pn * 256 + wc * 32 + 8 * fq, grow0 = CTX ? (u.pm ? 256 : 0) + wr * 64 + fr : row0;
#pragma unroll
        for (int ai = 0; ai < 2; ++ai)
#pragma unroll
            for (int m = 0; m < 4; ++m)
#pragma unroll
                for (int bj = 0; bj < 2; ++bj) { const size_t o = (size_t)(row0 + ai * 128 + m * 16) * DM + col0 + bj * 128;
                    const u32x4 g = *(const u32x4*)(GS + (size_t)(grow0 + ai * 128 + m * 16) * DM + col0 + bj * 128); u32x4 t = {0u, 0u, 0u, 0u}; if (!FIRST) t = *(const u32x4*)(T + o);
                    f32x4 a = acc[ai][bj][m][0], b = acc[ai][bj][m][1];
#pragma unroll
                    for (int q = 0; q < 2; ++q) { const unsigned gw = g[q], tw = t[q], gw2 = g[q + 2], tw2 = t[q + 2];
                        a[2 * q] = __builtin_bit_cast(float, tw << 16) + (__builtin_bit_cast(float, gw << 16)) * a[2 * q]; a[2 * q + 1] = __builtin_bit_cast(float, tw & 0xffff0000u) + (__builtin_bit_cast(float, gw & 0xffff0000u)) * a[2 * q + 1];
                        b[2 * q] = __builtin_bit_cast(float, tw2 << 16) + (__builtin_bit_cast(float, gw2 << 16)) * b[2 * q]; b[2 * q + 1] = __builtin_bit_cast(float, tw2 & 0xffff0000u) + (__builtin_bit_cast(float, gw2 & 0xffff0000u)) * b[2 * q + 1]; }
                    *(u32x4*)(T + o) = pack8(a, b); }
    }
};
struct EpiPlain { static constexpr bool PERM = true, AFTER_DRAIN = false; bf16_t* O; int ldc;
    __device__ __forceinline__ void operator()(EPI_ARGS) const { EPI_PIN
        const int row0 = u.pm * 256 + wr * 64 + fr, col0 = u.pn * 256 + wc * 32 + 8 * fq;
#pragma unroll
        for (int ai = 0; ai < 2; ++ai)
#pragma unroll
            for (int m = 0; m < 4; ++m)
#pragma unroll
                for (int bj = 0; bj < 2; ++bj) *(u32x4*)(O + (size_t)(row0 + ai * 128 + m * 16) * ldc + col0 + bj * 128) = pack8(acc[ai][bj][m][0], acc[ai][bj][m][1]);
    }
};
struct EpiGlu { static constexpr bool PERM = true, AFTER_DRAIN = false; bf16_t* O;
    __device__ __forceinline__ void operator()(EPI_ARGS) const { EPI_PIN
        const int row0 = u.pm * 256 + wr * 64 + fr, col0 = u.pn * 128 + wc * 32 + 8 * fq;
#pragma unroll
        for (int ai = 0; ai < 2; ++ai)
#pragma unroll
            for (int m = 0; m < 4; ++m) { f32x4 a = acc[ai][0][m][0], b = acc[ai][0][m][1]; const f32x4 ga = acc[ai][1][m][0], gb = acc[ai][1][m][1];
#pragma unroll
                for (int j = 0; j < 4; ++j) { a[j] *= sigm(ga[j]); b[j] *= sigm(gb[j]); }
                *(u32x4*)(O + (size_t)(row0 + ai * 128 + m * 16) * 256 + col0) = pack8(a, b); }
    }
};
struct EpiF32 { static constexpr bool PERM = true, AFTER_DRAIN = false; float* O;
    __device__ __forceinline__ void operator()(EPI_ARGS) const { EPI_PIN
        const int row0 = u.pm * 256 + wr * 64 + fr, col0 = wc * 32 + 8 * fq;
#pragma unroll
        for (int ai = 0; ai < 2; ++ai)
#pragma unroll
            for (int m = 0; m < 4; ++m)
#pragma unroll
                for (int bj = 0; bj < 2; ++bj)
#pragma unroll
                    for (int n = 0; n < 2; ++n) *(f32x4*)(O + (size_t)(row0 + ai * 128 + m * 16) * 256 + col0 + bj * 128 + 4 * n) = acc[ai][bj][m][n];
    }
};
__device__ __forceinline__ float gelu_tanh(float x) { const float y = 0.7978845608028654f * (x + 0.044715f * x * x * x); return x * sigm(2.0f * y); }
struct EpiS5Y { static constexpr bool PERM = true, AFTER_DRAIN = false; bf16_t* Gb;
    __device__ __forceinline__ void operator()(EPI_ARGS) const { EPI_PIN
        const int g = u.pm / 5, i = u.pm - 5 * g, jn = u.pn & 1;
#pragma unroll
        for (int ai = 0; ai < 2; ++ai)
#pragma unroll
            for (int m = 0; m < 4; ++m) { const int cidx = i * 256 + ai * 128 + wr * 64 + m * 16 + fr;
                if (cidx < S5CH) {
#pragma unroll
                    for (int bj = 0; bj < 2; ++bj) { const int c = jn * 256 + bj * 128 + wc * 32 + 8 * fq, jo = c >> 4, h0 = c & 15; f32x4 a = acc[ai][bj][m][0], b = acc[ai][bj][m][1];
#pragma unroll
                        for (int j = 0; j < 4; ++j) { a[j] = gelu_tanh(a[j]); b[j] = gelu_tanh(b[j]); }
                        *(u32x4*)(Gb + (size_t)(cidx * S5L + jo) * 256 + g * 16 + h0) = pack8(a, b); } } }
    }
};
struct RowOrder { pg8::StaticOrder so; bool skip;
    __device__ void init(int N, int G, int c, bool skip_) { skip = skip_; so.init(skip_ ? NBATCH * SEQ : MR, N, G, c); }
    __device__ bool next(int i, Unit& u) const { if (!so.next(i, u)) return false; if (skip) u.pm = u.pm + 1 + (u.pm >> 6); return true; }
    __device__ __forceinline__ void a_ready(const Unit&) const {}
    __device__ __forceinline__ void done(const Unit&) const {}
};
struct CtxSliceOrder { int nsl, G, c;
    __device__ bool next(int i, Unit& u) const { const int L = i * G + c; if (L >= 8 * nsl) return false; const int t = L / nsl, sl = L - t * nsl; u.pm = (t >> 2) ? 65 : 0; u.pn = t & 3; u.k0 = sl * 256; return true; }
    __device__ __forceinline__ void a_ready(const Unit&) const {}
    __device__ __forceinline__ void done(const Unit&) const {}
};
struct EpiPart { static constexpr bool PERM = true, AFTER_DRAIN = false; float* P;
    __device__ __forceinline__ void operator()(EPI_ARGS) const { EPI_PIN
        const int sl = u.k0 >> 8, bb = u.pm ? 1 : 0; float* base = P + ((size_t)(sl * 2 + bb) * 256 + wr * 64 + fr) * DM + u.pn * 256 + wc * 32 + 8 * fq;
#pragma unroll
        for (int ai = 0; ai < 2; ++ai)
#pragma unroll
            for (int m = 0; m < 4; ++m)
#pragma unroll
                for (int bj = 0; bj < 2; ++bj)
#pragma unroll
                    for (int n = 0; n < 2; ++n) *(f32x4*)(base + (size_t)(ai * 128 + m * 16) * DM + bj * 128 + 4 * n) = acc[ai][bj][m][n];
    }
};
struct InprojOrder { RowOrder ro; int nct, G, c;
    __device__ void init(int G_, int c_, int nct_) { ro.init(1536, G_, c_, true); nct = nct_; G = G_; c = c_; }
    __device__ bool next(int i, Unit& u) const { if (ro.next(i, u)) return true; const int idx = i * G + c - 768; if (idx < 0 || idx >= 2 * nct) return false; const int t = idx >= nct ? 1 : 0; u.pm = t ? 65 : 0; u.pn = idx - t * nct; u.k0 = 0; return true; }
    __device__ __forceinline__ void a_ready(const Unit&) const {}
    __device__ __forceinline__ void done(const Unit&) const {}
};
struct CtxTileOrder { int G, c;
    __device__ bool next(int i, Unit& u) const { const int L = i * G + c; if (L >= 8) return false; u.pm = (L >> 2) ? 65 : 0; u.pn = L & 3; u.k0 = 0; return true; }
    __device__ __forceinline__ void a_ready(const Unit&) const {}
    __device__ __forceinline__ void done(const Unit&) const {}
};
struct S5Order { int ncol, G, c;
    __device__ bool next(int i, Unit& u) const { const int L = i * G + c; if (L >= 80 * ncol) return false; const int g = L / (5 * ncol), rem = L - g * 5 * ncol; u.pm = g * 5 + rem / ncol; u.pn = g * ncol + rem % ncol; u.k0 = 0; return true; }
    __device__ __forceinline__ void a_ready(const Unit&) const {}
    __device__ __forceinline__ void done(const Unit&) const {}
};
__device__ __forceinline__ float shx(float v, int o, int lane) { return __builtin_bit_cast(float, __builtin_amdgcn_ds_bpermute((lane ^ o) << 2, __builtin_bit_cast(int, v))); }
__device__ __forceinline__ float wave_sum(float v, int lane) {
#pragma unroll
    for (int o = 1; o < 64; o <<= 1) v += shx(v, o, lane);
    return v;
}
__device__ __forceinline__ void tr_item(const float* W, int K, int ldw, int src_c0, bf16* WT, int dst_r0, int k0, LAS float* scr, int lane) {
    float tv[32];
#pragma unroll
    for (int i = 0; i < 32; ++i) { const int kk = 2 * i + (lane >> 5); tv[i] = W[(size_t)(k0 + kk) * ldw + src_c0 + (lane & 31)]; }
#pragma unroll
    for (int i = 0; i < 32; ++i) { const int kk = 2 * i + (lane >> 5); scr[kk * 33 + (lane & 31)] = tv[i]; }
    LDS_WAIT(); asm volatile("" ::: "memory");
    const int c = lane & 7;
#pragma unroll
    for (int j = 0; j < 4; ++j) { const int n = (lane >> 3) + 8 * j; const LAS float* s = scr + (8 * c) * 33 + n;
        v4u o; o.x = pk2(s[0 * 33], s[1 * 33]); o.y = pk2(s[2 * 33], s[3 * 33]); o.z = pk2(s[4 * 33], s[5 * 33]); o.w = pk2(s[6 * 33], s[7 * 33]);
        *(v4u*)(WT + (size_t)(dst_r0 + n) * K + k0 + 8 * c) = o; }
    LDS_WAIT(); asm volatile("" ::: "memory");
}
constexpr int CONV_ITEMS = 2 * 2816 + 2 * 1408 + 2816 + 4 * 128 + 512 + 64;
__device__ __forceinline__ void conv_item(Frame& F, int l, int it, LAS float* scr) {
    int r = it; const int lane = F.lane;
    if (r < 5632) { const int f = r / 2816; r -= f * 2816; const int kb = r / 176, n0 = (r % 176) * 32, pn = n0 >> 8, bj = (n0 >> 7) & 1, q = n0 & 127;
        tr_item(AIN(7) + (size_t)(l * 2 + f) * DM * 5632, DM, 5632, bj * DFF + 128 * pn + q, WSP(bf16, WS_W1T) + (size_t)f * 5632 * DM, n0, kb * 64, scr, lane); return; } r -= 5632;
    if (r < 2816) { const int f = r / 1408; r -= f * 1408; const int kb = r / 32, n0 = (r % 32) * 32;
        tr_item(AIN(8) + (size_t)(l * 2 + f) * DFF * DM, DFF, DM, n0, WSP(bf16, WS_W2T) + (size_t)f * DM * DFF, n0, kb * 64, scr, lane); return; } r -= 2816;
    if (r < 2816) { const int kb = r / 176, n0 = (r % 176) * 32; int src;
        if (n0 >= 1536) src = n0; else { const int t = n0 >> 8, off = n0 & 255;
            src = t == 0 ? 768 + off : t == 1 ? 1024 + off : t == 2 ? (off < 128 ? off : 512 + off - 128) : t == 3 ? (off < 128 ? 128 + off : 640 + off - 128) : t == 4 ? 256 + off : 1280 + off; }
        tr_item(AIN(9) + (size_t)l * DM * 5632, DM, 5632, src, WSP(bf16, WS_WINT), n0, kb * 64, scr, lane); return; } r -= 2816;
    if (r < 512) { const int k = r / 128; r -= k * 128; const int kb = r / 32, n0 = (r % 32) * 32;
        tr_item(AIN(23) + (size_t)(l * 4 + k) * 256 * DM, 256, DM, n0, WSP(bf16, WS_WBT) + (size_t)k * DM * 256, n0, kb * 64, scr, lane); return; } r -= 512;
    if (r < 512) { const int kb = r / 32, n0 = (r % 32) * 32;
        tr_item(AIN(24) + (size_t)l * DM * DM, DM, DM, n0, WSP(bf16, WS_WOT), n0, kb * 64, scr, lane); return; } r -= 512;
    { const int kb = r / 16, n0 = (r % 16) * 32, pn = n0 >> 8, bj = (n0 >> 7) & 1, q = n0 & 127;
        tr_item(AIN(22) + (size_t)l * 256 * 512, 256, 512, bj * 256 + 128 * pn + q, WSP(bf16, WS_WGT), n0, kb * 64, scr, lane); }
}
__device__ __forceinline__ void s5_table_item(Frame& F, int l, int item4, LAS float* scr) {
    asm volatile("" : "+s"(item4));
    const int item = item4 >> 2, qt = item4 & 3; const int g = item >> 5, j = item & 31, lane = F.lane, p = lane;
    bf16* BtY = WSP(bf16, WS_BTY) + (size_t)g * 512 * S5K; bf16* BtE = WSP(bf16, WS_BTE) + (size_t)g * 256 * S5K;
    float lre[2], lim[2], cfr[2], cfi[2], are[2], aim[2], dtv[2];
#pragma unroll
    for (int d = 0; d < 2; ++d) { const int ix = ((l * 2 + d) * 16 + g) * 64 + p; are[d] = AIN(14)[ix]; aim[d] = AIN(15)[ix]; dtv[d] = expf(AIN(16)[(l * 2 + d) * 16 + g]);
        const float mg = expf(are[d] * dtv[d]); float sn, cs; sincosf(aim[d] * dtv[d], &sn, &cs); const float br = mg * cs - 1.0f, bi = mg * sn; const float den = 1.0f / (are[d] * are[d] + aim[d] * aim[d]);
        cfr[d] = (br * are[d] + bi * aim[d]) * den; cfi[d] = (bi * are[d] - br * aim[d]) * den; }
#define LAMPOW(d, e, outr, outi) do { const float mg_ = expf(are[d] * dtv[d] * (float)(e)); float sn_, cs_; sincosf(aim[d] * dtv[d] * (float)(e), &sn_, &cs_); outr = mg_ * cs_; outi = mg_ * sn_; } while (0)
#pragma unroll
    for (int d = 0; d < 2; ++d) { float pr, pi; LAMPOW(d, j, pr, pi); scr[(d * 64 + p) * 2] = pr * cfr[d] - pi * cfi[d]; scr[(d * 64 + p) * 2 + 1] = pr * cfi[d] + pi * cfr[d]; }
    LDS_WAIT(); asm volatile("" ::: "memory");
    const int hi_ = lane & 15;
    { const int i2 = qt; const int ho = (lane >> 4) + 4 * i2; float kv[2];
#pragma unroll
        for (int d = 0; d < 2; ++d) { const float* cr = AIN(19) + (((size_t)(l * 2 + d) * 16 + g) * 16 + ho) * 64; const float* ci = AIN(20) + (((size_t)(l * 2 + d) * 16 + g) * 16 + ho) * 64;
            const float* br = AIN(17) + ((size_t)(l * 2 + d) * 16 + g) * 64 * 16 + hi_; const float* bi = AIN(18) + ((size_t)(l * 2 + d) * 16 + g) * 64 * 16 + hi_; float s = 0.f;
#pragma unroll 16
            for (int pp = 0; pp < 64; ++pp) { const float zr = scr[(d * 64 + pp) * 2], zi = scr[(d * 64 + pp) * 2 + 1], b_r = br[pp * 16], b_i = bi[pp * 16];
                const float wr_ = zr * b_r - zi * b_i, wi_ = zr * b_i + zi * b_r; s += cr[pp] * wr_ - ci[pp] * wi_; }
            kv[d] = s; }
        if (j == 0) { const float v = kv[0] + kv[1] + (ho == hi_ ? AIN(21)[l * 256 + g * 16 + ho] : 0.f);
            for (int q = 0; q < 32; ++q) BtY[(size_t)(q * 16 + ho) * S5K + q * 16 + hi_] = (bf16)f2bf(v); }
        else { const bf16 vf = (bf16)f2bf(kv[0]), vb = (bf16)f2bf(kv[1]);
            for (int q = 0; q + j < 32; ++q) { BtY[(size_t)((q + j) * 16 + ho) * S5K + q * 16 + hi_] = vf; BtY[(size_t)(q * 16 + ho) * S5K + (q + j) * 16 + hi_] = vb; } }
    }
    { const int d = qt >> 1; float pr, pi; LAMPOW(d, (d == 0 ? j + 1 : S5L - j), pr, pi);
#pragma unroll
        for (int ho = (qt & 1) * 8; ho < (qt & 1) * 8 + 8; ++ho) { const size_t ci_ = (((size_t)(l * 2 + d) * 16 + g) * 16 + ho) * 64 + p; const float c_r = AIN(19)[ci_], c_i = AIN(20)[ci_];
            bf16* row = BtY + (size_t)(j * 16 + ho) * S5K + 512 + d * 128; row[p] = (bf16)f2bf(c_r * pr - c_i * pi); row[64 + p] = (bf16)f2bf(-(c_r * pi + c_i * pr)); } }
    { const int d = qt >> 1, hh0 = (qt & 1) * 8; float pr, pi; LAMPOW(d, (d == 0 ? S5L - 1 - j : j), pr, pi); const float zr = pr * cfr[d] - pi * cfi[d], zi = pr * cfi[d] + pi * cfr[d];
        const size_t bi_ = (((size_t)(l * 2 + d) * 16 + g) * 64 + p) * 16 + hh0; unsigned wre[4], wim[4];
#pragma unroll
        for (int h4 = 0; h4 < 2; ++h4) { const f32x4 b_r = *(const f32x4*)(AIN(17) + bi_ + 4 * h4), b_i = *(const f32x4*)(AIN(18) + bi_ + 4 * h4);
            wre[2 * h4] = pk2(zr * b_r.x - zi * b_i.x, zr * b_r.y - zi * b_i.y); wre[2 * h4 + 1] = pk2(zr * b_r.z - zi * b_i.z, zr * b_r.w - zi * b_i.w);
            wim[2 * h4] = pk2(zr * b_i.x + zi * b_r.x, zr * b_i.y + zi * b_r.y); wim[2 * h4 + 1] = pk2(zr * b_i.z + zi * b_r.z, zr * b_i.w + zi * b_r.w); }
        *(v4u*)(BtE + (size_t)(d * 128 + p) * S5K + j * 16 + hh0) = (v4u){wre[0], wre[1], wre[2], wre[3]};
        *(v4u*)(BtE + (size_t)(d * 128 + 64 + p) * S5K + j * 16 + hh0) = (v4u){wim[0], wim[1], wim[2], wim[3]}; }
    for (int q = lane; q < 2 * 256; q += 64) BtE[(size_t)(8 * j + 2 * qt + (q >> 8)) * S5K + 512 + (q & 255)] = 0;
#undef LAMPOW
    LDS_WAIT(); asm volatile("" ::: "memory");
}
__device__ __forceinline__ void prep_layer(Frame& F, int l) {
    LAS float* scr = (LAS float*)(F.lds + F.wave * 16384);
    const int gw = F.vcu * NWAVES + F.wave, NGW = F.G * NWAVES;
    for (int it = gw; it < CONV_ITEMS; it += NGW) conv_item(F, l, it, scr);
    for (int it = NGW - 1 - gw; it < 2048; it += NGW) s5_table_item(F, l, it, scr);
    const int gt = gw * 64 + F.lane, NGT = NGW * 64;
    { bf16* Wp = WSP(bf16, WS_WPT); const float* pw = AIN(12) + (size_t)l * 4 * 64 * 64; const float* ps = AIN(13) + l * 256;
      for (int e = gt; e < 65536; e += NGT) { const int n = e >> 8, k = e & 255; Wp[e] = (bf16)(((n >> 6) == (k >> 6)) ? f2bf(pw[((n >> 6) * 64 + (k & 63)) * 64 + (n & 63)] * ps[n]) : 0u); } }
    { bf16* A2 = WSP(bf16, WS_A2); unsigned z_ = 0u; asm volatile("" : "+v"(z_)); for (int e = gt; e < 16 * S5ROWS * 32; e += NGT) { const int row = e >> 5, c8 = e & 31; *(v4u*)(A2 + (size_t)row * S5K + 512 + c8 * 8) = (v4u){z_, z_, z_, z_}; } }
}
__device__ __forceinline__ void mod_phase(Frame& F) {
    LAS float* red = (LAS float*)F.lds;
    for (int it = F.vcu; it < DEPTH * (NSUBMOD / 64); it += F.G) { const int l = it / (NSUBMOD / 64), n = (it % (NSUBMOD / 64)) * 64 + F.lane;
        const float* w = AIN(4) + ((size_t)l * DM + F.wave * 128) * NSUBMOD + n; float a0 = 0.f, a1 = 0.f, a2 = 0.f;
#pragma unroll 16
        for (int k = 0; k < 128; ++k) { const int kk = F.wave * 128 + k; const float c0 = AIN(1)[kk], c1 = AIN(1)[DM + kk], c2 = AIN(3)[kk]; const float wv = w[(size_t)k * NSUBMOD];
            a0 += c0 * sigm(c0) * wv; a1 += c1 * sigm(c1) * wv; a2 += c2 * sigm(c2) * wv; }
        red[(F.wave * 3 + 0) * 64 + F.lane] = a0; red[(F.wave * 3 + 1) * 64 + F.lane] = a1; red[(F.wave * 3 + 2) * 64 + F.lane] = a2;
        __syncthreads();
        if (F.wave < 3) { float s = AIN(5)[l * NSUBMOD + n];
#pragma unroll
            for (int w8 = 0; w8 < 8; ++w8) s += red[(w8 * 3 + F.wave) * 64 + F.lane];
            WSP(float, WS_MOD)[((size_t)l * 3 + F.wave) * NSUBMOD + n] = s; }
        __syncthreads();
    }
}
__device__ __forceinline__ void norm_phase(Frame& F, int l, int sub, const float* lat, const float* ctxp, const float* part = nullptr, int nsl = 0, const float* pgate = nullptr, float psc = 0.f, const float* psrc = nullptr, float* pdst = nullptr) {
    const int gw = F.vcu * NWAVES + F.wave, NGW = F.G * NWAVES; const float* gptr = AIN(6) + (size_t)(l * 3 + sub) * DM; bf16* HN = WSP(bf16, WS_HN);
    for (int r0 = gw; r0 < MR; r0 += 2 * NGW) { f32x4 v[2][4]; float s[2]; const float* mod[2]; int rr[2];
#pragma unroll
        for (int q2 = 0; q2 < 2; ++q2) { int r = r0 + q2 * NGW; if (r >= MR) r = r0; rr[q2] = r; const int b = r / TOK, i = r - b * TOK;
            const float* xr = i < CTXL ? ctxp + (size_t)(b * CTXL + i) * DM : lat + (size_t)(b * SEQ + i - CTXL) * DM;
            mod[q2] = WSP(float, WS_MOD) + ((size_t)l * 3 + (i < CTXL ? 2 : b)) * NSUBMOD + sub * 3072; s[q2] = 0.f;
            if (part != nullptr && i < CTXL) { const size_t ro = (size_t)(b * CTXL + i) * DM;
#pragma unroll
                for (int j = 0; j < 4; ++j) { f32x4 a = {0.f, 0.f, 0.f, 0.f};
                    for (int sl = 0; sl < nsl; ++sl) a += *((const f32x4*)(part + (size_t)sl * 2 * CTXL * DM + ro) + F.lane + 64 * j);
                    const f32x4 o = *((const f32x4*)(psrc + ro) + F.lane + 64 * j) + (*((const f32x4*)pgate + F.lane + 64 * j) * psc) * a;
                    if (q2 == 0 || r != r0) *((f32x4*)(pdst + ro) + F.lane + 64 * j) = o; v[q2][j] = o; } }
            else {
#pragma unroll
                for (int j = 0; j < 4; ++j) v[q2][j] = *((const f32x4*)xr + F.lane + 64 * j); } }
#pragma unroll
        for (int q2 = 0; q2 < 2; ++q2) {
#pragma unroll
            for (int j = 0; j < 4; ++j) s[q2] += (v[q2][j].x * v[q2][j].x + v[q2][j].y * v[q2][j].y) + (v[q2][j].z * v[q2][j].z + v[q2][j].w * v[q2][j].w);
            const float rstd = 1.0f / sqrtf(wave_sum(s[q2], F.lane) * (1.0f / DM) + EPS);
            if (q2 == 0 || rr[1] != rr[0]) {
#pragma unroll
                for (int j = 0; j < 4; ++j) { const f32x4 gg = *((const f32x4*)gptr + F.lane + 64 * j), sh = *((const f32x4*)mod[q2] + F.lane + 64 * j), sc = *((const f32x4*)(mod[q2] + DM) + F.lane + 64 * j);
                    const f32x4 o = (v[q2][j] * rstd * gg) * (sc + 1.0f) + sh;
                    *((unsigned long long*)(HN + (size_t)rr[q2] * DM) + F.lane + 64 * j) = (unsigned long long)pk2(o.x, o.y) | ((unsigned long long)pk2(o.z, o.w) << 32); } } }
    }
}
__device__ __forceinline__ void final_norm_phase(Frame& F) {
    const int gw = F.vcu * NWAVES + F.wave, NGW = F.G * NWAVES; const float* gptr = AIN(25);
    for (int r = gw; r < NBATCH * SEQ; r += NGW) { float* xr = AOUT + (size_t)r * DM; f32x4 v[4]; float s = 0.f;
#pragma unroll
        for (int j = 0; j < 4; ++j) { v[j] = *((const f32x4*)xr + F.lane + 64 * j); s += (v[j].x * v[j].x + v[j].y * v[j].y) + (v[j].z * v[j].z + v[j].w * v[j].w); }
        const float rstd = 1.0f / sqrtf(wave_sum(s, F.lane) * (1.0f / DM) + EPS);
#pragma unroll
        for (int j = 0; j < 4; ++j) { const f32x4 gg = *((const f32x4*)gptr + F.lane + 64 * j); *((f32x4*)xr + F.lane + 64 * j) = v[j] * rstd * gg; }
    }
}
__device__ __forceinline__ void post_phase(Frame& F, int l) {
    const int gw = F.vcu * NWAVES + F.wave, NGW = F.G * NWAVES, lane = F.lane, hh = lane >> 4, d = lane & 15;
    bf16* Q = WSP(bf16, WS_Q); bf16* K = WSP(bf16, WS_K); const bf16* XA = WSP(bf16, WS_XA); bf16* DF = WSP(bf16, WS_DIFF);
    const float inv = exp2f(-(float)d * (13.287712379549449f / 16.0f));
    const float* qg = AIN(11) + (size_t)l * 128; const float* kg = qg + 64;
    for (int r = gw; r < MR; r += NGW) { const int b = r / TOK, i = r - b * TOK; const bool lat = i >= CTXL; const int t = i - CTXL;
        const int n = lat ? SEQ : CTXL, ts = lat ? t : i; const size_t seg0 = (size_t)(r - ts); float pd[4];
#pragma unroll
        for (int j = 0; j < 4; ++j) { const int w = 2 << j; int lo = ts - (w >> 1), hi2 = lo + w; lo = lo < 0 ? 0 : lo; hi2 = hi2 > n ? n : hi2; float s = 0.f;
            for (int q2 = lo; q2 < hi2; ++q2) s += bf2f(XA[(seg0 + q2) * 256 + j * 64 + lane]);
            pd[j] = s / (float)(hi2 - lo) - bf2f(XA[(size_t)r * 256 + j * 64 + lane]); }
        float x[3][4];
#pragma unroll
        for (int it = 0; it < 3; ++it) { const bf16* p = it < 2 ? Q + (size_t)r * 512 + (it * 4 + hh) * 64 + d : K + (size_t)r * 256 + hh * 64 + d;
            x[it][0] = bf2f(p[0]); x[it][1] = bf2f(p[16]); x[it][2] = bf2f(p[32]); x[it][3] = bf2f(p[48]); }
        float cr = 1.f, sr = 0.f, cc = 1.f, sc = 0.f;
        if (lat) { sincosf((float)(t >> 6) * inv, &sr, &cr); sincosf((float)(t & 63) * inv, &sc, &cc); }
#pragma unroll
        for (int it = 0; it < 3; ++it) { float x0 = x[it][0], x1 = x[it][1], x2 = x[it][2], x3 = x[it][3];
            const bool nrm = (it == 1) || (it == 2 && hh >= 2);
            float ss = (x0 * x0 + x1 * x1) + (x2 * x2 + x3 * x3);
            ss += shx(ss, 1, lane); ss += shx(ss, 2, lane); ss += shx(ss, 4, lane); ss += shx(ss, 8, lane);
            if (nrm) { const float rs = 1.0f / sqrtf(ss * (1.0f / 64.0f) + EPS); const float* gp = it == 1 ? qg : kg; x0 *= rs * gp[d]; x1 *= rs * gp[d + 16]; x2 *= rs * gp[d + 32]; x3 *= rs * gp[d + 48]; }
            float o0 = x0 * cr - x1 * sr, o1 = x1 * cr + x0 * sr, o2 = x2 * cc - x3 * sc, o3 = x3 * cc + x2 * sc;
            if (it < 2) { o0 *= attn_body::C2; o1 *= attn_body::C2; o2 *= attn_body::C2; o3 *= attn_body::C2; }
            x[it][0] = o0; x[it][1] = o1; x[it][2] = o2; x[it][3] = o3; }
#pragma unroll
        for (int it = 0; it < 3; ++it) { bf16* p = it < 2 ? Q + (size_t)r * 512 + (it * 4 + hh) * 64 + d : K + (size_t)r * 256 + hh * 64 + d;
            p[0] = (bf16)f2bf(x[it][0]); p[16] = (bf16)f2bf(x[it][1]); p[32] = (bf16)f2bf(x[it][2]); p[48] = (bf16)f2bf(x[it][3]); }
#pragma unroll
        for (int j = 0; j < 4; ++j) DF[(size_t)r * 256 + j * 64 + lane] = (bf16)f2bf(pd[j]);
    }
}
__device__ __forceinline__ void s5_carry_phase(Frame& F, int l) {
    const int cid = (int)blockIdx.x - (F.G - 64);
    if (cid < 0) return;
    const int b = cid >> 5, d = (cid >> 4) & 1, g = cid & 15, p = F.lane, w = F.wave;
    LAS float* ex = (LAS float*)F.lds;
    float Lr = 0.f, Li = 0.f, Mr = 0.f, Mi = 0.f; const float* E = nullptr; bf16* A2 = nullptr;
    if (w < 4) { const int ix = ((l * 2 + d) * 16 + g) * 64 + p; const float are = AIN(14)[ix], aim = AIN(15)[ix], dt = expf(AIN(16)[(l * 2 + d) * 16 + g]);
        { const float mg = expf(are * dt * (float)S5L); float sn, cs; sincosf(aim * dt * (float)S5L, &sn, &cs); Lr = mg * cs; Li = mg * sn; }
        { const float mg = expf(are * dt * (float)(S5L * 130)); float sn, cs; sincosf(aim * dt * (float)(S5L * 130), &sn, &cs); Mr = mg * cs; Mi = mg * sn; }
        E = WSP(float, WS_E) + (size_t)g * S5ROWS * 256 + d * 128 + p; A2 = WSP(bf16, WS_A2) + (size_t)g * S5ROWS * S5K + 512 + d * 128 + p; }
    float sr = 0.f, si = 0.f;
#pragma unroll 1
    for (int pass = 0; pass < 2; ++pass) {
        if (w < 4) {
#pragma unroll 1
            for (int k0 = 130 * w; k0 < 130 * w + 130; k0 += 65) { float er[65], ei[65];
#pragma unroll
                for (int k = 0; k < 65; ++k) { const int kk = k0 + k; const int ch = d == 0 ? kk : (kk < 8 ? 7 - kk : 527 - kk); const size_t row = (size_t)b * 520 + ch; er[k] = E[row * 256]; ei[k] = E[row * 256 + 64]; }
#pragma unroll
                for (int k = 0; k < 65; ++k) { const int kk = k0 + k; const int ch = d == 0 ? kk : (kk < 8 ? 7 - kk : 527 - kk); const size_t row = (size_t)b * 520 + ch;
                    if (pass) { A2[row * S5K] = (bf16)f2bf(sr); A2[row * S5K + 64] = (bf16)f2bf(si); }
                    const float nr = Lr * sr - Li * si + er[k], ni = Lr * si + Li * sr + ei[k]; sr = nr; si = ni; } } }
        if (pass == 0) {
            if (w < 4) { ex[(w * 64 + p) * 2] = sr; ex[(w * 64 + p) * 2 + 1] = si; }
            LDS_WAIT(); __syncthreads();
            sr = 0.f; si = 0.f;
            if (w < 4) { for (int v = 0; v < w; ++v) { const float tr = ex[(v * 64 + p) * 2], ti = ex[(v * 64 + p) * 2 + 1]; const float nr = Mr * sr - Mi * si + tr, ni = Mr * si + Mi * sr + ti; sr = nr; si = ni; } } }
    }
}
__device__ __forceinline__ void attn_one(Frame& F, int l, int kind, int b, int h, int qb, char* lds) {
    using namespace attn_body;
    const attn_body::bf16* Q = (const attn_body::bf16*)WSP(::bf16, WS_Q); const attn_body::bf16* K = (const attn_body::bf16*)WSP(::bf16, WS_K); const attn_body::bf16* V = (const attn_body::bf16*)WSP(::bf16, WS_V);
    attn_body::bf16* O = (attn_body::bf16*)WSP(::bf16, WS_Y4) + (size_t)(kind == 0 ? 1 : 3) * MR * 256;
    const size_t row0 = (size_t)b * TOK + (size_t)qb * 256;
    const attn_body::bf16* Qu = Q + row0 * 512 + kind * 256 + h * 64; const attn_body::bf16* Kh = K + (size_t)b * TOK * 256 + kind * 128 + (h >> 1) * 64; const attn_body::bf16* Vh = V + (size_t)b * TOK * 256 + kind * 128 + (h >> 1) * 64;
    attn_body::bf16* Ou = O + row0 * 256 + h * 64;
    if (kind == 0) { int NT = 4, shift = 0;
        if (qb > 0) { const int lo = (4 * qb - 2) < 4 ? 4 : (4 * qb - 2), hi = (4 * qb + 5) > 259 ? 259 : (4 * qb + 5); NT = 4 + hi - lo + 1; shift = lo - 4; }
        attn_unit<8, true>(Qu, Kh, Vh, Ou, NT, shift, (qb - 1) * 256, AIN(10)[l * 4 + h] * LOG2E, lds, F.wave * 64 + F.lane);
    } else attn_unit<8, false>(Qu, Kh, Vh, Ou, qb > 0 ? 260 : 4, 0, 0, 0.f, lds, F.wave * 64 + F.lane);
}
__device__ __forceinline__ void attn_phase(Frame& F, int l, char* lds) {
    const int c = F.vcu;
#pragma unroll 1
    for (int u = c; u < 512; u += F.G) attn_one(F, l, 0, u >> 8, (u >> 6) & 3, 1 + (u & 63), lds);
#pragma unroll 1
    for (int u = c; u < 16; u += F.G) attn_one(F, l, u >> 3, (u >> 2) & 1, u & 3, 0, lds);
#pragma unroll 1
    for (int u = c; u < 512; u += F.G) attn_one(F, l, 1, u >> 8, (u >> 6) & 3, 1 + (u & 63), lds);
}

#define XB_TMO      128
#define XB_XCNT(j)  (256  + 64 * (j))
#define XB_XSUB(j)  (1280 + 64 * (j))
#define XB_XGEN(j)  (2304 + 64 * (j))
#define XB_TOP      3328
#define XB_TOPGEN   3392
#define XCD_BAR_WORDS 3456
#define XB_SPIN_CAP (1u << 18)

__device__ __forceinline__ unsigned xb_ld(unsigned* p)              { return __hip_atomic_load(p, __ATOMIC_RELAXED, __HIP_MEMORY_SCOPE_AGENT); }
__device__ __forceinline__ unsigned xb_add(unsigned* p, unsigned v) { return __hip_atomic_fetch_add(p, v, __ATOMIC_RELAXED, __HIP_MEMORY_SCOPE_AGENT); }
__device__ __forceinline__ unsigned xb_xcc_id() { return (unsigned)__builtin_amdgcn_s_getreg((3 << 11) | 20) & 0xFu; }
#define XB_SPIN(cond, bar) do { unsigned _sp = 0; while (cond) { __builtin_amdgcn_s_sleep(1); \
    if ((++_sp & 255u) == 0u) { if (xb_ld(&(bar)[XB_TMO])) break; if (_sp > XB_SPIN_CAP) { atomicAdd(&(bar)[XB_TMO], 1u); break; } } } } while (0)

struct XcdBarrier {
    unsigned* bar; unsigned x;
    volatile LAS unsigned* st;
};

__device__ __forceinline__ XcdBarrier xcd_barrier_post(unsigned* bar, volatile LAS unsigned* st) {
    XcdBarrier b; b.bar = bar; b.x = xb_xcc_id(); b.st = st;
    if (threadIdx.x == 0) (void)xb_add(&bar[XB_XCNT(b.x)], 1u);
    return b;
}
__device__ __forceinline__ void xcd_barrier_complete(unsigned* bar, unsigned x, unsigned& nloc, unsigned& nx) {
    const unsigned G = gridDim.x * gridDim.y * gridDim.z;
    unsigned sum, cnt, mine, sp = 0u;
    for (;;) {
        sum = 0u; cnt = 0u; mine = 0u;
#pragma unroll
        for (unsigned j = 0; j < 16; ++j) { const unsigned c = xb_ld(&bar[XB_XCNT(j)]); sum += c; cnt += (c > 0u) ? 1u : 0u; mine = (j == x) ? c : mine; }
        if (sum == G) break;
        __builtin_amdgcn_s_sleep(1);
        if ((++sp & 255u) == 0u) { if (xb_ld(&bar[XB_TMO])) break; if (sp > XB_SPIN_CAP) { atomicAdd(&bar[XB_TMO], 1u); break; } }
    }
    nloc = mine > 0u ? mine : 1u; nx = cnt > 0u ? cnt : 1u;
}

__device__ __forceinline__ void xcd_barrier(const XcdBarrier& b) {
    asm volatile("s_waitcnt vmcnt(0)" ::: "memory");
    __syncthreads();
    if (threadIdx.x == 0) {
        unsigned* bar = b.bar;
        __builtin_amdgcn_s_waitcnt(0);
        unsigned nloc = b.st[0], nx = b.st[1];
        if (nloc == 0u) { xcd_barrier_complete(bar, b.x, nloc, nx); b.st[0] = nloc; b.st[1] = nx; }
        const unsigned old = xb_add(&bar[XB_XSUB(b.x)], 1u);
        const unsigned gen = old / nloc;
        if (old + 1u == (gen + 1u) * nloc) {
            __builtin_amdgcn_fence(__ATOMIC_RELEASE, "agent");
            asm volatile("s_waitcnt vmcnt(0)" ::: "memory");
            const unsigned og = xb_add(&bar[XB_TOP], 1u);
            const unsigned tg = og / nx;
            if (og + 1u == (tg + 1u) * nx) xb_add(&bar[XB_TOPGEN], 1u);
            else XB_SPIN(xb_ld(&bar[XB_TOPGEN]) == tg, bar);
            __builtin_amdgcn_fence(__ATOMIC_ACQUIRE, "agent");
            xb_add(&bar[XB_XGEN(b.x)], 1u);
            asm volatile("s_waitcnt vmcnt(0)" ::: "memory");
        } else {
            XB_SPIN(xb_ld(&bar[XB_XGEN(b.x)]) == gen, bar);
            __builtin_amdgcn_fence(__ATOMIC_ACQUIRE, "agent");
            asm volatile("s_waitcnt vmcnt(0)" ::: "memory");
        }
    }
    __syncthreads();
}

constexpr size_t WS_BAR = 16384;
using EpiMergeCT = EpiMerge<true, true>; using EpiMergeCF = EpiMerge<false, true>;
#ifndef MK_SPLIT
#define MK_SPLIT 0
#endif
constexpr int N_PHASES = 2 + DEPTH * 14 + 1;
__global__ void __launch_bounds__(NWAVES * 64, 2) mk_fwd(Args args) {
    extern __shared__ __attribute__((aligned(16))) unsigned char lds[];
    Frame F;
    F.lds = (LAS unsigned char*)lds; F.lane = 0; F.wave = __builtin_amdgcn_readfirstlane(threadIdx.x >> 6);
    F.G = gridDim.x; { const int bx = blockIdx.x; F.vcu = (F.G % 8 == 0) ? (bx % 8) * (F.G / 8) + bx / 8 : bx; }
    { volatile LAS unsigned* st_ = (volatile LAS unsigned*)(F.lds + RING_BYTES + 512); if (threadIdx.x < 2) st_[threadIdx.x] = 0u; __syncthreads();
      (void)xcd_barrier_post((unsigned*)(AWS + WS_BAR), st_); }
    const int lo = args.ph_lo, hi = args.ph_hi; int ph = 0;
    if (hi < 0) cg::this_grid().sync();
#ifndef ONLY_MASK
#define ONLY_MASK 0xffffffffu
#endif
#define SEL(n) ((ONLY_MASK >> (n)) & 1u)
#define PH_BEGIN if (lo <= ph && ph < hi) { { int l_; asm volatile("v_mbcnt_lo_u32_b32 %0, -1, 0\n\tv_mbcnt_hi_u32_b32 %0, -1, %0" : "=v"(l_)); F.lane = l_; }
#define PH_END   if (ph + 1 < hi) { asm volatile("s_waitcnt vmcnt(0) lgkmcnt(0)" ::: "memory");   \
        { XcdBarrier xb_; xb_.bar = (unsigned*)(AWS + WS_BAR); xb_.x = xb_xcc_id(); xb_.st = (volatile LAS unsigned*)(F.lds + RING_BYTES + 512); xcd_barrier(xb_); } } } ++ph;
#define GEMM(EPI, SCHEDT, A_, B_, K_, S_, E_) pg8::gemm_phase<EPI, SCHEDT, true, true>(F.lds, pg8::Gemm{(const pg8::bf16_t*)(A_), (const pg8::bf16_t*)(B_), 0, 0, (K_), (K_)}, S_, E_, F.wave * 64 + F.lane)
#define GEMM_P4(EPI, SCHEDT, A_, B_, K_, S_, E_) pg8::gemm_phase<EPI, SCHEDT, true, false>(F.lds, pg8::Gemm{(const pg8::bf16_t*)(A_), (const pg8::bf16_t*)(B_), 0, 0, (K_), (K_)}, S_, E_, F.wave * 64 + F.lane)
#define GEMML(EPI, SCHEDT, A_, B_, K_, LD_, S_, E_) pg8::gemm_phase<EPI, SCHEDT, true, true>(F.lds, pg8::Gemm{(const pg8::bf16_t*)(A_), (const pg8::bf16_t*)(B_), 0, 0, (K_), (LD_)}, S_, E_, F.wave * 64 + F.lane)
    float* XC = WSP(float, WS_XC);
    PH_BEGIN if (SEL(1)) { prep_layer(F, 0); __syncthreads(); mod_phase(F); } PH_END
#pragma unroll 1
    for (int l = 0; l < DEPTH; ++l) {
        const bool last = (l == DEPTH - 1);
        const float* MODl = WSP(float, WS_MOD) + (size_t)l * 3 * NSUBMOD;
        const float* srcL = l == 0 ? AIN(0) : AOUT; const float* srcC = l == 0 ? AIN(2) : XC;
        PH_BEGIN if (SEL(2)) { if (l > 0) { prep_layer(F, l); } if (l > 0) norm_phase(F, l, 0, srcL, srcC, WSP(float, WS_Y4), 11, WSP(float, WS_MOD) + (size_t)(l - 1) * 3 * NSUBMOD + 2 * 3072 + 2048 + 2 * NSUBMOD, 0.5f, XC, XC); else norm_phase(F, l, 0, srcL, srcC); } PH_END
#pragma unroll 1
        for (int f = 0; f < 2; ++f) {
            if (f == 1) {
                PH_BEGIN if (SEL(3)) { { InprojOrder S; S.init(F.G, (int)blockIdx.x, last ? 6 : 22); EpiRoute E{WSP(bf16_t, WS_Q), WSP(bf16_t, WS_K), WSP(bf16_t, WS_V), WSP(bf16_t, WS_A2), WSP(bf16_t, WS_XA), WSP(bf16_t, WS_GSC)};
                    GEMM(EpiRoute, InprojOrder, WSP(bf16, WS_HN), WSP(bf16, WS_WINT), DM, S, E); } } PH_END
                PH_BEGIN if (SEL(4)) { { post_phase(F, l); S5Order S{1, F.G, (int)blockIdx.x}; EpiF32 E{WSP(float, WS_E)}; GEMM(EpiF32, S5Order, WSP(bf16, WS_A2), WSP(bf16, WS_BTE), S5K, S, E); } } PH_END
                PH_BEGIN if (SEL(5)) { { s5_carry_phase(F, l); RowOrder S; S.init(256, F.G, (int)blockIdx.x, last); EpiPlain E{WSP(bf16_t, WS_Y4), 256}; GEMM(EpiPlain, RowOrder, WSP(bf16, WS_DIFF), WSP(bf16, WS_WPT), 256, S, E); } } PH_END
                PH_BEGIN if (SEL(6)) { { S5Order S{2, F.G, (int)blockIdx.x}; EpiS5Y E{WSP(bf16_t, WS_G)}; GEMM(EpiS5Y, S5Order, WSP(bf16, WS_A2), WSP(bf16, WS_BTY), S5K, S, E); } } PH_END
                PH_BEGIN if (SEL(7)) { { RowOrder S; S.init(512, F.G, (int)blockIdx.x, last); EpiGlu E{WSP(bf16_t, WS_Y4) + (size_t)2 * MR * 256}; GEMM(EpiGlu, RowOrder, WSP(bf16, WS_G), WSP(bf16, WS_WGT), 256, S, E);
                    attn_phase(F, l, (char*)lds); } } PH_END
                PH_BEGIN if (SEL(8)) { { RowOrder S; S.init(DM, F.G, (int)blockIdx.x, true); CtxTileOrder SC{F.G, (int)blockIdx.x};
#pragma unroll 1
                    for (int k = 0; k < 4; ++k) { EpiGate Eg{WSP(bf16_t, WS_GS)}; GEMM(EpiGate, RowOrder, WSP(bf16, WS_HN), WSP(bf16, WS_WINT) + (size_t)(1536 + k * 1024) * DM, DM, S, Eg);
                        const bf16* Ak = WSP(bf16, WS_Y4) + (size_t)k * MR * 256; const bf16* Bk = WSP(bf16, WS_WBT) + (size_t)k * DM * 256; const bf16_t* Gc = WSP(bf16_t, WS_GSC) + (size_t)k * 512 * DM;
                        if (k == 0) { EpiMerge<true> Em{WSP(bf16_t, WS_GS), WSP(bf16_t, WS_T)}; GEMM_P4(EpiMerge<true>, RowOrder, Ak, Bk, 256, S, Em);
                            if (!last) { EpiMerge<true, true> Ec{Gc, WSP(bf16_t, WS_T)}; GEMM_P4(EpiMergeCT, CtxTileOrder, Ak, Bk, 256, SC, Ec); } }
                        else { EpiMerge<false> Em{WSP(bf16_t, WS_GS), WSP(bf16_t, WS_T)}; GEMM_P4(EpiMerge<false>, RowOrder, Ak, Bk, 256, S, Em);
                            if (!last) { EpiMerge<false, true> Ec{Gc, WSP(bf16_t, WS_T)}; GEMM_P4(EpiMergeCF, CtxTileOrder, Ak, Bk, 256, SC, Ec); } } } } } PH_END
                PH_BEGIN if (SEL(9)) { { RowOrder S; S.init(DM, F.G, (int)blockIdx.x, true); EpiResid E{AOUT, XC, AOUT, XC, MODl + 1 * 3072 + 2048, 1.0f}; GEMM(EpiResid, RowOrder, WSP(bf16, WS_T), WSP(bf16, WS_WOT), DM, S, E); }
                    if (!last) { CtxSliceOrder S{4, F.G, (int)blockIdx.x}; EpiPart E{WSP(float, WS_Y4)}; GEMML(EpiPart, CtxSliceOrder, WSP(bf16, WS_T), WSP(bf16, WS_WOT), 256, DM, S, E); } } PH_END
                PH_BEGIN if (SEL(10)) { if (!last) norm_phase(F, l, 2, AOUT, XC, WSP(float, WS_Y4), 4, MODl + 1 * 3072 + 2048 + 2 * NSUBMOD, 1.0f, XC, XC); else norm_phase(F, l, 2, AOUT, XC); } PH_END
            }
            PH_BEGIN if (SEL(11)) { { RowOrder S; S.init(5632, F.G, (int)blockIdx.x, last && f == 1); EpiSwiglu E{WSP(bf16_t, WS_HID)}; GEMM(EpiSwiglu, RowOrder, WSP(bf16, WS_HN), WSP(bf16, WS_W1T) + (size_t)f * 5632 * DM, DM, S, E); } } PH_END
            PH_BEGIN if (SEL(12)) { { RowOrder S; S.init(DM, F.G, (int)blockIdx.x, true); const bool first = (l == 0 && f == 0);
                EpiResid E{first ? AIN(0) : AOUT, first ? AIN(2) : XC, AOUT, XC, MODl + (f == 0 ? 0 : 2) * 3072 + 2048, 0.5f};
                GEMM(EpiResid, RowOrder, WSP(bf16, WS_HID), WSP(bf16, WS_W2T) + (size_t)f * DM * DFF, DFF, S, E); }
                if (!(last && f == 1)) { CtxSliceOrder S{11, F.G, (int)blockIdx.x}; EpiPart E{WSP(float, WS_Y4)}; GEMML(EpiPart, CtxSliceOrder, WSP(bf16, WS_HID), WSP(bf16, WS_W2T) + (size_t)f * DM * DFF, 256, DFF, S, E); } } PH_END
            if (f == 0) { PH_BEGIN if (SEL(13)) { norm_phase(F, l, 1, AOUT, XC, WSP(float, WS_Y4), 11, MODl + 0 * 3072 + 2048 + 2 * NSUBMOD, 0.5f, l == 0 ? AIN(2) : XC, XC); } PH_END }
        }
    }
    PH_BEGIN if (SEL(14)) { final_norm_phase(F); } PH_END
}

extern "C" void kernel_launch(void* const* d_in, const int* in_sizes, int n_in, void* d_out, int out_size, void* d_ws, size_t ws_size, hipStream_t stream) {
    static int grid = 0;
    if (grid == 0) {
        int dev = 0, cus = 0, per_cu = 0;
        if (n_in != 26 || ws_size < WS_END) { fprintf(stderr, "kernel_launch: unexpected inputs (n_in %d, ws %zu < %zu)\n", n_in, ws_size, (size_t)WS_END); grid = -1; return; }
        hipGetDevice(&dev); hipDeviceGetAttribute(&cus, hipDeviceAttributeMultiprocessorCount, dev);
        hipFuncSetAttribute((const void*)mk_fwd, hipFuncAttributeMaxDynamicSharedMemorySize, LDS_BYTES);
        hipOccupancyMaxActiveBlocksPerMultiprocessor(&per_cu, (const void*)mk_fwd, NWAVES * 64, LDS_BYTES);
        if (per_cu < 1) { fprintf(stderr, "kernel_launch: occupancy query says %d blocks per CU\n", per_cu); per_cu = 1; }
        (void)hipGetLastError();
        grid = cus * per_cu;
    }
    if (grid < 0) return;
    Args a{};
    for (int i = 0; i < 26; ++i) a.in[i] = (const float*)d_in[i];
    a.out = (float*)d_out; a.ws = (unsigned char*)d_ws;
#if MK_SPLIT
    for (int p = 0; p < N_PHASES; ++p) { a.ph_lo = p; a.ph_hi = p + 1; hipLaunchKernelGGL(mk_fwd, dim3(grid), dim3(NWAVES * 64), LDS_BYTES, stream, a); }
#else
    if (hipMemsetAsync((char*)d_ws + WS_BAR, 0, 65536, stream) != hipSuccess) { fprintf(stderr, "kernel_launch: memset of the barrier words failed\n"); return; }
    a.ph_lo = 0; a.ph_hi = N_PHASES;
    void* kargs[] = {&a};
    hipError_t e = hipLaunchCooperativeKernel((const void*)mk_fwd, dim3(grid), dim3(NWAVES * 64), kargs, LDS_BYTES, stream);
    if (e != hipSuccess) fprintf(stderr, "cooperative launch failed: %s (grid %d)\n", hipGetErrorString(e), grid);
#endif
}
```
